# Optimizing an MI355X kernel written in HIP

```python
import math
import jax, jax.numpy as jnp
from jax import lax
import numpy as np

D_MODEL = 1024
BATCH = 16
SEQ = 2048
DEPTH = 1

EPS = 1e-6
HG_HEADS = 8
HG_KDIM = 128
HG_VDIM = 128
HG_CHUNK = 64
HG_WIDTH_K = HG_HEADS * HG_KDIM
HG_WIDTH_V = HG_HEADS * HG_VDIM
MLA_HEADS = 8
MLA_Q_RANK = 384
MLA_KV_RANK = 256
MLA_NOPE = 128
MLA_ROPE = 64
MLA_VDIM = 128
MLA_QK_DIM = MLA_NOPE + MLA_ROPE
ROPE_THETA = 10000.0
Q_BLOCK = 128
N_BRANCH = 2
IN_SPLITS = (HG_WIDTH_K, HG_WIDTH_K, HG_WIDTH_V, HG_WIDTH_V, MLA_Q_RANK, MLA_KV_RANK, MLA_ROPE, D_MODEL, D_MODEL)
IN_COLS = sum(IN_SPLITS)
N_GROUPS = 8
EXPERTS_PER_GROUP = 8
N_EXPERTS = N_GROUPS * EXPERTS_PER_GROUP
TOP_K_IN_GROUP = 2
EXPERT_FF = 512
MOE_BLOCK = 128

kernel_name = "hybrid_hgrn2_mla_hmoe_block"


def rmsnorm(x, w):
    xf = x.astype(jnp.float32)
    y = xf * lax.rsqrt(jnp.mean(xf * xf, axis=-1, keepdims=True) + EPS)
    return (y * w.astype(jnp.float32)).astype(x.dtype)


def apply_rope(x, cos, sin):
    x1, x2 = jnp.split(x.astype(jnp.float32), 2, axis=-1)
    return jnp.concatenate([x1 * cos - x2 * sin, x2 * cos + x1 * sin], axis=-1).astype(x.dtype)


def hgrn2_mixer(q_raw, f_raw, i_raw, g_raw, lb, out_norm_w):
    B, S, _ = q_raw.shape
    n = S // HG_CHUNK
    f32 = jnp.float32
    q = jax.nn.silu(q_raw.astype(f32)) * (HG_KDIM ** -0.5)
    lbf = lb.astype(f32)
    fg = lbf + (1.0 - lbf) * jax.nn.sigmoid(f_raw.astype(f32))
    k = 1.0 - fg
    logf = jnp.log(fg)
    v = i_raw.astype(f32)

    def to_chunks(t, d):
        return t.reshape(B, n, HG_CHUNK, HG_HEADS, d).transpose(1, 0, 3, 2, 4)

    qc, kc, lfc = to_chunks(q, HG_KDIM), to_chunks(k, HG_KDIM), to_chunks(logf, HG_KDIM)
    vc = to_chunks(v, HG_VDIM)
    causal = jnp.tril(jnp.ones((HG_CHUNK, HG_CHUNK), dtype=bool))

    def step(state, inp):
        qt, kt, lft, vt = inp
        bcum = jnp.cumsum(lft, axis=2)
        diff = bcum[:, :, :, None, :] - bcum[:, :, None, :, :]
        decay = jnp.exp(jnp.where(causal[None, None, :, :, None], diff, -jnp.inf))
        attn = jnp.sum(qt[:, :, :, None, :] * kt[:, :, None, :, :] * decay, axis=-1)
        o = jnp.einsum('bhts,bhsv->bhtv', attn, vt) + \
            jnp.einsum('bhtk,bhkv->bhtv', qt * jnp.exp(bcum), state)
        b_last = bcum[:, :, -1]
        k_dec = kt * jnp.exp(b_last[:, :, None, :] - bcum)
        state = jnp.exp(b_last)[..., None] * state + jnp.einsum('bhsk,bhsv->bhkv', k_dec, vt)
        return state, o

    s0 = jnp.zeros((B, HG_HEADS, HG_KDIM, HG_VDIM), f32)
    _, o = lax.scan(step, s0, (qc, kc, lfc, vc))
    o = o.transpose(1, 0, 3, 2, 4).reshape(B, S, HG_HEADS, HG_VDIM)
    o = rmsnorm(o, out_norm_w).reshape(B, S, HG_WIDTH_V)
    g = g_raw.astype(f32)
    return o * jax.nn.silu(g)


def mla_mixer(c_q, c_kv, k_rope_raw, positions, q_norm_w, w_uq, kv_norm_w, w_ukv):
    B, S, _ = c_q.shape
    half = MLA_ROPE // 2
    inv_freq = ROPE_THETA ** (-jnp.arange(half, dtype=jnp.float32) / half)
    ang = positions.astype(jnp.float32)[..., None] * inv_freq
    cos, sin = jnp.cos(ang), jnp.sin(ang)

    q = (rmsnorm(c_q, q_norm_w) @ w_uq).reshape(B, S, MLA_HEADS, MLA_QK_DIM)
    q_nope, q_pe = q[..., :MLA_NOPE], q[..., MLA_NOPE:]
    q_pe = apply_rope(q_pe, cos[:, :, None, :], sin[:, :, None, :])
    kv = (rmsnorm(c_kv, kv_norm_w) @ w_ukv).reshape(B, S, MLA_HEADS, MLA_NOPE + MLA_VDIM)
    k_nope, v = kv[..., :MLA_NOPE], kv[..., MLA_NOPE:]
    k_pe = apply_rope(k_rope_raw, cos, sin)
    k = jnp.concatenate([k_nope, jnp.broadcast_to(k_pe[:, :, None, :], (B, S, MLA_HEADS, MLA_ROPE))], axis=-1)
    qf = jnp.concatenate([q_nope, q_pe], axis=-1) * (MLA_QK_DIM ** -0.5)

    nq = S // Q_BLOCK
    qb = qf.reshape(B, nq, Q_BLOCK, MLA_HEADS, MLA_QK_DIM).transpose(1, 0, 3, 2, 4)
    kpos = jnp.arange(S)

    def attend(args):
        qblk, blk = args
        s = jnp.einsum('bhqd,bkhd->bhqk', qblk, k, preferred_element_type=jnp.float32)
        qpos = blk * Q_BLOCK + jnp.arange(Q_BLOCK)
        s = jnp.where(kpos[None, :] <= qpos[:, None], s, -jnp.inf)
        p = jax.nn.softmax(s, axis=-1)
        return jnp.einsum('bhqk,bkhd->bqhd', p.astype(v.dtype), v)

    o = lax.map(attend, (qb, jnp.arange(nq)))
    return o.transpose(1, 0, 2, 3, 4).reshape(B, S, MLA_HEADS * MLA_VDIM)


def hierarchical_moe(h, w_group, b_group, w_expert, b_expert, w1, w3, w2):
    B, S, D = h.shape
    T = B * S
    xt = h.reshape(T, D)
    g_prob = jax.nn.softmax((xt @ w_group).astype(jnp.float32) + b_group.astype(jnp.float32), axis=-1)
    g_w, g_idx = lax.top_k(g_prob, 1)
    e_logits = ((xt @ w_expert).astype(jnp.float32) + b_expert.astype(jnp.float32)).reshape(T, N_GROUPS, EXPERTS_PER_GROUP)
    e_sel = jnp.take_along_axis(e_logits, g_idx[:, :, None], axis=1)[:, 0]
    e_prob = jax.nn.softmax(e_sel, axis=-1)
    e_w, e_idx = lax.top_k(e_prob, TOP_K_IN_GROUP)
    e_w = e_w / jnp.sum(e_w, axis=-1, keepdims=True)
    weights = g_w * e_w
    expert_ids = g_idx * EXPERTS_PER_GROUP + e_idx

    A = T * TOP_K_IN_GROUP
    flat_e = expert_ids.reshape(A)
    flat_t = jnp.repeat(jnp.arange(T, dtype=jnp.int32), TOP_K_IN_GROUP)
    flat_w = weights.reshape(A)
    order = jnp.argsort(flat_e)
    se, st, sw = flat_e[order], flat_t[order], flat_w[order]
    counts = jax.ops.segment_sum(jnp.ones_like(se), se, num_segments=N_EXPERTS)
    starts = jnp.cumsum(counts) - counts
    padded = (counts + MOE_BLOCK - 1) // MOE_BLOCK * MOE_BLOCK
    pends = jnp.cumsum(padded)
    pstarts = pends - padded
    dest = pstarts[se] + (jnp.arange(A, dtype=se.dtype) - starts[se])
    n_blocks = A // MOE_BLOCK + N_EXPERTS
    cap = n_blocks * MOE_BLOCK
    tok_buf = jnp.full((cap,), T, dtype=jnp.int32).at[dest].set(st)
    w_buf = jnp.zeros((cap,), jnp.float32).at[dest].set(sw)
    block_start = jnp.arange(n_blocks, dtype=pends.dtype) * MOE_BLOCK
    block_expert = jnp.minimum(jnp.searchsorted(pends, block_start, side='right'), N_EXPERTS - 1)
    x_pad = jnp.concatenate([xt, jnp.zeros((1, D), xt.dtype)], axis=0)

    def run_block(args):
        toks, wts, e = args
        xb = x_pad[toks]
        hid = jax.nn.silu(xb @ w1[e]) * (xb @ w3[e])
        return (hid @ w2[e]) * wts[:, None].astype(xb.dtype)

    yb = lax.map(run_block, (tok_buf.reshape(n_blocks, MOE_BLOCK), w_buf.reshape(n_blocks, MOE_BLOCK), block_expert))
    out = jax.ops.segment_sum(yb.reshape(cap, D), tok_buf, num_segments=T + 1)[:T]
    return out.reshape(B, S, D)


def setup_inputs(seed: int = 0) -> dict:
    key = jax.random.key(seed)
    ks = jax.random.split(key, 24)
    f32 = jnp.float32
    nrm = lambda k, shape, scale: jax.random.normal(k, shape, f32) * scale
    gain = lambda k, shape: 1.0 + 0.02 * jax.random.normal(k, shape, f32)
    x = jax.random.normal(ks[0], (BATCH, SEQ, D_MODEL), f32)
    offsets = jax.random.randint(ks[1], (BATCH, 1), 0, 4096, dtype=jnp.int32)
    positions = offsets + jnp.arange(SEQ, dtype=jnp.int32)[None, :]
    return {
        "x": x,
        "positions": positions,
        "attn_norm_w": gain(ks[2], (DEPTH, D_MODEL)),
        "w_in": nrm(ks[3], (DEPTH, D_MODEL, IN_COLS), D_MODEL ** -0.5),
        "hg_lower_bound": nrm(ks[4], (DEPTH + 1, HG_WIDTH_K), 0.5),
        "hg_out_norm_w": gain(ks[5], (DEPTH, HG_VDIM)),
        "mla_q_norm_w": gain(ks[6], (DEPTH, MLA_Q_RANK)),
        "mla_w_uq": nrm(ks[7], (DEPTH, MLA_Q_RANK, MLA_HEADS * MLA_QK_DIM), MLA_Q_RANK ** -0.5),
        "mla_kv_norm_w": gain(ks[8], (DEPTH, MLA_KV_RANK)),
        "mla_w_ukv": nrm(ks[9], (DEPTH, MLA_KV_RANK, MLA_HEADS * (MLA_NOPE + MLA_VDIM)), MLA_KV_RANK ** -0.5),
        "w_branch_hgrn": nrm(ks[10], (DEPTH, HG_WIDTH_V, D_MODEL), HG_WIDTH_V ** -0.5),
        "w_branch_mla": nrm(ks[11], (DEPTH, MLA_HEADS * MLA_VDIM, D_MODEL), (MLA_HEADS * MLA_VDIM) ** -0.5),
        "w_out": nrm(ks[12], (DEPTH, D_MODEL, D_MODEL), D_MODEL ** -0.5),
        "ffn_norm_w": gain(ks[13], (DEPTH, D_MODEL)),
        "router_group_w": nrm(ks[14], (DEPTH, D_MODEL, N_GROUPS), D_MODEL ** -0.5),
        "router_group_b": nrm(ks[15], (DEPTH, N_GROUPS), 0.01),
        "router_expert_w": nrm(ks[16], (DEPTH, D_MODEL, N_EXPERTS), D_MODEL ** -0.5),
        "router_expert_b": nrm(ks[17], (DEPTH, N_EXPERTS), 0.01),
        "expert_w1": nrm(ks[18], (DEPTH, N_EXPERTS, D_MODEL, EXPERT_FF), D_MODEL ** -0.5),
        "expert_w3": nrm(ks[19], (DEPTH, N_EXPERTS, D_MODEL, EXPERT_FF), D_MODEL ** -0.5),
        "expert_w2": nrm(ks[20], (DEPTH, N_EXPERTS, EXPERT_FF, D_MODEL), EXPERT_FF ** -0.5),
        "final_norm_w": gain(ks[21], (D_MODEL,)),
    }


def reference(x, positions, attn_norm_w, w_in, hg_lower_bound, hg_out_norm_w, mla_q_norm_w, mla_w_uq,
              mla_kv_norm_w, mla_w_ukv, w_branch_hgrn, w_branch_mla, w_out, ffn_norm_w, router_group_w,
              router_group_b, router_expert_w, router_expert_b, expert_w1, expert_w3, expert_w2, final_norm_w):
    split_idx = [int(v) for v in np.cumsum(IN_SPLITS)[:-1]]
    lb_all = jnp.cumsum(jax.nn.softmax(hg_lower_bound.astype(jnp.float32), axis=0), axis=0)
    for l in range(DEPTH):
        h = rmsnorm(x, attn_norm_w[l])
        z = h @ w_in[l]
        hq, hf, hi, hg, cq, ckv, kr, gate_a, gate_b = jnp.split(z, split_idx, axis=-1)
        o_a = hgrn2_mixer(hq, hf, hi, hg, lb_all[l], hg_out_norm_w[l]).astype(x.dtype)
        o_b = mla_mixer(cq, ckv, kr, positions, mla_q_norm_w[l], mla_w_uq[l], mla_kv_norm_w[l], mla_w_ukv[l])
        y = jax.nn.sigmoid(gate_a) * (o_a @ w_branch_hgrn[l]) + jax.nn.sigmoid(gate_b) * (o_b @ w_branch_mla[l])
        x = x + y @ w_out[l]
        h = rmsnorm(x, ffn_norm_w[l])
        x = x + hierarchical_moe(h, router_group_w[l], router_group_b[l], router_expert_w[l], router_expert_b[l],
                                 expert_w1[l], expert_w3[l], expert_w2[l])
    return rmsnorm(x, final_norm_w)
```

```cpp
#include <hip/hip_runtime.h>
#include <hip/hip_cooperative_groups.h>
#include <cstdio>
#include <cstdint>
namespace cg = cooperative_groups;

#ifndef MK_MULTI
#define MK_MULTI 1
#endif

#define DEVI __device__ __forceinline__
typedef unsigned short bf16_t;
typedef short bf16x8 __attribute__((ext_vector_type(8)));
typedef float f32x4 __attribute__((ext_vector_type(4)));
typedef unsigned u32x4 __attribute__((ext_vector_type(4)));
typedef unsigned u32x2 __attribute__((ext_vector_type(2)));

constexpr int NB = 16, SEQ = 2048, T = NB * SEQ, D = 1024;
constexpr int NTHR = 512;
constexpr int ZH_P = 4096, ZL_P = 768, ZG_P = 2048;
constexpr int NZ = 6912;
constexpr int NEXP = 64, EFF = 512;
constexpr int SLOT_CAP = 2 * T + NEXP * 256;
constexpr int MAX_TILES = SLOT_CAP / 256;

constexpr size_t MiB = 1u << 20;
constexpr size_t WS_CTL = 0;
constexpr size_t WS_WRT = 1 * MiB;
constexpr size_t WS_WIN = 2 * MiB;
constexpr size_t WS_WUQ = 16 * MiB;
constexpr size_t WS_WUKV = 18 * MiB;
constexpr size_t WS_WBR = 20 * MiB;
constexpr size_t WS_WOUT = 24 * MiB;
constexpr size_t WS_COS = 26 * MiB, WS_SIN = 30 * MiB;
constexpr size_t WS_ROUTE = 34 * MiB;
constexpr size_t WS_KPE = 36 * MiB;
constexpr size_t WS_ZH = 40 * MiB;
constexpr size_t WS_Q = 40 * MiB, WS_KN = 136 * MiB, WS_V = 200 * MiB;
constexpr size_t WS_Y = 40 * MiB;
constexpr size_t WS_H2 = 40 * MiB;
constexpr size_t WS_HID = 104 * MiB;
constexpr size_t WS_YEXP = 184 * MiB;
constexpr size_t WS_OB = 264 * MiB;
constexpr size_t WS_ZL = 296 * MiB;
constexpr size_t WS_ZG = 344 * MiB;
constexpr size_t WS_W13 = 344 * MiB;
constexpr size_t WS_OA = 472 * MiB;
constexpr size_t WS_H = 472 * MiB;
constexpr size_t WS_W2 = 472 * MiB;
constexpr size_t WS_END = 536 * MiB;
constexpr size_t RT_AE = 0, RT_AP = 256 * 1024, RT_AW = 512 * 1024, RT_AS = 768 * 1024, RT_ST = 1024 * 1024, RT_SW = 1536 * 1024;
constexpr int CW_CNT = 0;

struct Params {
    const float* x; const int* pos; const float* attn_norm_w; const float* w_in; const float* hg_lb; const float* hg_onw;
    const float* q_norm_w; const float* w_uq; const float* kv_norm_w; const float* w_ukv; const float* w_bra; const float* w_brb;
    const float* w_out; const float* ffn_norm_w; const float* rg_w; const float* rg_b; const float* re_w; const float* re_b;
    const float* ew1; const float* ew3; const float* ew2; const float* final_w;
    float* out; unsigned char* ws;
    int ph_lo, ph_hi;
};

DEVI unsigned f2bf(float f) { unsigned u = __builtin_bit_cast(unsigned, f); return (u + 0x7fffu + ((u >> 16) & 1u)) >> 16; }
DEVI float bf2f(unsigned h) { return __builtin_bit_cast(float, h << 16); }
DEVI unsigned pk2(float lo, float hi) { return f2bf(lo) | (f2bf(hi) << 16); }
DEVI float sigmoidf_(float v) { return 1.f / (1.f + __expf(-v)); }
DEVI float siluf_(float v) { return v / (1.f + __expf(-v)); }
DEVI float wave_sum(float v) {
#pragma unroll
    for (int o = 1; o < 64; o <<= 1) v += __shfl_xor(v, o);
    return v;
}
DEVI void store4bf(bf16_t* p, f32x4 v) { u32x2 w; w.x = pk2(v[0], v[1]); w.y = pk2(v[2], v[3]); *(u32x2*)p = w; }
DEVI void unpack8(bf16x8 v, float* f) {
#pragma unroll
    for (int j = 0; j < 8; ++j) f[j] = bf2f((unsigned)(unsigned short)v[j]);
}

template <class ColMap, class KScale>
DEVI void transpose_tile(const float* src, int Nsrc, bf16_t* dst, int ldk, int k0, int n0, ColMap cm, KScale ks, float* scr) {
    const int tid = threadIdx.x;
    {
        const int nl = tid & 63, kq = tid >> 6; const int col = cm(n0 + nl);
#pragma unroll
        for (int i = 0; i < 8; ++i) { const int k = kq * 8 + i; float v = 0.f; if (col >= 0) v = src[(size_t)(k0 + k) * Nsrc + col] * ks(k0 + k); scr[k * 65 + nl] = v; }
    }
    __syncthreads();
    {
        const int nl = tid >> 3, kc = tid & 7; const float* s = scr + (kc * 8) * 65 + nl;
        u32x4 o; o.x = pk2(s[0], s[65]); o.y = pk2(s[2 * 65], s[3 * 65]); o.z = pk2(s[4 * 65], s[5 * 65]); o.w = pk2(s[6 * 65], s[7 * 65]);
        *(u32x4*)(dst + (size_t)(n0 + nl) * ldk + k0 + kc * 8) = o;
    }
    __syncthreads();
}

template <class Epi>
DEVI void gemm_tile_simple(char* lds, const bf16_t* A, int lda, const int* arow, const bf16_t* Bt, int ldb, int K, const Epi& epi) {
    const int tid = threadIdx.x, lane = tid & 63, wid = tid >> 6, wr = wid >> 2, wc = wid & 3, fr = lane & 15, fq = lane >> 4;
    char* As = lds; char* Bs = lds + 256 * 80;
    f32x4 acc[8][4];
#pragma unroll
    for (int m = 0; m < 8; ++m)
#pragma unroll
        for (int n = 0; n < 4; ++n) acc[m][n] = (f32x4){0.f, 0.f, 0.f, 0.f};
    unsigned ao[2], bo[2]; int lo[2];
#pragma unroll
    for (int i = 0; i < 2; ++i) { const int c = tid + 512 * i, row = c >> 2, kc = c & 3; const unsigned ar = arow ? (unsigned)arow[row] : (unsigned)row;
        ao[i] = ar * (unsigned)lda + kc * 8; bo[i] = (unsigned)row * (unsigned)ldb + kc * 8; lo[i] = row * 80 + kc * 16; }
    for (int k0 = 0; k0 < K; k0 += 32) {
        bf16x8 ra[2], rb[2];
#pragma unroll
        for (int i = 0; i < 2; ++i) { ra[i] = *(const bf16x8*)(A + ao[i] + k0); rb[i] = *(const bf16x8*)(Bt + bo[i] + k0); }
        __syncthreads();
#pragma unroll
        for (int i = 0; i < 2; ++i) { *(bf16x8*)(As + lo[i]) = ra[i]; *(bf16x8*)(Bs + lo[i]) = rb[i]; }
        __syncthreads();
        bf16x8 bfr[4];
#pragma unroll
        for (int n = 0; n < 4; ++n) bfr[n] = *(const bf16x8*)(Bs + (wc * 64 + n * 16 + fr) * 80 + fq * 16);
#pragma unroll
        for (int mh = 0; mh < 2; ++mh) { bf16x8 af[4];
#pragma unroll
            for (int m = 0; m < 4; ++m) af[m] = *(const bf16x8*)(As + (wr * 128 + (mh * 4 + m) * 16 + fr) * 80 + fq * 16);
#pragma unroll
            for (int m = 0; m < 4; ++m)
#pragma unroll
                for (int n = 0; n < 4; ++n) acc[mh * 4 + m][n] = __builtin_amdgcn_mfma_f32_16x16x32_bf16(bfr[n], af[m], acc[mh * 4 + m][n], 0, 0, 0); }
    }
#pragma unroll
    for (int m = 0; m < 8; ++m)
#pragma unroll
        for (int n = 0; n < 4; ++n) epi(wr * 128 + m * 16 + fr, wc * 64 + n * 16 + 4 * fq, acc[m][n]);
    __syncthreads();
}

struct EpiZ { bf16_t* zh; bf16_t* zl; bf16_t* zg; int pm, pn;
    DEVI void operator()(int r, int c, f32x4 v) const {
        const size_t row = (size_t)pm * 256 + r; const int col = pn * 256 + c;
        if (pn < 16) store4bf(zh + row * ZH_P + col, v);
        else if (pn < 19) store4bf(zl + row * ZL_P + (col - 4096), v);
        else { f32x4 s; s[0] = sigmoidf_(v[0]); s[1] = sigmoidf_(v[1]); s[2] = sigmoidf_(v[2]); s[3] = sigmoidf_(v[3]); store4bf(zg + row * ZG_P + (col - 4864), s); }
    } };
struct EpiQKV { bf16_t* q; bf16_t* kn; bf16_t* vv; const float* cosT; const float* sinT; int pm, pn, isq;
    DEVI void operator()(int r, int c, f32x4 v) const {
        const size_t row = (size_t)pm * 256 + r; const int col = pn * 256 + c;
        if (isq) { const int cc = col % 192;
            if (cc >= 128) { const int i = (cc - 128) >> 1; const float c0 = cosT[row * 32 + i], s0 = sinT[row * 32 + i], c1 = cosT[row * 32 + i + 1], s1 = sinT[row * 32 + i + 1];
                f32x4 o; o[0] = v[0] * c0 - v[1] * s0; o[1] = v[1] * c0 + v[0] * s0; o[2] = v[2] * c1 - v[3] * s1; o[3] = v[3] * c1 + v[2] * s1; v = o; }
            store4bf(q + row * 1536 + col, v);
        } else { const int hh = col >> 8, cc = col & 255;
            if (cc < 128) store4bf(kn + row * 1024 + hh * 128 + cc, v); else store4bf(vv + row * 1024 + hh * 128 + (cc - 128), v); }
    } };
struct EpiBr { float* tmp; const bf16_t* zg; bf16_t* y; int pm, pn, second;
    DEVI void operator()(int r, int c, f32x4 v) const {
        const size_t row = (size_t)pm * 256 + r; const int col = pn * 256 + c; const u32x2 g = *(const u32x2*)(zg + row * ZG_P + second * 1024 + col);
        f32x4 o; o[0] = v[0] * bf2f(g.x & 0xffffu); o[1] = v[1] * bf2f(g.x >> 16); o[2] = v[2] * bf2f(g.y & 0xffffu); o[3] = v[3] * bf2f(g.y >> 16);
        if (!second) *(f32x4*)(tmp + row * 1024 + col) = o;
        else { const f32x4 t = *(const f32x4*)(tmp + row * 1024 + col); store4bf(y + row * 1024 + col, t + o); }
    } };
struct EpiOut { const float* x; float* x2; int pm, pn;
    DEVI void operator()(int r, int c, f32x4 v) const {
        const size_t off = ((size_t)pm * 256 + r) * 1024 + pn * 256 + c; const f32x4 xv = *(const f32x4*)(x + off); *(f32x4*)(x2 + off) = xv + v;
    } };
struct EpiHid { bf16_t* hid; int tile, pn;
    DEVI void operator()(int r, int c, f32x4 v) const {
        const size_t slot = (size_t)tile * 256 + r; const int hc = (pn * 256 + c) >> 1;
        *(unsigned*)(hid + slot * EFF + hc) = pk2(siluf_(v[0]) * v[2], siluf_(v[1]) * v[3]);
    } };
struct EpiY { bf16_t* yexp; const float* sw; int tile, pn;
    DEVI void operator()(int r, int c, f32x4 v) const {
        const size_t slot = (size_t)tile * 256 + r; const float w = sw[slot]; store4bf(yexp + slot * 1024 + pn * 256 + c, v * w);
    } };

DEVI void phase0(const Params& p, char* lds) {
    float* scr = (float*)lds; unsigned char* ws = p.ws;
    bf16_t* WinT = (bf16_t*)(ws + WS_WIN); bf16_t* WuqT = (bf16_t*)(ws + WS_WUQ); bf16_t* WukvT = (bf16_t*)(ws + WS_WUKV);
    bf16_t* WbrT = (bf16_t*)(ws + WS_WBR); bf16_t* WoutT = (bf16_t*)(ws + WS_WOUT);
    constexpr int I_IN = (NZ / 64) * 16, I_UQ = 24 * 6, I_UKV = 32 * 4, I_BR = 16 * 16, I_OUT = 16 * 16;
    constexpr int NIT = I_IN + I_UQ + I_UKV + 2 * I_BR + I_OUT;
    for (int it = blockIdx.x; it < NIT; it += gridDim.x) {
        int r = it;
        if (r < I_IN) { const int nb = r / 16, kb = r % 16; const float* nw = p.attn_norm_w;
            transpose_tile(p.w_in, 6848, WinT, 1024, kb * 64, nb * 64, [](int n) { return n < 4800 ? n : (n < 4864 ? -1 : n - 64); }, [nw](int k) { return nw[k]; }, scr); continue; }
        r -= I_IN;
        if (r < I_UQ) { const int nb = r / 6, kb = r % 6; const float* nw = p.q_norm_w;
            transpose_tile(p.w_uq, 1536, WuqT, 384, kb * 64, nb * 64,
                           [](int n) { const int hh = n / 192, c = n % 192; if (c < 128) return n; const int rr = c - 128; return hh * 192 + 128 + (rr & 1) * 32 + (rr >> 1); },
                           [nw](int k) { return nw[k] * 0.07216878364870322f; }, scr); continue; }
        r -= I_UQ;
        if (r < I_UKV) { const int nb = r / 4, kb = r % 4; const float* nw = p.kv_norm_w;
            transpose_tile(p.w_ukv, 2048, WukvT, 256, kb * 64, nb * 64, [](int n) { return n; }, [nw](int k) { return nw[k]; }, scr); continue; }
        r -= I_UKV;
        if (r < I_BR) { const int nb = r / 16, kb = r % 16;
            transpose_tile(p.w_bra, 1024, WbrT, 2048, kb * 64, nb * 64, [](int n) { return n; }, [](int) { return 1.f; }, scr); continue; }
        r -= I_BR;
        if (r < I_BR) { const int nb = r / 16, kb = r % 16;
            transpose_tile(p.w_brb, 1024, WbrT + 1024, 2048, kb * 64, nb * 64, [](int n) { return n; }, [](int) { return 1.f; }, scr); continue; }
        r -= I_BR;
        { const int nb = r / 16, kb = r % 16;
            transpose_tile(p.w_out, 1024, WoutT, 1024, kb * 64, nb * 64, [](int n) { return n; }, [](int) { return 1.f; }, scr); }
    }
    float* WrT = (float*)(ws + WS_WRT);
    for (int e = blockIdx.x * NTHR + threadIdx.x; e < 72 * 1024; e += gridDim.x * NTHR) { const int c = e >> 10, k = e & 1023;
        const float w = c < 8 ? p.rg_w[k * 8 + c] : p.re_w[k * 64 + (c - 8)]; WrT[e] = w * p.ffn_norm_w[k]; }
    bf16_t* H = (bf16_t*)(ws + WS_H);
    const int lane = threadIdx.x & 63, gw = blockIdx.x * 8 + (threadIdx.x >> 6), NGW = gridDim.x * 8;
    for (int m = gw; m < T; m += NGW) {
        const f32x4* xr = (const f32x4*)(p.x + (size_t)m * D) + lane; f32x4 v[4]; float s = 0.f;
#pragma unroll
        for (int j = 0; j < 4; ++j) { v[j] = xr[64 * j]; s += v[j][0] * v[j][0] + v[j][1] * v[j][1] + v[j][2] * v[j][2] + v[j][3] * v[j][3]; }
        const float rstd = rsqrtf(wave_sum(s) * (1.f / D) + 1e-6f);
        u32x2* o = (u32x2*)(H + (size_t)m * D) + lane;
#pragma unroll
        for (int j = 0; j < 4; ++j) { u32x2 w; w.x = pk2(v[j][0] * rstd, v[j][1] * rstd); w.y = pk2(v[j][2] * rstd, v[j][3] * rstd); o[64 * j] = w; }
    }
}

DEVI void phase1(const Params& p, char* lds) {
    unsigned char* ws = p.ws; const bf16_t* H = (const bf16_t*)(ws + WS_H); const bf16_t* WinT = (const bf16_t*)(ws + WS_WIN);
    constexpr int nN = NZ / 256, NU = (T / 256) * nN;
    for (int u = blockIdx.x; u < NU; u += gridDim.x) { const int pm = u / nN, pn = u % nN;
        EpiZ E{(bf16_t*)(ws + WS_ZH), (bf16_t*)(ws + WS_ZL), (bf16_t*)(ws + WS_ZG), pm, pn};
        gemm_tile_simple(lds, H + (size_t)pm * 256 * D, D, nullptr, WinT + (size_t)pn * 256 * D, D, D, E); }
}

DEVI void hgrn_chain(const Params& p, char* lds, int b, int h) {
    float* qv = (float*)lds; float* fv = qv + 4096; float* kv = fv + 4096; float* vv = kv + 4096; float* ov = vv + 4096; float* red = ov + 4096;
    const bf16_t* zh = (const bf16_t*)(p.ws + WS_ZH); bf16_t* oa = (bf16_t*)(p.ws + WS_OA);
    const int tid = threadIdx.x, lane = tid & 63, wid = tid >> 6, v = tid & 127, kq = tid >> 7;
    float S[32];
#pragma unroll
    for (int j = 0; j < 32; ++j) S[j] = 0.f;
    const int lrow = tid >> 4, c8 = (tid & 15) * 8;
    float lbv[8];
#pragma unroll
    for (int j = 0; j < 8; ++j) { const float a0 = p.hg_lb[h * 128 + c8 + j], a1 = p.hg_lb[1024 + h * 128 + c8 + j]; lbv[j] = 1.f / (1.f + expf(a1 - a0)); }
    const float nw0 = p.hg_onw[lane], nw1 = p.hg_onw[64 + lane];
    for (int chunk = 0; chunk < SEQ / 32; ++chunk) {
        const size_t t0 = (size_t)b * SEQ + chunk * 32;
        __syncthreads();
        {
            const bf16_t* zr = zh + (t0 + lrow) * ZH_P + h * 128 + c8;
            float hq[8], hf[8], hi[8]; unpack8(*(const bf16x8*)zr, hq); unpack8(*(const bf16x8*)(zr + 1024), hf); unpack8(*(const bf16x8*)(zr + 2048), hi);
#pragma unroll
            for (int j = 0; j < 8; ++j) { const int o = lrow * 128 + c8 + j; qv[o] = siluf_(hq[j]) * 0.08838834764831845f;
                const float fg = lbv[j] + (1.f - lbv[j]) * sigmoidf_(hf[j]); fv[o] = fg; kv[o] = 1.f - fg; vv[o] = hi[j]; }
        }
        __syncthreads();
        for (int t = 0; t < 32; ++t) {
            const float vt = vv[t * 128 + v]; float part = 0.f; const float* fr_ = fv + t * 128 + kq * 32; const float* kr_ = kv + t * 128 + kq * 32; const float* qr_ = qv + t * 128 + kq * 32;
#pragma unroll
            for (int j = 0; j < 32; ++j) { S[j] = fr_[j] * S[j] + kr_[j] * vt; part += qr_[j] * S[j]; }
            red[((t & 1) * 4 + kq) * 128 + v] = part;
            __syncthreads();
            if (kq == 0) { const float* rr = red + (t & 1) * 512 + v; ov[t * 128 + v] = (rr[0] + rr[128]) + (rr[256] + rr[384]); }
        }
        __syncthreads();
#pragma unroll
        for (int rr = 0; rr < 4; ++rr) { const int r = wid * 4 + rr; const float a = ov[r * 128 + lane], bb = ov[r * 128 + 64 + lane];
            const float rstd = rsqrtf(wave_sum(a * a + bb * bb) * (1.f / 128.f) + 1e-6f);
            const bf16_t* gp = zh + (t0 + r) * ZH_P + 3072 + h * 128; const float g0 = bf2f(gp[lane]), g1 = bf2f(gp[64 + lane]);
            bf16_t* op = oa + (t0 + r) * 1024 + h * 128; op[lane] = (bf16_t)f2bf(a * rstd * nw0 * siluf_(g0)); op[64 + lane] = (bf16_t)f2bf(bb * rstd * nw1 * siluf_(g1)); }
    }
}
DEVI void mla_prep(const Params& p, int chunk) {
    bf16_t* zl = (bf16_t*)(p.ws + WS_ZL); float* cosT = (float*)(p.ws + WS_COS); float* sinT = (float*)(p.ws + WS_SIN);
    const int lane = threadIdx.x & 63, wid = threadIdx.x >> 6;
    for (int rr = wid; rr < 256; rr += 8) { const size_t t = (size_t)chunk * 256 + rr; bf16_t* zr = zl + t * ZL_P;
        float cq[6], ck[4]; float s = 0.f, s2 = 0.f;
#pragma unroll
        for (int j = 0; j < 6; ++j) { cq[j] = bf2f(zr[lane + 64 * j]); s += cq[j] * cq[j]; }
#pragma unroll
        for (int j = 0; j < 4; ++j) { ck[j] = bf2f(zr[384 + lane + 64 * j]); s2 += ck[j] * ck[j]; }
        const float kr = bf2f(zr[640 + lane]);
        const float r1 = rsqrtf(wave_sum(s) * (1.f / 384.f) + 1e-6f), r2 = rsqrtf(wave_sum(s2) * (1.f / 256.f) + 1e-6f);
        const float other = __shfl_xor(kr, 32);
        const int i = lane & 31; const float invf = powf(10000.f, -(float)i / 32.f); const float ang = (float)p.pos[t] * invf; const float cs = cosf(ang), sn = sinf(ang);
        const float x1 = lane < 32 ? kr : other, x2 = lane < 32 ? other : kr;
        const float outv = lane < 32 ? (x1 * cs - x2 * sn) : (x2 * cs + x1 * sn);
#pragma unroll
        for (int j = 0; j < 6; ++j) zr[lane + 64 * j] = (bf16_t)f2bf(cq[j] * r1);
#pragma unroll
        for (int j = 0; j < 4; ++j) zr[384 + lane + 64 * j] = (bf16_t)f2bf(ck[j] * r2);
        ((bf16_t*)(p.ws + WS_KPE))[t * 64 + 2 * i + (lane >> 5)] = (bf16_t)f2bf(outv);
        if (lane < 32) { cosT[t * 32 + i] = cs; sinT[t * 32 + i] = sn; }
    }
}
DEVI void phase2a(const Params& p, char* lds) {
    for (int it = blockIdx.x; it < 256; it += gridDim.x) { if (it < 128) hgrn_chain(p, lds, it >> 3, it & 7); else mla_prep(p, it - 128); }
}

DEVI void phase2b(const Params& p, char* lds) {
    unsigned char* ws = p.ws; const bf16_t* zl = (const bf16_t*)(ws + WS_ZL);
    constexpr int NUQ = 128 * 6, NUKV = 128 * 8;
    for (int u = blockIdx.x; u < NUQ + NUKV; u += gridDim.x) {
        const int isq = u < NUQ, uu = isq ? u : u - NUQ, nn = isq ? 6 : 8, pm = uu / nn, pn = uu % nn, K = isq ? 384 : 256;
        EpiQKV E{(bf16_t*)(ws + WS_Q), (bf16_t*)(ws + WS_KN), (bf16_t*)(ws + WS_V), (const float*)(ws + WS_COS), (const float*)(ws + WS_SIN), pm, pn, isq};
        const bf16_t* Bt = isq ? (const bf16_t*)(ws + WS_WUQ) + (size_t)pn * 256 * 384 : (const bf16_t*)(ws + WS_WUKV) + (size_t)pn * 256 * 256;
        gemm_tile_simple(lds, zl + (size_t)pm * 256 * ZL_P + (isq ? 0 : 384), ZL_P, nullptr, Bt, K, K, E);
    }
}

DEVI void attn_item(const Params& p, char* lds, int b, int h, int qb) {
    const bf16_t* q = (const bf16_t*)(p.ws + WS_Q); const bf16_t* kn = (const bf16_t*)(p.ws + WS_KN); const bf16_t* vg = (const bf16_t*)(p.ws + WS_V);
    const bf16_t* kpe = (const bf16_t*)(p.ws + WS_KPE); bf16_t* ob = (bf16_t*)(p.ws + WS_OB);
    const int tid = threadIdx.x, lane = tid & 63, wid = tid >> 6, fr = lane & 15, fq = lane >> 4;
    bf16_t* Ks = (bf16_t*)lds; bf16_t* Vt = (bf16_t*)(lds + 64 * 400); bf16_t* Ps = (bf16_t*)(lds + 64 * 400 + 128 * 144) + wid * 16 * 72;
    const int q0 = qb * 128 + wid * 16; const size_t tb = (size_t)b * SEQ;
    bf16x8 qf[6];
    { const bf16_t* qrow = q + (tb + q0 + fr) * 1536 + h * 192;
#pragma unroll
      for (int kk = 0; kk < 6; ++kk) qf[kk] = *(const bf16x8*)(qrow + kk * 32 + fq * 8); }
    f32x4 o[8]; float m[4], l[4];
#pragma unroll
    for (int n = 0; n < 8; ++n) o[n] = (f32x4){0.f, 0.f, 0.f, 0.f};
#pragma unroll
    for (int i = 0; i < 4; ++i) { m[i] = -1e30f; l[i] = 0.f; }
    const int nkt = (qb + 1) * 2;
    for (int kt = 0; kt < nkt; ++kt) {
        __syncthreads();
#pragma unroll
        for (int i = 0; i < 3; ++i) { const int c = tid + 512 * i, key = c / 24, ch = c % 24; const size_t tk = tb + kt * 64 + key;
            const bf16_t* src = ch < 16 ? kn + tk * 1024 + h * 128 + ch * 8 : kpe + tk * 64 + (ch - 16) * 8;
            *(bf16x8*)(Ks + key * 200 + ch * 8) = *(const bf16x8*)src; }
#pragma unroll
        for (int i = 0; i < 2; ++i) { const int c = tid + 512 * i, key = c >> 4, ch = c & 15; const bf16x8 vv = *(const bf16x8*)(vg + (tb + kt * 64 + key) * 1024 + h * 128 + ch * 8);
#pragma unroll
            for (int j = 0; j < 8; ++j) Vt[(ch * 8 + j) * 72 + key] = (bf16_t)vv[j]; }
        __syncthreads();
        if (kt * 64 <= q0 + 15) {
            f32x4 s[4];
#pragma unroll
            for (int n = 0; n < 4; ++n) s[n] = (f32x4){0.f, 0.f, 0.f, 0.f};
#pragma unroll
            for (int kk = 0; kk < 6; ++kk)
#pragma unroll
                for (int n = 0; n < 4; ++n) { const bf16x8 kf = *(const bf16x8*)(Ks + (n * 16 + fr) * 200 + kk * 32 + fq * 8); s[n] = __builtin_amdgcn_mfma_f32_16x16x32_bf16(qf[kk], kf, s[n], 0, 0, 0); }
#pragma unroll
            for (int i = 0; i < 4; ++i) { const int qi = q0 + 4 * fq + i; float mx = -__builtin_inff();
#pragma unroll
                for (int n = 0; n < 4; ++n) { const int key = kt * 64 + 16 * n + fr; if (key > qi) s[n][i] = -__builtin_inff(); mx = fmaxf(mx, s[n][i]); }
                mx = fmaxf(mx, __shfl_xor(mx, 1)); mx = fmaxf(mx, __shfl_xor(mx, 2)); mx = fmaxf(mx, __shfl_xor(mx, 4)); mx = fmaxf(mx, __shfl_xor(mx, 8));
                const float mn = fmaxf(m[i], mx), alpha = __expf(m[i] - mn); m[i] = mn; float rs = 0.f;
#pragma unroll
                for (int n = 0; n < 4; ++n) { const float pv = __expf(s[n][i] - mn); s[n][i] = pv; rs += pv; }
                rs += __shfl_xor(rs, 1); rs += __shfl_xor(rs, 2); rs += __shfl_xor(rs, 4); rs += __shfl_xor(rs, 8);
                l[i] = l[i] * alpha + rs;
#pragma unroll
                for (int n = 0; n < 8; ++n) o[n][i] *= alpha;
#pragma unroll
                for (int n = 0; n < 4; ++n) Ps[(4 * fq + i) * 72 + 16 * n + fr] = (bf16_t)f2bf(s[n][i]);
            }
#pragma unroll
            for (int ks = 0; ks < 2; ++ks) { const bf16x8 pf = *(const bf16x8*)(Ps + fr * 72 + ks * 32 + fq * 8);
#pragma unroll
                for (int n = 0; n < 8; ++n) { const bf16x8 vf = *(const bf16x8*)(Vt + (n * 16 + fr) * 72 + ks * 32 + fq * 8); o[n] = __builtin_amdgcn_mfma_f32_16x16x32_bf16(pf, vf, o[n], 0, 0, 0); } }
        }
    }
#pragma unroll
    for (int i = 0; i < 4; ++i) { const float rl = 1.f / l[i]; bf16_t* orow = ob + (tb + q0 + 4 * fq + i) * 1024 + h * 128;
#pragma unroll
        for (int n = 0; n < 8; ++n) orow[n * 16 + fr] = (bf16_t)f2bf(o[n][i] * rl); }
}
DEVI void phase3(const Params& p, char* lds) {
    for (int it = blockIdx.x; it < 2048; it += gridDim.x) { const int qb = 15 - (it >> 7), bh = it & 127; attn_item(p, lds, bh >> 3, bh & 7, qb); }
}

DEVI void phase4(const Params& p, char* lds) {
    unsigned char* ws = p.ws; const bf16_t* oa = (const bf16_t*)(ws + WS_OA); const bf16_t* obp = (const bf16_t*)(ws + WS_OB);
    const bf16_t* W = (const bf16_t*)(ws + WS_WBR); const bf16_t* zg = (const bf16_t*)(ws + WS_ZG);
    for (int u2 = blockIdx.x * 2; u2 < 1024; u2 += (u2 & 1) ? 2 * gridDim.x - 1 : 1) { const int u = u2 >> 1, second = u2 & 1, pm = u >> 2, pn = u & 3;
        EpiBr E{p.out, zg, (bf16_t*)(ws + WS_Y), pm, pn, second};
        gemm_tile_simple(lds, (second ? obp : oa) + (size_t)pm * 256 * 1024, 1024, nullptr, W + (size_t)pn * 256 * 2048 + second * 1024, 2048, 1024, E); }
}
DEVI void phase5(const Params& p, char* lds) {
    unsigned char* ws = p.ws; const bf16_t* y = (const bf16_t*)(ws + WS_Y); const bf16_t* W = (const bf16_t*)(ws + WS_WOUT);
    for (int u = blockIdx.x; u < 512; u += gridDim.x) { const int pm = u >> 2, pn = u & 3; EpiOut E{p.x, p.out, pm, pn};
        gemm_tile_simple(lds, y + (size_t)pm * 256 * 1024, 1024, nullptr, W + (size_t)pn * 256 * 1024, 1024, 1024, E); }
}

DEVI void phase6a(const Params& p, char* lds) {
    unsigned char* ws = p.ws; float* scr = (float*)lds;
    bf16_t* W13 = (bf16_t*)(ws + WS_W13); bf16_t* W2 = (bf16_t*)(ws + WS_W2);
    constexpr int I13 = 16 * 16, I2 = 16 * 8;
    for (int it = blockIdx.x; it < NEXP * (I13 + I2); it += gridDim.x) { const int e = it / (I13 + I2); int r = it % (I13 + I2);
        if (r < I13) { const int nb = r / 16, kb = r % 16; const float* w1 = p.ew1 + (size_t)e * 1024 * 512; const float* w3 = p.ew3 + (size_t)e * 1024 * 512; const float* nw = p.ffn_norm_w;
            const int tid = threadIdx.x;
            { const int nl = tid & 63, kq = tid >> 6; const int n = nb * 64 + nl, j = n >> 2, rr = n & 3; const float* src = rr < 2 ? w1 : w3; const int col = 2 * j + (rr & 1);
#pragma unroll
              for (int i = 0; i < 8; ++i) { const int k = kq * 8 + i; scr[k * 65 + nl] = src[(size_t)(kb * 64 + k) * 512 + col] * nw[kb * 64 + k]; } }
            __syncthreads();
            { const int nl = tid >> 3, kc = tid & 7; const float* s = scr + (kc * 8) * 65 + nl;
              u32x4 o; o.x = pk2(s[0], s[65]); o.y = pk2(s[2 * 65], s[3 * 65]); o.z = pk2(s[4 * 65], s[5 * 65]); o.w = pk2(s[6 * 65], s[7 * 65]);
              *(u32x4*)(W13 + ((size_t)e * 1024 + nb * 64 + nl) * 1024 + kb * 64 + kc * 8) = o; }
            __syncthreads();
        } else { r -= I13; const int nb = r / 8, kb = r % 8;
            transpose_tile(p.ew2 + (size_t)e * 512 * 1024, 1024, W2 + (size_t)e * 1024 * 512, 512, kb * 64, nb * 64, [](int n) { return n; }, [](int) { return 1.f; }, scr); }
    }
    __syncthreads();
    const float* WrT = (const float*)(ws + WS_WRT); bf16_t* H2 = (bf16_t*)(ws + WS_H2);
    int* AE = (int*)(ws + WS_ROUTE + RT_AE); int* AP = (int*)(ws + WS_ROUTE + RT_AP); float* AW = (float*)(ws + WS_ROUTE + RT_AW);
    unsigned* cnt = (unsigned*)(ws + WS_CTL) + CW_CNT;
    const int lane = threadIdx.x & 63, wid = threadIdx.x >> 6, gw = blockIdx.x * 8 + wid, NGW = gridDim.x * 8;
    float* lg = (float*)lds + wid * 80;
    for (int t = gw; t < T; t += NGW) {
        const f32x4* xr = (const f32x4*)(p.out + (size_t)t * D) + lane; f32x4 v[4]; float s = 0.f;
#pragma unroll
        for (int j = 0; j < 4; ++j) { v[j] = xr[64 * j]; s += v[j][0] * v[j][0] + v[j][1] * v[j][1] + v[j][2] * v[j][2] + v[j][3] * v[j][3]; }
        const float rstd = rsqrtf(wave_sum(s) * (1.f / D) + 1e-6f);
#pragma unroll
        for (int j = 0; j < 4; ++j) v[j] = v[j] * rstd;
        u32x2* o = (u32x2*)(H2 + (size_t)t * D) + lane;
#pragma unroll
        for (int j = 0; j < 4; ++j) { u32x2 w; w.x = pk2(v[j][0], v[j][1]); w.y = pk2(v[j][2], v[j][3]); o[64 * j] = w; }
        for (int c = 0; c < 72; ++c) { const f32x4* wr = (const f32x4*)(WrT + c * 1024) + lane; float a = 0.f;
#pragma unroll
            for (int j = 0; j < 4; ++j) { const f32x4 w = wr[64 * j]; a += v[j][0] * w[0] + v[j][1] * w[1] + v[j][2] * w[2] + v[j][3] * w[3]; }
            a = wave_sum(a); if (lane == 0) lg[c] = a; }
        if (lane == 0) {
            float gl[8]; int g = 0;
#pragma unroll
            for (int j = 0; j < 8; ++j) { gl[j] = lg[j] + p.rg_b[j]; }
#pragma unroll
            for (int j = 1; j < 8; ++j) if (gl[j] > gl[g]) g = j;
            float gs = 0.f;
#pragma unroll
            for (int j = 0; j < 8; ++j) gs += expf(gl[j] - gl[g]);
            const float gwt = 1.f / gs;
            float el[8]; int e1 = 0, e2 = -1;
            for (int j = 0; j < 8; ++j) el[j] = lg[8 + g * 8 + j] + p.re_b[g * 8 + j];
            for (int j = 1; j < 8; ++j) if (el[j] > el[e1]) e1 = j;
            for (int j = 0; j < 8; ++j) if (j != e1 && (e2 < 0 || el[j] > el[e2])) e2 = j;
            const float d = expf(el[e2] - el[e1]); const float w1 = 1.f / (1.f + d), w2 = d / (1.f + d);
            const int ea = g * 8 + e1, eb = g * 8 + e2;
            const unsigned pa = atomicAdd(cnt + ea, 1u), pb = atomicAdd(cnt + eb, 1u);
            AE[2 * t] = ea; AE[2 * t + 1] = eb; AP[2 * t] = (int)pa; AP[2 * t + 1] = (int)pb; AW[2 * t] = gwt * w1; AW[2 * t + 1] = gwt * w2;
        }
    }
}
DEVI int build_prefix(const Params& p, int* li) {
    const unsigned* cnt = (const unsigned*)(p.ws + WS_CTL) + CW_CNT;
    __syncthreads();
    if (threadIdx.x == 0) { int acc = 0; for (int e = 0; e < NEXP; ++e) { li[e] = acc; const int c = (int)cnt[e]; const int pd = (c + 255) & ~255; for (int tt = acc / 256; tt < (acc + pd) / 256; ++tt) li[80 + tt] = e; acc += pd; } li[64] = acc; }
    __syncthreads();
    return li[64] / 256;
}
DEVI void phase6b(const Params& p, char* lds) {
    unsigned char* ws = p.ws; int* li = (int*)lds; build_prefix(p, li);
    const unsigned* cnt = (const unsigned*)(ws + WS_CTL) + CW_CNT;
    const int* AE = (const int*)(ws + WS_ROUTE + RT_AE); const int* AP = (const int*)(ws + WS_ROUTE + RT_AP); const float* AW = (const float*)(ws + WS_ROUTE + RT_AW);
    int* AS = (int*)(ws + WS_ROUTE + RT_AS); int* ST = (int*)(ws + WS_ROUTE + RT_ST); float* SW = (float*)(ws + WS_ROUTE + RT_SW);
    for (int a = blockIdx.x * NTHR + threadIdx.x; a < 2 * T; a += gridDim.x * NTHR) { const int slot = li[AE[a]] + AP[a]; AS[a] = slot; ST[slot] = a >> 1; SW[slot] = AW[a]; }
    for (int e = blockIdx.x; e < NEXP; e += gridDim.x) { const int c = (int)cnt[e], pd = (c + 255) & ~255; for (int s = c + threadIdx.x; s < pd; s += NTHR) { ST[li[e] + s] = 0; SW[li[e] + s] = 0.f; } }
}
DEVI void phase7a(const Params& p, char* lds) {
    unsigned char* ws = p.ws; int* li = (int*)(lds + 48 * 1024); const int ntile = build_prefix(p, li);
    const bf16_t* H2 = (const bf16_t*)(ws + WS_H2); const bf16_t* W13 = (const bf16_t*)(ws + WS_W13); const int* ST = (const int*)(ws + WS_ROUTE + RT_ST);
    for (int u = blockIdx.x; u < ntile * 4; u += gridDim.x) { const int tile = u >> 2, pn = u & 3, e = li[80 + tile]; EpiHid E{(bf16_t*)(ws + WS_HID), tile, pn};
        gemm_tile_simple(lds, H2, 1024, ST + tile * 256, W13 + ((size_t)e * 1024 + pn * 256) * 1024, 1024, 1024, E); }
}
DEVI void phase7b(const Params& p, char* lds) {
    unsigned char* ws = p.ws; int* li = (int*)(lds + 48 * 1024); const int ntile = build_prefix(p, li);
    const bf16_t* hid = (const bf16_t*)(ws + WS_HID); const bf16_t* W2 = (const bf16_t*)(ws + WS_W2); const float* SW = (const float*)(ws + WS_ROUTE + RT_SW);
    for (int u = blockIdx.x; u < ntile * 4; u += gridDim.x) { const int tile = u >> 2, pn = u & 3, e = li[80 + tile]; EpiY E{(bf16_t*)(ws + WS_YEXP), SW, tile, pn};
        gemm_tile_simple(lds, hid + (size_t)tile * 256 * EFF, EFF, nullptr, W2 + ((size_t)e * 1024 + pn * 256) * EFF, EFF, EFF, E); }
}
DEVI void phase8(const Params& p) {
    unsigned char* ws = p.ws; const int* AS = (const int*)(ws + WS_ROUTE + RT_AS); const bf16_t* yexp = (const bf16_t*)(ws + WS_YEXP);
    const int lane = threadIdx.x & 63, gw = blockIdx.x * 8 + (threadIdx.x >> 6), NGW = gridDim.x * 8;
    for (int t = gw; t < T; t += NGW) {
        f32x4* xr = (f32x4*)(p.out + (size_t)t * D) + lane; const int s0 = AS[2 * t], s1 = AS[2 * t + 1];
        const u32x2* y0 = (const u32x2*)(yexp + (size_t)s0 * 1024) + lane; const u32x2* y1 = (const u32x2*)(yexp + (size_t)s1 * 1024) + lane;
        f32x4 v[4]; float s = 0.f;
#pragma unroll
        for (int j = 0; j < 4; ++j) { v[j] = xr[64 * j]; const u32x2 a = y0[64 * j], b = y1[64 * j];
            v[j][0] = (v[j][0] + bf2f(a.x & 0xffffu)) + bf2f(b.x & 0xffffu); v[j][1] = (v[j][1] + bf2f(a.x >> 16)) + bf2f(b.x >> 16);
            v[j][2] = (v[j][2] + bf2f(a.y & 0xffffu)) + bf2f(b.y & 0xffffu); v[j][3] = (v[j][3] + bf2f(a.y >> 16)) + bf2f(b.y >> 16);
            s += v[j][0] * v[j][0] + v[j][1] * v[j][1] + v[j][2] * v[j][2] + v[j][3] * v[j][3]; }
        const float rstd = rsqrtf(wave_sum(s) * (1.f / D) + 1e-6f);
#pragma unroll
        for (int j = 0; j < 4; ++j) { const f32x4 w = ((const f32x4*)p.final_w)[lane + 64 * j]; xr[64 * j] = v[j] * rstd * w; }
    }
}

constexpr int NPHASE = 12;
constexpr int LDS_BYTES = 147456;
__global__ void __launch_bounds__(NTHR, 2) mega(Params p) {
    extern __shared__ __attribute__((aligned(16))) char lds[];
    cg::grid_group grid = cg::this_grid();
    const int lo = p.ph_lo, hi = p.ph_hi;
#define PH(k, call) if (lo <= (k) && (k) < hi) { call; if ((k) + 1 < hi) grid.sync(); }
    PH(0, phase0(p, lds))
    PH(1, phase1(p, lds))
    PH(2, phase2a(p, lds))
    PH(3, phase2b(p, lds))
    PH(4, phase3(p, lds))
    PH(5, phase4(p, lds))
    PH(6, phase5(p, lds))
    PH(7, phase6a(p, lds))
    PH(8, phase6b(p, lds))
    PH(9, phase7a(p, lds))
    PH(10, phase7b(p, lds))
    PH(11, phase8(p))
#undef PH
}

extern "C" void kernel_launch(void* const* d_in, const int* in_sizes, int n_in, void* d_out, int out_size, void* d_ws, size_t ws_size, hipStream_t stream) {
    static int grid = 0;
    if (grid == 0) {
        if (n_in != 22 || out_size != T * D || ws_size < WS_END) { fprintf(stderr, "kernel_launch: unexpected shapes (n_in %d out %d ws %zu, need ws >= %zu)\n", n_in, out_size, ws_size, (size_t)WS_END); grid = -1; return; }
        int dev = 0, cus = 0, per_cu = 0; hipGetDevice(&dev); hipDeviceGetAttribute(&cus, hipDeviceAttributeMultiprocessorCount, dev);
        hipFuncSetAttribute((const void*)mega, hipFuncAttributeMaxDynamicSharedMemorySize, LDS_BYTES);
        hipOccupancyMaxActiveBlocksPerMultiprocessor(&per_cu, (const void*)mega, NTHR, LDS_BYTES);
        if (per_cu < 1) { fprintf(stderr, "kernel_launch: occupancy query says %d blocks per CU\n", per_cu); per_cu = 1; }
        grid = cus * per_cu; (void)hipGetLastError();
    }
    if (grid < 0) return;
    hipMemsetAsync((char*)d_ws + WS_CTL, 0, 4096, stream);
    Params p{};
    p.x = (const float*)d_in[0]; p.pos = (const int*)d_in[1]; p.attn_norm_w = (const float*)d_in[2]; p.w_in = (const float*)d_in[3]; p.hg_lb = (const float*)d_in[4];
    p.hg_onw = (const float*)d_in[5]; p.q_norm_w = (const float*)d_in[6]; p.w_uq = (const float*)d_in[7]; p.kv_norm_w = (const float*)d_in[8]; p.w_ukv = (const float*)d_in[9];
    p.w_bra = (const float*)d_in[10]; p.w_brb = (const float*)d_in[11]; p.w_out = (const float*)d_in[12]; p.ffn_norm_w = (const float*)d_in[13]; p.rg_w = (const float*)d_in[14];
    p.rg_b = (const float*)d_in[15]; p.re_w = (const float*)d_in[16]; p.re_b = (const float*)d_in[17]; p.ew1 = (const float*)d_in[18]; p.ew3 = (const float*)d_in[19];
    p.ew2 = (const float*)d_in[20]; p.final_w = (const float*)d_in[21]; p.out = (float*)d_out; p.ws = (unsigned char*)d_ws;
#if MK_MULTI
    for (int ph = 0; ph < NPHASE; ++ph) { p.ph_lo = ph; p.ph_hi = ph + 1; hipLaunchKernelGGL(mega, dim3(grid), dim3(NTHR), LDS_BYTES, stream, p); }
#else
    p.ph_lo = 0; p.ph_hi = NPHASE;
    void* args[] = {&p};
    hipError_t e = hipLaunchCooperativeKernel((const void*)mega, dim3(grid), dim3(NTHR), args, LDS_BYTES, stream);
    if (e != hipSuccess) fprintf(stderr, "cooperative launch failed: %s (grid %d)\n", hipGetErrorString(e), grid);
#endif
}
```

```cpp
#include <hip/hip_runtime.h>
#include <hip/hip_cooperative_groups.h>
#include <cstdio>
#include <cstdint>
namespace cg = cooperative_groups;

#ifndef MK_MULTI
#define MK_MULTI 0
#endif

#define DEVI __device__ __forceinline__
typedef unsigned short bf16_t;
typedef short bf16x8 __attribute__((ext_vector_type(8)));
typedef float f32x4 __attribute__((ext_vector_type(4)));
typedef unsigned u32x4 __attribute__((ext_vector_type(4)));
typedef unsigned u32x2 __attribute__((ext_vector_type(2)));

constexpr int NB = 16, SEQ = 2048, T = NB * SEQ, D = 1024;
constexpr int NTHR = 512;
constexpr int ZH_P = 4096, ZL_P = 768, ZG_P = 2048;
constexpr int NZ = 6912;
constexpr int NEXP = 64, EFF = 512;
constexpr int SLOT_CAP = 2 * T + NEXP * 256;
constexpr int MAX_TILES = SLOT_CAP / 256;

constexpr size_t MiB = 1u << 20;
constexpr size_t WS_CTL = 0;
constexpr size_t WS_WRT = 1 * MiB;
constexpr size_t WS_WIN = 2 * MiB;
constexpr size_t WS_WUQ = 16 * MiB;
constexpr size_t WS_WUKV = 18 * MiB;
constexpr size_t WS_WBR = 20 * MiB;
constexpr size_t WS_WOUT = 24 * MiB;
constexpr size_t WS_COS = 26 * MiB, WS_SIN = 30 * MiB;
constexpr size_t WS_ROUTE = 34 * MiB;
constexpr size_t WS_KPE = 36 * MiB;
constexpr size_t WS_ZH = 40 * MiB;
constexpr size_t WS_Q = 40 * MiB, WS_KN = 136 * MiB, WS_V = 200 * MiB;
constexpr size_t WS_Y = 40 * MiB;
constexpr size_t WS_H2 = 40 * MiB;
constexpr size_t WS_HID = 104 * MiB;
constexpr size_t WS_YEXP = 184 * MiB;
constexpr size_t WS_OB = 264 * MiB;
constexpr size_t WS_ZL = 296 * MiB;
constexpr size_t WS_ZG = 344 * MiB;
constexpr size_t WS_W13 = 344 * MiB;
constexpr size_t WS_OA = 472 * MiB;
constexpr size_t WS_H = 472 * MiB;
constexpr size_t WS_W2 = 472 * MiB;
constexpr size_t WS_END = 536 * MiB;
constexpr size_t RT_AE = 0, RT_AP = 256 * 1024, RT_AW = 512 * 1024, RT_AS = 768 * 1024, RT_ST = 1024 * 1024, RT_SW = 1536 * 1024;
constexpr int CW_CNT = 0;

struct Params {
    const float* x; const int* pos; const float* attn_norm_w; const float* w_in; const float* hg_lb; const float* hg_onw;
    const float* q_norm_w; const float* w_uq; const float* kv_norm_w; const float* w_ukv; const float* w_bra; const float* w_brb;
    const float* w_out; const float* ffn_norm_w; const float* rg_w; const float* rg_b; const float* re_w; const float* re_b;
    const float* ew1; const float* ew3; const float* ew2; const float* final_w;
    float* out; unsigned char* ws;
    int ph_lo, ph_hi;
};

DEVI unsigned f2bf(float f) { unsigned u = __builtin_bit_cast(unsigned, f); return (u + 0x7fffu + ((u >> 16) & 1u)) >> 16; }
DEVI float bf2f(unsigned h) { return __builtin_bit_cast(float, h << 16); }
DEVI unsigned pk2(float lo, float hi) { return f2bf(lo) | (f2bf(hi) << 16); }
DEVI float sigmoidf_(float v) { return 1.f / (1.f + __expf(-v)); }
DEVI float siluf_(float v) { return v / (1.f + __expf(-v)); }
DEVI float wave_sum(float v) {
#pragma unroll
    for (int o = 1; o < 64; o <<= 1) v += __shfl_xor(v, o);
    return v;
}
DEVI void store4bf(bf16_t* p, f32x4 v) { u32x2 w; w.x = pk2(v[0], v[1]); w.y = pk2(v[2], v[3]); *(u32x2*)p = w; }
DEVI void unpack8(bf16x8 v, float* f) {
#pragma unroll
    for (int j = 0; j < 8; ++j) f[j] = bf2f((unsigned)(unsigned short)v[j]);
}

template <class ColMap, class KScale>
DEVI void transpose_tile(const float* src, int Nsrc, bf16_t* dst, int ldk, int k0, int n0, ColMap cm, KScale ks, float* scr) {
    const int tid = threadIdx.x;
    {
        const int nl = tid & 63, kq = tid >> 6; const int col = cm(n0 + nl);
#pragma unroll
        for (int i = 0; i < 8; ++i) { const int k = kq * 8 + i; float v = 0.f; if (col >= 0) v = src[(size_t)(k0 + k) * Nsrc + col] * ks(k0 + k); scr[k * 65 + nl] = v; }
    }
    __syncthreads();
    {
        const int nl = tid >> 3, kc = tid & 7; const float* s = scr + (kc * 8) * 65 + nl;
        u32x4 o; o.x = pk2(s[0], s[65]); o.y = pk2(s[2 * 65], s[3 * 65]); o.z = pk2(s[4 * 65], s[5 * 65]); o.w = pk2(s[6 * 65], s[7 * 65]);
        *(u32x4*)(dst + (size_t)(n0 + nl) * ldk + k0 + kc * 8) = o;
    }
    __syncthreads();
}

template <class Epi>
DEVI void gemm_tile_simple(char* lds, const bf16_t* A, int lda, const int* arow, const bf16_t* Bt, int ldb, int K, const Epi& epi) {
    const int tid = threadIdx.x, lane = tid & 63, wid = tid >> 6, wr = wid >> 2, wc = wid & 3, fr = lane & 15, fq = lane >> 4;
    char* As = lds; char* Bs = lds + 256 * 80;
    f32x4 acc[8][4];
#pragma unroll
    for (int m = 0; m < 8; ++m)
#pragma unroll
        for (int n = 0; n < 4; ++n) acc[m][n] = (f32x4){0.f, 0.f, 0.f, 0.f};
    unsigned ao[2], bo[2]; int lo[2];
#pragma unroll
    for (int i = 0; i < 2; ++i) { const int c = tid + 512 * i, row = c >> 2, kc = c & 3; const unsigned ar = arow ? (unsigned)arow[row] : (unsigned)row;
        ao[i] = ar * (unsigned)lda + kc * 8; bo[i] = (unsigned)row * (unsigned)ldb + kc * 8; lo[i] = row * 80 + kc * 16; }
    for (int k0 = 0; k0 < K; k0 += 32) {
        bf16x8 ra[2], rb[2];
#pragma unroll
        for (int i = 0; i < 2; ++i) { ra[i] = *(const bf16x8*)(A + ao[i] + k0); rb[i] = *(const bf16x8*)(Bt + bo[i] + k0); }
        __syncthreads();
#pragma unroll
        for (int i = 0; i < 2; ++i) { *(bf16x8*)(As + lo[i]) = ra[i]; *(bf16x8*)(Bs + lo[i]) = rb[i]; }
        __syncthreads();
        bf16x8 bfr[4];
#pragma unroll
        for (int n = 0; n < 4; ++n) bfr[n] = *(const bf16x8*)(Bs + (wc * 64 + n * 16 + fr) * 80 + fq * 16);
#pragma unroll
        for (int mh = 0; mh < 2; ++mh) { bf16x8 af[4];
#pragma unroll
            for (int m = 0; m < 4; ++m) af[m] = *(const bf16x8*)(As + (wr * 128 + (mh * 4 + m) * 16 + fr) * 80 + fq * 16);
#pragma unroll
            for (int m = 0; m < 4; ++m)
#pragma unroll
                for (int n = 0; n < 4; ++n) acc[mh * 4 + m][n] = __builtin_amdgcn_mfma_f32_16x16x32_bf16(bfr[n], af[m], acc[mh * 4 + m][n], 0, 0, 0); }
    }
#pragma unroll
    for (int m = 0; m < 8; ++m)
#pragma unroll
        for (int n = 0; n < 4; ++n) epi(wr * 128 + m * 16 + fr, wc * 64 + n * 16 + 4 * fq, acc[m][n]);
    __syncthreads();
}

struct EpiZ { bf16_t* zh; bf16_t* zl; bf16_t* zg; int pm, pn;
    DEVI void operator()(int r, int c, f32x4 v) const {
        const size_t row = (size_t)pm * 256 + r; const int col = pn * 256 + c;
        if (pn < 16) store4bf(zh + row * ZH_P + col, v);
        else if (pn < 19) store4bf(zl + row * ZL_P + (col - 4096), v);
        else { f32x4 s; s[0] = sigmoidf_(v[0]); s[1] = sigmoidf_(v[1]); s[2] = sigmoidf_(v[2]); s[3] = sigmoidf_(v[3]); store4bf(zg + row * ZG_P + (col - 4864), s); }
    } };
struct EpiQKV { bf16_t* q; bf16_t* kn; bf16_t* vv; const float* cosT; const float* sinT; int pm, pn, isq;
    DEVI void operator()(int r, int c, f32x4 v) const {
        const size_t row = (size_t)pm * 256 + r; const int col = pn * 256 + c;
        if (isq) { const int cc = col % 192;
            if (cc >= 128) { const int i = (cc - 128) >> 1; const float c0 = cosT[row * 32 + i], s0 = sinT[row * 32 + i], c1 = cosT[row * 32 + i + 1], s1 = sinT[row * 32 + i + 1];
                f32x4 o; o[0] = v[0] * c0 - v[1] * s0; o[1] = v[1] * c0 + v[0] * s0; o[2] = v[2] * c1 - v[3] * s1; o[3] = v[3] * c1 + v[2] * s1; v = o; }
            store4bf(q + row * 1536 + col, v);
        } else { const int hh = col >> 8, cc = col & 255;
            if (cc < 128) store4bf(kn + row * 1024 + hh * 128 + cc, v); else store4bf(vv + row * 1024 + hh * 128 + (cc - 128), v); }
    } };
struct EpiBr { float* tmp; const bf16_t* zg; bf16_t* y; int pm, pn, second;
    DEVI void operator()(int r, int c, f32x4 v) const {
        const size_t row = (size_t)pm * 256 + r; const int col = pn * 256 + c; const u32x2 g = *(const u32x2*)(zg + row * ZG_P + second * 1024 + col);
        f32x4 o; o[0] = v[0] * bf2f(g.x & 0xffffu); o[1] = v[1] * bf2f(g.x >> 16); o[2] = v[2] * bf2f(g.y & 0xffffu); o[3] = v[3] * bf2f(g.y >> 16);
        if (!second) *(f32x4*)(tmp + row * 1024 + col) = o;
        else { const f32x4 t = *(const f32x4*)(tmp + row * 1024 + col); store4bf(y + row * 1024 + col, t + o); }
    } };
struct EpiOut { const float* x; float* x2; int pm, pn;
    DEVI void operator()(int r, int c, f32x4 v) const {
        const size_t off = ((size_t)pm * 256 + r) * 1024 + pn * 256 + c; const f32x4 xv = *(const f32x4*)(x + off); *(f32x4*)(x2 + off) = xv + v;
    } };
struct EpiHid { bf16_t* hid; int tile, pn;
    DEVI void operator()(int r, int c, f32x4 v) const {
        const size_t slot = (size_t)tile * 256 + r; const int hc = (pn * 256 + c) >> 1;
        *(unsigned*)(hid + slot * EFF + hc) = pk2(siluf_(v[0]) * v[2], siluf_(v[1]) * v[3]);
    } };
struct EpiY { bf16_t* yexp; const float* sw; int tile, pn;
    DEVI void operator()(int r, int c, f32x4 v) const {
        const size_t slot = (size_t)tile * 256 + r; const float w = sw[slot]; store4bf(yexp + slot * 1024 + pn * 256 + c, v * w);
    } };

DEVI void phase0(const Params& p, char* lds) {
    float* scr = (float*)lds; unsigned char* ws = p.ws;
    bf16_t* WinT = (bf16_t*)(ws + WS_WIN); bf16_t* WuqT = (bf16_t*)(ws + WS_WUQ); bf16_t* WukvT = (bf16_t*)(ws + WS_WUKV);
    bf16_t* WbrT = (bf16_t*)(ws + WS_WBR); bf16_t* WoutT = (bf16_t*)(ws + WS_WOUT);
    constexpr int I_IN = (NZ / 64) * 16, I_UQ = 24 * 6, I_UKV = 32 * 4, I_BR = 16 * 16, I_OUT = 16 * 16;
    constexpr int NIT = I_IN + I_UQ + I_UKV + 2 * I_BR + I_OUT;
    for (int it = blockIdx.x; it < NIT; it += gridDim.x) {
        int r = it;
        if (r < I_IN) { const int nb = r / 16, kb = r % 16; const float* nw = p.attn_norm_w;
            transpose_tile(p.w_in, 6848, WinT, 1024, kb * 64, nb * 64, [](int n) { return n < 4800 ? n : (n < 4864 ? -1 : n - 64); }, [nw](int k) { return nw[k]; }, scr); continue; }
        r -= I_IN;
        if (r < I_UQ) { const int nb = r / 6, kb = r % 6; const float* nw = p.q_norm_w;
            transpose_tile(p.w_uq, 1536, WuqT, 384, kb * 64, nb * 64,
                           [](int n) { const int hh = n / 192, c = n % 192; if (c < 128) return n; const int rr = c - 128; return hh * 192 + 128 + (rr & 1) * 32 + (rr >> 1); },
                           [nw](int k) { return nw[k] * 0.07216878364870322f; }, scr); continue; }
        r -= I_UQ;
        if (r < I_UKV) { const int nb = r / 4, kb = r % 4; const float* nw = p.kv_norm_w;
            transpose_tile(p.w_ukv, 2048, WukvT, 256, kb * 64, nb * 64, [](int n) { return n; }, [nw](int k) { return nw[k]; }, scr); continue; }
        r -= I_UKV;
        if (r < I_BR) { const int nb = r / 16, kb = r % 16;
            transpose_tile(p.w_bra, 1024, WbrT, 2048, kb * 64, nb * 64, [](int n) { return n; }, [](int) { return 1.f; }, scr); continue; }
        r -= I_BR;
        if (r < I_BR) { const int nb = r / 16, kb = r % 16;
            transpose_tile(p.w_brb, 1024, WbrT + 1024, 2048, kb * 64, nb * 64, [](int n) { return n; }, [](int) { return 1.f; }, scr); continue; }
        r -= I_BR;
        { const int nb = r / 16, kb = r % 16;
            transpose_tile(p.w_out, 1024, WoutT, 1024, kb * 64, nb * 64, [](int n) { return n; }, [](int) { return 1.f; }, scr); }
    }
    float* WrT = (float*)(ws + WS_WRT);
    for (int e = blockIdx.x * NTHR + threadIdx.x; e < 72 * 1024; e += gridDim.x * NTHR) { const int c = e >> 10, k = e & 1023;
        const float w = c < 8 ? p.rg_w[k * 8 + c] : p.re_w[k * 64 + (c - 8)]; WrT[e] = w * p.ffn_norm_w[k]; }
    bf16_t* H = (bf16_t*)(ws + WS_H);
    const int lane = threadIdx.x & 63, gw = blockIdx.x * 8 + (threadIdx.x >> 6), NGW = gridDim.x * 8;
    for (int m = gw; m < T; m += NGW) {
        const f32x4* xr = (const f32x4*)(p.x + (size_t)m * D) + lane; f32x4 v[4]; float s = 0.f;
#pragma unroll
        for (int j = 0; j < 4; ++j) { v[j] = xr[64 * j]; s += v[j][0] * v[j][0] + v[j][1] * v[j][1] + v[j][2] * v[j][2] + v[j][3] * v[j][3]; }
        const float rstd = rsqrtf(wave_sum(s) * (1.f / D) + 1e-6f);
        u32x2* o = (u32x2*)(H + (size_t)m * D) + lane;
#pragma unroll
        for (int j = 0; j < 4; ++j) { u32x2 w; w.x = pk2(v[j][0] * rstd, v[j][1] * rstd); w.y = pk2(v[j][2] * rstd, v[j][3] * rstd); o[64 * j] = w; }
    }
}

DEVI void phase1(const Params& p, char* lds) {
    unsigned char* ws = p.ws; const bf16_t* H = (const bf16_t*)(ws + WS_H); const bf16_t* WinT = (const bf16_t*)(ws + WS_WIN);
    constexpr int nN = NZ / 256, NU = (T / 256) * nN;
    for (int u = blockIdx.x; u < NU; u += gridDim.x) { const int pm = u / nN, pn = u % nN;
        EpiZ E{(bf16_t*)(ws + WS_ZH), (bf16_t*)(ws + WS_ZL), (bf16_t*)(ws + WS_ZG), pm, pn};
        gemm_tile_simple(lds, H + (size_t)pm * 256 * D, D, nullptr, WinT + (size_t)pn * 256 * D, D, D, E); }
}

DEVI void hgrn_chain(const Params& p, char* lds, int b, int h) {
    float* qv = (float*)lds; float* fv = qv + 4096; float* kv = fv + 4096; float* vv = kv + 4096; float* ov = vv + 4096; float* red = ov + 4096;
    const bf16_t* zh = (const bf16_t*)(p.ws + WS_ZH); bf16_t* oa = (bf16_t*)(p.ws + WS_OA);
    const int tid = threadIdx.x, lane = tid & 63, wid = tid >> 6, v = tid & 127, kq = tid >> 7;
    float S[32];
#pragma unroll
    for (int j = 0; j < 32; ++j) S[j] = 0.f;
    const int lrow = tid >> 4, c8 = (tid & 15) * 8;
    float lbv[8];
#pragma unroll
    for (int j = 0; j < 8; ++j) { const float a0 = p.hg_lb[h * 128 + c8 + j], a1 = p.hg_lb[1024 + h * 128 + c8 + j]; lbv[j] = 1.f / (1.f + expf(a1 - a0)); }
    const float nw0 = p.hg_onw[lane], nw1 = p.hg_onw[64 + lane];
    for (int chunk = 0; chunk < SEQ / 32; ++chunk) {
        const size_t t0 = (size_t)b * SEQ + chunk * 32;
        __syncthreads();
        {
            const bf16_t* zr = zh + (t0 + lrow) * ZH_P + h * 128 + c8;
            float hq[8], hf[8], hi[8]; unpack8(*(const bf16x8*)zr, hq); unpack8(*(const bf16x8*)(zr + 1024), hf); unpack8(*(const bf16x8*)(zr + 2048), hi);
#pragma unroll
            for (int j = 0; j < 8; ++j) { const int o = lrow * 128 + c8 + j; qv[o] = siluf_(hq[j]) * 0.08838834764831845f;
                const float fg = lbv[j] + (1.f - lbv[j]) * sigmoidf_(hf[j]); fv[o] = fg; kv[o] = 1.f - fg; vv[o] = hi[j]; }
        }
        __syncthreads();
        for (int t = 0; t < 32; ++t) {
            const float vt = vv[t * 128 + v]; float part = 0.f; const float* fr_ = fv + t * 128 + kq * 32; const float* kr_ = kv + t * 128 + kq * 32; const float* qr_ = qv + t * 128 + kq * 32;
#pragma unroll
            for (int j = 0; j < 32; ++j) { S[j] = fr_[j] * S[j] + kr_[j] * vt; part += qr_[j] * S[j]; }
            red[((t & 1) * 4 + kq) * 128 + v] = part;
            __syncthreads();
            if (kq == 0) { const float* rr = red + (t & 1) * 512 + v; ov[t * 128 + v] = (rr[0] + rr[128]) + (rr[256] + rr[384]); }
        }
        __syncthreads();
#pragma unroll
        for (int rr = 0; rr < 4; ++rr) { const int r = wid * 4 + rr; const float a = ov[r * 128 + lane], bb = ov[r * 128 + 64 + lane];
            const float rstd = rsqrtf(wave_sum(a * a + bb * bb) * (1.f / 128.f) + 1e-6f);
            const bf16_t* gp = zh + (t0 + r) * ZH_P + 3072 + h * 128; const float g0 = bf2f(gp[lane]), g1 = bf2f(gp[64 + lane]);
            bf16_t* op = oa + (t0 + r) * 1024 + h * 128; op[lane] = (bf16_t)f2bf(a * rstd * nw0 * siluf_(g0)); op[64 + lane] = (bf16_t)f2bf(bb * rstd * nw1 * siluf_(g1)); }
    }
}
DEVI void mla_prep(const Params& p, int chunk) {
    bf16_t* zl = (bf16_t*)(p.ws + WS_ZL); float* cosT = (float*)(p.ws + WS_COS); float* sinT = (float*)(p.ws + WS_SIN);
    const int lane = threadIdx.x & 63, wid = threadIdx.x >> 6;
    for (int rr = wid; rr < 256; rr += 8) { const size_t t = (size_t)chunk * 256 + rr; bf16_t* zr = zl + t * ZL_P;
        float cq[6], ck[4]; float s = 0.f, s2 = 0.f;
#pragma unroll
        for (int j = 0; j < 6; ++j) { cq[j] = bf2f(zr[lane + 64 * j]); s += cq[j] * cq[j]; }
#pragma unroll
        for (int j = 0; j < 4; ++j) { ck[j] = bf2f(zr[384 + lane + 64 * j]); s2 += ck[j] * ck[j]; }
        const float kr = bf2f(zr[640 + lane]);
        const float r1 = rsqrtf(wave_sum(s) * (1.f / 384.f) + 1e-6f), r2 = rsqrtf(wave_sum(s2) * (1.f / 256.f) + 1e-6f);
        const float other = __shfl_xor(kr, 32);
        const int i = lane & 31; const float invf = powf(10000.f, -(float)i / 32.f); const float ang = (float)p.pos[t] * invf; const float cs = cosf(ang), sn = sinf(ang);
        const float x1 = lane < 32 ? kr : other, x2 = lane < 32 ? other : kr;
        const float outv = lane < 32 ? (x1 * cs - x2 * sn) : (x2 * cs + x1 * sn);
#pragma unroll
        for (int j = 0; j < 6; ++j) zr[lane + 64 * j] = (bf16_t)f2bf(cq[j] * r1);
#pragma unroll
        for (int j = 0; j < 4; ++j) zr[384 + lane + 64 * j] = (bf16_t)f2bf(ck[j] * r2);
        ((bf16_t*)(p.ws + WS_KPE))[t * 64 + 2 * i + (lane >> 5)] = (bf16_t)f2bf(outv);
        if (lane < 32) { cosT[t * 32 + i] = cs; sinT[t * 32 + i] = sn; }
    }
}
DEVI void phase2a(const Params& p, char* lds) {
    for (int it = blockIdx.x; it < 256; it += gridDim.x) { if (it < 128) hgrn_chain(p, lds, it >> 3, it & 7); else mla_prep(p, it - 128); }
}

DEVI void phase2b(const Params& p, char* lds) {
    unsigned char* ws = p.ws; const bf16_t* zl = (const bf16_t*)(ws + WS_ZL);
    constexpr int NUQ = 128 * 6, NUKV = 128 * 8;
    for (int u = blockIdx.x; u < NUQ + NUKV; u += gridDim.x) {
        const int isq = u < NUQ, uu = isq ? u : u - NUQ, nn = isq ? 6 : 8, pm = uu / nn, pn = uu % nn, K = isq ? 384 : 256;
        EpiQKV E{(bf16_t*)(ws + WS_Q), (bf16_t*)(ws + WS_KN), (bf16_t*)(ws + WS_V), (const float*)(ws + WS_COS), (const float*)(ws + WS_SIN), pm, pn, isq};
        const bf16_t* Bt = isq ? (const bf16_t*)(ws + WS_WUQ) + (size_t)pn * 256 * 384 : (const bf16_t*)(ws + WS_WUKV) + (size_t)pn * 256 * 256;
        gemm_tile_simple(lds, zl + (size_t)pm * 256 * ZL_P + (isq ? 0 : 384), ZL_P, nullptr, Bt, K, K, E);
    }
}

DEVI void attn_item(const Params& p, char* lds, int b, int h, int qb) {
    const bf16_t* q = (const bf16_t*)(p.ws + WS_Q); const bf16_t* kn = (const bf16_t*)(p.ws + WS_KN); const bf16_t* vg = (const bf16_t*)(p.ws + WS_V);
    const bf16_t* kpe = (const bf16_t*)(p.ws + WS_KPE); bf16_t* ob = (bf16_t*)(p.ws + WS_OB);
    const int tid = threadIdx.x, lane = tid & 63, wid = tid >> 6, fr = lane & 15, fq = lane >> 4;
    bf16_t* Ks = (bf16_t*)lds; bf16_t* Vt = (bf16_t*)(lds + 64 * 400); bf16_t* Ps = (bf16_t*)(lds + 64 * 400 + 128 * 144) + wid * 16 * 72;
    const int q0 = qb * 128 + wid * 16; const size_t tb = (size_t)b * SEQ;
    bf16x8 qf[6];
    { const bf16_t* qrow = q + (tb + q0 + fr) * 1536 + h * 192;
#pragma unroll
      for (int kk = 0; kk < 6; ++kk) qf[kk] = *(const bf16x8*)(qrow + kk * 32 + fq * 8); }
    f32x4 o[8]; float m[4], l[4];
#pragma unroll
    for (int n = 0; n < 8; ++n) o[n] = (f32x4){0.f, 0.f, 0.f, 0.f};
#pragma unroll
    for (int i = 0; i < 4; ++i) { m[i] = -1e30f; l[i] = 0.f; }
    const int nkt = (qb + 1) * 2;
    for (int kt = 0; kt < nkt; ++kt) {
        __syncthreads();
#pragma unroll
        for (int i = 0; i < 3; ++i) { const int c = tid + 512 * i, key = c / 24, ch = c % 24; const size_t tk = tb + kt * 64 + key;
            const bf16_t* src = ch < 16 ? kn + tk * 1024 + h * 128 + ch * 8 : kpe + tk * 64 + (ch - 16) * 8;
            *(bf16x8*)(Ks + key * 200 + ch * 8) = *(const bf16x8*)src; }
#pragma unroll
        for (int i = 0; i < 2; ++i) { const int c = tid + 512 * i, key = c >> 4, ch = c & 15; const bf16x8 vv = *(const bf16x8*)(vg + (tb + kt * 64 + key) * 1024 + h * 128 + ch * 8);
#pragma unroll
            for (int j = 0; j < 8; ++j) Vt[(ch * 8 + j) * 72 + key] = (bf16_t)vv[j]; }
        __syncthreads();
        if (kt * 64 <= q0 + 15) {
            f32x4 s[4];
#pragma unroll
            for (int n = 0; n < 4; ++n) s[n] = (f32x4){0.f, 0.f, 0.f, 0.f};
#pragma unroll
            for (int kk = 0; kk < 6; ++kk)
#pragma unroll
                for (int n = 0; n < 4; ++n) { const bf16x8 kf = *(const bf16x8*)(Ks + (n * 16 + fr) * 200 + kk * 32 + fq * 8); s[n] = __builtin_amdgcn_mfma_f32_16x16x32_bf16(qf[kk], kf, s[n], 0, 0, 0); }
#pragma unroll
            for (int i = 0; i < 4; ++i) { const int qi = q0 + 4 * fq + i; float mx = -__builtin_inff();
#pragma unroll
                for (int n = 0; n < 4; ++n) { const int key = kt * 64 + 16 * n + fr; if (key > qi) s[n][i] = -__builtin_inff(); mx = fmaxf(mx, s[n][i]); }
                mx = fmaxf(mx, __shfl_xor(mx, 1)); mx = fmaxf(mx, __shfl_xor(mx, 2)); mx = fmaxf(mx, __shfl_xor(mx, 4)); mx = fmaxf(mx, __shfl_xor(mx, 8));
                const float mn = fmaxf(m[i], mx), alpha = __expf(m[i] - mn); m[i] = mn; float rs = 0.f;
#pragma unroll
                for (int n = 0; n < 4; ++n) { const float pv = __expf(s[n][i] - mn); s[n][i] = pv; rs += pv; }
                rs += __shfl_xor(rs, 1); rs += __shfl_xor(rs, 2); rs += __shfl_xor(rs, 4); rs += __shfl_xor(rs, 8);
                l[i] = l[i] * alpha + rs;
#pragma unroll
                for (int n = 0; n < 8; ++n) o[n][i] *= alpha;
#pragma unroll
                for (int n = 0; n < 4; ++n) Ps[(4 * fq + i) * 72 + 16 * n + fr] = (bf16_t)f2bf(s[n][i]);
            }
#pragma unroll
            for (int ks = 0; ks < 2; ++ks) { const bf16x8 pf = *(const bf16x8*)(Ps + fr * 72 + ks * 32 + fq * 8);
#pragma unroll
                for (int n = 0; n < 8; ++n) { const bf16x8 vf = *(const bf16x8*)(Vt + (n * 16 + fr) * 72 + ks * 32 + fq * 8); o[n] = __builtin_amdgcn_mfma_f32_16x16x32_bf16(pf, vf, o[n], 0, 0, 0); } }
        }
    }
#pragma unroll
    for (int i = 0; i < 4; ++i) { const float rl = 1.f / l[i]; bf16_t* orow = ob + (tb + q0 + 4 * fq + i) * 1024 + h * 128;
#pragma unroll
        for (int n = 0; n < 8; ++n) orow[n * 16 + fr] = (bf16_t)f2bf(o[n][i] * rl); }
}
DEVI void phase3(const Params& p, char* lds) {
    for (int it = blockIdx.x; it < 2048; it += gridDim.x) { const int qb = 15 - (it >> 7), bh = it & 127; attn_item(p, lds, bh >> 3, bh & 7, qb); }
}

DEVI void phase4(const Params& p, char* lds) {
    unsigned char* ws = p.ws; const bf16_t* oa = (const bf16_t*)(ws + WS_OA); const bf16_t* obp = (const bf16_t*)(ws + WS_OB);
    const bf16_t* W = (const bf16_t*)(ws + WS_WBR); const bf16_t* zg = (const bf16_t*)(ws + WS_ZG);
    for (int u2 = blockIdx.x * 2; u2 < 1024; u2 += (u2 & 1) ? 2 * gridDim.x - 1 : 1) { const int u = u2 >> 1, second = u2 & 1, pm = u >> 2, pn = u & 3;
        EpiBr E{p.out, zg, (bf16_t*)(ws + WS_Y), pm, pn, second};
        gemm_tile_simple(lds, (second ? obp : oa) + (size_t)pm * 256 * 1024, 1024, nullptr, W + (size_t)pn * 256 * 2048 + second * 1024, 2048, 1024, E); }
}
DEVI void phase5(const Params& p, char* lds) {
    unsigned char* ws = p.ws; const bf16_t* y = (const bf16_t*)(ws + WS_Y); const bf16_t* W = (const bf16_t*)(ws + WS_WOUT);
    for (int u = blockIdx.x; u < 512; u += gridDim.x) { const int pm = u >> 2, pn = u & 3; EpiOut E{p.x, p.out, pm, pn};
        gemm_tile_simple(lds, y + (size_t)pm * 256 * 1024, 1024, nullptr, W + (size_t)pn * 256 * 1024, 1024, 1024, E); }
}

DEVI void phase6a(const Params& p, char* lds) {
    unsigned char* ws = p.ws; float* scr = (float*)lds;
    bf16_t* W13 = (bf16_t*)(ws + WS_W13); bf16_t* W2 = (bf16_t*)(ws + WS_W2);
    constexpr int I13 = 16 * 16, I2 = 16 * 8;
    for (int it = blockIdx.x; it < NEXP * (I13 + I2); it += gridDim.x) { const int e = it / (I13 + I2); int r = it % (I13 + I2);
        if (r < I13) { const int nb = r / 16, kb = r % 16; const float* w1 = p.ew1 + (size_t)e * 1024 * 512; const float* w3 = p.ew3 + (size_t)e * 1024 * 512; const float* nw = p.ffn_norm_w;
            const int tid = threadIdx.x;
            { const int nl = tid & 63, kq = tid >> 6; const int n = nb * 64 + nl, j = n >> 2, rr = n & 3; const float* src = rr < 2 ? w1 : w3; const int col = 2 * j + (rr & 1);
#pragma unroll
              for (int i = 0; i < 8; ++i) { const int k = kq * 8 + i; scr[k * 65 + nl] = src[(size_t)(kb * 64 + k) * 512 + col] * nw[kb * 64 + k]; } }
            __syncthreads();
            { const int nl = tid >> 3, kc = tid & 7; const float* s = scr + (kc * 8) * 65 + nl;
              u32x4 o; o.x = pk2(s[0], s[65]); o.y = pk2(s[2 * 65], s[3 * 65]); o.z = pk2(s[4 * 65], s[5 * 65]); o.w = pk2(s[6 * 65], s[7 * 65]);
              *(u32x4*)(W13 + ((size_t)e * 1024 + nb * 64 + nl) * 1024 + kb * 64 + kc * 8) = o; }
            __syncthreads();
        } else { r -= I13; const int nb = r / 8, kb = r % 8;
            transpose_tile(p.ew2 + (size_t)e * 512 * 1024, 1024, W2 + (size_t)e * 1024 * 512, 512, kb * 64, nb * 64, [](int n) { return n; }, [](int) { return 1.f; }, scr); }
    }
    __syncthreads();
    const float* WrT = (const float*)(ws + WS_WRT); bf16_t* H2 = (bf16_t*)(ws + WS_H2);
    int* AE = (int*)(ws + WS_ROUTE + RT_AE); int* AP = (int*)(ws + WS_ROUTE + RT_AP); float* AW = (float*)(ws + WS_ROUTE + RT_AW);
    unsigned* cnt = (unsigned*)(ws + WS_CTL) + CW_CNT;
    const int lane = threadIdx.x & 63, wid = threadIdx.x >> 6, gw = blockIdx.x * 8 + wid, NGW = gridDim.x * 8;
    float* lg = (float*)lds + wid * 80;
    for (int t = gw; t < T; t += NGW) {
        const f32x4* xr = (const f32x4*)(p.out + (size_t)t * D) + lane; f32x4 v[4]; float s = 0.f;
#pragma unroll
        for (int j = 0; j < 4; ++j) { v[j] = xr[64 * j]; s += v[j][0] * v[j][0] + v[j][1] * v[j][1] + v[j][2] * v[j][2] + v[j][3] * v[j][3]; }
        const float rstd = rsqrtf(wave_sum(s) * (1.f / D) + 1e-6f);
#pragma unroll
        for (int j = 0; j < 4; ++j) v[j] = v[j] * rstd;
        u32x2* o = (u32x2*)(H2 + (size_t)t * D) + lane;
#pragma unroll
        for (int j = 0; j < 4; ++j) { u32x2 w; w.x = pk2(v[j][0], v[j][1]); w.y = pk2(v[j][2], v[j][3]); o[64 * j] = w; }
        for (int c = 0; c < 72; ++c) { const f32x4* wr = (const f32x4*)(WrT + c * 1024) + lane; float a = 0.f;
#pragma unroll
            for (int j = 0; j < 4; ++j) { const f32x4 w = wr[64 * j]; a += v[j][0] * w[0] + v[j][1] * w[1] + v[j][2] * w[2] + v[j][3] * w[3]; }
            a = wave_sum(a); if (lane == 0) lg[c] = a; }
        if (lane == 0) {
            float gl[8]; int g = 0;
#pragma unroll
            for (int j = 0; j < 8; ++j) { gl[j] = lg[j] + p.rg_b[j]; }
#pragma unroll
            for (int j = 1; j < 8; ++j) if (gl[j] > gl[g]) g = j;
            float gs = 0.f;
#pragma unroll
            for (int j = 0; j < 8; ++j) gs += expf(gl[j] - gl[g]);
            const float gwt = 1.f / gs;
            float el[8]; int e1 = 0, e2 = -1;
            for (int j = 0; j < 8; ++j) el[j] = lg[8 + g * 8 + j] + p.re_b[g * 8 + j];
            for (int j = 1; j < 8; ++j) if (el[j] > el[e1]) e1 = j;
            for (int j = 0; j < 8; ++j) if (j != e1 && (e2 < 0 || el[j] > el[e2])) e2 = j;
            const float d = expf(el[e2] - el[e1]); const float w1 = 1.f / (1.f + d), w2 = d / (1.f + d);
            const int ea = g * 8 + e1, eb = g * 8 + e2;
            const unsigned pa = atomicAdd(cnt + ea, 1u), pb = atomicAdd(cnt + eb, 1u);
            AE[2 * t] = ea; AE[2 * t + 1] = eb; AP[2 * t] = (int)pa; AP[2 * t + 1] = (int)pb; AW[2 * t] = gwt * w1; AW[2 * t + 1] = gwt * w2;
        }
    }
}
DEVI int build_prefix(const Params& p, int* li) {
    const unsigned* cnt = (const unsigned*)(p.ws + WS_CTL) + CW_CNT;
    __syncthreads();
    if (threadIdx.x == 0) { int acc = 0; for (int e = 0; e < NEXP; ++e) { li[e] = acc; const int c = (int)cnt[e]; const int pd = (c + 255) & ~255; for (int tt = acc / 256; tt < (acc + pd) / 256; ++tt) li[80 + tt] = e; acc += pd; } li[64] = acc; }
    __syncthreads();
    return li[64] / 256;
}
DEVI void phase6b(const Params& p, char* lds) {
    unsigned char* ws = p.ws; int* li = (int*)lds; build_prefix(p, li);
    const unsigned* cnt = (const unsigned*)(ws + WS_CTL) + CW_CNT;
    const int* AE = (const int*)(ws + WS_ROUTE + RT_AE); const int* AP = (const int*)(ws + WS_ROUTE + RT_AP); const float* AW = (const float*)(ws + WS_ROUTE + RT_AW);
    int* AS = (int*)(ws + WS_ROUTE + RT_AS); int* ST = (int*)(ws + WS_ROUTE + RT_ST); float* SW = (float*)(ws + WS_ROUTE + RT_SW);
    for (int a = blockIdx.x * NTHR + threadIdx.x; a < 2 * T; a += gridDim.x * NTHR) { const int slot = li[AE[a]] + AP[a]; AS[a] = slot; ST[slot] = a >> 1; SW[slot] = AW[a]; }
    for (int e = blockIdx.x; e < NEXP; e += gridDim.x) { const int c = (int)cnt[e], pd = (c + 255) & ~255; for (int s = c + threadIdx.x; s < pd; s += NTHR) { ST[li[e] + s] = 0; SW[li[e] + s] = 0.f; } }
}
DEVI void phase7a(const Params& p, char* lds) {
    unsigned char* ws = p.ws; int* li = (int*)(lds + 48 * 1024); const int ntile = build_prefix(p, li);
    const bf16_t* H2 = (const bf16_t*)(ws + WS_H2); const bf16_t* W13 = (const bf16_t*)(ws + WS_W13); const int* ST = (const int*)(ws + WS_ROUTE + RT_ST);
    for (int u = blockIdx.x; u < ntile * 4; u += gridDim.x) { const int tile = u >> 2, pn = u & 3, e = li[80 + tile]; EpiHid E{(bf16_t*)(ws + WS_HID), tile, pn};
        gemm_tile_simple(lds, H2, 1024, ST + tile * 256, W13 + ((size_t)e * 1024 + pn * 256) * 1024, 1024, 1024, E); }
}
DEVI void phase7b(const Params& p, char* lds) {
    unsigned char* ws = p.ws; int* li = (int*)(lds + 48 * 1024); const int ntile = build_prefix(p, li);
    const bf16_t* hid = (const bf16_t*)(ws + WS_HID); const bf16_t* W2 = (const bf16_t*)(ws + WS_W2); const float* SW = (const float*)(ws + WS_ROUTE + RT_SW);
    for (int u = blockIdx.x; u < ntile * 4; u += gridDim.x) { const int tile = u >> 2, pn = u & 3, e = li[80 + tile]; EpiY E{(bf16_t*)(ws + WS_YEXP), SW, tile, pn};
        gemm_tile_simple(lds, hid + (size_t)tile * 256 * EFF, EFF, nullptr, W2 + ((size_t)e * 1024 + pn * 256) * EFF, EFF, EFF, E); }
}
DEVI void phase8(const Params& p) {
    unsigned char* ws = p.ws; const int* AS = (const int*)(ws + WS_ROUTE + RT_AS); const bf16_t* yexp = (const bf16_t*)(ws + WS_YEXP);
    const int lane = threadIdx.x & 63, gw = blockIdx.x * 8 + (threadIdx.x >> 6), NGW = gridDim.x * 8;
    for (int t = gw; t < T; t += NGW) {
        f32x4* xr = (f32x4*)(p.out + (size_t)t * D) + lane; const int s0 = AS[2 * t], s1 = AS[2 * t + 1];
        const u32x2* y0 = (const u32x2*)(yexp + (size_t)s0 * 1024) + lane; const u32x2* y1 = (const u32x2*)(yexp + (size_t)s1 * 1024) + lane;
        f32x4 v[4]; float s = 0.f;
#pragma unroll
        for (int j = 0; j < 4; ++j) { v[j] = xr[64 * j]; const u32x2 a = y0[64 * j], b = y1[64 * j];
            v[j][0] = (v[j][0] + bf2f(a.x & 0xffffu)) + bf2f(b.x & 0xffffu); v[j][1] = (v[j][1] + bf2f(a.x >> 16)) + bf2f(b.x >> 16);
            v[j][2] = (v[j][2] + bf2f(a.y & 0xffffu)) + bf2f(b.y & 0xffffu); v[j][3] = (v[j][3] + bf2f(a.y >> 16)) + bf2f(b.y >> 16);
            s += v[j][0] * v[j][0] + v[j][1] * v[j][1] + v[j][2] * v[j][2] + v[j][3] * v[j][3]; }
        const float rstd = rsqrtf(wave_sum(s) * (1.f / D) + 1e-6f);
#pragma unroll
        for (int j = 0; j < 4; ++j) { const f32x4 w = ((const f32x4*)p.final_w)[lane + 64 * j]; xr[64 * j] = v[j] * rstd * w; }
    }
}

constexpr int NPHASE = 12;
constexpr int LDS_BYTES = 147456;
__global__ void __launch_bounds__(NTHR, 2) mega(Params p) {
    extern __shared__ __attribute__((aligned(16))) char lds[];
    cg::grid_group grid = cg::this_grid();
    const int lo = p.ph_lo, hi = p.ph_hi;
#define PH(k, call) if (lo <= (k) && (k) < hi) { call; if ((k) + 1 < hi) grid.sync(); }
    PH(0, phase0(p, lds))
    PH(1, phase1(p, lds))
    PH(2, phase2a(p, lds))
    PH(3, phase2b(p, lds))
    PH(4, phase3(p, lds))
    PH(5, phase4(p, lds))
    PH(6, phase5(p, lds))
    PH(7, phase6a(p, lds))
    PH(8, phase6b(p, lds))
    PH(9, phase7a(p, lds))
    PH(10, phase7b(p, lds))
    PH(11, phase8(p))
#undef PH
}

extern "C" void kernel_launch(void* const* d_in, const int* in_sizes, int n_in, void* d_out, int out_size, void* d_ws, size_t ws_size, hipStream_t stream) {
    static int grid = 0;
    if (grid == 0) {
        if (n_in != 22 || out_size != T * D || ws_size < WS_END) { fprintf(stderr, "kernel_launch: unexpected shapes (n_in %d out %d ws %zu, need ws >= %zu)\n", n_in, out_size, ws_size, (size_t)WS_END); grid = -1; return; }
        int dev = 0, cus = 0, per_cu = 0; hipGetDevice(&dev); hipDeviceGetAttribute(&cus, hipDeviceAttributeMultiprocessorCount, dev);
        hipFuncSetAttribute((const void*)mega, hipFuncAttributeMaxDynamicSharedMemorySize, LDS_BYTES);
        hipOccupancyMaxActiveBlocksPerMultiprocessor(&per_cu, (const void*)mega, NTHR, LDS_BYTES);
        if (per_cu < 1) { fprintf(stderr, "kernel_launch: occupancy query says %d blocks per CU\n", per_cu); per_cu = 1; }
        grid = cus * per_cu; (void)hipGetLastError();
    }
    if (grid < 0) return;
    hipMemsetAsync((char*)d_ws + WS_CTL, 0, 4096, stream);
    Params p{};
    p.x = (const float*)d_in[0]; p.pos = (const int*)d_in[1]; p.attn_norm_w = (const float*)d_in[2]; p.w_in = (const float*)d_in[3]; p.hg_lb = (const float*)d_in[4];
    p.hg_onw = (const float*)d_in[5]; p.q_norm_w = (const float*)d_in[6]; p.w_uq = (const float*)d_in[7]; p.kv_norm_w = (const float*)d_in[8]; p.w_ukv = (const float*)d_in[9];
    p.w_bra = (const float*)d_in[10]; p.w_brb = (const float*)d_in[11]; p.w_out = (const float*)d_in[12]; p.ffn_norm_w = (const float*)d_in[13]; p.rg_w = (const float*)d_in[14];
    p.rg_b = (const float*)d_in[15]; p.re_w = (const float*)d_in[16]; p.re_b = (const float*)d_in[17]; p.ew1 = (const float*)d_in[18]; p.ew3 = (const float*)d_in[19];
    p.ew2 = (const float*)d_in[20]; p.final_w = (const float*)d_in[21]; p.out = (float*)d_out; p.ws = (unsigned char*)d_ws;
#if MK_MULTI
    for (int ph = 0; ph < NPHASE; ++ph) { p.ph_lo = ph; p.ph_hi = ph + 1; hipLaunchKernelGGL(mega, dim3(grid), dim3(NTHR), LDS_BYTES, stream, p); }
#else
    p.ph_lo = 0; p.ph_hi = NPHASE;
    void* args[] = {&p};
    hipError_t e = hipLaunchCooperativeKernel((const void*)mega, dim3(grid), dim3(NTHR), args, LDS_BYTES, stream);
    if (e != hipSuccess) fprintf(stderr, "cooperative launch failed: %s (grid %d)\n", hipGetErrorString(e), grid);
#endif
}
```

```cpp
#include <hip/hip_runtime.h>
#include <hip/hip_cooperative_groups.h>
#include <cstdio>
#include <cstdint>
namespace cg = cooperative_groups;

#ifndef MK_MULTI
#define MK_MULTI 0
#endif

#define DEVI __device__ __forceinline__
typedef unsigned short bf16_t;
typedef short bf16x8 __attribute__((ext_vector_type(8)));
typedef float f32x4 __attribute__((ext_vector_type(4)));
typedef unsigned u32x4 __attribute__((ext_vector_type(4)));
typedef unsigned u32x2 __attribute__((ext_vector_type(2)));

constexpr int NB = 16, SEQ = 2048, T = NB * SEQ, D = 1024;
constexpr int NTHR = 512;
constexpr int ZH_P = 4096, ZL_P = 768, ZG_P = 2048;
constexpr int NZ = 6912;
constexpr int NEXP = 64, EFF = 512;
constexpr int SLOT_CAP = 2 * T + NEXP * 256;
constexpr int MAX_TILES = SLOT_CAP / 256;

constexpr size_t MiB = 1u << 20;
constexpr size_t WS_CTL = 0;
constexpr size_t WS_WRT = 1 * MiB;
constexpr size_t WS_WIN = 2 * MiB;
constexpr size_t WS_WUQ = 16 * MiB;
constexpr size_t WS_WUKV = 18 * MiB;
constexpr size_t WS_WBR = 20 * MiB;
constexpr size_t WS_WOUT = 24 * MiB;
constexpr size_t WS_COS = 26 * MiB, WS_SIN = 30 * MiB;
constexpr size_t WS_ROUTE = 34 * MiB;
constexpr size_t WS_KPE = 36 * MiB;
constexpr size_t WS_ZH = 40 * MiB;
constexpr size_t WS_Q = 40 * MiB, WS_KN = 136 * MiB, WS_V = 200 * MiB;
constexpr size_t WS_Y = 40 * MiB;
constexpr size_t WS_H2 = 40 * MiB;
constexpr size_t WS_HS = 104 * MiB;
constexpr size_t WS_HID = 264 * MiB;
constexpr size_t WS_YEXP = 40 * MiB;
constexpr size_t WS_OB = 264 * MiB;
constexpr size_t WS_ZL = 296 * MiB;
constexpr size_t WS_ZG = 344 * MiB;
constexpr size_t WS_W13 = 344 * MiB;
constexpr size_t WS_OA = 472 * MiB;
constexpr size_t WS_H = 472 * MiB;
constexpr size_t WS_W2 = 472 * MiB;
constexpr size_t WS_END = 536 * MiB;
constexpr size_t RT_AE = 0, RT_AP = 256 * 1024, RT_AW = 512 * 1024, RT_AS = 768 * 1024, RT_ST = 1024 * 1024, RT_SW = 1536 * 1024;
constexpr int CW_CNT = 0;
constexpr size_t WS_PTRS = 8192;
enum { PT_POS = 0, PT_HGLB, PT_HGONW, PT_RGB, PT_REB, PT_EW1, PT_EW3, PT_EW2, PT_FFNW, PT_FINW, PT_X };
DEVI const void* ptab(const unsigned char* ws, int i) { return (const void*)(((const unsigned long long*)(ws + WS_PTRS))[i]); }

struct Params {
    const float* x; const int* pos; const float* attn_norm_w; const float* w_in; const float* hg_lb; const float* hg_onw;
    const float* q_norm_w; const float* w_uq; const float* kv_norm_w; const float* w_ukv; const float* w_bra; const float* w_brb;
    const float* w_out; const float* ffn_norm_w; const float* rg_w; const float* rg_b; const float* re_w; const float* re_b;
    const float* ew1; const float* ew3; const float* ew2; const float* final_w;
    float* out; unsigned char* ws;
    int ph_lo, ph_hi;
};

DEVI unsigned f2bf(float f) { unsigned u = __builtin_bit_cast(unsigned, f); return (u + 0x7fffu + ((u >> 16) & 1u)) >> 16; }
DEVI float bf2f(unsigned h) { return __builtin_bit_cast(float, h << 16); }
DEVI unsigned pk2(float lo, float hi) { return f2bf(lo) | (f2bf(hi) << 16); }
DEVI float sigmoidf_(float v) { return 1.f / (1.f + __expf(-v)); }
DEVI float siluf_(float v) { return v / (1.f + __expf(-v)); }
DEVI float wave_sum(float v) {
#pragma unroll
    for (int o = 1; o < 64; o <<= 1) v += __shfl_xor(v, o);
    return v;
}
DEVI void store4bf(bf16_t* p, f32x4 v) { u32x2 w; w.x = pk2(v[0], v[1]); w.y = pk2(v[2], v[3]); *(u32x2*)p = w; }
DEVI void unpack8(bf16x8 v, float* f) {
#pragma unroll
    for (int j = 0; j < 8; ++j) f[j] = bf2f((unsigned)(unsigned short)v[j]);
}

template <class ColMap, class KScale>
DEVI void transpose_tile(const float* src, int Nsrc, bf16_t* dst, int ldk, int k0, int n0, ColMap cm, KScale ks, float* scr) {
    const int tid = threadIdx.x;
    {
        const int nl = tid & 63, kq = tid >> 6; const int col = cm(n0 + nl);
#pragma unroll
        for (int i = 0; i < 8; ++i) { const int k = kq * 8 + i; float v = 0.f; if (col >= 0) v = src[(size_t)(k0 + k) * Nsrc + col] * ks(k0 + k); scr[k * 65 + nl] = v; }
    }
    __syncthreads();
    {
        const int nl = tid >> 3, kc = tid & 7; const float* s = scr + (kc * 8) * 65 + nl;
        u32x4 o; o.x = pk2(s[0], s[65]); o.y = pk2(s[2 * 65], s[3 * 65]); o.z = pk2(s[4 * 65], s[5 * 65]); o.w = pk2(s[6 * 65], s[7 * 65]);
        *(u32x4*)(dst + (size_t)(n0 + nl) * ldk + k0 + kc * 8) = o;
    }
    __syncthreads();
}

template <class Epi>
DEVI void gemm_tile_simple(char* lds, const bf16_t* A, int lda, const int* arow, const bf16_t* Bt, int ldb, int K, const Epi& epi) {
    const int tid = threadIdx.x, lane = tid & 63, wid = tid >> 6, wr = wid >> 2, wc = wid & 3, fr = lane & 15, fq = lane >> 4;
    char* As = lds; char* Bs = lds + 256 * 80;
    f32x4 acc[8][4];
#pragma unroll
    for (int m = 0; m < 8; ++m)
#pragma unroll
        for (int n = 0; n < 4; ++n) acc[m][n] = (f32x4){0.f, 0.f, 0.f, 0.f};
    unsigned ao[2], bo[2]; int lo[2];
#pragma unroll
    for (int i = 0; i < 2; ++i) { const int c = tid + 512 * i, row = c >> 2, kc = c & 3; const unsigned ar = arow ? (unsigned)arow[row] : (unsigned)row;
        ao[i] = ar * (unsigned)lda + kc * 8; bo[i] = (unsigned)row * (unsigned)ldb + kc * 8; lo[i] = row * 80 + kc * 16; }
    for (int k0 = 0; k0 < K; k0 += 32) {
        bf16x8 ra[2], rb[2];
#pragma unroll
        for (int i = 0; i < 2; ++i) { ra[i] = *(const bf16x8*)(A + ao[i] + k0); rb[i] = *(const bf16x8*)(Bt + bo[i] + k0); }
        __syncthreads();
#pragma unroll
        for (int i = 0; i < 2; ++i) { *(bf16x8*)(As + lo[i]) = ra[i]; *(bf16x8*)(Bs + lo[i]) = rb[i]; }
        __syncthreads();
        bf16x8 bfr[4];
#pragma unroll
        for (int n = 0; n < 4; ++n) bfr[n] = *(const bf16x8*)(Bs + (wc * 64 + n * 16 + fr) * 80 + fq * 16);
#pragma unroll
        for (int mh = 0; mh < 2; ++mh) { bf16x8 af[4];
#pragma unroll
            for (int m = 0; m < 4; ++m) af[m] = *(const bf16x8*)(As + (wr * 128 + (mh * 4 + m) * 16 + fr) * 80 + fq * 16);
#pragma unroll
            for (int m = 0; m < 4; ++m)
#pragma unroll
                for (int n = 0; n < 4; ++n) acc[mh * 4 + m][n] = __builtin_amdgcn_mfma_f32_16x16x32_bf16(bfr[n], af[m], acc[mh * 4 + m][n], 0, 0, 0); }
    }
#pragma unroll
    for (int m = 0; m < 8; ++m)
#pragma unroll
        for (int n = 0; n < 4; ++n) epi(wr * 128 + m * 16 + fr, wc * 64 + n * 16 + 4 * fq, acc[m][n]);
    __syncthreads();
}

namespace g8 {
#define G8_LAS __attribute__((address_space(3)))
constexpr int BM = 256, BK = 64, HALF = 128, HTB = HALF * BK * 2, STAGE_BYTES = 8 * HTB, NXCD = 8, WGM = 8;
__host__ __device__ __forceinline__ int lds_byte(int r, int c) { const int st = (r >> 4) * 2 + (c >> 5), rr = r & 15, cc = c & 31, ob = rr * 64 + cc * 2; return st * 1024 + (ob ^ (((ob >> 9) & 1) << 5)); }
__host__ __device__ __forceinline__ void stage_rc(int b, int& R, int& C) { const int st = b / 1024, sb = b % 1024, swz = sb ^ (((sb >> 9) & 1) << 5); R = (st >> 1) * 16 + swz / 64; C = (st & 1) * 32 + (swz % 64) / 2; }
struct Unit { int pm, pn; const char* a; const char* b; };
struct DenseOrder {
    const char* A; const char* Bt; size_t tstepA, tstepB; int nM, nN, nwg, G, c;
    DEVI void init(const void* A_, int lda, const void* Bt_, int ldb, int M, int N) { A = (const char*)A_; Bt = (const char*)Bt_; tstepA = (size_t)BM * lda * 2; tstepB = (size_t)BM * ldb * 2;
        nM = M / BM; nN = N / BM; nwg = nM * nN; G = gridDim.x; c = blockIdx.x; }
    DEVI bool next(int i, Unit& u) const {
        const long L = (long)i * G + c; if (L >= nwg) return false;
        int wgid = (int)L; { const int q = nwg / NXCD, r = nwg % NXCD, xcd = wgid % NXCD, off = wgid / NXCD; wgid = (xcd < r ? xcd * (q + 1) : r * (q + 1) + (xcd - r) * q) + off; }
        const int nig = WGM * nN, gid = wgid / nig, fm = gid * WGM, gsz = (nM - fm) < WGM ? (nM - fm) : WGM;
        u.pm = fm + ((wgid % nig) % gsz); u.pn = (wgid % nig) / gsz; u.a = A + (size_t)u.pm * tstepA; u.b = Bt + (size_t)u.pn * tstepB; return true;
    }
};
template <class Epi, class Sched, bool ALIGN_EPI>
DEVI void gemm_phase(G8_LAS unsigned char* lds, const int lda, const int ldb, const int K, const Sched& S, const Epi& E) {
    const int tid = threadIdx.x, wid = __builtin_amdgcn_readfirstlane(tid >> 6), lane = tid & 63, wr = wid >> 2, wc = wid & 3, fr = lane & 15, fq = lane >> 4;
    const int nt = K / BK;
    unsigned voffA[2], voffB[2];
#pragma unroll
    for (int i = 0; i < 2; ++i) { int R, C; stage_rc(tid * 16 + i * 8192, R, C); voffA[i] = (unsigned)(R * lda + C) * 2u; voffB[i] = (unsigned)(R * ldb + C) * 2u; }
    const size_t kstep = (size_t)(BK * 2);
    const size_t hstepA = (size_t)HALF * lda * 2, hstepB = (size_t)HALF * ldb * 2;
    const unsigned ldsw = (unsigned)wid * 1024u;
    const int aoff = lds_byte(wr * 64 + fr, fq * 8), boff = lds_byte(wc * 32 + fr, fq * 8);
#define G8_SA(b, h) (((b) * 2 + (h)) * HTB)
#define G8_SB(b, h) ((4 + (b) * 2 + (h)) * HTB)
#define G8_STAGE(bufoff, gbase, voff) do { _Pragma("unroll") for (int _i = 0; _i < 2; ++_i) \
        __builtin_amdgcn_global_load_lds((const unsigned*)((const char*)(gbase) + (voff)[_i]), (G8_LAS unsigned*)(lds + (bufoff) + ldsw + _i * 8192), 16, 0, 0); } while (0)
#define G8_LDA(dst, b, h) do { _Pragma("unroll") for (int m = 0; m < 4; ++m) _Pragma("unroll") for (int k = 0; k < 2; ++k) dst[m][k] = *(const G8_LAS bf16x8*)(lds + G8_SA(b, h) + aoff + m * 2048 + k * 1024); } while (0)
#define G8_LDB(dst, b, h) do { _Pragma("unroll") for (int n = 0; n < 2; ++n) _Pragma("unroll") for (int k = 0; k < 2; ++k) dst[n][k] = *(const G8_LAS bf16x8*)(lds + G8_SB(b, h) + boff + n * 2048 + k * 1024); } while (0)
#define G8_MMA(ai, bj, At, Bt) do { __builtin_amdgcn_s_setprio(1); _Pragma("unroll") for (int m = 0; m < 4; ++m) _Pragma("unroll") for (int n = 0; n < 2; ++n) _Pragma("unroll") for (int k = 0; k < 2; ++k) \
        acc[ai][bj][m][n] = __builtin_amdgcn_mfma_f32_16x16x32_bf16(Bt[n][k], At[m][k], acc[ai][bj][m][n], 0, 0, 0); __builtin_amdgcn_s_setprio(0); } while (0)
#define G8_WAIT_V(n) asm volatile("s_waitcnt vmcnt(" #n ")" ::: "memory")
#define G8_WAIT_L(n) asm volatile("s_waitcnt lgkmcnt(" #n ")" ::: "memory")
#define G8_BAR __builtin_amdgcn_s_barrier()
#define G8_SCHED __builtin_amdgcn_sched_barrier(0)
    Unit cur, nxt; int ui = 0;
    if (!S.next(0, cur)) return;
    f32x4 acc[2][2][4][2];
#pragma unroll
    for (int a = 0; a < 2; ++a)
#pragma unroll
        for (int b = 0; b < 2; ++b)
#pragma unroll
            for (int m = 0; m < 4; ++m)
#pragma unroll
                for (int n = 0; n < 2; ++n) acc[a][b][m][n] = (f32x4){0.f, 0.f, 0.f, 0.f};
    bf16x8 At[4][2], B0[2][2], B1[2][2];
    const char* cA = cur.a; const char* cB = cur.b;
    G8_STAGE(G8_SB(0, 0), cB, voffB); G8_STAGE(G8_SB(0, 1), cB + hstepB, voffB); G8_STAGE(G8_SA(0, 0), cA, voffA); G8_STAGE(G8_SA(0, 1), cA + hstepA, voffA);
    if (wr == 1) G8_BAR;
    G8_WAIT_V(2); G8_BAR;
    G8_STAGE(G8_SB(1, 0), cB + kstep, voffB); G8_STAGE(G8_SA(1, 0), cA + kstep, voffA); G8_STAGE(G8_SB(1, 1), cB + hstepB + kstep, voffB);
    G8_WAIT_V(6); G8_BAR;
    for (;;) {
        const bool has_next = S.next(ui + 1, nxt);
        const char* nA = has_next ? nxt.a : cA; const char* nB = has_next ? nxt.b : cB;
#pragma unroll 1
        for (int t = 0; t < nt; t += 2) {
            const bool last = (t == nt - 2);
            const char* a1 = cA + (size_t)(t + 1) * kstep;
            const char* a2 = last ? nA : cA + (size_t)(t + 2) * kstep; const char* b2 = last ? nB : cB + (size_t)(t + 2) * kstep;
            const char* a3 = a2 + kstep; const char* b3 = b2 + kstep;
            G8_LDB(B0, 0, 0); G8_LDB(B1, 0, 1); G8_SCHED; G8_LDA(At, 0, 0); G8_STAGE(G8_SA(1, 1), a1 + hstepA, voffA);
            G8_WAIT_V(8); G8_WAIT_L(0); G8_BAR; G8_MMA(0, 0, At, B0); G8_MMA(0, 1, At, B1); G8_BAR; G8_SCHED;
            G8_LDA(At, 0, 1); G8_STAGE(G8_SB(0, 0), b2, voffB); G8_STAGE(G8_SB(0, 1), b2 + hstepB, voffB); G8_STAGE(G8_SA(0, 0), a2, voffA);
            G8_WAIT_V(8); G8_WAIT_L(0); G8_BAR; G8_MMA(1, 0, At, B0); G8_MMA(1, 1, At, B1); G8_BAR; G8_SCHED;
            G8_LDB(B0, 1, 0); G8_LDB(B1, 1, 1); G8_SCHED; G8_LDA(At, 1, 0); G8_STAGE(G8_SA(0, 1), a2 + hstepA, voffA);
            G8_WAIT_V(8); G8_WAIT_L(0); G8_BAR; G8_MMA(0, 0, At, B0); G8_MMA(0, 1, At, B1); G8_BAR; G8_SCHED;
            G8_LDA(At, 1, 1); G8_STAGE(G8_SB(1, 0), b3, voffB); G8_STAGE(G8_SB(1, 1), b3 + hstepB, voffB); G8_STAGE(G8_SA(1, 0), a3, voffA);
            G8_WAIT_V(8); G8_WAIT_L(0); G8_BAR; G8_MMA(1, 0, At, B0); G8_MMA(1, 1, At, B1); G8_BAR; G8_SCHED;
        }
        if constexpr (ALIGN_EPI) { if (wr == 0) G8_BAR; }
        E(acc, cur, wr, wc, fr, fq);
        if (!has_next) break;
#pragma unroll
        for (int a = 0; a < 2; ++a)
#pragma unroll
            for (int b = 0; b < 2; ++b)
#pragma unroll
                for (int m = 0; m < 4; ++m)
#pragma unroll
                    for (int n = 0; n < 2; ++n) acc[a][b][m][n] = (f32x4){0.f, 0.f, 0.f, 0.f};
        cur = nxt; cA = nA; cB = nB; ++ui;
        if constexpr (ALIGN_EPI) { if (wr == 1) G8_BAR; }
    }
    G8_WAIT_V(0);
    if constexpr (!ALIGN_EPI) { if (wr == 0) G8_BAR; }
    G8_BAR;
#undef G8_SA
#undef G8_SB
#undef G8_STAGE
#undef G8_LDA
#undef G8_LDB
#undef G8_MMA
#undef G8_WAIT_V
#undef G8_WAIT_L
#undef G8_BAR
#undef G8_SCHED
}
template <class F> struct Epi4 { F f;
    DEVI void operator()(const f32x4 (&acc)[2][2][4][2], const Unit& u, int wr, int wc, int fr, int fq) const {
#pragma unroll
        for (int ai = 0; ai < 2; ++ai)
#pragma unroll
            for (int m = 0; m < 4; ++m) {
#pragma unroll
                for (int bj = 0; bj < 2; ++bj)
#pragma unroll
                    for (int n = 0; n < 2; ++n) f(u.pm, u.pn, ai * 128 + wr * 64 + m * 16 + fr, bj * 128 + wc * 32 + n * 16 + 4 * fq, acc[ai][bj][m][n]);
                asm volatile("" ::: "memory"); }
    } };
}

struct EpiZ { unsigned char* ws;
    DEVI void operator()(int pm, int pn, int r, int c, f32x4 v) const {
        const size_t row = (size_t)pm * 256 + r; const int col = pn * 256 + c;
        const bool s0 = pn < 16, s1 = pn < 19;
        const size_t boff = s0 ? WS_ZH : (s1 ? WS_ZL : WS_ZG); const int pitch = s0 ? ZH_P : (s1 ? ZL_P : ZG_P), co = s0 ? 0 : (s1 ? 4096 : 4864);
        if (!s1) { v[0] = sigmoidf_(v[0]); v[1] = sigmoidf_(v[1]); v[2] = sigmoidf_(v[2]); v[3] = sigmoidf_(v[3]); }
        store4bf((bf16_t*)(ws + boff) + row * pitch + (col - co), v);
    } };
struct EpiQ { bf16_t* q; const float* cosT; const float* sinT;
    DEVI void operator()(int pm, int pn, int r, int c, f32x4 v) const {
        const size_t row = (size_t)pm * 256 + r; const int col = pn * 256 + c; const int cc = col % 192;
        if (cc >= 128) { const int i = (cc - 128) >> 1; const float c0 = cosT[row * 32 + i], s0 = sinT[row * 32 + i], c1 = cosT[row * 32 + i + 1], s1 = sinT[row * 32 + i + 1];
            f32x4 o; o[0] = v[0] * c0 - v[1] * s0; o[1] = v[1] * c0 + v[0] * s0; o[2] = v[2] * c1 - v[3] * s1; o[3] = v[3] * c1 + v[2] * s1; v = o; }
        store4bf(q + row * 1536 + col, v);
    } };
struct EpiKV { bf16_t* kn; bf16_t* vv;
    DEVI void operator()(int pm, int pn, int r, int c, f32x4 v) const {
        const size_t row = (size_t)pm * 256 + r; const int col = pn * 256 + c; const int hh = col >> 8, cc = col & 255;
        if (cc < 128) store4bf(kn + row * 1024 + hh * 128 + cc, v); else store4bf(vv + row * 1024 + hh * 128 + (cc - 128), v);
    } };
struct EpiBr { float* tmp; const bf16_t* zg; bf16_t* y; int second;
    DEVI void operator()(int pm, int pn, int r, int c, f32x4 v) const {
        const size_t row = (size_t)pm * 256 + r; const int col = pn * 256 + c; const u32x2 g = *(const u32x2*)(zg + row * ZG_P + second * 1024 + col);
        f32x4 o; o[0] = v[0] * bf2f(g.x & 0xffffu); o[1] = v[1] * bf2f(g.x >> 16); o[2] = v[2] * bf2f(g.y & 0xffffu); o[3] = v[3] * bf2f(g.y >> 16);
        if (!second) *(f32x4*)(tmp + row * 1024 + col) = o;
        else { const f32x4 t = *(const f32x4*)(tmp + row * 1024 + col); store4bf(y + row * 1024 + col, t + o); }
    } };
struct EpiOut { const float* x; float* x2;
    DEVI void operator()(int pm, int pn, int r, int c, f32x4 v) const {
        const size_t off = ((size_t)pm * 256 + r) * 1024 + pn * 256 + c; const f32x4 xv = *(const f32x4*)(x + off); *(f32x4*)(x2 + off) = xv + v;
    } };
struct EpiHid { bf16_t* hid;
    DEVI void operator()(int tile, int pn, int r, int c, f32x4 v) const {
        const size_t slot = (size_t)tile * 256 + r; const int hc = (pn * 256 + c) >> 1;
        *(unsigned*)(hid + slot * EFF + hc) = pk2(siluf_(v[0]) * v[2], siluf_(v[1]) * v[3]);
    } };
struct EpiY { bf16_t* yexp; const float* sw;
    DEVI void operator()(int tile, int pn, int r, int c, f32x4 v) const {
        const size_t slot = (size_t)tile * 256 + r; const float w = sw[slot]; store4bf(yexp + slot * 1024 + pn * 256 + c, v * w);
    } };

DEVI void phase0(const Params& p, char* lds) {
    float* scr = (float*)lds; unsigned char* ws = p.ws;
    bf16_t* WinT = (bf16_t*)(ws + WS_WIN); bf16_t* WuqT = (bf16_t*)(ws + WS_WUQ); bf16_t* WukvT = (bf16_t*)(ws + WS_WUKV);
    bf16_t* WbrT = (bf16_t*)(ws + WS_WBR); bf16_t* WoutT = (bf16_t*)(ws + WS_WOUT);
    constexpr int I_IN = (NZ / 64) * 16, I_UQ = 24 * 6, I_UKV = 32 * 4, I_BR = 16 * 16, I_OUT = 16 * 16;
    constexpr int NIT = I_IN + I_UQ + I_UKV + 2 * I_BR + I_OUT;
    for (int it = blockIdx.x; it < NIT; it += gridDim.x) {
        int r = it;
        if (r < I_IN) { const int nb = r / 16, kb = r % 16; const float* nw = p.attn_norm_w;
            transpose_tile(p.w_in, 6848, WinT, 1024, kb * 64, nb * 64, [](int n) { return n < 4800 ? n : (n < 4864 ? -1 : n - 64); }, [nw](int k) { return nw[k]; }, scr); continue; }
        r -= I_IN;
        if (r < I_UQ) { const int nb = r / 6, kb = r % 6; const float* nw = p.q_norm_w;
            transpose_tile(p.w_uq, 1536, WuqT, 384, kb * 64, nb * 64,
                           [](int n) { const int hh = n / 192, c = n % 192; if (c < 128) return n; const int rr = c - 128; return hh * 192 + 128 + (rr & 1) * 32 + (rr >> 1); },
                           [nw](int k) { return nw[k] * 0.07216878364870322f; }, scr); continue; }
        r -= I_UQ;
        if (r < I_UKV) { const int nb = r / 4, kb = r % 4; const float* nw = p.kv_norm_w;
            transpose_tile(p.w_ukv, 2048, WukvT, 256, kb * 64, nb * 64, [](int n) { return n; }, [nw](int k) { return nw[k]; }, scr); continue; }
        r -= I_UKV;
        if (r < I_BR) { const int nb = r / 16, kb = r % 16;
            transpose_tile(p.w_bra, 1024, WbrT, 2048, kb * 64, nb * 64, [](int n) { return n; }, [](int) { return 1.f; }, scr); continue; }
        r -= I_BR;
        if (r < I_BR) { const int nb = r / 16, kb = r % 16;
            transpose_tile(p.w_brb, 1024, WbrT + 1024, 2048, kb * 64, nb * 64, [](int n) { return n; }, [](int) { return 1.f; }, scr); continue; }
        r -= I_BR;
        { const int nb = r / 16, kb = r % 16;
            transpose_tile(p.w_out, 1024, WoutT, 1024, kb * 64, nb * 64, [](int n) { return n; }, [](int) { return 1.f; }, scr); }
    }
    if (blockIdx.x == 0 && threadIdx.x == 0) { unsigned long long* tb = (unsigned long long*)(ws + WS_PTRS);
        tb[PT_POS] = (unsigned long long)p.pos; tb[PT_HGLB] = (unsigned long long)p.hg_lb; tb[PT_HGONW] = (unsigned long long)p.hg_onw; tb[PT_RGB] = (unsigned long long)p.rg_b; tb[PT_REB] = (unsigned long long)p.re_b;
        tb[PT_EW1] = (unsigned long long)p.ew1; tb[PT_EW3] = (unsigned long long)p.ew3; tb[PT_EW2] = (unsigned long long)p.ew2; tb[PT_FFNW] = (unsigned long long)p.ffn_norm_w; tb[PT_FINW] = (unsigned long long)p.final_w; tb[PT_X] = (unsigned long long)p.x; }
    float* WrT = (float*)(ws + WS_WRT);
    for (int e = blockIdx.x * NTHR + threadIdx.x; e < 72 * 1024; e += gridDim.x * NTHR) { const int c = e >> 10, k = e & 1023;
        const float w = c < 8 ? p.rg_w[k * 8 + c] : p.re_w[k * 64 + (c - 8)]; WrT[e] = w * p.ffn_norm_w[k]; }
    bf16_t* H = (bf16_t*)(ws + WS_H);
    const int lane = threadIdx.x & 63, gw = blockIdx.x * 8 + (threadIdx.x >> 6), NGW = gridDim.x * 8;
    for (int m = gw; m < T; m += NGW) {
        const f32x4* xr = (const f32x4*)(p.x + (size_t)m * D) + lane; f32x4 v[4]; float s = 0.f;
#pragma unroll
        for (int j = 0; j < 4; ++j) { v[j] = xr[64 * j]; s += v[j][0] * v[j][0] + v[j][1] * v[j][1] + v[j][2] * v[j][2] + v[j][3] * v[j][3]; }
        const float rstd = rsqrtf(wave_sum(s) * (1.f / D) + 1e-6f);
        u32x2* o = (u32x2*)(H + (size_t)m * D) + lane;
#pragma unroll
        for (int j = 0; j < 4; ++j) { u32x2 w; w.x = pk2(v[j][0] * rstd, v[j][1] * rstd); w.y = pk2(v[j][2] * rstd, v[j][3] * rstd); o[64 * j] = w; }
    }
}

DEVI void phase1(const Params& p, char* lds) {
    unsigned char* ws = p.ws;
    g8::DenseOrder S; S.init(ws + WS_H, D, ws + WS_WIN, D, T, NZ);
    g8::Epi4<EpiZ> E{{ws}};
    g8::gemm_phase<g8::Epi4<EpiZ>, g8::DenseOrder, true>((G8_LAS unsigned char*)lds, D, D, D, S, E);
}

DEVI void hgrn_chain(const Params& p, char* lds, int b, int h) {
    float* qv = (float*)lds; float* fv = qv + 4096; float* kv = fv + 4096; float* vv = kv + 4096; float* ov = vv + 4096; float* red = ov + 4096;
    const bf16_t* zh = (const bf16_t*)(p.ws + WS_ZH); bf16_t* oa = (bf16_t*)(p.ws + WS_OA);
    const float* hglb = (const float*)ptab(p.ws, PT_HGLB); const float* hgonw = (const float*)ptab(p.ws, PT_HGONW);
    const int tid = threadIdx.x, lane = tid & 63, wid = tid >> 6, v = tid & 127, kq = tid >> 7;
    float S[32];
#pragma unroll
    for (int j = 0; j < 32; ++j) S[j] = 0.f;
    const int lrow = tid >> 4, c8 = (tid & 15) * 8;
    float lbv[8];
#pragma unroll
    for (int j = 0; j < 8; ++j) { const float a0 = hglb[h * 128 + c8 + j], a1 = hglb[1024 + h * 128 + c8 + j]; lbv[j] = 1.f / (1.f + expf(a1 - a0)); }
    const float nw0 = hgonw[lane], nw1 = hgonw[64 + lane];
    for (int chunk = 0; chunk < SEQ / 32; ++chunk) {
        const size_t t0 = (size_t)b * SEQ + chunk * 32;
        __syncthreads();
        {
            const bf16_t* zr = zh + (t0 + lrow) * ZH_P + h * 128 + c8;
            float hq[8], hf[8], hi[8]; unpack8(*(const bf16x8*)zr, hq); unpack8(*(const bf16x8*)(zr + 1024), hf); unpack8(*(const bf16x8*)(zr + 2048), hi);
#pragma unroll
            for (int j = 0; j < 8; ++j) { const int o = lrow * 128 + c8 + j; qv[o] = siluf_(hq[j]) * 0.08838834764831845f;
                const float fg = lbv[j] + (1.f - lbv[j]) * sigmoidf_(hf[j]); fv[o] = fg; kv[o] = 1.f - fg; vv[o] = hi[j]; }
        }
        __syncthreads();
        for (int t = 0; t < 32; ++t) {
            const float vt = vv[t * 128 + v]; float part = 0.f; const float* fr_ = fv + t * 128 + kq * 32; const float* kr_ = kv + t * 128 + kq * 32; const float* qr_ = qv + t * 128 + kq * 32;
#pragma unroll
            for (int j = 0; j < 32; ++j) { S[j] = fr_[j] * S[j] + kr_[j] * vt; part += qr_[j] * S[j]; }
            red[((t & 1) * 4 + kq) * 128 + v] = part;
            __syncthreads();
            if (kq == 0) { const float* rr = red + (t & 1) * 512 + v; ov[t * 128 + v] = (rr[0] + rr[128]) + (rr[256] + rr[384]); }
        }
        __syncthreads();
#pragma unroll
        for (int rr = 0; rr < 4; ++rr) { const int r = wid * 4 + rr; const float a = ov[r * 128 + lane], bb = ov[r * 128 + 64 + lane];
            const float rstd = rsqrtf(wave_sum(a * a + bb * bb) * (1.f / 128.f) + 1e-6f);
            const bf16_t* gp = zh + (t0 + r) * ZH_P + 3072 + h * 128; const float g0 = bf2f(gp[lane]), g1 = bf2f(gp[64 + lane]);
            bf16_t* op = oa + (t0 + r) * 1024 + h * 128; op[lane] = (bf16_t)f2bf(a * rstd * nw0 * siluf_(g0)); op[64 + lane] = (bf16_t)f2bf(bb * rstd * nw1 * siluf_(g1)); }
    }
}
constexpr int HL_A = 0, HL_B = 17408, HL_BT = 34816, HL_VT = 53248, HL_AT = 71680, HL_ST = 80896, HL_SEG = 115712, HL_SS = 119808;
DEVI void hgrn_chain_mfma(const Params& p, char* lds, int b, int h) {
    const bf16_t* zh = (const bf16_t*)(p.ws + WS_ZH); bf16_t* oa = (bf16_t*)(p.ws + WS_OA);
    const float* hglb = (const float*)ptab(p.ws, PT_HGLB); const float* hgonw = (const float*)ptab(p.ws, PT_HGONW);
    const int tid = threadIdx.x, lane = tid & 63, wid = __builtin_amdgcn_readfirstlane(tid >> 6), fr = lane & 15, g4 = lane >> 4;
    const int k2 = lane * 2, seg = wid;
    float lb[2];
#pragma unroll
    for (int e = 0; e < 2; ++e) { const float a0 = hglb[h * 128 + k2 + e], a1 = hglb[1024 + h * 128 + k2 + e]; lb[e] = 1.f / (1.f + __expf(a1 - a0)); }
    f32x4 S[8];
#pragma unroll
    for (int n = 0; n < 8; ++n) S[n] = (f32x4){0.f, 0.f, 0.f, 0.f};
    const bf16_t* zb = zh + (size_t)b * SEQ * ZH_P + h * 128;
    float* segs = (float*)(lds + HL_SEG); float* lss = (float*)(lds + HL_SS);
    unsigned rq[8], rf[8], rv[8];
#pragma unroll
    for (int i = 0; i < 8; ++i) { const bf16_t* r = zb + (size_t)(seg * 8 + i) * ZH_P + k2; rq[i] = *(const unsigned*)r; rf[i] = *(const unsigned*)(r + 1024); rv[i] = *(const unsigned*)(r + 2048); }
    const int tt = wid >> 1, vh = wid & 1;
    for (int c = 0; c < SEQ / 64; ++c) {
        const int t0 = c * 64;
        float cs[8][2], qq[8][2], kk[8][2]; float run[2] = {0.f, 0.f};
#pragma unroll
        for (int i = 0; i < 8; ++i)
#pragma unroll
            for (int e = 0; e < 2; ++e) { const float f = bf2f(e ? rf[i] >> 16 : rf[i] & 0xffffu), q = bf2f(e ? rq[i] >> 16 : rq[i] & 0xffffu);
                const float fg = lb[e] + (1.f - lb[e]) * sigmoidf_(f); run[e] += __logf(fg); cs[i][e] = run[e]; kk[i][e] = 1.f - fg; qq[i][e] = siluf_(q) * 0.08838834764831845f; }
        __syncthreads();
        *(float2*)(segs + seg * 128 + k2) = make_float2(run[0], run[1]);
#pragma unroll
        for (int e = 0; e < 2; ++e) { u32x4 w;
            w.x = e ? (rv[0] >> 16) | (rv[1] & 0xffff0000u) : (rv[0] & 0xffffu) | (rv[1] << 16); w.y = e ? (rv[2] >> 16) | (rv[3] & 0xffff0000u) : (rv[2] & 0xffffu) | (rv[3] << 16);
            w.z = e ? (rv[4] >> 16) | (rv[5] & 0xffff0000u) : (rv[4] & 0xffffu) | (rv[5] << 16); w.w = e ? (rv[6] >> 16) | (rv[7] & 0xffff0000u) : (rv[6] & 0xffffu) | (rv[7] << 16);
            *(u32x4*)(lds + HL_VT + (k2 + e) * 144 + seg * 16) = w; }
        __syncthreads();
        {
            float off[2] = {0.f, 0.f}, bm[2] = {0.f, 0.f};
#pragma unroll
            for (int s_ = 0; s_ < 8; ++s_) { const float2 v = *(const float2*)(segs + s_ * 128 + k2); if (s_ < seg) { off[0] += v.x; off[1] += v.y; } if (s_ < 4) { bm[0] += v.x; bm[1] += v.y; } }
            unsigned bt[2][4];
#pragma unroll
            for (int i = 0; i < 8; ++i) { float av[2], bv[2];
#pragma unroll
                for (int e = 0; e < 2; ++e) { const float ea = __expf(cs[i][e] + off[e] - bm[e]); av[e] = qq[i][e] * ea; bv[e] = kk[i][e] * __builtin_amdgcn_rcpf(ea); }
                *(unsigned*)(lds + HL_A + (seg * 8 + i) * 272 + k2 * 2) = pk2(av[0], av[1]);
                const unsigned pb = pk2(bv[0], bv[1]); *(unsigned*)(lds + HL_B + (seg * 8 + i) * 272 + k2 * 2) = pb;
                if (i & 1) { bt[0][i >> 1] |= pb << 16; bt[1][i >> 1] |= pb & 0xffff0000u; } else { bt[0][i >> 1] = pb & 0xffffu; bt[1][i >> 1] = pb >> 16; } }
#pragma unroll
            for (int e = 0; e < 2; ++e) { u32x4 w = {bt[e][0], bt[e][1], bt[e][2], bt[e][3]}; *(u32x4*)(lds + HL_BT + (k2 + e) * 144 + seg * 16) = w; }
        }
        f32x4 bmid = {0.f, 0.f, 0.f, 0.f}, blast = {0.f, 0.f, 0.f, 0.f};
#pragma unroll
        for (int s_ = 0; s_ < 8; ++s_) { const f32x4 v = *(const f32x4*)(segs + s_ * 128 + 16 * wid + 4 * g4); blast += v; if (s_ < 4) bmid += v; }
        {
            f32x4 em; em[0] = __expf(bmid[0]); em[1] = __expf(bmid[1]); em[2] = __expf(bmid[2]); em[3] = __expf(bmid[3]);
#pragma unroll
            for (int n = 0; n < 8; ++n) { u32x2 w; w.x = pk2(S[n][0] * em[0], S[n][1] * em[1]); w.y = pk2(S[n][2] * em[2], S[n][3] * em[3]); *(u32x2*)(lds + HL_ST + (16 * n + fr) * 272 + (16 * wid + 4 * g4) * 2) = w; }
        }
        if (c + 1 < SEQ / 64) {
#pragma unroll
            for (int i = 0; i < 8; ++i) { const bf16_t* r = zb + (size_t)(t0 + 64 + seg * 8 + i) * ZH_P + k2; rq[i] = *(const unsigned*)r; rf[i] = *(const unsigned*)(r + 1024); rv[i] = *(const unsigned*)(r + 2048); }
        }
        __syncthreads();
#pragma unroll
        for (int si = 0; si < 2; ++si) { const int ss = 2 * vh + si; f32x4 acc = {0.f, 0.f, 0.f, 0.f};
            if (ss <= tt) {
#pragma unroll
                for (int kk4 = 0; kk4 < 4; ++kk4) { const bf16x8 a = *(const bf16x8*)(lds + HL_B + (16 * ss + fr) * 272 + (32 * kk4 + 8 * g4) * 2); const bf16x8 bb = *(const bf16x8*)(lds + HL_A + (16 * tt + fr) * 272 + (32 * kk4 + 8 * g4) * 2);
                    acc = __builtin_amdgcn_mfma_f32_16x16x32_bf16(a, bb, acc, 0, 0, 0); }
                if (ss == tt) {
#pragma unroll
                    for (int i = 0; i < 4; ++i) if (4 * g4 + i > fr) acc[i] = 0.f; }
            }
            u32x2 w; w.x = pk2(acc[0], acc[1]); w.y = pk2(acc[2], acc[3]); *(u32x2*)(lds + HL_AT + (16 * tt + fr) * 144 + (16 * ss + 4 * g4) * 2) = w; }
        __syncthreads();
        f32x4 o[4];
#pragma unroll
        for (int n = 0; n < 4; ++n) o[n] = (f32x4){0.f, 0.f, 0.f, 0.f};
        for (int ks = 0; ks <= (tt >> 1); ++ks) { const bf16x8 bb = *(const bf16x8*)(lds + HL_AT + (16 * tt + fr) * 144 + (32 * ks + 8 * g4) * 2);
#pragma unroll
            for (int n = 0; n < 4; ++n) { const bf16x8 a = *(const bf16x8*)(lds + HL_VT + (16 * (4 * vh + n) + fr) * 144 + (32 * ks + 8 * g4) * 2); o[n] = __builtin_amdgcn_mfma_f32_16x16x32_bf16(a, bb, o[n], 0, 0, 0); } }
#pragma unroll
        for (int kk4 = 0; kk4 < 4; ++kk4) { const bf16x8 bb = *(const bf16x8*)(lds + HL_A + (16 * tt + fr) * 272 + (32 * kk4 + 8 * g4) * 2);
#pragma unroll
            for (int n = 0; n < 4; ++n) { const bf16x8 a = *(const bf16x8*)(lds + HL_ST + (16 * (4 * vh + n) + fr) * 272 + (32 * kk4 + 8 * g4) * 2); o[n] = __builtin_amdgcn_mfma_f32_16x16x32_bf16(a, bb, o[n], 0, 0, 0); } }
        { float ssq = 0.f;
#pragma unroll
          for (int n = 0; n < 4; ++n) ssq += o[n][0] * o[n][0] + o[n][1] * o[n][1] + o[n][2] * o[n][2] + o[n][3] * o[n][3];
          ssq += __shfl_xor(ssq, 16); ssq += __shfl_xor(ssq, 32); if (g4 == 0) lss[vh * 64 + 16 * tt + fr] = ssq; }
        {
            f32x4 U[8];
#pragma unroll
            for (int n = 0; n < 8; ++n) U[n] = (f32x4){0.f, 0.f, 0.f, 0.f};
#pragma unroll
            for (int ks = 0; ks < 2; ++ks) { const bf16x8 a = *(const bf16x8*)(lds + HL_BT + (16 * wid + fr) * 144 + (32 * ks + 8 * g4) * 2);
#pragma unroll
                for (int n = 0; n < 8; ++n) { const bf16x8 bb = *(const bf16x8*)(lds + HL_VT + (16 * n + fr) * 144 + (32 * ks + 8 * g4) * 2); U[n] = __builtin_amdgcn_mfma_f32_16x16x32_bf16(a, bb, U[n], 0, 0, 0); } }
            f32x4 el, elm;
#pragma unroll
            for (int i = 0; i < 4; ++i) { el[i] = __expf(blast[i]); elm[i] = __expf(blast[i] - bmid[i]); }
#pragma unroll
            for (int n = 0; n < 8; ++n) S[n] = S[n] * el + U[n] * elm;
        }
        __syncthreads();
        {
            const int t = 16 * tt + fr; const float rstd = rsqrtf((lss[t] + lss[64 + t]) * (1.f / 128.f) + 1e-6f);
            const size_t trow = (size_t)b * SEQ + t0 + t; const bf16_t* gp = zh + trow * ZH_P + 3072 + h * 128; bf16_t* op = oa + trow * 1024 + h * 128;
#pragma unroll
            for (int n = 0; n < 4; ++n) { const int v0 = 16 * (4 * vh + n) + 4 * g4; const u32x2 gg = *(const u32x2*)(gp + v0); const f32x4 nw = *(const f32x4*)(hgonw + v0);
                f32x4 r; r[0] = o[n][0] * rstd * nw[0] * siluf_(bf2f(gg.x & 0xffffu)); r[1] = o[n][1] * rstd * nw[1] * siluf_(bf2f(gg.x >> 16));
                r[2] = o[n][2] * rstd * nw[2] * siluf_(bf2f(gg.y & 0xffffu)); r[3] = o[n][3] * rstd * nw[3] * siluf_(bf2f(gg.y >> 16)); store4bf(op + v0, r); }
        }
    }
    __syncthreads();
}
DEVI void mla_prep(const Params& p, int chunk) {
    bf16_t* zl = (bf16_t*)(p.ws + WS_ZL); float* cosT = (float*)(p.ws + WS_COS); float* sinT = (float*)(p.ws + WS_SIN); const int* posp = (const int*)ptab(p.ws, PT_POS);
    const int lane = threadIdx.x & 63, wid = threadIdx.x >> 6;
    for (int rr = wid; rr < 256; rr += 8) { const size_t t = (size_t)chunk * 256 + rr; bf16_t* zr = zl + t * ZL_P;
        float cq[6], ck[4]; float s = 0.f, s2 = 0.f;
#pragma unroll
        for (int j = 0; j < 6; ++j) { cq[j] = bf2f(zr[lane + 64 * j]); s += cq[j] * cq[j]; }
#pragma unroll
        for (int j = 0; j < 4; ++j) { ck[j] = bf2f(zr[384 + lane + 64 * j]); s2 += ck[j] * ck[j]; }
        const float kr = bf2f(zr[640 + lane]);
        const float r1 = rsqrtf(wave_sum(s) * (1.f / 384.f) + 1e-6f), r2 = rsqrtf(wave_sum(s2) * (1.f / 256.f) + 1e-6f);
        const float other = __shfl_xor(kr, 32);
        const int i = lane & 31; const float invf = powf(10000.f, -(float)i / 32.f); const float ang = (float)posp[t] * invf; const float cs = cosf(ang), sn = sinf(ang);
        const float x1 = lane < 32 ? kr : other, x2 = lane < 32 ? other : kr;
        const float outv = lane < 32 ? (x1 * cs - x2 * sn) : (x2 * cs + x1 * sn);
#pragma unroll
        for (int j = 0; j < 6; ++j) zr[lane + 64 * j] = (bf16_t)f2bf(cq[j] * r1);
#pragma unroll
        for (int j = 0; j < 4; ++j) zr[384 + lane + 64 * j] = (bf16_t)f2bf(ck[j] * r2);
        ((bf16_t*)(p.ws + WS_KPE))[t * 64 + 2 * i + (lane >> 5)] = (bf16_t)f2bf(outv);
        if (lane < 32) { cosT[t * 32 + i] = cs; sinT[t * 32 + i] = sn; }
    }
}
DEVI void phase2a(const Params& p, char* lds, bool prep = true) {
    for (int it = blockIdx.x; it < 256; it += gridDim.x) { if (it < 128) hgrn_chain_mfma(p, lds, it >> 3, it & 7); else if (prep) mla_prep(p, it - 128); }
}

DEVI void phase2b(const Params& p, char* lds) {
    unsigned char* ws = p.ws;
    { g8::DenseOrder S; S.init(ws + WS_ZL, ZL_P, ws + WS_WUQ, 384, T, 1536);
      g8::Epi4<EpiQ> E{{(bf16_t*)(ws + WS_Q), (const float*)(ws + WS_COS), (const float*)(ws + WS_SIN)}};
      g8::gemm_phase<g8::Epi4<EpiQ>, g8::DenseOrder, true>((G8_LAS unsigned char*)lds, ZL_P, 384, 384, S, E); }
    { g8::DenseOrder S; S.init(ws + WS_ZL + 384 * 2, ZL_P, ws + WS_WUKV, 256, T, 2048);
      g8::Epi4<EpiKV> E{{(bf16_t*)(ws + WS_KN), (bf16_t*)(ws + WS_V)}};
      g8::gemm_phase<g8::Epi4<EpiKV>, g8::DenseOrder, true>((G8_LAS unsigned char*)lds, ZL_P, 256, 256, S, E); }
}

DEVI void attn_item(const Params& p, char* lds, int b, int h, int qb) {
    const bf16_t* q = (const bf16_t*)(p.ws + WS_Q); const bf16_t* kn = (const bf16_t*)(p.ws + WS_KN); const bf16_t* vg = (const bf16_t*)(p.ws + WS_V);
    const bf16_t* kpe = (const bf16_t*)(p.ws + WS_KPE); bf16_t* ob = (bf16_t*)(p.ws + WS_OB);
    const int tid = threadIdx.x, lane = tid & 63, wid = tid >> 6, fr = lane & 15, fq = lane >> 4;
    bf16_t* Ks = (bf16_t*)lds; bf16_t* Vt = (bf16_t*)(lds + 64 * 400); bf16_t* Ps = (bf16_t*)(lds + 64 * 400 + 128 * 144) + wid * 16 * 72;
    const int q0 = qb * 128 + wid * 16; const size_t tb = (size_t)b * SEQ;
    bf16x8 qf[6];
    { const bf16_t* qrow = q + (tb + q0 + fr) * 1536 + h * 192;
#pragma unroll
      for (int kk = 0; kk < 6; ++kk) qf[kk] = *(const bf16x8*)(qrow + kk * 32 + fq * 8); }
    f32x4 o[8]; float m[4], l[4];
#pragma unroll
    for (int n = 0; n < 8; ++n) o[n] = (f32x4){0.f, 0.f, 0.f, 0.f};
#pragma unroll
    for (int i = 0; i < 4; ++i) { m[i] = -1e30f; l[i] = 0.f; }
    const int nkt = (qb + 1) * 2;
    for (int kt = 0; kt < nkt; ++kt) {
        __syncthreads();
#pragma unroll
        for (int i = 0; i < 3; ++i) { const int c = tid + 512 * i, key = c / 24, ch = c % 24; const size_t tk = tb + kt * 64 + key;
            const bf16_t* src = ch < 16 ? kn + tk * 1024 + h * 128 + ch * 8 : kpe + tk * 64 + (ch - 16) * 8;
            *(bf16x8*)(Ks + key * 200 + ch * 8) = *(const bf16x8*)src; }
#pragma unroll
        for (int i = 0; i < 2; ++i) { const int c = tid + 512 * i, key = c >> 4, ch = c & 15; const bf16x8 vv = *(const bf16x8*)(vg + (tb + kt * 64 + key) * 1024 + h * 128 + ch * 8);
#pragma unroll
            for (int j = 0; j < 8; ++j) Vt[(ch * 8 + j) * 72 + key] = (bf16_t)vv[j]; }
        __syncthreads();
        if (kt * 64 <= q0 + 15) {
            f32x4 s[4];
#pragma unroll
            for (int n = 0; n < 4; ++n) s[n] = (f32x4){0.f, 0.f, 0.f, 0.f};
#pragma unroll
            for (int kk = 0; kk < 6; ++kk)
#pragma unroll
                for (int n = 0; n < 4; ++n) { const bf16x8 kf = *(const bf16x8*)(Ks + (n * 16 + fr) * 200 + kk * 32 + fq * 8); s[n] = __builtin_amdgcn_mfma_f32_16x16x32_bf16(qf[kk], kf, s[n], 0, 0, 0); }
#pragma unroll
            for (int i = 0; i < 4; ++i) { const int qi = q0 + 4 * fq + i; float mx = -__builtin_inff();
#pragma unroll
                for (int n = 0; n < 4; ++n) { const int key = kt * 64 + 16 * n + fr; if (key > qi) s[n][i] = -__builtin_inff(); mx = fmaxf(mx, s[n][i]); }
                mx = fmaxf(mx, __shfl_xor(mx, 1)); mx = fmaxf(mx, __shfl_xor(mx, 2)); mx = fmaxf(mx, __shfl_xor(mx, 4)); mx = fmaxf(mx, __shfl_xor(mx, 8));
                const float mn = fmaxf(m[i], mx), alpha = __expf(m[i] - mn); m[i] = mn; float rs = 0.f;
#pragma unroll
                for (int n = 0; n < 4; ++n) { const float pv = __expf(s[n][i] - mn); s[n][i] = pv; rs += pv; }
                rs += __shfl_xor(rs, 1); rs += __shfl_xor(rs, 2); rs += __shfl_xor(rs, 4); rs += __shfl_xor(rs, 8);
                l[i] = l[i] * alpha + rs;
#pragma unroll
                for (int n = 0; n < 8; ++n) o[n][i] *= alpha;
#pragma unroll
                for (int n = 0; n < 4; ++n) Ps[(4 * fq + i) * 72 + 16 * n + fr] = (bf16_t)f2bf(s[n][i]);
            }
#pragma unroll
            for (int ks = 0; ks < 2; ++ks) { const bf16x8 pf = *(const bf16x8*)(Ps + fr * 72 + ks * 32 + fq * 8);
#pragma unroll
                for (int n = 0; n < 8; ++n) { const bf16x8 vf = *(const bf16x8*)(Vt + (n * 16 + fr) * 72 + ks * 32 + fq * 8); o[n] = __builtin_amdgcn_mfma_f32_16x16x32_bf16(pf, vf, o[n], 0, 0, 0); } }
        }
    }
#pragma unroll
    for (int i = 0; i < 4; ++i) { const float rl = 1.f / l[i]; bf16_t* orow = ob + (tb + q0 + 4 * fq + i) * 1024 + h * 128;
#pragma unroll
        for (int n = 0; n < 8; ++n) orow[n * 16 + fr] = (bf16_t)f2bf(o[n][i] * rl); }
}
namespace at2 {
typedef short s16x4 __attribute__((ext_vector_type(4)));
typedef float f32x16 __attribute__((ext_vector_type(16)));
constexpr int KROW = 384;
constexpr int SHM_K = 64 * KROW, SHM_V = 64 * 256;
constexpr int L_V = 0, L_K = 2 * SHM_V, L_WS = 2 * SHM_V + 2 * SHM_K;
constexpr float THR = 8.f;
#define AT_KSWZ(row, colB) ((row) * at2::KROW + ((colB) ^ (((row) & 7) << 4)))
DEVI int v_st(int k, int c) { const int kk = (k & ~0xC) | ((k & 4) << 1) | ((k & 8) >> 1); return ((kk >> 3) * 4 + (c >> 5)) * 512 + ((kk & 7) * 32 + (c & 31)) * 2; }
DEVI int v_rd_base(int lane) { return ((lane & 3) << 3) | (((lane >> 2) & 3) << 6) | (((lane >> 4) & 1) << 5) | (((lane >> 5) & 1) << 8); }
constexpr int v_rd_off(int d0, int ks, int half) { return d0 * 512 + ks * 4096 + half * 2048; }
DEVI int crow(int r, int hi) { return (r & 3) + 8 * (r >> 2) + 4 * hi; }
DEVI unsigned cvtpk(float lo, float hi) { unsigned r; asm volatile("v_cvt_pk_bf16_f32 %0, %1, %2" : "=v"(r) : "v"(lo), "v"(hi)); return r; }
DEVI void mask_tile(f32x16& p0, f32x16& p1, int dq) {
    const float NEG = -__builtin_inff();
#pragma unroll
    for (int r = 0; r < 16; ++r) { const int c = (r & 3) + 8 * (r >> 2); if (dq - c < 0) p0[r] = NEG; if (dq - c - 32 < 0) p1[r] = NEG; }
}
DEVI void partialSM(f32x16& p0, f32x16& p1, float& m_reg, float& mn, float& alpha) {
    float pmax = p0[0];
#pragma unroll
    for (int r = 1; r < 16; ++r) pmax = fmaxf(pmax, p0[r]);
#pragma unroll
    for (int r = 0; r < 16; ++r) pmax = fmaxf(pmax, p1[r]);
    { auto rr = __builtin_amdgcn_permlane32_swap(__float_as_uint(pmax), __float_as_uint(pmax), false, false); pmax = fmaxf(__uint_as_float(rr[0]), __uint_as_float(rr[1])); }
    constexpr float C2 = 1.4426950408889634f;
    if (__builtin_expect(__all((pmax - m_reg) <= THR), 1)) { mn = m_reg; alpha = 1.f; }
    else { mn = fmaxf(m_reg, pmax); alpha = __builtin_amdgcn_exp2f((m_reg - mn) * C2); m_reg = mn; }
    const float mnL = -mn * C2;
#pragma unroll
    for (int r = 0; r < 16; ++r) p0[r] = fmaf(p0[r], C2, mnL);
#pragma unroll
    for (int r = 0; r < 16; ++r) p1[r] = fmaf(p1[r], C2, mnL);
#pragma unroll
    for (int r = 0; r < 16; ++r) p0[r] = __builtin_amdgcn_exp2f(p0[r]);
}
DEVI void finishSM(f32x16& p0, f32x16& p1, float alpha, float& l_reg, bf16x8& pa0, bf16x8& pa1, bf16x8& pa2, bf16x8& pa3) {
#pragma unroll
    for (int r = 0; r < 16; ++r) p1[r] = __builtin_amdgcn_exp2f(p1[r]);
    float ps = 0;
#pragma unroll
    for (int r = 0; r < 16; ++r) ps += p0[r];
#pragma unroll
    for (int r = 0; r < 16; ++r) ps += p1[r];
    { auto rr = __builtin_amdgcn_permlane32_swap(__float_as_uint(ps), __float_as_uint(ps), false, false); ps = __uint_as_float(rr[0]) + __uint_as_float(rr[1]); }
    l_reg = l_reg * alpha + ps;
#define AT_PK4(P, B_, OUT) do { unsigned a0 = cvtpk(P[B_+0], P[B_+1]), a1 = cvtpk(P[B_+2], P[B_+3]); unsigned b0 = cvtpk(P[B_+4], P[B_+5]), b1 = cvtpk(P[B_+6], P[B_+7]); \
        auto r0 = __builtin_amdgcn_permlane32_swap(a0, b0, false, false); auto r1 = __builtin_amdgcn_permlane32_swap(a1, b1, false, false); \
        u32x4 w = {r0[0], r1[0], r0[1], r1[1]}; OUT = *reinterpret_cast<bf16x8*>(&w); } while (0)
    AT_PK4(p0, 0, pa0); AT_PK4(p0, 8, pa1); AT_PK4(p1, 0, pa2); AT_PK4(p1, 8, pa3);
#undef AT_PK4
}
template <int KB>
DEVI void qkt(f32x16& p0, f32x16& p1, const char* K_lds, int r32, int hi, const bf16x8* qr) {
    p0 = f32x16{}; p1 = f32x16{};
    const char* kb[4];
#pragma unroll
    for (int dd = 0; dd < 4; ++dd) kb[dd] = K_lds + KB * SHM_K + AT_KSWZ(r32, (dd * 16 + hi * 8) * 2);
#pragma unroll
    for (int d0 = 0; d0 < 12; ++d0) { const char* a = kb[d0 & 3] + (d0 >> 2) * 128;
        const bf16x8 b0 = *reinterpret_cast<const bf16x8*>(a); const bf16x8 b1 = *reinterpret_cast<const bf16x8*>(a + 32 * KROW);
        p0 = __builtin_amdgcn_mfma_f32_32x32x16_bf16(b0, qr[d0], p0, 0, 0, 0); p1 = __builtin_amdgcn_mfma_f32_32x32x16_bf16(b1, qr[d0], p1, 0, 0, 0); }
}
template <int VB>
DEVI void pv_tile(f32x16* o, int vb0, bf16x8 pa0, bf16x8 pa1, bf16x8 pa2, bf16x8 pa3) {
#define AT_TRRD(dst, off) asm volatile("ds_read_b64_tr_b16 %0, %1 offset:%2" : "=&v"(dst) : "v"(vb0), "i"(off) : "memory")
#define AT_PV_D0(d0) do { s16x4 l0, l1, l2, l3, h0, h1, h2, h3; constexpr int b_ = VB * SHM_V + v_rd_off(d0, 0, 0); \
        AT_TRRD(l0, b_); AT_TRRD(h0, b_ + 2048); AT_TRRD(l1, b_ + 4096); AT_TRRD(h1, b_ + 6144); AT_TRRD(l2, b_ + 8192); AT_TRRD(h2, b_ + 10240); AT_TRRD(l3, b_ + 12288); AT_TRRD(h3, b_ + 14336); \
        asm volatile("s_waitcnt lgkmcnt(0)" ::: "memory"); __builtin_amdgcn_sched_barrier(0); \
        o[d0] = __builtin_amdgcn_mfma_f32_32x32x16_bf16(pa0, (bf16x8){l0[0], l0[1], l0[2], l0[3], h0[0], h0[1], h0[2], h0[3]}, o[d0], 0, 0, 0); \
        o[d0] = __builtin_amdgcn_mfma_f32_32x32x16_bf16(pa1, (bf16x8){l1[0], l1[1], l1[2], l1[3], h1[0], h1[1], h1[2], h1[3]}, o[d0], 0, 0, 0); \
        o[d0] = __builtin_amdgcn_mfma_f32_32x32x16_bf16(pa2, (bf16x8){l2[0], l2[1], l2[2], l2[3], h2[0], h2[1], h2[2], h2[3]}, o[d0], 0, 0, 0); \
        o[d0] = __builtin_amdgcn_mfma_f32_32x32x16_bf16(pa3, (bf16x8){l3[0], l3[1], l3[2], l3[3], h3[0], h3[1], h3[2], h3[3]}, o[d0], 0, 0, 0); } while (0)
    AT_PV_D0(0); AT_PV_D0(1); AT_PV_D0(2); AT_PV_D0(3);
#undef AT_PV_D0
#undef AT_TRRD
}
DEVI void block(const Params& p, char* lds, int b, int h, int qb) {
    const bf16_t* q = (const bf16_t*)(p.ws + WS_Q); const bf16_t* kn = (const bf16_t*)(p.ws + WS_KN); const bf16_t* vg = (const bf16_t*)(p.ws + WS_V);
    const bf16_t* kpe = (const bf16_t*)(p.ws + WS_KPE); bf16_t* ob = (bf16_t*)(p.ws + WS_OB);
    const int tid = threadIdx.x, wid = __builtin_amdgcn_readfirstlane(tid >> 6), lane = tid & 63, r32 = lane & 31, hi = lane >> 5;
    const size_t tb = (size_t)b * SEQ; const int P0 = qb * 256, NT = (P0 + 256) / 64;
    char* V_lds = lds + L_V; char* K_lds = lds + L_K; float* ws = (float*)(lds + L_WS) + wid * 64; float* li_l = ws; float* al_l = ws + 32;
    const int qlo = P0 + wid * 32, qm = qlo + r32 - 4 * hi;
    const int sr = tid >> 4, sc = (tid & 15) * 8, vst0 = v_st(sr, sc), vst1 = v_st(32 + sr, sc);
    const int kd0 = AT_KSWZ(sr, sc * 2), kd2 = AT_KSWZ(tid >> 3, 256 + (tid & 7) * 16);
    const bf16_t* knp = kn + (tb + sr) * 1024 + h * 128 + sc; const bf16_t* vp = vg + (tb + sr) * 1024 + h * 128 + sc; const bf16_t* kpp = kpe + (tb + (tid >> 3)) * 64 + (tid & 7) * 8;
    const int vb0 = (int)(uintptr_t)V_lds + v_rd_base(lane);
    bf16x8 stk[3], stv[2];
#define AT_LOAD(t_) do { const size_t o_ = (size_t)(t_) * 64; stk[0] = *(const bf16x8*)(knp + o_ * 1024); stk[1] = *(const bf16x8*)(knp + (o_ + 32) * 1024); stk[2] = *(const bf16x8*)(kpp + o_ * 64); \
        stv[0] = *(const bf16x8*)(vp + o_ * 1024); stv[1] = *(const bf16x8*)(vp + (o_ + 32) * 1024); } while (0)
#define AT_WRITE(bf) do { *(bf16x8*)(K_lds + (bf) * SHM_K + kd0) = stk[0]; *(bf16x8*)(K_lds + (bf) * SHM_K + kd0 + 32 * KROW) = stk[1]; *(bf16x8*)(K_lds + (bf) * SHM_K + kd2) = stk[2]; \
        *(bf16x8*)(V_lds + (bf) * SHM_V + vst0) = stv[0]; *(bf16x8*)(V_lds + (bf) * SHM_V + vst1) = stv[1]; } while (0)
    AT_LOAD(0);
    bf16x8 qr[12];
    { const bf16_t* qrow = q + (tb + qlo + r32) * 1536 + h * 192;
#pragma unroll
      for (int d0 = 0; d0 < 12; ++d0) qr[d0] = *(const bf16x8*)(qrow + d0 * 16 + hi * 8); }
    float m_reg = -1e30f, l_reg = 0.f; f32x16 o[4] = {};
    __syncthreads();
    AT_WRITE(0);
    __syncthreads();
#define AT_RESC(a) do { if (__any((a) < 1.f)) { if (hi == 0) al_l[r32] = (a); asm volatile("s_waitcnt lgkmcnt(0)" ::: "memory"); \
        _Pragma("unroll") for (int d_ = 0; d_ < 4; ++d_) _Pragma("unroll") for (int r = 0; r < 16; ++r) o[d_][r] *= al_l[crow(r, hi)]; } } while (0)
#define AT_STEP(t_, BF) do { const int tq = (t_); if (tq + 1 < NT) AT_LOAD(tq + 1); \
        f32x16 p0, p1; float mn, al; bf16x8 pa0, pa1, pa2, pa3; \
        qkt<BF>(p0, p1, K_lds, r32, hi, qr); \
        { const int kb_ = tq * 64; if (kb_ + 63 > qlo) mask_tile(p0, p1, qm - kb_); } \
        partialSM(p0, p1, m_reg, mn, al); finishSM(p0, p1, al, l_reg, pa0, pa1, pa2, pa3); AT_RESC(al); \
        pv_tile<BF>(o, vb0, pa0, pa1, pa2, pa3); \
        if (tq + 1 < NT) AT_WRITE(1 - BF); \
        __syncthreads(); } while (0)
#pragma unroll 1
    for (int t = 0; t < NT; t += 2) { AT_STEP(t, 0); AT_STEP(t + 1, 1); }
    if (hi == 0) li_l[r32] = l_reg;
    asm volatile("s_waitcnt lgkmcnt(0)" ::: "memory");
    float rli[16];
#pragma unroll
    for (int r = 0; r < 16; ++r) rli[r] = __builtin_amdgcn_rcpf(li_l[crow(r, hi)]);
    bf16_t* Ow = ob + (tb + qlo) * 1024 + h * 128;
#pragma unroll
    for (int r = 0; r < 16; ++r) { const int orow = crow(r, hi);
#pragma unroll
        for (int d0 = 0; d0 < 4; ++d0) { const float v = o[d0][r] * rli[r]; const float vn = __shfl_xor(v, 1);
            if ((r32 & 1) == 0) *(unsigned*)(Ow + (size_t)orow * 1024 + d0 * 32 + r32) = cvtpk(v, vn); } }
#undef AT_LOAD
#undef AT_WRITE
#undef AT_RESC
#undef AT_STEP
}
}
DEVI void phase3(const Params& p, char* lds) {
#pragma unroll 1
    for (int it2 = blockIdx.x * 2; it2 < 1024; it2 += (it2 & 1) ? 2 * (int)gridDim.x - 1 : 1) { const int it = it2 >> 1, bh = it >> 2, x = it & 3;
        at2::block(p, lds, bh >> 3, bh & 7, (it2 & 1) ? x : 7 - x); }
    __syncthreads();
}

DEVI void phase4(const Params& p, char* lds) {
    unsigned char* ws = p.ws; const bf16_t* zg = (const bf16_t*)(ws + WS_ZG);
    for (int second = 0; second < 2; ++second) {
        g8::DenseOrder S; S.init(ws + (second ? WS_OB : WS_OA), 1024, ws + WS_WBR + second * 2048, 2048, T, 1024);
        g8::Epi4<EpiBr> E{{p.out, zg, (bf16_t*)(ws + WS_Y), second}};
        g8::gemm_phase<g8::Epi4<EpiBr>, g8::DenseOrder, true>((G8_LAS unsigned char*)lds, 1024, 2048, 1024, S, E); }
}
DEVI void phase5(const Params& p, char* lds) {
    unsigned char* ws = p.ws;
    g8::DenseOrder S; S.init(ws + WS_Y, 1024, ws + WS_WOUT, 1024, T, 1024);
    g8::Epi4<EpiOut> E{{(const float*)ptab(ws, PT_X), p.out}};
    g8::gemm_phase<g8::Epi4<EpiOut>, g8::DenseOrder, true>((G8_LAS unsigned char*)lds, 1024, 1024, 1024, S, E);
}

DEVI void phase6a(const Params& p, char* lds, bool router = true) {
    unsigned char* ws = p.ws; float* scr = (float*)lds;
    const float* ew1 = (const float*)ptab(ws, PT_EW1); const float* ew3 = (const float*)ptab(ws, PT_EW3); const float* ew2 = (const float*)ptab(ws, PT_EW2); const float* ffnw = (const float*)ptab(ws, PT_FFNW);
    const float* rgb = (const float*)ptab(ws, PT_RGB); const float* reb = (const float*)ptab(ws, PT_REB);
    bf16_t* W13 = (bf16_t*)(ws + WS_W13); bf16_t* W2 = (bf16_t*)(ws + WS_W2);
    constexpr int I13 = 16 * 16, I2 = 16 * 8;
    for (int it = blockIdx.x; it < NEXP * (I13 + I2); it += gridDim.x) { const int e = it / (I13 + I2); int r = it % (I13 + I2);
        if (r < I13) { const int nb = r / 16, kb = r % 16; const float* w1 = ew1 + (size_t)e * 1024 * 512; const float* w3 = ew3 + (size_t)e * 1024 * 512; const float* nw = ffnw;
            const int tid = threadIdx.x;
            { const int nl = tid & 63, kq = tid >> 6; const int n = nb * 64 + nl, j = n >> 2, rr = n & 3; const float* src = rr < 2 ? w1 : w3; const int col = 2 * j + (rr & 1);
#pragma unroll
              for (int i = 0; i < 8; ++i) { const int k = kq * 8 + i; scr[k * 65 + nl] = src[(size_t)(kb * 64 + k) * 512 + col] * nw[kb * 64 + k]; } }
            __syncthreads();
            { const int nl = tid >> 3, kc = tid & 7; const float* s = scr + (kc * 8) * 65 + nl;
              u32x4 o; o.x = pk2(s[0], s[65]); o.y = pk2(s[2 * 65], s[3 * 65]); o.z = pk2(s[4 * 65], s[5 * 65]); o.w = pk2(s[6 * 65], s[7 * 65]);
              *(u32x4*)(W13 + ((size_t)e * 1024 + nb * 64 + nl) * 1024 + kb * 64 + kc * 8) = o; }
            __syncthreads();
        } else { r -= I13; const int nb = r / 8, kb = r % 8;
            transpose_tile(ew2 + (size_t)e * 512 * 1024, 1024, W2 + (size_t)e * 1024 * 512, 512, kb * 64, nb * 64, [](int n) { return n; }, [](int) { return 1.f; }, scr); }
    }
    __syncthreads();
    if (!router) return;
    const float* WrT = (const float*)(ws + WS_WRT); bf16_t* H2 = (bf16_t*)(ws + WS_H2);
    int* AE = (int*)(ws + WS_ROUTE + RT_AE); int* AP = (int*)(ws + WS_ROUTE + RT_AP); float* AW = (float*)(ws + WS_ROUTE + RT_AW);
    unsigned* cnt = (unsigned*)(ws + WS_CTL) + CW_CNT;
    const int lane = threadIdx.x & 63, wid = threadIdx.x >> 6, gw = blockIdx.x * 8 + wid, NGW = gridDim.x * 8;
    float* lg = (float*)lds + wid * 80;
    for (int t = gw; t < T; t += NGW) {
        const f32x4* xr = (const f32x4*)(p.out + (size_t)t * D) + lane; f32x4 v[4]; float s = 0.f;
#pragma unroll
        for (int j = 0; j < 4; ++j) { v[j] = xr[64 * j]; s += v[j][0] * v[j][0] + v[j][1] * v[j][1] + v[j][2] * v[j][2] + v[j][3] * v[j][3]; }
        const float rstd = rsqrtf(wave_sum(s) * (1.f / D) + 1e-6f);
#pragma unroll
        for (int j = 0; j < 4; ++j) v[j] = v[j] * rstd;
        u32x2* o = (u32x2*)(H2 + (size_t)t * D) + lane;
#pragma unroll
        for (int j = 0; j < 4; ++j) { u32x2 w; w.x = pk2(v[j][0], v[j][1]); w.y = pk2(v[j][2], v[j][3]); o[64 * j] = w; }
        for (int c = 0; c < 72; ++c) { const f32x4* wr = (const f32x4*)(WrT + c * 1024) + lane; float a = 0.f;
#pragma unroll
            for (int j = 0; j < 4; ++j) { const f32x4 w = wr[64 * j]; a += v[j][0] * w[0] + v[j][1] * w[1] + v[j][2] * w[2] + v[j][3] * w[3]; }
            a = wave_sum(a); if (lane == 0) lg[c] = a; }
        if (lane == 0) {
            int g = 0; float gbest = lg[0] + rgb[0]; float glv[8]; glv[0] = gbest;
#pragma unroll
            for (int j = 1; j < 8; ++j) { glv[j] = lg[j] + rgb[j]; if (glv[j] > gbest) { gbest = glv[j]; g = j; } }
            float gs = 0.f;
#pragma unroll
            for (int j = 0; j < 8; ++j) gs += expf(glv[j] - gbest);
            const float gwt = 1.f / gs;
            int e1 = 0, e2 = 0; float b1 = -__builtin_inff(), b2 = -__builtin_inff();
            for (int j = 0; j < 8; ++j) { const float v = lg[8 + g * 8 + j] + reb[g * 8 + j];
                if (v > b1) { b2 = b1; e2 = e1; b1 = v; e1 = j; } else if (v > b2) { b2 = v; e2 = j; } }
            const float d = expf(b2 - b1); const float w1 = 1.f / (1.f + d), w2 = d / (1.f + d);
            const int ea = g * 8 + e1, eb = g * 8 + e2;
            const unsigned pa = atomicAdd(cnt + ea, 1u), pb = atomicAdd(cnt + eb, 1u);
            AE[2 * t] = ea; AE[2 * t + 1] = eb; AP[2 * t] = (int)pa; AP[2 * t + 1] = (int)pb; AW[2 * t] = gwt * w1; AW[2 * t + 1] = gwt * w2;
        }
    }
}
DEVI int build_prefix(const Params& p, int* li) {
    const unsigned* cnt = (const unsigned*)(p.ws + WS_CTL) + CW_CNT;
    __syncthreads();
    if (threadIdx.x == 0) { int acc = 0; for (int e = 0; e < NEXP; ++e) { li[e] = acc; const int c = (int)cnt[e]; const int pd = (c + 255) & ~255; for (int tt = acc / 256; tt < (acc + pd) / 256; ++tt) li[80 + tt] = e; acc += pd; } li[64] = acc; }
    __syncthreads();
    return li[64] / 256;
}
DEVI void phase6b(const Params& p, char* lds) {
    unsigned char* ws = p.ws; int* li = (int*)lds; build_prefix(p, li);
    const unsigned* cnt = (const unsigned*)(ws + WS_CTL) + CW_CNT;
    const int* AE = (const int*)(ws + WS_ROUTE + RT_AE); const int* AP = (const int*)(ws + WS_ROUTE + RT_AP); const float* AW = (const float*)(ws + WS_ROUTE + RT_AW);
    int* AS = (int*)(ws + WS_ROUTE + RT_AS); float* SW = (float*)(ws + WS_ROUTE + RT_SW);
    const bf16_t* H2 = (const bf16_t*)(ws + WS_H2); bf16_t* HS = (bf16_t*)(ws + WS_HS);
    const int lane = threadIdx.x & 63, wid = threadIdx.x >> 6, gw = blockIdx.x * 8 + wid, NGW = gridDim.x * 8;
    for (int a = gw; a < 2 * T; a += NGW) { const int slot = li[AE[a]] + AP[a]; if (lane == 0) { AS[a] = slot; SW[slot] = AW[a]; }
        const u32x4* src = (const u32x4*)(H2 + (size_t)(a >> 1) * 1024) + lane; u32x4* dst = (u32x4*)(HS + (size_t)slot * 1024) + lane; const u32x4 v0 = src[0], v1 = src[64]; dst[0] = v0; dst[64] = v1; }
    for (int e = blockIdx.x; e < NEXP; e += gridDim.x) { const int c = (int)cnt[e], pd = (c + 255) & ~255;
        for (int s_ = c + wid; s_ < pd; s_ += 8) { const int slot = li[e] + s_; u32x4* dst = (u32x4*)(HS + (size_t)slot * 1024) + lane; const u32x4 z = {0u, 0u, 0u, 0u}; dst[0] = z; dst[64] = z; if (lane == 0) SW[slot] = 0.f; } }
}
struct MoeOrder { const char* A; const char* W; size_t a_tile, w_exp, w_pn; const int* tile_e; int nunits;
    DEVI bool next(int i, g8::Unit& u) const { const int L = i * (int)gridDim.x + (int)blockIdx.x; if (L >= nunits) return false; const int tile = L >> 2, pn = L & 3, e = tile_e[tile];
        u.pm = tile; u.pn = pn; u.a = A + (size_t)tile * a_tile; u.b = W + (size_t)e * w_exp + (size_t)pn * w_pn; return true; } };
constexpr int LDS_LI = 132096;
DEVI void phase7a(const Params& p, char* lds) {
    unsigned char* ws = p.ws; int* li = (int*)(lds + LDS_LI); const int ntile = build_prefix(p, li);
    MoeOrder S{(const char*)(ws + WS_HS), (const char*)(ws + WS_W13), (size_t)256 * 1024 * 2, (size_t)1024 * 1024 * 2, (size_t)256 * 1024 * 2, li + 80, ntile * 4};
    g8::Epi4<EpiHid> E{{(bf16_t*)(ws + WS_HID)}};
    g8::gemm_phase<g8::Epi4<EpiHid>, MoeOrder, true>((G8_LAS unsigned char*)lds, 1024, 1024, 1024, S, E);
}
DEVI void phase7b(const Params& p, char* lds) {
    unsigned char* ws = p.ws; int* li = (int*)(lds + LDS_LI); const int ntile = build_prefix(p, li);
    MoeOrder S{(const char*)(ws + WS_HID), (const char*)(ws + WS_W2), (size_t)256 * EFF * 2, (size_t)1024 * EFF * 2, (size_t)256 * EFF * 2, li + 80, ntile * 4};
    g8::Epi4<EpiY> E{{(bf16_t*)(ws + WS_YEXP), (const float*)(ws + WS_ROUTE + RT_SW)}};
    g8::gemm_phase<g8::Epi4<EpiY>, MoeOrder, true>((G8_LAS unsigned char*)lds, EFF, EFF, EFF, S, E);
}
DEVI void phase8(const Params& p) {
    unsigned char* ws = p.ws; const int* AS = (const int*)(ws + WS_ROUTE + RT_AS); const bf16_t* yexp = (const bf16_t*)(ws + WS_YEXP); const f32x4* finw = (const f32x4*)ptab(ws, PT_FINW);
    const int lane = threadIdx.x & 63, gw = blockIdx.x * 8 + (threadIdx.x >> 6), NGW = gridDim.x * 8;
    for (int t = gw; t < T; t += NGW) {
        f32x4* xr = (f32x4*)(p.out + (size_t)t * D) + lane; const int s0 = AS[2 * t], s1 = AS[2 * t + 1];
        const u32x2* y0 = (const u32x2*)(yexp + (size_t)s0 * 1024) + lane; const u32x2* y1 = (const u32x2*)(yexp + (size_t)s1 * 1024) + lane;
        f32x4 v[4]; float s = 0.f;
#pragma unroll
        for (int j = 0; j < 4; ++j) { v[j] = xr[64 * j]; const u32x2 a = y0[64 * j], b = y1[64 * j];
            v[j][0] = (v[j][0] + bf2f(a.x & 0xffffu)) + bf2f(b.x & 0xffffu); v[j][1] = (v[j][1] + bf2f(a.x >> 16)) + bf2f(b.x >> 16);
            v[j][2] = (v[j][2] + bf2f(a.y & 0xffffu)) + bf2f(b.y & 0xffffu); v[j][3] = (v[j][3] + bf2f(a.y >> 16)) + bf2f(b.y >> 16);
            s += v[j][0] * v[j][0] + v[j][1] * v[j][1] + v[j][2] * v[j][2] + v[j][3] * v[j][3]; }
        const float rstd = rsqrtf(wave_sum(s) * (1.f / D) + 1e-6f);
#pragma unroll
        for (int j = 0; j < 4; ++j) { const f32x4 w = finw[lane + 64 * j]; xr[64 * j] = v[j] * rstd * w; }
    }
}

constexpr int NPHASE = 12;
constexpr int LDS_BYTES = 147456;
__global__ void __launch_bounds__(NTHR, 2) mega(Params p) {
    extern __shared__ __attribute__((aligned(16))) char lds[];
    cg::grid_group grid = cg::this_grid();
    const int lo = p.ph_lo, hi = p.ph_hi;
#ifdef ONLY_PH
#define PH(k, call) if constexpr ((k) == ONLY_PH) { if (lo <= (k) && (k) < hi) { call; if ((k) + 1 < hi) grid.sync(); } }
#else
#define PH(k, call) if (lo <= (k) && (k) < hi) { call; DUP(k) if ((k) + 1 < hi) grid.sync(); }
#endif
#ifndef DUP_PH
#define DUP_PH -1
#endif
#define DUP(k) if constexpr ((k) == DUP_PH) { for (int rep_ = 0; rep_ < 2; ++rep_) { __syncthreads(); if constexpr ((k) == 0) phase0(p, lds); if constexpr ((k) == 1) phase1(p, lds); if constexpr ((k) == 2) phase2a(p, lds, false); \
    if constexpr ((k) == 3) phase2b(p, lds); if constexpr ((k) == 4) phase3(p, lds); if constexpr ((k) == 5) phase4(p, lds); if constexpr ((k) == 6) phase5(p, lds); if constexpr ((k) == 7) phase6a(p, lds, false); \
    if constexpr ((k) == 9) phase7a(p, lds); if constexpr ((k) == 10) phase7b(p, lds); } }
    PH(0, phase0(p, lds))
    PH(1, phase1(p, lds))
    PH(2, phase2a(p, lds))
    PH(3, phase2b(p, lds))
    PH(4, phase3(p, lds))
    PH(5, phase4(p, lds))
    PH(6, phase5(p, lds))
    PH(7, phase6a(p, lds))
    PH(8, phase6b(p, lds))
    PH(9, phase7a(p, lds))
    PH(10, phase7b(p, lds))
    PH(11, phase8(p))
#undef PH
}

extern "C" void kernel_launch(void* const* d_in, const int* in_sizes, int n_in, void* d_out, int out_size, void* d_ws, size_t ws_size, hipStream_t stream) {
    static int grid = 0;
    if (grid == 0) {
        if (n_in != 22 || out_size != T * D || ws_size < WS_END) { fprintf(stderr, "kernel_launch: unexpected shapes (n_in %d out %d ws %zu, need ws >= %zu)\n", n_in, out_size, ws_size, (size_t)WS_END); grid = -1; return; }
        int dev = 0, cus = 0, per_cu = 0; hipGetDevice(&dev); hipDeviceGetAttribute(&cus, hipDeviceAttributeMultiprocessorCount, dev);
        hipFuncSetAttribute((const void*)mega, hipFuncAttributeMaxDynamicSharedMemorySize, LDS_BYTES);
        hipOccupancyMaxActiveBlocksPerMultiprocessor(&per_cu, (const void*)mega, NTHR, LDS_BYTES);
        if (per_cu < 1) { fprintf(stderr, "kernel_launch: occupancy query says %d blocks per CU\n", per_cu); per_cu = 1; }
        grid = cus * per_cu; (void)hipGetLastError();
    }
    if (grid < 0) return;
    hipMemsetAsync((char*)d_ws + WS_CTL, 0, 4096, stream);
    Params p{};
    p.x = (const float*)d_in[0]; p.pos = (const int*)d_in[1]; p.attn_norm_w = (const float*)d_in[2]; p.w_in = (const float*)d_in[3]; p.hg_lb = (const float*)d_in[4];
    p.hg_onw = (const float*)d_in[5]; p.q_norm_w = (const float*)d_in[6]; p.w_uq = (const float*)d_in[7]; p.kv_norm_w = (const float*)d_in[8]; p.w_ukv = (const float*)d_in[9];
    p.w_bra = (const float*)d_in[10]; p.w_brb = (const float*)d_in[11]; p.w_out = (const float*)d_in[12]; p.ffn_norm_w = (const float*)d_in[13]; p.rg_w = (const float*)d_in[14];
    p.rg_b = (const float*)d_in[15]; p.re_w = (const float*)d_in[16]; p.re_b = (const float*)d_in[17]; p.ew1 = (const float*)d_in[18]; p.ew3 = (const float*)d_in[19];
    p.ew2 = (const float*)d_in[20]; p.final_w = (const float*)d_in[21]; p.out = (float*)d_out; p.ws = (unsigned char*)d_ws;
#if MK_MULTI
    for (int ph = 0; ph < NPHASE; ++ph) { p.ph_lo = ph; p.ph_hi = ph + 1; hipLaunchKernelGGL(mega, dim3(grid), dim3(NTHR), LDS_BYTES, stream, p); }
#else
    p.ph_lo = 0; p.ph_hi = NPHASE;
    void* args[] = {&p};
    hipError_t e = hipLaunchCooperativeKernel((const void*)mega, dim3(grid), dim3(NTHR), args, LDS_BYTES, stream);
    if (e != hipSuccess) fprintf(stderr, "cooperative launch failed: %s (grid %d)\n", hipGetErrorString(e), grid);
#endif
}
```

```cpp
#include <hip/hip_runtime.h>
#include <hip/hip_cooperative_groups.h>
#include <cstdio>
#include <cstdint>
namespace cg = cooperative_groups;

#ifndef MK_MULTI
#define MK_MULTI 0
#endif

#define DEVI __device__ __forceinline__
typedef unsigned short bf16_t;
typedef short bf16x8 __attribute__((ext_vector_type(8)));
typedef float f32x4 __attribute__((ext_vector_type(4)));
typedef unsigned u32x4 __attribute__((ext_vector_type(4)));
typedef unsigned u32x2 __attribute__((ext_vector_type(2)));

constexpr int NB = 16, SEQ = 2048, T = NB * SEQ, D = 1024;
constexpr int NTHR = 512;
constexpr int ZH_P = 4096, ZL_P = 768, ZG_P = 2048;
constexpr int NZ = 6912;
constexpr int NEXP = 64, EFF = 512;
constexpr int SLOT_CAP = 2 * T + NEXP * 256;
constexpr int MAX_TILES = SLOT_CAP / 256;

constexpr size_t MiB = 1u << 20;
constexpr size_t WS_CTL = 0;
constexpr size_t WS_WRT = 1 * MiB;
constexpr size_t WS_LBT = 1 * MiB + 512 * 1024;
constexpr size_t WS_WIN = 2 * MiB;
constexpr size_t WS_WUQ = 16 * MiB;
constexpr size_t WS_WUKV = 18 * MiB;
constexpr size_t WS_WBR = 20 * MiB;
constexpr size_t WS_WOUT = 24 * MiB;
constexpr size_t WS_COS = 26 * MiB, WS_SIN = 30 * MiB;
constexpr size_t WS_ROUTE = 34 * MiB;
constexpr size_t WS_KPE = 36 * MiB;
constexpr size_t WS_ZH = 40 * MiB;
constexpr size_t WS_Q = 40 * MiB, WS_KN = 136 * MiB, WS_V = 200 * MiB;
constexpr size_t WS_Y = 40 * MiB;
constexpr size_t WS_X2B = 104 * MiB;
constexpr size_t WS_HID = 168 * MiB;
constexpr size_t WS_YEXP = 248 * MiB;
constexpr size_t WS_X2F8 = 344 * MiB;
constexpr size_t WS_H8 = 408 * MiB;
constexpr size_t WS_WIN8 = 440 * MiB;
constexpr size_t WS_TOK = 512 * 1024;
constexpr size_t WS_OB = 264 * MiB;
constexpr size_t WS_ZL = 296 * MiB;
constexpr size_t WS_ZG = 344 * MiB;
constexpr size_t WS_W13 = 408 * MiB;
constexpr size_t WS_OA = 472 * MiB;
constexpr size_t WS_H = 472 * MiB;
constexpr size_t WS_W2 = 472 * MiB;
constexpr size_t WS_END = 536 * MiB;
constexpr size_t RT_AE = 0, RT_AP = 256 * 1024, RT_AW = 512 * 1024, RT_AS = 768 * 1024, RT_ST = 1024 * 1024, RT_SW = 1536 * 1024;
constexpr int CW_CNT = 8192, CNT_STRIDE = 64;
constexpr size_t WS_TS = 16384;
constexpr size_t WS_PTRS = 8192;
enum { PT_POS = 0, PT_HGLB, PT_HGONW, PT_RGB, PT_REB, PT_EW1, PT_EW3, PT_EW2, PT_FFNW, PT_FINW, PT_X };
DEVI const void* ptab(const unsigned char* ws, int i) { return (const void*)(((const unsigned long long*)(ws + WS_PTRS))[i]); }

struct Params {
    const float* x; const int* pos; const float* attn_norm_w; const float* w_in; const float* hg_lb; const float* hg_onw;
    const float* q_norm_w; const float* w_uq; const float* kv_norm_w; const float* w_ukv; const float* w_bra; const float* w_brb;
    const float* w_out; const float* ffn_norm_w; const float* rg_w; const float* rg_b; const float* re_w; const float* re_b;
    const float* ew1; const float* ew3; const float* ew2; const float* final_w;
    float* out; unsigned char* ws;
    int ph_lo, ph_hi;
};

DEVI unsigned f2bf(float f) { unsigned u = __builtin_bit_cast(unsigned, f); return (u + 0x7fffu + ((u >> 16) & 1u)) >> 16; }
DEVI float bf2f(unsigned h) { return __builtin_bit_cast(float, h << 16); }
typedef float f32x2_t __attribute__((ext_vector_type(2))); typedef __bf16 bf16x2_t __attribute__((ext_vector_type(2)));
DEVI unsigned pk2(float lo, float hi) { f32x2_t v = {lo, hi}; bf16x2_t b = __builtin_convertvector(v, bf16x2_t); return __builtin_bit_cast(unsigned, b); }
DEVI float sigmoidf_(float v) { return __builtin_amdgcn_rcpf(1.f + __expf(-v)); }
DEVI float siluf_(float v) { return v * __builtin_amdgcn_rcpf(1.f + __expf(-v)); }
DEVI float wave_sum(float v) {
#pragma unroll
    for (int o = 1; o < 64; o <<= 1) v += __shfl_xor(v, o);
    return v;
}
typedef int i32x4 __attribute__((ext_vector_type(4))); typedef int i32x8 __attribute__((ext_vector_type(8)));
DEVI unsigned pk4_fp8(float a, float b, float c, float d) { int w = __builtin_amdgcn_cvt_pk_fp8_f32(a, b, 0, false); w = __builtin_amdgcn_cvt_pk_fp8_f32(c, d, w, true); return (unsigned)w; }
DEVI void store4bf(bf16_t* p, f32x4 v) { u32x2 w; w.x = pk2(v[0], v[1]); w.y = pk2(v[2], v[3]); *(u32x2*)p = w; }
DEVI void unpack8(bf16x8 v, float* f) {
#pragma unroll
    for (int j = 0; j < 8; ++j) f[j] = bf2f((unsigned)(unsigned short)v[j]);
}

template <class ColMap, class KScale>
DEVI void transpose_tile_f8(const float* src, int Nsrc, unsigned char* dst, int ldk, int k0, int n0, ColMap cm, KScale ks, float* scr) {
    const int tid = threadIdx.x;
    {
        const int nl = tid & 63, kq = tid >> 6; const int col = cm(n0 + nl);
#pragma unroll
        for (int i = 0; i < 8; ++i) { const int k = kq * 8 + i; float v = 0.f; if (col >= 0) v = src[(size_t)(k0 + k) * Nsrc + col] * ks(k0 + k); scr[k * 65 + nl] = v; }
    }
    __syncthreads();
    {
        const int nl = tid >> 3, kc = tid & 7; const float* s = scr + (kc * 8) * 65 + nl;
        u32x2 o; o.x = pk4_fp8(s[0], s[65], s[2 * 65], s[3 * 65]); o.y = pk4_fp8(s[4 * 65], s[5 * 65], s[6 * 65], s[7 * 65]);
        *(u32x2*)(dst + (size_t)(n0 + nl) * ldk + k0 + kc * 8) = o;
    }
    __syncthreads();
}
template <class ColMap, class KScale>
DEVI void transpose_tile(const float* src, int Nsrc, bf16_t* dst, int ldk, int k0, int n0, ColMap cm, KScale ks, float* scr) {
    const int tid = threadIdx.x;
    {
        const int nl = tid & 63, kq = tid >> 6; const int col = cm(n0 + nl);
#pragma unroll
        for (int i = 0; i < 8; ++i) { const int k = kq * 8 + i; float v = 0.f; if (col >= 0) v = src[(size_t)(k0 + k) * Nsrc + col] * ks(k0 + k); scr[k * 65 + nl] = v; }
    }
    __syncthreads();
    {
        const int nl = tid >> 3, kc = tid & 7; const float* s = scr + (kc * 8) * 65 + nl;
        u32x4 o; o.x = pk2(s[0], s[65]); o.y = pk2(s[2 * 65], s[3 * 65]); o.z = pk2(s[4 * 65], s[5 * 65]); o.w = pk2(s[6 * 65], s[7 * 65]);
        *(u32x4*)(dst + (size_t)(n0 + nl) * ldk + k0 + kc * 8) = o;
    }
    __syncthreads();
}

namespace g8 {
#define G8_LAS __attribute__((address_space(3)))
constexpr int BM = 256, BK = 64, HALF = 128, HTB = HALF * BK * 2, STAGE_BYTES = 8 * HTB, NXCD = 8, WGM = 8;
__host__ __device__ __forceinline__ int lds_byte(int r, int c) { const int st = (r >> 4) * 2 + (c >> 5), rr = r & 15, cc = c & 31, ob = rr * 64 + cc * 2; return st * 1024 + (ob ^ (((ob >> 9) & 1) << 5)); }
__host__ __device__ __forceinline__ int perm32(int rho) { const int n = rho >> 4, i = rho & 15; return 8 * (i >> 2) + 4 * n + (i & 3); }
__host__ __device__ __forceinline__ void stage_rc(int b, int& R, int& C) { const int st = b / 1024, sb = b % 1024, swz = sb ^ (((sb >> 9) & 1) << 5); R = (st >> 1) * 16 + swz / 64; C = (st & 1) * 32 + (swz % 64) / 2; }
struct Unit { int pm, pn; const char* a; const char* b; const int* tok; };
struct DenseOrder {
    const char* A; const char* Bt; size_t tstepA, tstepB; int nM, nN, nwg, G, c;
    DEVI void init(const void* A_, int lda, const void* Bt_, int ldb, int M, int N) { A = (const char*)A_; Bt = (const char*)Bt_; tstepA = (size_t)BM * lda * 2; tstepB = (size_t)BM * ldb * 2;
        nM = M / BM; nN = N / BM; nwg = nM * nN; G = gridDim.x; c = blockIdx.x; }
    DEVI bool next(int i, Unit& u) const {
        const long L = (long)i * G + c; if (L >= nwg) return false;
        int wgid = (int)L; { const int q = nwg / NXCD, r = nwg % NXCD, xcd = wgid % NXCD, off = wgid / NXCD; wgid = (xcd < r ? xcd * (q + 1) : r * (q + 1) + (xcd - r) * q) + off; }
        const int nig = WGM * nN, gid = wgid / nig, fm = gid * WGM, gsz = (nM - fm) < WGM ? (nM - fm) : WGM;
        u.pm = fm + ((wgid % nig) % gsz); u.pn = (wgid % nig) / gsz; u.a = A + (size_t)u.pm * tstepA; u.b = Bt + (size_t)u.pn * tstepB; u.tok = nullptr; return true;
    }
};
struct NoHook { static constexpr bool ON = false; template <class U> DEVI void operator()(f32x4 (&)[2][2][4][2], const U&, int, int, int, int) const {} };
template <class Epi, class Sched, bool ALIGN_EPI, class Hook = NoHook, bool GATHER = false, bool FP8 = false>
DEVI void gemm_phase(G8_LAS unsigned char* lds, const int lda, const int ldb, const int K, const Sched& S, const Epi& E, unsigned long long* tsp = nullptr, const Hook& H = Hook(), const int seg_t = 1 << 30, const long segj = 0, const int scA = 127, const int scB = 127) {
    const int tid = threadIdx.x, wid = __builtin_amdgcn_readfirstlane(tid >> 6), lane = tid & 63, wr = wid >> 2, wc = wid & 3, fr = lane & 15, fq = lane >> 4;
    const int nt = K / BK;
    unsigned voffA[2], voffB[2]; int gR[2]; unsigned gC[2];
#pragma unroll
    for (int i = 0; i < 2; ++i) { int R, C; stage_rc(tid * 16 + i * 8192, R, C); voffA[i] = (unsigned)(R * lda + C) * 2u; voffB[i] = (unsigned)(((R & ~31) + perm32(R & 31)) * ldb + C) * 2u; gR[i] = R; gC[i] = (unsigned)C * 2u; }
    unsigned vG[2][2], vGn[2][2];
#define G8_TOK(dst, tokp) do { _Pragma("unroll") for (int h_ = 0; h_ < 2; ++h_) _Pragma("unroll") for (int i_ = 0; i_ < 2; ++i_) dst[h_][i_] = (unsigned)(tokp)[gR[i_] + 128 * h_] * (unsigned)(lda * 2) + gC[i_]; } while (0)
#define G8_STAGE_A(bufoff, gbase, h, usenext) do { if constexpr (GATHER) { unsigned v_[2] = {(usenext) ? vGn[h][0] : vG[h][0], (usenext) ? vGn[h][1] : vG[h][1]}; G8_STAGE(bufoff, gbase, v_); } \
        else { G8_STAGE(bufoff, (gbase) + (h) * hstepA, voffA); } } while (0)
    const size_t kstep = (size_t)(BK * 2);
    const size_t hstepA = (size_t)HALF * lda * 2, hstepB = (size_t)HALF * ldb * 2;
    const unsigned ldsw = (unsigned)wid * 1024u;
    const int aoff = lds_byte(wr * 64 + fr, fq * 8), boff = lds_byte(wc * 32 + fr, fq * 8);
#define G8_SA(b, h) (((b) * 2 + (h)) * HTB)
#define G8_SB(b, h) ((4 + (b) * 2 + (h)) * HTB)
#define G8_STAGE(bufoff, gbase, voff) do { _Pragma("unroll") for (int _i = 0; _i < 2; ++_i) \
        __builtin_amdgcn_global_load_lds((const unsigned*)((const char*)(gbase) + (voff)[_i]), (G8_LAS unsigned*)(lds + (bufoff) + ldsw + _i * 8192), 16, 0, 0); } while (0)
#define G8_LD16(off) __builtin_bit_cast(i32x4, *(const G8_LAS bf16x8*)(lds + (off)))
#define G8_LDA8(dst, b, h) do { _Pragma("unroll") for (int m = 0; m < 4; ++m) dst[m] = __builtin_shufflevector(G8_LD16(G8_SA(b, h) + aoff + m * 2048), G8_LD16(G8_SA(b, h) + aoff + m * 2048 + 1024), 0, 1, 2, 3, 4, 5, 6, 7); } while (0)
#define G8_LDB8(dst, b, h) do { _Pragma("unroll") for (int n = 0; n < 2; ++n) dst[n] = __builtin_shufflevector(G8_LD16(G8_SB(b, h) + boff + n * 2048), G8_LD16(G8_SB(b, h) + boff + n * 2048 + 1024), 0, 1, 2, 3, 4, 5, 6, 7); } while (0)
#define G8_LDA(dst, b, h) do { if constexpr (FP8) { G8_LDA8(dst##8, b, h); break; } _Pragma("unroll") for (int m = 0; m < 4; ++m) _Pragma("unroll") for (int k = 0; k < 2; ++k) dst[m][k] = *(const G8_LAS bf16x8*)(lds + G8_SA(b, h) + aoff + m * 2048 + k * 1024); } while (0)
#define G8_LDB(dst, b, h) do { if constexpr (FP8) { G8_LDB8(dst##8, b, h); break; } _Pragma("unroll") for (int n = 0; n < 2; ++n) _Pragma("unroll") for (int k = 0; k < 2; ++k) dst[n][k] = *(const G8_LAS bf16x8*)(lds + G8_SB(b, h) + boff + n * 2048 + k * 1024); } while (0)
#define G8_MMA(ai, bj, At, Bt) do { __builtin_amdgcn_s_setprio(1); _Pragma("unroll") for (int m = 0; m < 4; ++m) _Pragma("unroll") for (int n = 0; n < 2; ++n) { \
        if constexpr (FP8) { asm volatile("v_mfma_scale_f32_16x16x128_f8f6f4 %0, %1, %2, %0, %3, %4 op_sel_hi:[0,0,0]" : "+v"(acc[ai][bj][m][n]) : "v"(Bt##8[n]), "v"(At##8[m]), "v"(scB), "v"(scA)); } \
        else { _Pragma("unroll") for (int k = 0; k < 2; ++k) acc[ai][bj][m][n] = __builtin_amdgcn_mfma_f32_16x16x32_bf16(Bt[n][k], At[m][k], acc[ai][bj][m][n], 0, 0, 0); } } __builtin_amdgcn_s_setprio(0); } while (0)
#define G8_WAIT_V(n) asm volatile("s_waitcnt vmcnt(" #n ")" ::: "memory")
#define G8_WAIT_L(n) asm volatile("s_waitcnt lgkmcnt(" #n ")" ::: "memory")
#define G8_BAR __builtin_amdgcn_s_barrier()
#define G8_SCHED __builtin_amdgcn_sched_barrier(0)
    Unit cur, nxt; int ui = 0;
    if (!S.next(0, cur)) return;
    f32x4 acc[2][2][4][2];
#pragma unroll
    for (int a = 0; a < 2; ++a)
#pragma unroll
        for (int b = 0; b < 2; ++b)
#pragma unroll
            for (int m = 0; m < 4; ++m)
#pragma unroll
                for (int n = 0; n < 2; ++n) acc[a][b][m][n] = (f32x4){0.f, 0.f, 0.f, 0.f};
    bf16x8 At[4][2], B0[2][2], B1[2][2];
    i32x8 At8[4], B08[2], B18[2];
    const char* cA = cur.a; const char* cB = cur.b;
    if constexpr (GATHER) { G8_TOK(vG, cur.tok); G8_TOK(vGn, cur.tok); }
    G8_STAGE(G8_SB(0, 0), cB, voffB); G8_STAGE(G8_SB(0, 1), cB + hstepB, voffB); G8_STAGE_A(G8_SA(0, 0), cA, 0, false); G8_STAGE_A(G8_SA(0, 1), cA, 1, false);
    if (wr == 1) G8_BAR;
    G8_WAIT_V(2); G8_BAR;
    G8_STAGE(G8_SB(1, 0), cB + kstep, voffB); G8_STAGE_A(G8_SA(1, 0), cA + kstep, 0, false); G8_STAGE(G8_SB(1, 1), cB + hstepB + kstep, voffB);
    G8_WAIT_V(6); G8_BAR;
    unsigned long long tk_ = 0, te_ = 0, tp_ = tsp ? __builtin_amdgcn_s_memrealtime() : 0;
    for (;;) {
        const bool has_next = S.next(ui + 1, nxt);
        const char* nA = has_next ? nxt.a : cA; const char* nB = has_next ? nxt.b : cB;
        if constexpr (GATHER) { if (has_next) G8_TOK(vGn, nxt.tok); }
#pragma unroll 1
        for (int t = 0; t < nt; t += 2) {
            const bool last = (t == nt - 2);
            if constexpr (Hook::ON) { if (t == seg_t) H(acc, cur, wr, wc, fr, fq); }
            const char* a1 = cA + (size_t)(t + 1) * kstep + (Hook::ON && t + 1 >= seg_t ? segj : 0);
            const char* a2 = last ? nA : cA + (size_t)(t + 2) * kstep + (Hook::ON && t + 2 >= seg_t ? segj : 0); const char* b2 = last ? nB : cB + (size_t)(t + 2) * kstep;
            const char* a3 = a2 + kstep; const char* b3 = b2 + kstep;
            G8_LDB(B0, 0, 0); G8_LDB(B1, 0, 1); G8_SCHED; G8_LDA(At, 0, 0); G8_STAGE_A(G8_SA(1, 1), a1, 1, false);
            G8_WAIT_V(8); G8_WAIT_L(0); G8_BAR; G8_MMA(0, 0, At, B0); G8_MMA(0, 1, At, B1); G8_BAR; G8_SCHED;
            G8_LDA(At, 0, 1); G8_STAGE(G8_SB(0, 0), b2, voffB); G8_STAGE(G8_SB(0, 1), b2 + hstepB, voffB); G8_STAGE_A(G8_SA(0, 0), a2, 0, last);
            G8_WAIT_V(8); G8_WAIT_L(0); G8_BAR; G8_MMA(1, 0, At, B0); G8_MMA(1, 1, At, B1); G8_BAR; G8_SCHED;
            G8_LDB(B0, 1, 0); G8_LDB(B1, 1, 1); G8_SCHED; G8_LDA(At, 1, 0); G8_STAGE_A(G8_SA(0, 1), a2, 1, last);
            G8_WAIT_V(8); G8_WAIT_L(0); G8_BAR; G8_MMA(0, 0, At, B0); G8_MMA(0, 1, At, B1); G8_BAR; G8_SCHED;
            G8_LDA(At, 1, 1); G8_STAGE(G8_SB(1, 0), b3, voffB); G8_STAGE(G8_SB(1, 1), b3 + hstepB, voffB); G8_STAGE_A(G8_SA(1, 0), a3, 0, last);
            G8_WAIT_V(8); G8_WAIT_L(0); G8_BAR; G8_MMA(1, 0, At, B0); G8_MMA(1, 1, At, B1); G8_BAR; G8_SCHED;
        }
        if constexpr (ALIGN_EPI) { if (wr == 0) G8_BAR; }
        if (tsp) { const unsigned long long n_ = __builtin_amdgcn_s_memrealtime(); tk_ += n_ - tp_; tp_ = n_; }
        if constexpr (FP8) asm volatile("s_nop 15\n\ts_nop 15" ::: "memory");
        E(acc, cur, wr, wc, fr, fq);
        if (tsp) { const unsigned long long n_ = __builtin_amdgcn_s_memrealtime(); te_ += n_ - tp_; tp_ = n_; }
        if (!has_next) break;
#pragma unroll
        for (int a = 0; a < 2; ++a)
#pragma unroll
            for (int b = 0; b < 2; ++b)
#pragma unroll
                for (int m = 0; m < 4; ++m)
#pragma unroll
                    for (int n = 0; n < 2; ++n) acc[a][b][m][n] = (f32x4){0.f, 0.f, 0.f, 0.f};
        cur = nxt; cA = nA; cB = nB; ++ui;
        if constexpr (GATHER) { _Pragma("unroll") for (int h_ = 0; h_ < 2; ++h_) _Pragma("unroll") for (int i_ = 0; i_ < 2; ++i_) vG[h_][i_] = vGn[h_][i_]; }
        if constexpr (ALIGN_EPI) { if (wr == 1) G8_BAR; }
    }
    G8_WAIT_V(0);
    if constexpr (!ALIGN_EPI) { if (wr == 0) G8_BAR; }
    G8_BAR;
    if (tsp && blockIdx.x == 0 && threadIdx.x == 0) { tsp[0] = 0; tsp[1] = tk_; tsp[2] = 0; tsp[3] = te_; tsp[4] = 0; tsp[5] = (unsigned long long)(ui + 1) * 100ull; }
#undef G8_SA
#undef G8_SB
#undef G8_STAGE
#undef G8_STAGE_A
#undef G8_TOK
#undef G8_LDA
#undef G8_LDA8
#undef G8_LDB8
#undef G8_LD16
#undef G8_LDB
#undef G8_MMA
#undef G8_WAIT_V
#undef G8_WAIT_L
#undef G8_BAR
#undef G8_SCHED
}
template <class F> struct Epi4 { F f;
    DEVI void operator()(const f32x4 (&acc)[2][2][4][2], const Unit& u, int wr, int wc, int fr, int fq) const {
        constexpr int NB = F::NB;
        asm volatile("" : "+v"(fr), "+v"(fq));
#pragma unroll
        for (int g0 = 0; g0 < 8; g0 += NB) {
            typename F::L ld[NB][2];
#pragma unroll
            for (int gg = 0; gg < NB; ++gg) { const int ai = (g0 + gg) >> 2, m = (g0 + gg) & 3;
#pragma unroll
                for (int bj = 0; bj < 2; ++bj) ld[gg][bj] = f.load(u.pm, u.pn, ai * 128 + wr * 64 + m * 16 + fr, bj * 128 + wc * 32 + 8 * fq); }
#pragma unroll
            for (int gg = 0; gg < NB; ++gg) { const int ai = (g0 + gg) >> 2, m = (g0 + gg) & 3;
#pragma unroll
                for (int bj = 0; bj < 2; ++bj) f.apply(u.pm, u.pn, ai * 128 + wr * 64 + m * 16 + fr, bj * 128 + wc * 32 + 8 * fq, acc[ai][bj][m][0], acc[ai][bj][m][1], ld[gg][bj]); }
            asm volatile("" ::: "memory");
        }
    } };
template <class F> struct Hook4 { static constexpr bool ON = true; F f;
    DEVI void operator()(f32x4 (&acc)[2][2][4][2], const Unit& u, int wr, int wc, int fr, int fq) const {
        constexpr int NB = F::NB;
        asm volatile("" : "+v"(fr), "+v"(fq));
#pragma unroll
        for (int g0 = 0; g0 < 8; g0 += NB) {
            typename F::L ld[NB][2];
#pragma unroll
            for (int gg = 0; gg < NB; ++gg) { const int ai = (g0 + gg) >> 2, m = (g0 + gg) & 3;
#pragma unroll
                for (int bj = 0; bj < 2; ++bj) ld[gg][bj] = f.load(u.pm, u.pn, ai * 128 + wr * 64 + m * 16 + fr, bj * 128 + wc * 32 + 8 * fq); }
#pragma unroll
            for (int gg = 0; gg < NB; ++gg) { const int ai = (g0 + gg) >> 2, m = (g0 + gg) & 3;
#pragma unroll
                for (int bj = 0; bj < 2; ++bj) f.apply(u.pm, u.pn, ai * 128 + wr * 64 + m * 16 + fr, bj * 128 + wc * 32 + 8 * fq, acc[ai][bj][m][0], acc[ai][bj][m][1], ld[gg][bj]); }
            asm volatile("" ::: "memory");
        }
    } };
}

struct NoLd {};
struct LbLd { f32x4 a, b; };
DEVI void store8bf(bf16_t* p, f32x4 a, f32x4 b) { u32x4 w; w.x = pk2(a[0], a[1]); w.y = pk2(a[2], a[3]); w.z = pk2(b[0], b[1]); w.w = pk2(b[2], b[3]); *(u32x4*)p = w; }
struct EpiZa { typedef LbLd L; static constexpr int NB = 1; unsigned char* ws;
    DEVI L load(int, int pn, int, int c) const { L l; l.a = (f32x4){0.f, 0.f, 0.f, 0.f}; l.b = l.a; if ((pn >> 2) == 1) { const float* lp = (const float*)(ws + WS_LBT) + (pn - 4) * 256 + c; l.a = *(const f32x4*)lp; l.b = *(const f32x4*)(lp + 4); } return l; }
    DEVI void apply(int pm, int pn, int r, int c, f32x4 v0, f32x4 v1, const L& lb) const {
        const size_t row = (size_t)pm * 256 + r; const int col = pn * 256 + c; const int kind = pn >> 2;
        if (pn >= 16) { store8bf((bf16_t*)(ws + WS_ZL) + row * ZL_P + (pn - 16) * 256 + c, v0, v1); return; }
        if (kind == 3) {
#pragma unroll
            for (int j = 0; j < 4; ++j) { v0[j] = siluf_(v0[j]); v1[j] = siluf_(v1[j]); } }
        if (kind == 0) {
#pragma unroll
            for (int j = 0; j < 4; ++j) { v0[j] = siluf_(v0[j]) * 0.08838834764831845f; v1[j] = siluf_(v1[j]) * 0.08838834764831845f; } }
        else if (kind == 1) {
#pragma unroll
            for (int j = 0; j < 4; ++j) { v0[j] = __logf(lb.a[j] + (1.f - lb.a[j]) * sigmoidf_(v0[j])); v1[j] = __logf(lb.b[j] + (1.f - lb.b[j]) * sigmoidf_(v1[j])); } }
        store8bf((bf16_t*)(ws + WS_ZH) + row * ZH_P + col, v0, v1);
    } };
struct EpiZb { typedef NoLd L; static constexpr int NB = 8; unsigned char* ws;
    DEVI L load(int, int, int, int) const { return {}; }
    DEVI void apply(int pm, int pn, int r, int c, f32x4 v0, f32x4 v1, L) const {
        const size_t row = (size_t)pm * 256 + r; u32x2 w = {0u, 0u};
#pragma unroll
        for (int j = 0; j < 4; ++j) { w.x |= (unsigned)fmaxf(__builtin_rintf(255.f * sigmoidf_(v0[j])), 1.f) << (8 * j); w.y |= (unsigned)fmaxf(__builtin_rintf(255.f * sigmoidf_(v1[j])), 1.f) << (8 * j); }
        *(u32x2*)(ws + WS_ZG + row * ZG_P + pn * 256 + c) = w;
    } };
struct EpiQ { typedef NoLd L; static constexpr int NB = 8; bf16_t* q;
    DEVI L load(int, int, int, int) const { return {}; }
    DEVI void apply(int pm, int pn, int r, int c, f32x4 v0, f32x4 v1, L) const { store8bf(q + ((size_t)pm * 256 + r) * 1536 + pn * 256 + c, v0, v1); } };
struct EpiKV { typedef NoLd L; static constexpr int NB = 8; bf16_t* kn; bf16_t* vv;
    DEVI L load(int, int, int, int) const { return {}; }
    DEVI void apply(int pm, int pn, int r, int c, f32x4 v0, f32x4 v1, L) const {
        const size_t row = (size_t)pm * 256 + r; const int col = pn * 256 + c; const int hh = col >> 8, cc = col & 255;
        if (cc < 128) store8bf(kn + row * 1024 + hh * 128 + cc, v0, v1); else store8bf(vv + row * 1024 + hh * 128 + (cc - 128), v0, v1);
    } };
struct BrHookF { typedef u32x4 L; static constexpr int NB = 1; const unsigned char* zg;
    DEVI L load(int pm, int pn, int r, int c) const { const unsigned char* g = zg + ((size_t)pm * 256 + r) * ZG_P + pn * 256 + c; const u32x2 a = *(const u32x2*)g, b = *(const u32x2*)(g + 1024); return (L){a.x, a.y, b.x, b.y}; }
    DEVI void apply(int, int, int, int, f32x4& v0, f32x4& v1, L l) const {
#pragma unroll
        for (int j = 0; j < 4; ++j) { v0[j] *= (float)((l.x >> (8 * j)) & 255u) * __builtin_amdgcn_rcpf((float)((l.z >> (8 * j)) & 255u)); v1[j] *= (float)((l.y >> (8 * j)) & 255u) * __builtin_amdgcn_rcpf((float)((l.w >> (8 * j)) & 255u)); } } };
struct EpiBr2 { typedef u32x2 L; static constexpr int NB = 2; const unsigned char* zg; bf16_t* y;
    DEVI L load(int pm, int pn, int r, int c) const { return *(const u32x2*)(zg + ((size_t)pm * 256 + r) * ZG_P + 1024 + pn * 256 + c); }
    DEVI void apply(int pm, int pn, int r, int c, f32x4 v0, f32x4 v1, L g) const {
#pragma unroll
        for (int j = 0; j < 4; ++j) { v0[j] *= (float)((g.x >> (8 * j)) & 255u) * (1.f / 255.f); v1[j] *= (float)((g.y >> (8 * j)) & 255u) * (1.f / 255.f); }
        store8bf(y + ((size_t)pm * 256 + r) * 1024 + pn * 256 + c, v0, v1); } };
struct EpiOut { typedef LbLd L; static constexpr int NB = 2; const float* x; bf16_t* x2b; unsigned char* x2f8;
    DEVI L load(int pm, int pn, int r, int c) const { const float* xp = x + ((size_t)pm * 256 + r) * 1024 + pn * 256 + c; L l; l.a = *(const f32x4*)xp; l.b = *(const f32x4*)(xp + 4); return l; }
    DEVI void apply(int pm, int pn, int r, int c, f32x4 v0, f32x4 v1, const L& xv) const { const size_t o = ((size_t)pm * 256 + r) * 1024 + pn * 256 + c; const f32x4 a = xv.a + v0, b = xv.b + v1; store8bf(x2b + o, a, b);
        u32x2 w; w.x = pk4_fp8(4.f * a[0], 4.f * a[1], 4.f * a[2], 4.f * a[3]); w.y = pk4_fp8(4.f * b[0], 4.f * b[1], 4.f * b[2], 4.f * b[3]); *(u32x2*)(x2f8 + o) = w; } };
struct EpiHid8 { unsigned char* hid; const float* srs;
    DEVI void operator()(const f32x4 (&acc)[2][2][4][2], const g8::Unit& u, int wr, int wc, int fr, int fq) const {
        asm volatile("" : "+v"(fr), "+v"(fq));
        float rs[8];
#pragma unroll
        for (int g = 0; g < 8; ++g) rs[g] = srs[(size_t)u.pm * 256 + (g >> 2) * 128 + wr * 64 + (g & 3) * 16 + fr];
#pragma unroll
        for (int g = 0; g < 8; ++g) { const int ai = g >> 2, m = g & 3; unsigned char* hrow = hid + ((size_t)u.pm * 256 + ai * 128 + wr * 64 + m * 16 + fr) * EFF + u.pn * 128 + wc * 16 + 4 * fq;
#pragma unroll
            for (int bj = 0; bj < 2; ++bj) { const f32x4 gg = acc[ai][bj][m][0] * rs[g], uu = acc[ai][bj][m][1] * rs[g]; float h4[4];
#pragma unroll
                for (int i = 0; i < 4; ++i) h4[i] = fminf(fmaxf(8.f * siluf_(gg[i]) * uu[i], -440.f), 440.f);
                *(unsigned*)(hrow + bj * 64) = pk4_fp8(h4[0], h4[1], h4[2], h4[3]); } }
    } };
struct EpiY { typedef float L; static constexpr int NB = 8; bf16_t* yexp; const float* sw;
    DEVI L load(int tile, int, int r, int) const { return sw[(size_t)tile * 256 + r]; }
    DEVI void apply(int tile, int pn, int r, int c, f32x4 v0, f32x4 v1, L w) const { store8bf(yexp + ((size_t)tile * 256 + r) * 1024 + pn * 256 + c, v0 * w, v1 * w); } };

DEVI void phase0(const Params& p, char* lds) {
    float* scr = (float*)lds; unsigned char* ws = p.ws;
    bf16_t* WinT = (bf16_t*)(ws + WS_WIN); bf16_t* WuqT = (bf16_t*)(ws + WS_WUQ); bf16_t* WukvT = (bf16_t*)(ws + WS_WUKV);
    bf16_t* WbrT = (bf16_t*)(ws + WS_WBR); bf16_t* WoutT = (bf16_t*)(ws + WS_WOUT);
    constexpr int I_IN = (4864 / 64) * 16, I_IN8 = (2048 / 64) * 16, I_UQ = 24 * 6, I_UKV = 32 * 4, I_BR = 16 * 16, I_OUT = 16 * 16;
    constexpr int NIT = I_IN + I_IN8 + I_UQ + I_UKV + 2 * I_BR + I_OUT;
    for (int it = blockIdx.x; it < NIT; it += gridDim.x) {
        int r = it;
        if (r < I_IN) { const int nb = r / 16, kb = r % 16; const float* nw = p.attn_norm_w;
            transpose_tile(p.w_in, 6848, WinT, 1024, kb * 64, nb * 64, [](int n) { return n < 4800 ? n : -1; }, [nw](int k) { return nw[k]; }, scr); continue; }
        r -= I_IN;
        if (r < I_IN8) { const int nb = r / 16, kb = r % 16; const float* nw = p.attn_norm_w;
            transpose_tile_f8(p.w_in, 6848, ws + WS_WIN8, 1024, kb * 64, nb * 64, [](int n) { return 4800 + n; }, [nw](int k) { return nw[k] * 64.f; }, scr); continue; }
        r -= I_IN8;
        if (r < I_UQ) { const int nb = r / 6, kb = r % 6; const float* nw = p.q_norm_w;
            transpose_tile(p.w_uq, 1536, WuqT, 384, kb * 64, nb * 64,
                           [](int n) { const int hh = n / 192, c = n % 192; if (c < 128) return n; const int rr = c - 128; return hh * 192 + 128 + (rr & 1) * 32 + (rr >> 1); },
                           [nw](int k) { return nw[k] * 0.07216878364870322f; }, scr); continue; }
        r -= I_UQ;
        if (r < I_UKV) { const int nb = r / 4, kb = r % 4; const float* nw = p.kv_norm_w;
            transpose_tile(p.w_ukv, 2048, WukvT, 256, kb * 64, nb * 64, [](int n) { return n; }, [nw](int k) { return nw[k]; }, scr); continue; }
        r -= I_UKV;
        if (r < I_BR) { const int nb = r / 16, kb = r % 16;
            transpose_tile(p.w_bra, 1024, WbrT, 2048, kb * 64, nb * 64, [](int n) { return n; }, [](int) { return 1.f; }, scr); continue; }
        r -= I_BR;
        if (r < I_BR) { const int nb = r / 16, kb = r % 16;
            transpose_tile(p.w_brb, 1024, WbrT + 1024, 2048, kb * 64, nb * 64, [](int n) { return n; }, [](int) { return 1.f; }, scr); continue; }
        r -= I_BR;
        { const int nb = r / 16, kb = r % 16;
            transpose_tile(p.w_out, 1024, WoutT, 1024, kb * 64, nb * 64, [](int n) { return n; }, [](int) { return 1.f; }, scr); }
    }
    if (blockIdx.x == 0 && threadIdx.x == 0) { unsigned long long* tb = (unsigned long long*)(ws + WS_PTRS);
        tb[PT_POS] = (unsigned long long)p.pos; tb[PT_HGLB] = (unsigned long long)p.hg_lb; tb[PT_HGONW] = (unsigned long long)p.hg_onw; tb[PT_RGB] = (unsigned long long)p.rg_b; tb[PT_REB] = (unsigned long long)p.re_b;
        tb[PT_EW1] = (unsigned long long)p.ew1; tb[PT_EW3] = (unsigned long long)p.ew3; tb[PT_EW2] = (unsigned long long)p.ew2; tb[PT_FFNW] = (unsigned long long)p.ffn_norm_w; tb[PT_FINW] = (unsigned long long)p.final_w; tb[PT_X] = (unsigned long long)p.x; }
    bf16_t* WrH = (bf16_t*)(ws + WS_WRT); bf16_t* WrL = WrH + 80 * 1024;
    for (int e = blockIdx.x * NTHR + threadIdx.x; e < 80 * 1024; e += gridDim.x * NTHR) { const int c = e >> 10, k = e & 1023;
        const float w = c < 8 ? p.rg_w[k * 8 + c] * p.ffn_norm_w[k] : (c < 72 ? p.re_w[k * 64 + (c - 8)] * p.ffn_norm_w[k] : 0.f);
        const unsigned hb = f2bf(w); WrH[e] = (bf16_t)hb; WrL[e] = (bf16_t)f2bf(w - bf2f(hb)); }
    { float* lbt = (float*)(ws + WS_LBT); for (int k = blockIdx.x * NTHR + threadIdx.x; k < 1024; k += gridDim.x * NTHR) lbt[k] = 1.f / (1.f + expf(p.hg_lb[1024 + k] - p.hg_lb[k])); }
    bf16_t* H = (bf16_t*)(ws + WS_H);
    const int lane = threadIdx.x & 63, gw = blockIdx.x * 8 + (threadIdx.x >> 6), NGW = gridDim.x * 8;
    for (int m0 = gw * 2; m0 < T; m0 += NGW * 2) {
        f32x4 v[2][4];
#pragma unroll
        for (int r = 0; r < 2; ++r) { const f32x4* xr = (const f32x4*)(p.x + (size_t)(m0 + r) * D) + lane;
#pragma unroll
            for (int j = 0; j < 4; ++j) v[r][j] = xr[64 * j]; }
#pragma unroll
        for (int r = 0; r < 2; ++r) { const int m = m0 + r; float s = 0.f;
#pragma unroll
            for (int j = 0; j < 4; ++j) s += v[r][j][0] * v[r][j][0] + v[r][j][1] * v[r][j][1] + v[r][j][2] * v[r][j][2] + v[r][j][3] * v[r][j][3];
            const float rstd = rsqrtf(wave_sum(s) * (1.f / D) + 1e-6f);
            u32x2* o = (u32x2*)(H + (size_t)m * D) + lane; unsigned* o8 = (unsigned*)(ws + WS_H8 + (size_t)m * D) + lane; const float r4 = 4.f * rstd;
#pragma unroll
            for (int j = 0; j < 4; ++j) { u32x2 w; w.x = pk2(v[r][j][0] * rstd, v[r][j][1] * rstd); w.y = pk2(v[r][j][2] * rstd, v[r][j][3] * rstd); o[64 * j] = w;
                o8[64 * j] = pk4_fp8(v[r][j][0] * r4, v[r][j][1] * r4, v[r][j][2] * r4, v[r][j][3] * r4); } }
    }
}

DEVI void phase1(const Params& p, char* lds) {
    unsigned char* ws = p.ws;
    { g8::DenseOrder S; S.init(ws + WS_H, D, ws + WS_WIN, D, T, 4864); g8::Epi4<EpiZa> E{{ws}};
      g8::gemm_phase<g8::Epi4<EpiZa>, g8::DenseOrder, true>((G8_LAS unsigned char*)lds, D, D, D, S, E); }
    { g8::DenseOrder S; S.init(ws + WS_H8, D / 2, ws + WS_WIN8, D / 2, T, 2048); g8::Epi4<EpiZb> E{{ws}};
      g8::gemm_phase<g8::Epi4<EpiZb>, g8::DenseOrder, true, g8::NoHook, false, true>((G8_LAS unsigned char*)lds, D / 2, D / 2, D / 2, S, E, nullptr, g8::NoHook(), 1 << 30, 0, 125, 121); }
}

constexpr int HL_A = 0, HL_B = 17408, HL_BT = 34816, HL_VT = 53248, HL_AT = 71680, HL_ST = 80896, HL_SEG = 115712, HL_SS = 119808;
#define HG_BAR() do { asm volatile("s_waitcnt lgkmcnt(0)" ::: "memory"); __builtin_amdgcn_s_barrier(); asm volatile("" ::: "memory"); } while (0)
DEVI void hgrn_chain_mfma(const Params& p, char* lds, int b, int h) {
    const bf16_t* zh = (const bf16_t*)(p.ws + WS_ZH); bf16_t* oa = (bf16_t*)(p.ws + WS_OA);
    const float* hgonw = (const float*)ptab(p.ws, PT_HGONW);
    const int tid = threadIdx.x, lane = tid & 63, wid = __builtin_amdgcn_readfirstlane(tid >> 6), fr = lane & 15, g4 = lane >> 4;
    const int k2 = lane * 2, seg = wid;
    f32x4 S[8];
#pragma unroll
    for (int n = 0; n < 8; ++n) S[n] = (f32x4){0.f, 0.f, 0.f, 0.f};
    const bf16_t* zb = zh + (size_t)b * SEQ * ZH_P + h * 128;
    float* segs = (float*)(lds + HL_SEG); float* lss = (float*)(lds + HL_SS);
    unsigned rq[8], rf[8], rv[8];
#pragma unroll
    for (int i = 0; i < 8; ++i) { const bf16_t* r = zb + (size_t)(seg * 8 + i) * ZH_P + k2; rq[i] = *(const unsigned*)r; rf[i] = *(const unsigned*)(r + 1024); rv[i] = *(const unsigned*)(r + 2048); }
    const int tt = wid >> 1, vh = wid & 1;
    f32x4 nwv[4];
#pragma unroll
    for (int n = 0; n < 4; ++n) nwv[n] = *(const f32x4*)(hgonw + 16 * (4 * vh + n) + 4 * g4);
#if defined(TPROBE_A)
    unsigned long long tacc[6] = {0, 0, 0, 0, 0, 0}; unsigned long long tprev = __builtin_amdgcn_s_memrealtime();
#define HG_T(k) do { const unsigned long long now_ = __builtin_amdgcn_s_memrealtime(); tacc[k] += now_ - tprev; tprev = now_; } while (0)
#else
#define HG_T(k)
#endif
    for (int c = 0; c < SEQ / 64; ++c) {
        const int t0 = c * 64;
        u32x2 gpre[4];
        { const bf16_t* gp_ = zh + ((size_t)b * SEQ + t0 + 16 * tt + fr) * ZH_P + 3072 + h * 128;
#pragma unroll
          for (int n = 0; n < 4; ++n) gpre[n] = *(const u32x2*)(gp_ + 16 * (4 * vh + n) + 4 * g4); }
        float cs[8][2], qq[8][2], kk[8][2]; float run[2] = {0.f, 0.f};
#pragma unroll
        for (int i = 0; i < 8; ++i)
#pragma unroll
            for (int e = 0; e < 2; ++e) { const float lf = bf2f(e ? rf[i] >> 16 : rf[i] & 0xffffu); run[e] += lf; cs[i][e] = run[e]; kk[i][e] = 1.f - __expf(lf); qq[i][e] = bf2f(e ? rq[i] >> 16 : rq[i] & 0xffffu); }
        HG_BAR();
        HG_T(0);
        *(float2*)(segs + seg * 128 + k2) = make_float2(run[0], run[1]);
#pragma unroll
        for (int e = 0; e < 2; ++e) { u32x4 w;
            w.x = e ? (rv[0] >> 16) | (rv[1] & 0xffff0000u) : (rv[0] & 0xffffu) | (rv[1] << 16); w.y = e ? (rv[2] >> 16) | (rv[3] & 0xffff0000u) : (rv[2] & 0xffffu) | (rv[3] << 16);
            w.z = e ? (rv[4] >> 16) | (rv[5] & 0xffff0000u) : (rv[4] & 0xffffu) | (rv[5] << 16); w.w = e ? (rv[6] >> 16) | (rv[7] & 0xffff0000u) : (rv[6] & 0xffffu) | (rv[7] << 16);
            *(u32x4*)(lds + HL_VT + (k2 + e) * 144 + seg * 16) = w; }
        HG_BAR();
        HG_T(1);
        {
            float off[2] = {0.f, 0.f}, bm[2] = {0.f, 0.f};
#pragma unroll
            for (int s_ = 0; s_ < 8; ++s_) { const float2 v = *(const float2*)(segs + s_ * 128 + k2); if (s_ < seg) { off[0] += v.x; off[1] += v.y; } if (s_ < 4) { bm[0] += v.x; bm[1] += v.y; } }
            unsigned bt[2][4];
#pragma unroll
            for (int i = 0; i < 8; ++i) { float av[2], bv[2];
#pragma unroll
                for (int e = 0; e < 2; ++e) { const float ea = __expf(cs[i][e] + off[e] - bm[e]); av[e] = qq[i][e] * ea; bv[e] = kk[i][e] * __builtin_amdgcn_rcpf(ea); }
                *(unsigned*)(lds + HL_A + (seg * 8 + i) * 272 + k2 * 2) = pk2(av[0], av[1]);
                const unsigned pb = pk2(bv[0], bv[1]); *(unsigned*)(lds + HL_B + (seg * 8 + i) * 272 + k2 * 2) = pb;
                if (i & 1) { bt[0][i >> 1] |= pb << 16; bt[1][i >> 1] |= pb & 0xffff0000u; } else { bt[0][i >> 1] = pb & 0xffffu; bt[1][i >> 1] = pb >> 16; } }
#pragma unroll
            for (int e = 0; e < 2; ++e) { u32x4 w = {bt[e][0], bt[e][1], bt[e][2], bt[e][3]}; *(u32x4*)(lds + HL_BT + (k2 + e) * 144 + seg * 16) = w; }
        }
        f32x4 bmid = {0.f, 0.f, 0.f, 0.f}, blast = {0.f, 0.f, 0.f, 0.f};
#pragma unroll
        for (int s_ = 0; s_ < 8; ++s_) { const f32x4 v = *(const f32x4*)(segs + s_ * 128 + 16 * wid + 4 * g4); blast += v; if (s_ < 4) bmid += v; }
        {
            f32x4 em; em[0] = __expf(bmid[0]); em[1] = __expf(bmid[1]); em[2] = __expf(bmid[2]); em[3] = __expf(bmid[3]);
#pragma unroll
            for (int n = 0; n < 8; ++n) { u32x2 w; w.x = pk2(S[n][0] * em[0], S[n][1] * em[1]); w.y = pk2(S[n][2] * em[2], S[n][3] * em[3]); *(u32x2*)(lds + HL_ST + (16 * n + fr) * 272 + (16 * wid + 4 * g4) * 2) = w; }
        }
        if (c + 1 < SEQ / 64) {
#pragma unroll
            for (int i = 0; i < 8; ++i) { const bf16_t* r = zb + (size_t)(t0 + 64 + seg * 8 + i) * ZH_P + k2; rq[i] = *(const unsigned*)r; rf[i] = *(const unsigned*)(r + 1024); rv[i] = *(const unsigned*)(r + 2048); }
        }
        HG_BAR();
        HG_T(2);
#define HG_LD(off) (*(const bf16x8*)(lds + (off)))
#define HG_FENCE() do { asm volatile("s_waitcnt lgkmcnt(0)" ::: "memory"); __builtin_amdgcn_sched_barrier(0); } while (0)
        {
            bf16x8 fa[4], fb0[4], fb1[4]; const int ss0 = 2 * vh, ss1 = 2 * vh + 1;
#pragma unroll
            for (int kk4 = 0; kk4 < 4; ++kk4) { fa[kk4] = HG_LD(HL_A + (16 * tt + fr) * 272 + (32 * kk4 + 8 * g4) * 2); fb0[kk4] = HG_LD(HL_B + (16 * ss0 + fr) * 272 + (32 * kk4 + 8 * g4) * 2); fb1[kk4] = HG_LD(HL_B + (16 * ss1 + fr) * 272 + (32 * kk4 + 8 * g4) * 2); }
            HG_FENCE();
            f32x4 acc0 = {0.f, 0.f, 0.f, 0.f}, acc1 = {0.f, 0.f, 0.f, 0.f};
#pragma unroll
            for (int kk4 = 0; kk4 < 4; ++kk4) { acc0 = __builtin_amdgcn_mfma_f32_16x16x32_bf16(fb0[kk4], fa[kk4], acc0, 0, 0, 0); acc1 = __builtin_amdgcn_mfma_f32_16x16x32_bf16(fb1[kk4], fa[kk4], acc1, 0, 0, 0); }
#pragma unroll
            for (int i = 0; i < 4; ++i) { if (ss0 > tt || (ss0 == tt && 4 * g4 + i > fr)) acc0[i] = 0.f; if (ss1 > tt || (ss1 == tt && 4 * g4 + i > fr)) acc1[i] = 0.f; }
            u32x2 w; w.x = pk2(acc0[0], acc0[1]); w.y = pk2(acc0[2], acc0[3]); *(u32x2*)(lds + HL_AT + (16 * tt + fr) * 144 + (16 * ss0 + 4 * g4) * 2) = w;
            w.x = pk2(acc1[0], acc1[1]); w.y = pk2(acc1[2], acc1[3]); *(u32x2*)(lds + HL_AT + (16 * tt + fr) * 144 + (16 * ss1 + 4 * g4) * 2) = w;
        }
        HG_BAR();
        HG_T(3);
        f32x4 o[4];
#pragma unroll
        for (int n = 0; n < 4; ++n) o[n] = (f32x4){0.f, 0.f, 0.f, 0.f};
        {
            bf16x8 fat[2], fa[4];
#pragma unroll
            for (int ks = 0; ks < 2; ++ks) fat[ks] = HG_LD(HL_AT + (16 * tt + fr) * 144 + (32 * ks + 8 * g4) * 2);
#pragma unroll
            for (int kk4 = 0; kk4 < 4; ++kk4) fa[kk4] = HG_LD(HL_A + (16 * tt + fr) * 272 + (32 * kk4 + 8 * g4) * 2);
#pragma unroll
            for (int nh = 0; nh < 2; ++nh) {
                bf16x8 fv[2][2], fs[2][4];
#pragma unroll
                for (int n2 = 0; n2 < 2; ++n2) { const int vrow = 16 * (4 * vh + 2 * nh + n2) + fr;
#pragma unroll
                    for (int ks = 0; ks < 2; ++ks) fv[n2][ks] = HG_LD(HL_VT + vrow * 144 + (32 * ks + 8 * g4) * 2);
#pragma unroll
                    for (int kk4 = 0; kk4 < 4; ++kk4) fs[n2][kk4] = HG_LD(HL_ST + vrow * 272 + (32 * kk4 + 8 * g4) * 2); }
                HG_FENCE();
#pragma unroll
                for (int ks = 0; ks < 2; ++ks)
#pragma unroll
                    for (int n2 = 0; n2 < 2; ++n2) o[2 * nh + n2] = __builtin_amdgcn_mfma_f32_16x16x32_bf16(fv[n2][ks], fat[ks], o[2 * nh + n2], 0, 0, 0);
#pragma unroll
                for (int kk4 = 0; kk4 < 4; ++kk4)
#pragma unroll
                    for (int n2 = 0; n2 < 2; ++n2) o[2 * nh + n2] = __builtin_amdgcn_mfma_f32_16x16x32_bf16(fs[n2][kk4], fa[kk4], o[2 * nh + n2], 0, 0, 0);
            }
        }
        { float ssq = 0.f;
#pragma unroll
          for (int n = 0; n < 4; ++n) ssq += o[n][0] * o[n][0] + o[n][1] * o[n][1] + o[n][2] * o[n][2] + o[n][3] * o[n][3];
          ssq += __shfl_xor(ssq, 16); ssq += __shfl_xor(ssq, 32); if (g4 == 0) lss[vh * 64 + 16 * tt + fr] = ssq; }
        {
            f32x4 U[8]; bf16x8 fbt[2], fv[8][2];
#pragma unroll
            for (int ks = 0; ks < 2; ++ks) { fbt[ks] = HG_LD(HL_BT + (16 * wid + fr) * 144 + (32 * ks + 8 * g4) * 2);
#pragma unroll
                for (int n = 0; n < 8; ++n) fv[n][ks] = HG_LD(HL_VT + (16 * n + fr) * 144 + (32 * ks + 8 * g4) * 2); }
            HG_FENCE();
#pragma unroll
            for (int n = 0; n < 8; ++n) { U[n] = __builtin_amdgcn_mfma_f32_16x16x32_bf16(fbt[0], fv[n][0], (f32x4){0.f, 0.f, 0.f, 0.f}, 0, 0, 0); }
#pragma unroll
            for (int n = 0; n < 8; ++n) { U[n] = __builtin_amdgcn_mfma_f32_16x16x32_bf16(fbt[1], fv[n][1], U[n], 0, 0, 0); }
            f32x4 el, elm;
#pragma unroll
            for (int i = 0; i < 4; ++i) { el[i] = __expf(blast[i]); elm[i] = __expf(blast[i] - bmid[i]); }
#pragma unroll
            for (int n = 0; n < 8; ++n) S[n] = S[n] * el + U[n] * elm;
        }
#undef HG_LD
#undef HG_FENCE
        HG_BAR();
        HG_T(4);
        {
            const int t = 16 * tt + fr; const float rstd = rsqrtf((lss[t] + lss[64 + t]) * (1.f / 128.f) + 1e-6f);
            const size_t trow = (size_t)b * SEQ + t0 + t; bf16_t* op = oa + trow * 1024 + h * 128;
#pragma unroll
            for (int n = 0; n < 4; ++n) { const int v0 = 16 * (4 * vh + n) + 4 * g4; const u32x2 gg = gpre[n]; const f32x4 nw = nwv[n];
                f32x4 r; r[0] = o[n][0] * rstd * nw[0] * bf2f(gg.x & 0xffffu); r[1] = o[n][1] * rstd * nw[1] * bf2f(gg.x >> 16);
                r[2] = o[n][2] * rstd * nw[2] * bf2f(gg.y & 0xffffu); r[3] = o[n][3] * rstd * nw[3] * bf2f(gg.y >> 16); store4bf(op + v0, r); }
        }
        HG_T(5);
    }
#if defined(TPROBE_A)
    if (blockIdx.x == 0 && threadIdx.x == 0) { unsigned long long* ts = (unsigned long long*)(p.ws + WS_TS); for (int k = 0; k < 6; ++k) { ts[20 + 2 * k] = 0; ts[21 + 2 * k] = tacc[k]; } }
#endif
    HG_BAR();
}
#undef HG_BAR
DEVI void conv_tile256(const float* colp, size_t rs, const float* kscale, bf16_t* dst, int ldk, float* scr) {
    const int tid = threadIdx.x;
    { const int nl = tid & 63, kq = tid >> 6;
      float v[32];
#pragma unroll
      for (int i = 0; i < 32; ++i) v[i] = colp[(size_t)(kq * 32 + i) * rs];
      if (kscale) {
#pragma unroll
          for (int i = 0; i < 32; ++i) v[i] *= kscale[kq * 32 + i]; }
#pragma unroll
      for (int i = 0; i < 32; ++i) scr[(kq * 32 + i) * 65 + nl] = v[i]; }
    __syncthreads();
    { const int nl = tid >> 3, kc = tid & 7;
#pragma unroll
      for (int j = 0; j < 4; ++j) { const float* s_ = scr + (kc * 8 + 64 * j) * 65 + nl;
          u32x4 o; o.x = pk2(s_[0], s_[65]); o.y = pk2(s_[2 * 65], s_[3 * 65]); o.z = pk2(s_[4 * 65], s_[5 * 65]); o.w = pk2(s_[6 * 65], s_[7 * 65]);
          *(u32x4*)(dst + (size_t)nl * ldk + kc * 8 + 64 * j) = o; } }
    __syncthreads();
}
DEVI void conv_tile256_f8(const float* colp, size_t rs, const float* kscale, float wscale, unsigned char* dst, int ldk, float* scr) {
    const int tid = threadIdx.x;
    { const int nl = tid & 63, kq = tid >> 6; float v[32];
#pragma unroll
      for (int i = 0; i < 32; ++i) v[i] = colp[(size_t)(kq * 32 + i) * rs];
#pragma unroll
      for (int i = 0; i < 32; ++i) v[i] *= kscale ? kscale[kq * 32 + i] * wscale : wscale;
#pragma unroll
      for (int i = 0; i < 32; ++i) scr[(kq * 32 + i) * 65 + nl] = v[i]; }
    __syncthreads();
    { const int nl = tid >> 3, kc = tid & 7;
#pragma unroll
      for (int j = 0; j < 4; ++j) { const float* s_ = scr + (kc * 8 + 64 * j) * 65 + nl;
          u32x2 o; o.x = pk4_fp8(s_[0], s_[65], s_[2 * 65], s_[3 * 65]); o.y = pk4_fp8(s_[4 * 65], s_[5 * 65], s_[6 * 65], s_[7 * 65]);
          *(u32x2*)(dst + (size_t)nl * ldk + kc * 8 + 64 * j) = o; } }
    __syncthreads();
}
DEVI void mla_prep(const Params& p, int chunk) {
    bf16_t* zl = (bf16_t*)(p.ws + WS_ZL); float* cosT = (float*)(p.ws + WS_COS); float* sinT = (float*)(p.ws + WS_SIN); const int* posp = (const int*)ptab(p.ws, PT_POS);
    const int lane = threadIdx.x & 63, wid = threadIdx.x >> 6;
    for (int rr = wid; rr < 256; rr += 8) { const size_t t = (size_t)chunk * 256 + rr; bf16_t* zr = zl + t * ZL_P;
        float cq[6], ck[4]; float s = 0.f, s2 = 0.f;
#pragma unroll
        for (int j = 0; j < 6; ++j) { cq[j] = bf2f(zr[lane + 64 * j]); s += cq[j] * cq[j]; }
#pragma unroll
        for (int j = 0; j < 4; ++j) { ck[j] = bf2f(zr[384 + lane + 64 * j]); s2 += ck[j] * ck[j]; }
        const float kr = bf2f(zr[640 + lane]);
        const float r1 = rsqrtf(wave_sum(s) * (1.f / 384.f) + 1e-6f), r2 = rsqrtf(wave_sum(s2) * (1.f / 256.f) + 1e-6f);
        const float other = __shfl_xor(kr, 32);
        const int i = lane & 31; const float invf = powf(10000.f, -(float)i / 32.f); const float ang = (float)posp[t] * invf; const float cs = cosf(ang), sn = sinf(ang);
        const float x1 = lane < 32 ? kr : other, x2 = lane < 32 ? other : kr;
        const float outv = lane < 32 ? (x1 * cs - x2 * sn) : (x2 * cs + x1 * sn);
#pragma unroll
        for (int j = 0; j < 6; ++j) zr[lane + 64 * j] = (bf16_t)f2bf(cq[j] * r1);
#pragma unroll
        for (int j = 0; j < 4; ++j) zr[384 + lane + 64 * j] = (bf16_t)f2bf(ck[j] * r2);
        ((bf16_t*)(p.ws + WS_KPE))[t * 64 + 2 * i + (lane >> 5)] = (bf16_t)f2bf(outv);
        if (lane < 32) { cosT[t * 32 + i] = cs; sinT[t * 32 + i] = sn; }
    }
}
DEVI void phase2a(const Params& p, char* lds, bool prep = true) {
#pragma unroll 1
    for (int it = blockIdx.x; it < 128; it += gridDim.x) {
        hgrn_chain_mfma(p, lds, it >> 3, it & 7);
#if defined(TPROBE_A)
        if (TPROBE_A == 12 && blockIdx.x == 0 && threadIdx.x == 0) ((unsigned long long*)(p.ws + WS_TS))[13] = __builtin_amdgcn_s_memrealtime();
#endif
    }
#pragma unroll 1
    for (int it = blockIdx.x; it < 256; it += gridDim.x) { if (it < 128) continue;
        if (prep) mla_prep(p, it - 128);
        const float* ew1 = (const float*)ptab(p.ws, PT_EW1); const float* ew3 = (const float*)ptab(p.ws, PT_EW3); const float* ffnw = (const float*)ptab(p.ws, PT_FFNW); const int nl = threadIdx.x & 63;
        __syncthreads();
#pragma unroll 1
        for (int ci = it - 128; ci < NEXP * 64; ci += 128) { const int e = ci >> 6, r = ci & 63, nb = r >> 2, kb = r & 3, n = nb * 64 + nl, col = (n >> 3) * 4 + (n & 3);
            const float* colp = ((n & 4) ? ew3 : ew1) + (size_t)e * 1024 * 512 + (size_t)(kb * 256) * 512 + col;
            conv_tile256_f8(colp, 512, ffnw + kb * 256, 64.f, p.ws + WS_W13 + ((size_t)e * 1024 + nb * 64) * 1024 + kb * 256, 1024, (float*)lds); }
    }
}

DEVI void phase2b(const Params& p, char* lds) {
    unsigned char* ws = p.ws;
    { g8::DenseOrder S; S.init(ws + WS_ZL, ZL_P, ws + WS_WUQ, 384, T, 1536);
      g8::Epi4<EpiQ> E{{(bf16_t*)(ws + WS_Q)}};
      g8::gemm_phase<g8::Epi4<EpiQ>, g8::DenseOrder, true>((G8_LAS unsigned char*)lds, ZL_P, 384, 384, S, E); }
    { g8::DenseOrder S; S.init(ws + WS_ZL + 384 * 2, ZL_P, ws + WS_WUKV, 256, T, 2048);
      g8::Epi4<EpiKV> E{{(bf16_t*)(ws + WS_KN), (bf16_t*)(ws + WS_V)}};
      g8::gemm_phase<g8::Epi4<EpiKV>, g8::DenseOrder, true>((G8_LAS unsigned char*)lds, ZL_P, 256, 256, S, E); }
}

namespace at2 {
typedef short s16x4 __attribute__((ext_vector_type(4)));
typedef float f32x16 __attribute__((ext_vector_type(16)));
constexpr int KROW = 384;
constexpr int SHM_K = 64 * KROW, SHM_V = 64 * 256;
constexpr int L_V = 0, L_K = 2 * SHM_V, L_WS = 2 * SHM_V + 2 * SHM_K;
constexpr float THR = 8.f;
#define AT_KSWZ(row, colB) ((row) * at2::KROW + ((colB) ^ (((row) & 7) << 4)))
DEVI int v_st(int k, int c) { const int kk = (k & ~0xC) | ((k & 4) << 1) | ((k & 8) >> 1); return ((kk >> 3) * 4 + (c >> 5)) * 512 + ((kk & 7) * 32 + (c & 31)) * 2; }
DEVI int v_rd_base(int lane) { return ((lane & 3) << 3) | (((lane >> 2) & 3) << 6) | (((lane >> 4) & 1) << 5) | (((lane >> 5) & 1) << 8); }
constexpr int v_rd_off(int d0, int ks, int half) { return d0 * 512 + ks * 4096 + half * 2048; }
DEVI int crow(int r, int hi) { return (r & 3) + 8 * (r >> 2) + 4 * hi; }
DEVI unsigned cvtpk(float lo, float hi) { unsigned r; asm volatile("v_cvt_pk_bf16_f32 %0, %1, %2" : "=v"(r) : "v"(lo), "v"(hi)); return r; }
DEVI void mask_tile(f32x16& p0, f32x16& p1, int dq) {
    const float NEG = -__builtin_inff();
#pragma unroll
    for (int r = 0; r < 16; ++r) { const int c = (r & 3) + 8 * (r >> 2); if (dq - c < 0) p0[r] = NEG; if (dq - c - 32 < 0) p1[r] = NEG; }
}
DEVI void partialSM(f32x16& p0, f32x16& p1, float& m_reg, float& mn, float& alpha) {
    float pmax = p0[0];
#pragma unroll
    for (int r = 1; r < 16; ++r) pmax = fmaxf(pmax, p0[r]);
#pragma unroll
    for (int r = 0; r < 16; ++r) pmax = fmaxf(pmax, p1[r]);
    { auto rr = __builtin_amdgcn_permlane32_swap(__float_as_uint(pmax), __float_as_uint(pmax), false, false); pmax = fmaxf(__uint_as_float(rr[0]), __uint_as_float(rr[1])); }
    constexpr float C2 = 1.4426950408889634f;
    if (__builtin_expect(__all((pmax - m_reg) <= THR), 1)) { mn = m_reg; alpha = 1.f; }
    else { mn = fmaxf(m_reg, pmax); alpha = __builtin_amdgcn_exp2f((m_reg - mn) * C2); m_reg = mn; }
    const float mnL = -mn * C2;
#pragma unroll
    for (int r = 0; r < 16; ++r) p0[r] = fmaf(p0[r], C2, mnL);
#pragma unroll
    for (int r = 0; r < 16; ++r) p1[r] = fmaf(p1[r], C2, mnL);
#pragma unroll
    for (int r = 0; r < 16; ++r) p0[r] = __builtin_amdgcn_exp2f(p0[r]);
}
DEVI void finishSM(f32x16& p0, f32x16& p1, float alpha, float& l_reg, bf16x8& pa0, bf16x8& pa1, bf16x8& pa2, bf16x8& pa3) {
#pragma unroll
    for (int r = 0; r < 16; ++r) p1[r] = __builtin_amdgcn_exp2f(p1[r]);
    float ps = 0;
#pragma unroll
    for (int r = 0; r < 16; ++r) ps += p0[r];
#pragma unroll
    for (int r = 0; r < 16; ++r) ps += p1[r];
    { auto rr = __builtin_amdgcn_permlane32_swap(__float_as_uint(ps), __float_as_uint(ps), false, false); ps = __uint_as_float(rr[0]) + __uint_as_float(rr[1]); }
    l_reg = l_reg * alpha + ps;
#define AT_PK4(P, B_, OUT) do { unsigned a0 = cvtpk(P[B_+0], P[B_+1]), a1 = cvtpk(P[B_+2], P[B_+3]); unsigned b0 = cvtpk(P[B_+4], P[B_+5]), b1 = cvtpk(P[B_+6], P[B_+7]); \
        auto r0 = __builtin_amdgcn_permlane32_swap(a0, b0, false, false); auto r1 = __builtin_amdgcn_permlane32_swap(a1, b1, false, false); \
        u32x4 w = {r0[0], r1[0], r0[1], r1[1]}; OUT = *reinterpret_cast<bf16x8*>(&w); } while (0)
    AT_PK4(p0, 0, pa0); AT_PK4(p0, 8, pa1); AT_PK4(p1, 0, pa2); AT_PK4(p1, 8, pa3);
#undef AT_PK4
}
template <int KB>
DEVI void qkt(f32x16& p0, f32x16& p1, const char* K_lds, int r32, int hi, const bf16x8* qr) {
    p0 = f32x16{}; p1 = f32x16{};
    const char* kb[4];
#pragma unroll
    for (int dd = 0; dd < 4; ++dd) kb[dd] = K_lds + KB * SHM_K + AT_KSWZ(r32, (dd * 16 + hi * 8) * 2);
#pragma unroll
    for (int d0 = 0; d0 < 12; ++d0) { const char* a = kb[d0 & 3] + (d0 >> 2) * 128;
        const bf16x8 b0 = *reinterpret_cast<const bf16x8*>(a); const bf16x8 b1 = *reinterpret_cast<const bf16x8*>(a + 32 * KROW);
        p0 = __builtin_amdgcn_mfma_f32_32x32x16_bf16(b0, qr[d0], p0, 0, 0, 0); p1 = __builtin_amdgcn_mfma_f32_32x32x16_bf16(b1, qr[d0], p1, 0, 0, 0); }
}
template <int VB>
DEVI void pv_tile(f32x16* o, int vb0, bf16x8 pa0, bf16x8 pa1, bf16x8 pa2, bf16x8 pa3) {
#define AT_TRRD(dst, off) asm volatile("ds_read_b64_tr_b16 %0, %1 offset:%2" : "=&v"(dst) : "v"(vb0), "i"(off) : "memory")
#define AT_PV_D0(d0) do { s16x4 l0, l1, l2, l3, h0, h1, h2, h3; constexpr int b_ = VB * SHM_V + v_rd_off(d0, 0, 0); \
        AT_TRRD(l0, b_); AT_TRRD(h0, b_ + 2048); AT_TRRD(l1, b_ + 4096); AT_TRRD(h1, b_ + 6144); AT_TRRD(l2, b_ + 8192); AT_TRRD(h2, b_ + 10240); AT_TRRD(l3, b_ + 12288); AT_TRRD(h3, b_ + 14336); \
        asm volatile("s_waitcnt lgkmcnt(0)" ::: "memory"); __builtin_amdgcn_sched_barrier(0); \
        o[d0] = __builtin_amdgcn_mfma_f32_32x32x16_bf16(pa0, (bf16x8){l0[0], l0[1], l0[2], l0[3], h0[0], h0[1], h0[2], h0[3]}, o[d0], 0, 0, 0); \
        o[d0] = __builtin_amdgcn_mfma_f32_32x32x16_bf16(pa1, (bf16x8){l1[0], l1[1], l1[2], l1[3], h1[0], h1[1], h1[2], h1[3]}, o[d0], 0, 0, 0); \
        o[d0] = __builtin_amdgcn_mfma_f32_32x32x16_bf16(pa2, (bf16x8){l2[0], l2[1], l2[2], l2[3], h2[0], h2[1], h2[2], h2[3]}, o[d0], 0, 0, 0); \
        o[d0] = __builtin_amdgcn_mfma_f32_32x32x16_bf16(pa3, (bf16x8){l3[0], l3[1], l3[2], l3[3], h3[0], h3[1], h3[2], h3[3]}, o[d0], 0, 0, 0); } while (0)
    AT_PV_D0(0); AT_PV_D0(1); AT_PV_D0(2); AT_PV_D0(3);
#undef AT_PV_D0
#undef AT_TRRD
}
DEVI void block(const Params& p, char* lds, int b, int h, int qb) {
    const bf16_t* q = (const bf16_t*)(p.ws + WS_Q); const bf16_t* kn = (const bf16_t*)(p.ws + WS_KN); const bf16_t* vg = (const bf16_t*)(p.ws + WS_V);
    const bf16_t* kpe = (const bf16_t*)(p.ws + WS_KPE); bf16_t* ob = (bf16_t*)(p.ws + WS_OB);
    const int tid = threadIdx.x, wid = __builtin_amdgcn_readfirstlane(tid >> 6), lane = tid & 63, r32 = lane & 31, hi = lane >> 5;
    const size_t tb = (size_t)b * SEQ; const int P0 = qb * 256, NT = (P0 + 256) / 64;
    char* V_lds = lds + L_V; char* K_lds = lds + L_K; float* ws = (float*)(lds + L_WS) + wid * 64; float* li_l = ws; float* al_l = ws + 32;
    const int qlo = P0 + wid * 32, qm = qlo + r32 - 4 * hi;
    const int sr = tid >> 4, sc = (tid & 15) * 8, vst0 = v_st(sr, sc), vst1 = v_st(32 + sr, sc);
    const int kd0 = AT_KSWZ(sr, sc * 2), kd2 = AT_KSWZ(tid >> 3, 256 + (tid & 7) * 16);
    const bf16_t* knp = kn + (tb + sr) * 1024 + h * 128 + sc; const bf16_t* vp = vg + (tb + sr) * 1024 + h * 128 + sc; const bf16_t* kpp = kpe + (tb + (tid >> 3)) * 64 + (tid & 7) * 8;
    const int vb0 = (int)(uintptr_t)V_lds + v_rd_base(lane);
    bf16x8 stk[3], stv[2];
#define AT_LOAD(t_) do { const size_t o_ = (size_t)(t_) * 64; stk[0] = *(const bf16x8*)(knp + o_ * 1024); stk[1] = *(const bf16x8*)(knp + (o_ + 32) * 1024); stk[2] = *(const bf16x8*)(kpp + o_ * 64); \
        stv[0] = *(const bf16x8*)(vp + o_ * 1024); stv[1] = *(const bf16x8*)(vp + (o_ + 32) * 1024); } while (0)
#define AT_WRITE(bf) do { *(bf16x8*)(K_lds + (bf) * SHM_K + kd0) = stk[0]; *(bf16x8*)(K_lds + (bf) * SHM_K + kd0 + 32 * KROW) = stk[1]; *(bf16x8*)(K_lds + (bf) * SHM_K + kd2) = stk[2]; \
        *(bf16x8*)(V_lds + (bf) * SHM_V + vst0) = stv[0]; *(bf16x8*)(V_lds + (bf) * SHM_V + vst1) = stv[1]; } while (0)
    AT_LOAD(0);
    bf16x8 qr[12];
    { const bf16_t* qrow = q + (tb + qlo + r32) * 1536 + h * 192;
#pragma unroll
      for (int d0 = 0; d0 < 12; ++d0) qr[d0] = *(const bf16x8*)(qrow + d0 * 16 + hi * 8);
      int r32o = r32; asm volatile("" : "+v"(r32o));
      const float* cosT = (const float*)(p.ws + WS_COS) + (tb + qlo + r32o) * 32; const float* sinT = cosT + (WS_SIN - WS_COS) / 4;
#pragma unroll
      for (int d0 = 8; d0 < 12; ++d0) { const f32x4 cs = *(const f32x4*)(cosT + 8 * (d0 - 8) + 4 * hi), sn = *(const f32x4*)(sinT + 8 * (d0 - 8) + 4 * hi); u32x4 w = __builtin_bit_cast(u32x4, qr[d0]);
#pragma unroll
          for (int jj = 0; jj < 4; ++jj) { const float x1 = bf2f(w[jj] & 0xffffu), x2 = bf2f(w[jj] >> 16); w[jj] = pk2(x1 * cs[jj] - x2 * sn[jj], x2 * cs[jj] + x1 * sn[jj]); }
          qr[d0] = __builtin_bit_cast(bf16x8, w); asm volatile("" ::: "memory"); } }
    float m_reg = -1e30f, l_reg = 0.f; f32x16 o[4] = {};
    __syncthreads();
    AT_WRITE(0);
    __syncthreads();
#define AT_RESC(a) do { if (__any((a) < 1.f)) { if (hi == 0) al_l[r32] = (a); asm volatile("s_waitcnt lgkmcnt(0)" ::: "memory"); \
        _Pragma("unroll") for (int d_ = 0; d_ < 4; ++d_) _Pragma("unroll") for (int r = 0; r < 16; ++r) o[d_][r] *= al_l[crow(r, hi)]; } } while (0)
#define AT_STEP(t_, BF) do { const int tq = (t_); if (tq + 1 < NT) AT_LOAD(tq + 1); \
        { \
        f32x16 p0, p1; float mn, al; bf16x8 pa0, pa1, pa2, pa3; \
        qkt<BF>(p0, p1, K_lds, r32, hi, qr); \
        { const int kb_ = tq * 64; if (kb_ + 63 > qlo) mask_tile(p0, p1, qm - kb_); } \
        partialSM(p0, p1, m_reg, mn, al); finishSM(p0, p1, al, l_reg, pa0, pa1, pa2, pa3); AT_RESC(al); \
        pv_tile<BF>(o, vb0, pa0, pa1, pa2, pa3); } \
        if (tq + 1 < NT) AT_WRITE(1 - BF); \
        __syncthreads(); } while (0)
#pragma unroll 1
    for (int t = 0; t < NT; t += 2) { AT_STEP(t, 0); AT_STEP(t + 1, 1); }
    if (hi == 0) li_l[r32] = l_reg;
    asm volatile("s_waitcnt lgkmcnt(0)" ::: "memory");
    float rli[16];
#pragma unroll
    for (int r = 0; r < 16; ++r) rli[r] = __builtin_amdgcn_rcpf(li_l[crow(r, hi)]);
    bf16_t* Ow = ob + (tb + qlo) * 1024 + h * 128;
#pragma unroll
    for (int r = 0; r < 16; ++r) { const int orow = crow(r, hi);
#pragma unroll
        for (int d0 = 0; d0 < 4; ++d0) { const float v = o[d0][r] * rli[r]; const float vn = __shfl_xor(v, 1);
            if ((r32 & 1) == 0) *(unsigned*)(Ow + (size_t)orow * 1024 + d0 * 32 + r32) = cvtpk(v, vn); } }
#undef AT_LOAD
#undef AT_WRITE
#undef AT_RESC
#undef AT_STEP
}
}
DEVI void phase3(const Params& p, char* lds) {
    const int G_ = (int)gridDim.x, vcu = (G_ % 8 == 0) ? ((int)blockIdx.x % 8) * (G_ / 8) + (int)blockIdx.x / 8 : (int)blockIdx.x;
#pragma unroll 1
    for (int it2 = vcu * 2; it2 < 1024; it2 += (it2 & 1) ? 2 * G_ - 1 : 1) { const int it = it2 >> 1, bh = it >> 2, x = it & 3;
        at2::block(p, lds, bh >> 3, bh & 7, (it2 & 1) ? x : 7 - x); }
    __syncthreads();
}

DEVI void phase4(const Params& p, char* lds) {
    unsigned char* ws = p.ws; const unsigned char* zg = ws + WS_ZG;
    g8::DenseOrder S; S.init(ws + WS_OA, 1024, ws + WS_WBR, 2048, T, 1024);
    g8::Epi4<EpiBr2> E{{zg, (bf16_t*)(ws + WS_Y)}}; g8::Hook4<BrHookF> H{{zg}};
    g8::gemm_phase<g8::Epi4<EpiBr2>, g8::DenseOrder, true, g8::Hook4<BrHookF>>((G8_LAS unsigned char*)lds, 1024, 2048, 2048, S, E, nullptr, H, 16, (long)WS_OB - (long)WS_OA - 16 * 128);
}
DEVI void phase5(const Params& p, char* lds) {
    unsigned char* ws = p.ws;
    g8::DenseOrder S; S.init(ws + WS_Y, 1024, ws + WS_WOUT, 1024, T, 1024);
    g8::Epi4<EpiOut> E{{(const float*)ptab(ws, PT_X), (bf16_t*)(ws + WS_X2B), ws + WS_X2F8}};
#if defined(TPROBE_A) && defined(TPROBE_GEMM) && TPROBE_GEMM == 6
    g8::gemm_phase<g8::Epi4<EpiOut>, g8::DenseOrder, true>((G8_LAS unsigned char*)lds, 1024, 1024, 1024, S, E, (unsigned long long*)(ws + WS_TS) + 20);
#else
    g8::gemm_phase<g8::Epi4<EpiOut>, g8::DenseOrder, true>((G8_LAS unsigned char*)lds, 1024, 1024, 1024, S, E);
#endif
}

constexpr size_t RT_SRS = RT_ST, RT_RS = 1888 * 1024;
DEVI void phase6a(const Params& p, char* lds, bool router = true) {
    unsigned char* ws = p.ws; float* scr = (float*)lds;
    const float* ew1 = (const float*)ptab(ws, PT_EW1); const float* ew3 = (const float*)ptab(ws, PT_EW3); const float* ew2 = (const float*)ptab(ws, PT_EW2); const float* ffnw = (const float*)ptab(ws, PT_FFNW);
    const float* rgb = (const float*)ptab(ws, PT_RGB); const float* reb = (const float*)ptab(ws, PT_REB);
    unsigned char* W2 = ws + WS_W2;
    constexpr int I2 = 2 * 16;
    for (int it = blockIdx.x; it < NEXP * I2; it += gridDim.x) { const int e = it / I2, r = it % I2, nb = r >> 1, kb = r & 1, nl = threadIdx.x & 63;
        conv_tile256_f8(ew2 + (size_t)e * 512 * 1024 + (size_t)(kb * 256) * 1024 + nb * 64 + nl, 1024, nullptr, 64.f, W2 + ((size_t)e * 1024 + nb * 64) * EFF + kb * 256, EFF, scr); }
    __syncthreads();
#if defined(TPROBE_A)
    if (TPROBE_A == 17 && blockIdx.x == 0 && threadIdx.x == 0) ((unsigned long long*)(p.ws + WS_TS))[13] = __builtin_amdgcn_s_memrealtime();
#endif
    if (!router) return;
    const bf16_t* WrH = (const bf16_t*)(ws + WS_WRT); const bf16_t* WrL = WrH + 80 * 1024; const bf16_t* X2B = (const bf16_t*)(ws + WS_X2B);
    int* AE = (int*)(ws + WS_ROUTE + RT_AE); int* AP = (int*)(ws + WS_ROUTE + RT_AP); float* AW = (float*)(ws + WS_ROUTE + RT_AW); float* RS = (float*)(ws + WS_ROUTE + RT_RS);
    unsigned* cnt = (unsigned*)(ws + WS_CTL) + CW_CNT;
    const int tid = threadIdx.x, lane = tid & 63, wid = tid >> 6, fr = lane & 15, g4 = lane >> 4;
    constexpr int WL_ROW = 528, WL_ARR = 80 * WL_ROW, WL_BYTES = 2 * WL_ARR;
    float* lgw = (float*)(lds + WL_BYTES) + wid * (16 * 84 + 16);
    for (int g0 = blockIdx.x * 8; g0 < T / 16; g0 += gridDim.x * 8) {
        const int grp = g0 + wid;
        const size_t t0 = (size_t)grp * 16; const bf16_t* xrow = X2B + (t0 + fr) * 1024 + 8 * g4;
        f32x4 acc[5]; float ssq = 0.f;
#pragma unroll
        for (int n = 0; n < 5; ++n) acc[n] = (f32x4){0.f, 0.f, 0.f, 0.f};
#pragma unroll 1
        for (int kq = 0; kq < 4; ++kq) {
            bf16x8 xa[8];
#pragma unroll
            for (int kk = 0; kk < 8; ++kk) xa[kk] = *(const bf16x8*)(xrow + kq * 256 + 32 * kk);
            __syncthreads();
#pragma unroll
            for (int j = 0; j < 5; ++j) { const int row = (tid >> 5) + 16 * j, ch = tid & 31; const size_t so = (size_t)row * 1024 + kq * 256 + ch * 8; const int dof = row * WL_ROW + ch * 16;
                *(u32x4*)(lds + dof) = *(const u32x4*)(WrH + so); *(u32x4*)(lds + WL_ARR + dof) = *(const u32x4*)(WrL + so); }
            __syncthreads();
#pragma unroll
            for (int kk = 0; kk < 8; ++kk) {
                const bf16x8 ah = xa[kk];
#pragma unroll
                for (int j = 0; j < 8; ++j) { const float xv = bf2f((unsigned)(unsigned short)ah[j]); ssq += xv * xv; }
#pragma unroll
                for (int n = 0; n < 5; ++n) { const bf16x8 bh = *(const bf16x8*)(lds + (16 * n + fr) * WL_ROW + (32 * kk + 8 * g4) * 2), bl = *(const bf16x8*)(lds + WL_ARR + (16 * n + fr) * WL_ROW + (32 * kk + 8 * g4) * 2);
                    acc[n] = __builtin_amdgcn_mfma_f32_16x16x32_bf16(ah, bh, acc[n], 0, 0, 0); acc[n] = __builtin_amdgcn_mfma_f32_16x16x32_bf16(ah, bl, acc[n], 0, 0, 0); }
            }
        }
        ssq += __shfl_xor(ssq, 16); ssq += __shfl_xor(ssq, 32);
        const float rstd = rsqrtf(ssq * (1.f / D) + 1e-6f);
        if (g4 == 0) lgw[16 * 84 + fr] = rstd;
#pragma unroll
        for (int n = 0; n < 5; ++n)
#pragma unroll
            for (int i = 0; i < 4; ++i) lgw[(4 * g4 + i) * 84 + 16 * n + fr] = acc[n][i];
        asm volatile("s_waitcnt lgkmcnt(0)" ::: "memory");
        int ea = 0, eb = 0;
        if (lane < 16) { const float* lg = lgw + lane * 84; const float rs = lgw[16 * 84 + lane]; const size_t t = t0 + lane;
            int g = 0; float glv[8]; glv[0] = lg[0] * rs + rgb[0]; float gbest = glv[0];
#pragma unroll
            for (int j = 1; j < 8; ++j) { glv[j] = lg[j] * rs + rgb[j]; if (glv[j] > gbest) { gbest = glv[j]; g = j; } }
            float gs = 0.f;
#pragma unroll
            for (int j = 0; j < 8; ++j) gs += expf(glv[j] - gbest);
            const float gwt = 1.f / gs;
            int e1 = 0, e2 = 0; float b1 = -__builtin_inff(), b2 = -__builtin_inff();
            for (int j = 0; j < 8; ++j) { const float v = lg[8 + g * 8 + j] * rs + reb[g * 8 + j];
                if (v > b1) { b2 = b1; e2 = e1; b1 = v; e1 = j; } else if (v > b2) { b2 = v; e2 = j; } }
            const float d = expf(b2 - b1); const float w1 = 1.f / (1.f + d), w2 = d / (1.f + d);
            ea = g * 8 + e1; eb = g * 8 + e2;
            AE[2 * t] = ea; AE[2 * t + 1] = eb; AW[2 * t] = gwt * w1; AW[2 * t + 1] = gwt * w2; RS[t] = rs;
        }
        int* lcnt = (int*)(lds + WL_BYTES + 8 * (16 * 84 + 16) * 4); int* lbase = lcnt + 64;
        __syncthreads();
        if (tid < 64) lcnt[tid] = 0;
        __syncthreads();
        int ra = 0, rb = 0;
        if (lane < 16) { ra = atomicAdd(lcnt + ea, 1); rb = atomicAdd(lcnt + eb, 1); }
        __syncthreads();
        if (tid < 64) { const int c = lcnt[tid]; lbase[tid] = c ? (int)atomicAdd(cnt + tid * CNT_STRIDE, (unsigned)c) : 0; }
        __syncthreads();
        if (lane < 16) { const size_t t = t0 + lane; AP[2 * t] = lbase[ea] + ra; AP[2 * t + 1] = lbase[eb] + rb; }
    }
}
DEVI int build_prefix(const Params& p, int* li) {
    const unsigned* cnt = (const unsigned*)(p.ws + WS_CTL) + CW_CNT;
    __syncthreads();
    if (threadIdx.x < NEXP) li[400 + threadIdx.x] = (int)cnt[threadIdx.x * CNT_STRIDE];
    __syncthreads();
    if (threadIdx.x == 0) { int acc = 0; for (int e = 0; e < NEXP; ++e) { li[e] = acc; const int c = li[400 + e]; const int pd = (c + 255) & ~255; for (int tt = acc / 256; tt < (acc + pd) / 256; ++tt) li[80 + tt] = e; acc += pd; } li[64] = acc; }
    __syncthreads();
    return li[64] / 256;
}
DEVI void phase6b(const Params& p, char* lds) {
    unsigned char* ws = p.ws; int* li = (int*)lds; build_prefix(p, li);
    const int* AE = (const int*)(ws + WS_ROUTE + RT_AE); const int* AP = (const int*)(ws + WS_ROUTE + RT_AP); const float* AW = (const float*)(ws + WS_ROUTE + RT_AW);
    int* AS = (int*)(ws + WS_ROUTE + RT_AS); float* SW = (float*)(ws + WS_ROUTE + RT_SW); float* SRS = (float*)(ws + WS_ROUTE + RT_SRS); const float* RS = (const float*)(ws + WS_ROUTE + RT_RS);
    int* TOK = (int*)(ws + WS_TOK);
    for (int a = blockIdx.x * NTHR + threadIdx.x; a < 2 * T; a += gridDim.x * NTHR) { const int slot = li[AE[a]] + AP[a]; AS[a] = slot; SW[slot] = AW[a]; SRS[slot] = RS[a >> 1]; TOK[slot] = a >> 1; }
    for (int e = blockIdx.x; e < NEXP; e += gridDim.x) { const int c = li[400 + e], pd = (c + 255) & ~255;
        for (int s_ = c + threadIdx.x; s_ < pd; s_ += NTHR) { const int slot = li[e] + s_; SW[slot] = 0.f; SRS[slot] = 0.f; TOK[slot] = 0; } }
}
struct MoeOrder { const char* A; const char* W; size_t a_tile, w_exp, w_pn; const int* tile_e; int nunits; const int* tok;
    DEVI bool next(int i, g8::Unit& u) const { const int G = (int)gridDim.x, bx = (int)blockIdx.x; const int L = (G % 8 == 0) ? (i * 8 + (bx & 7)) * (G >> 3) + (bx >> 3) : i * G + bx;
        if (L >= nunits) return false; const int tile = L >> 2, pn = L & 3, e = tile_e[tile];
        u.pm = tile; u.pn = pn; u.a = A + (size_t)tile * a_tile; u.b = W + (size_t)e * w_exp + (size_t)pn * w_pn; u.tok = tok ? tok + tile * 256 : nullptr; return true; } };
constexpr int LDS_LI = 132096;
DEVI void phase7a(const Params& p, char* lds) {
    unsigned char* ws = p.ws; int* li = (int*)(lds + LDS_LI); const int ntile = build_prefix(p, li);
    MoeOrder S{(const char*)(ws + WS_X2F8), (const char*)(ws + WS_W13), (size_t)0, (size_t)1024 * 1024, (size_t)256 * 1024, li + 80, ntile * 4, (const int*)(ws + WS_TOK)};
    EpiHid8 E{ws + WS_HID, (const float*)(ws + WS_ROUTE + RT_SRS)};
    g8::gemm_phase<EpiHid8, MoeOrder, true, g8::NoHook, true, true>((G8_LAS unsigned char*)lds, 512, 512, 512, S, E, nullptr, g8::NoHook(), 1 << 30, 0, 125, 121);
}
DEVI void phase7b(const Params& p, char* lds) {
    unsigned char* ws = p.ws; int* li = (int*)(lds + LDS_LI); const int ntile = build_prefix(p, li);
    MoeOrder S{(const char*)(ws + WS_HID), (const char*)(ws + WS_W2), (size_t)256 * EFF, (size_t)1024 * EFF, (size_t)256 * EFF, li + 80, ntile * 4, nullptr};
    g8::Epi4<EpiY> E{{(bf16_t*)(ws + WS_YEXP), (const float*)(ws + WS_ROUTE + RT_SW)}};
    g8::gemm_phase<g8::Epi4<EpiY>, MoeOrder, true, g8::NoHook, false, true>((G8_LAS unsigned char*)lds, EFF / 2, EFF / 2, EFF / 2, S, E, nullptr, g8::NoHook(), 1 << 30, 0, 124, 121);
}
DEVI void phase8(const Params& p) {
    unsigned char* ws = p.ws; const int* AS = (const int*)(ws + WS_ROUTE + RT_AS); const bf16_t* yexp = (const bf16_t*)(ws + WS_YEXP); const bf16_t* x2b = (const bf16_t*)(ws + WS_X2B); const f32x4* finw = (const f32x4*)ptab(ws, PT_FINW);
    const int lane = threadIdx.x & 63, gw = blockIdx.x * 8 + (threadIdx.x >> 6), NGW = gridDim.x * 8;
    f32x4 fw[4];
#pragma unroll
    for (int j = 0; j < 4; ++j) fw[j] = finw[lane + 64 * j];
    constexpr int RPI = 4;
    int4 sl[2]; sl[0] = *(const int4*)(AS + 2 * (size_t)gw * RPI); sl[1] = *(const int4*)(AS + 2 * (size_t)gw * RPI + 4);
    for (int t0 = gw * RPI; t0 < T; t0 += NGW * RPI) {
        u32x2 xv[RPI][4], ya[RPI][4], yb[RPI][4];
#pragma unroll
        for (int r = 0; r < RPI; ++r) { const u32x2* xr = (const u32x2*)(x2b + (size_t)(t0 + r) * D) + lane; const int4 q = sl[r >> 1]; const int s0 = (r & 1) ? q.z : q.x, s1 = (r & 1) ? q.w : q.y;
            const u32x2* y0 = (const u32x2*)(yexp + (size_t)s0 * 1024) + lane; const u32x2* y1 = (const u32x2*)(yexp + (size_t)s1 * 1024) + lane;
#pragma unroll
            for (int j = 0; j < 4; ++j) { xv[r][j] = xr[64 * j]; ya[r][j] = y0[64 * j]; yb[r][j] = y1[64 * j]; } }
        if (t0 + NGW * RPI < T) { sl[0] = *(const int4*)(AS + 2 * (size_t)(t0 + NGW * RPI)); sl[1] = *(const int4*)(AS + 2 * (size_t)(t0 + NGW * RPI) + 4); }
#pragma unroll
        for (int r = 0; r < RPI; ++r) { const int t = t0 + r; float s = 0.f; f32x4 v[4];
#pragma unroll
            for (int j = 0; j < 4; ++j) { const u32x2 xw = xv[r][j], a = ya[r][j], b = yb[r][j];
                v[j][0] = (bf2f(xw.x & 0xffffu) + bf2f(a.x & 0xffffu)) + bf2f(b.x & 0xffffu); v[j][1] = (bf2f(xw.x >> 16) + bf2f(a.x >> 16)) + bf2f(b.x >> 16);
                v[j][2] = (bf2f(xw.y & 0xffffu) + bf2f(a.y & 0xffffu)) + bf2f(b.y & 0xffffu); v[j][3] = (bf2f(xw.y >> 16) + bf2f(a.y >> 16)) + bf2f(b.y >> 16);
                s += v[j][0] * v[j][0] + v[j][1] * v[j][1] + v[j][2] * v[j][2] + v[j][3] * v[j][3]; }
            const float rstd = rsqrtf(wave_sum(s) * (1.f / D) + 1e-6f);
            f32x4* xo = (f32x4*)(p.out + (size_t)t * D) + lane;
#pragma unroll
            for (int j = 0; j < 4; ++j) xo[64 * j] = v[j] * rstd * fw[j];
        }
    }
}

#define XB_LAS __attribute__((address_space(3)))
constexpr int CW_BAR = 12288;
constexpr int LDS_XB = 147200;
#define XB_TMO      128
#define XB_XCNT(j)  (256  + 64 * (j))
#define XB_XSUB(j)  (1280 + 64 * (j))
#define XB_XGEN(j)  (2304 + 64 * (j))
#define XB_TOP      3328
#define XB_TOPGEN   3392
#define XCD_BAR_WORDS 3456
#define XB_SPIN_CAP (1u << 18)

__device__ __forceinline__ unsigned xb_ld(unsigned* p)              { return __hip_atomic_load(p, __ATOMIC_RELAXED, __HIP_MEMORY_SCOPE_AGENT); }
__device__ __forceinline__ unsigned xb_add(unsigned* p, unsigned v) { return __hip_atomic_fetch_add(p, v, __ATOMIC_RELAXED, __HIP_MEMORY_SCOPE_AGENT); }
__device__ __forceinline__ unsigned xb_xcc_id() { return (unsigned)__builtin_amdgcn_s_getreg((3 << 11) | 20) & 0xFu; }
#define XB_SPIN(cond, bar) do { unsigned _sp = 0; while (cond) { __builtin_amdgcn_s_sleep(1); \
    if ((++_sp & 255u) == 0u) { if (xb_ld(&(bar)[XB_TMO])) break; if (_sp > XB_SPIN_CAP) { atomicAdd(&(bar)[XB_TMO], 1u); break; } } } } while (0)

struct XcdBarrier {
    unsigned* bar; unsigned x;
    volatile XB_LAS unsigned* st;
};

__device__ __forceinline__ XcdBarrier xcd_barrier_post(unsigned* bar, volatile XB_LAS unsigned* st) {
    XcdBarrier b; b.bar = bar; b.x = xb_xcc_id(); b.st = st;
    if (threadIdx.x == 0) (void)xb_add(&bar[XB_XCNT(b.x)], 1u);
    return b;
}
__device__ __forceinline__ void xcd_barrier_complete(unsigned* bar, unsigned x, unsigned& nloc, unsigned& nx) {
    const unsigned G = gridDim.x * gridDim.y * gridDim.z;
    unsigned sum, cnt, mine, sp = 0u;
    for (;;) {
        sum = 0u; cnt = 0u; mine = 0u;
#pragma unroll
        for (unsigned j = 0; j < 16; ++j) { const unsigned c = xb_ld(&bar[XB_XCNT(j)]); sum += c; cnt += (c > 0u) ? 1u : 0u; mine = (j == x) ? c : mine; }
        if (sum == G) break;
        __builtin_amdgcn_s_sleep(1);
        if ((++sp & 255u) == 0u) { if (xb_ld(&bar[XB_TMO])) break; if (sp > XB_SPIN_CAP) { atomicAdd(&bar[XB_TMO], 1u); break; } }
    }
    nloc = mine > 0u ? mine : 1u; nx = cnt > 0u ? cnt : 1u;
}

__device__ __forceinline__ void xcd_barrier(const XcdBarrier& b) {
    asm volatile("s_waitcnt vmcnt(0)" ::: "memory");
    __syncthreads();
    if (threadIdx.x == 0) {
        unsigned* bar = b.bar;
        __builtin_amdgcn_s_waitcnt(0);
        unsigned nloc = b.st[0], nx = b.st[1];
        if (nloc == 0u) { xcd_barrier_complete(bar, b.x, nloc, nx); b.st[0] = nloc; b.st[1] = nx; }
        const unsigned old = xb_add(&bar[XB_XSUB(b.x)], 1u);
        const unsigned gen = old / nloc;
        if (old + 1u == (gen + 1u) * nloc) {
            __builtin_amdgcn_fence(__ATOMIC_RELEASE, "agent");
            asm volatile("s_waitcnt vmcnt(0)" ::: "memory");
            const unsigned og = xb_add(&bar[XB_TOP], 1u);
            const unsigned tg = og / nx;
            if (og + 1u == (tg + 1u) * nx) xb_add(&bar[XB_TOPGEN], 1u);
            else XB_SPIN(xb_ld(&bar[XB_TOPGEN]) == tg, bar);
            __builtin_amdgcn_fence(__ATOMIC_ACQUIRE, "agent");
            xb_add(&bar[XB_XGEN(b.x)], 1u);
            asm volatile("s_waitcnt vmcnt(0)" ::: "memory");
        } else {
            XB_SPIN(xb_ld(&bar[XB_XGEN(b.x)]) == gen, bar);
            __builtin_amdgcn_fence(__ATOMIC_ACQUIRE, "agent");
            asm volatile("s_waitcnt vmcnt(0)" ::: "memory");
        }
    }
    __syncthreads();
}


constexpr int NPHASE = 12;
constexpr int LDS_BYTES = 147456;
#if defined(TPROBE_A)
#define STAMP(k) if (blockIdx.x == 0 && threadIdx.x == 0) ((unsigned long long*)(p.ws + WS_TS))[(k)] = __builtin_amdgcn_s_memrealtime();
#else
#define STAMP(k)
#endif
__global__ void __launch_bounds__(NTHR, 2) mega(Params p) {
    extern __shared__ __attribute__((aligned(16))) char lds[];
    cg::grid_group grid = cg::this_grid();
    const int lo = p.ph_lo, hi = p.ph_hi;
    if (threadIdx.x < 2) ((volatile XB_LAS unsigned*)((XB_LAS unsigned char*)lds + LDS_XB))[threadIdx.x] = 0u;
    __syncthreads();
    const XcdBarrier xbar = xcd_barrier_post((unsigned*)(p.ws + WS_CTL) + CW_BAR, (volatile XB_LAS unsigned*)((XB_LAS unsigned char*)lds + LDS_XB));
    if (p.ph_hi < 0) grid.sync();
#define SEAM(k) xcd_barrier(xbar)
    STAMP(0)
#ifndef DUP_PH
#define DUP_PH -1
#endif
#ifdef ONLY_PH
#define PH(k, call) if constexpr ((k) == ONLY_PH) { if (lo <= (k) && (k) < hi) { const int rep_ = 0; call; if ((k) + 1 < hi) SEAM(k); } }
#else
#define PH(k, call) if (lo <= (k) && (k) < hi) { if constexpr ((k) == DUP_PH) { _Pragma("unroll 1") for (int rep_ = 0; rep_ < 3; ++rep_) { __syncthreads(); call; } } else { const int rep_ = 0; call; } if ((k) + 1 < hi) SEAM(k); STAMP((k) + 1) }
#endif
    PH(0, phase0(p, lds))
    PH(1, phase1(p, lds))
    PH(2, phase2a(p, lds, rep_ == 0))
    PH(3, phase2b(p, lds))
    PH(4, phase3(p, lds))
    PH(5, phase4(p, lds))
    PH(6, phase5(p, lds))
    PH(7, phase6a(p, lds, rep_ == 0))
    PH(8, phase6b(p, lds))
    PH(9, phase7a(p, lds))
    PH(10, phase7b(p, lds))
    PH(11, phase8(p))
#undef PH
}

extern "C" void kernel_launch(void* const* d_in, const int* in_sizes, int n_in, void* d_out, int out_size, void* d_ws, size_t ws_size, hipStream_t stream) {
    static int grid = 0;
    if (grid == 0) {
        if (n_in != 22 || out_size != T * D || ws_size < WS_END) { fprintf(stderr, "kernel_launch: unexpected shapes (n_in %d out %d ws %zu, need ws >= %zu)\n", n_in, out_size, ws_size, (size_t)WS_END); grid = -1; return; }
        int dev = 0, cus = 0, per_cu = 0; hipGetDevice(&dev); hipDeviceGetAttribute(&cus, hipDeviceAttributeMultiprocessorCount, dev);
        hipFuncSetAttribute((const void*)mega, hipFuncAttributeMaxDynamicSharedMemorySize, LDS_BYTES);
        hipOccupancyMaxActiveBlocksPerMultiprocessor(&per_cu, (const void*)mega, NTHR, LDS_BYTES);
        if (per_cu < 1) { fprintf(stderr, "kernel_launch: occupancy query says %d blocks per CU\n", per_cu); per_cu = 1; }
        grid = cus * per_cu; (void)hipGetLastError();
    }
    if (grid < 0) return;
    hipMemsetAsync((char*)d_ws + WS_CTL, 0, 65536, stream);
    Params p{};
    p.x = (const float*)d_in[0]; p.pos = (const int*)d_in[1]; p.attn_norm_w = (const float*)d_in[2]; p.w_in = (const float*)d_in[3]; p.hg_lb = (const float*)d_in[4];
    p.hg_onw = (const float*)d_in[5]; p.q_norm_w = (const float*)d_in[6]; p.w_uq = (const float*)d_in[7]; p.kv_norm_w = (const float*)d_in[8]; p.w_ukv = (const float*)d_in[9];
    p.w_bra = (const float*)d_in[10]; p.w_brb = (const float*)d_in[11]; p.w_out = (const float*)d_in[12]; p.ffn_norm_w = (const float*)d_in[13]; p.rg_w = (const float*)d_in[14];
    p.rg_b = (const float*)d_in[15]; p.re_w = (const float*)d_in[16]; p.re_b = (const float*)d_in[17]; p.ew1 = (const float*)d_in[18]; p.ew3 = (const float*)d_in[19];
    p.ew2 = (const float*)d_in[20]; p.final_w = (const float*)d_in[21]; p.out = (float*)d_out; p.ws = (unsigned char*)d_ws;
#if MK_MULTI
    for (int ph = 0; ph < NPHASE; ++ph) { p.ph_lo = ph; p.ph_hi = ph + 1; hipLaunchKernelGGL(mega, dim3(grid), dim3(NTHR), LDS_BYTES, stream, p); }
#else
    p.ph_lo = 0; p.ph_hi = NPHASE;
    void* args[] = {&p};
    hipError_t e = hipLaunchCooperativeKernel((const void*)mega, dim3(grid), dim3(NTHR), args, LDS_BYTES, stream);
    if (e != hipSuccess) fprintf(stderr, "cooperative launch failed: %s (grid %d)\n", hipGetErrorString(e), grid);
#endif
}
```

```cpp
#include <hip/hip_runtime.h>
#include <hip/hip_cooperative_groups.h>
#include <cstdio>
#include <cstdint>
namespace cg = cooperative_groups;

#ifndef MK_MULTI
#define MK_MULTI 0
#endif

#define DEVI __device__ __forceinline__
typedef unsigned short bf16_t;
typedef short bf16x8 __attribute__((ext_vector_type(8)));
typedef float f32x4 __attribute__((ext_vector_type(4)));
typedef unsigned u32x4 __attribute__((ext_vector_type(4)));
typedef unsigned u32x2 __attribute__((ext_vector_type(2)));

constexpr int NB = 16, SEQ = 2048, T = NB * SEQ, D = 1024;
constexpr int NTHR = 512;
constexpr int ZH_P = 4096, ZL_P = 768, ZG_P = 2048;
constexpr int NZ = 6912;
constexpr int NEXP = 64, EFF = 512;
constexpr int SLOT_CAP = 2 * T + NEXP * 256;
constexpr int MAX_TILES = SLOT_CAP / 256;

constexpr size_t MiB = 1u << 20;
constexpr size_t WS_CTL = 0;
constexpr size_t WS_WRT = 1 * MiB;
constexpr size_t WS_LBT = 1 * MiB + 512 * 1024;
constexpr size_t WS_WIN = 2 * MiB;
constexpr size_t WS_WUQ = 16 * MiB;
constexpr size_t WS_WUKV = 18 * MiB;
constexpr size_t WS_WBR = 20 * MiB;
constexpr size_t WS_WOUT = 24 * MiB;
constexpr size_t WS_COS = 26 * MiB, WS_SIN = 30 * MiB;
constexpr size_t WS_ROUTE = 34 * MiB;
constexpr size_t WS_KPE = 36 * MiB;
constexpr size_t WS_ZH = 40 * MiB;
constexpr size_t WS_Q = 40 * MiB, WS_KN = 136 * MiB, WS_V = 200 * MiB;
constexpr size_t WS_Y = 40 * MiB;
constexpr size_t WS_X2B = 104 * MiB;
constexpr size_t WS_HID = 168 * MiB;
constexpr size_t WS_YEXP = 248 * MiB;
constexpr size_t WS_X2F8 = 344 * MiB;
constexpr size_t WS_H8 = 408 * MiB;
constexpr size_t WS_WIN8 = 440 * MiB;
constexpr size_t WS_TOK = 512 * 1024;
constexpr size_t WS_OB = 264 * MiB;
constexpr size_t WS_ZL = 296 * MiB;
constexpr size_t WS_ZG = 344 * MiB;
constexpr size_t WS_W13 = 408 * MiB;
constexpr size_t WS_OA = 472 * MiB;
constexpr size_t WS_H = 472 * MiB;
constexpr size_t WS_W2 = 472 * MiB;
constexpr size_t WS_END = 536 * MiB;
constexpr size_t RT_AE = 0, RT_AP = 256 * 1024, RT_AW = 512 * 1024, RT_AS = 768 * 1024, RT_ST = 1024 * 1024, RT_SW = 1536 * 1024;
constexpr int CW_CNT = 8192, CNT_STRIDE = 64;
constexpr size_t WS_TS = 16384;
constexpr size_t WS_PTRS = 8192;
enum { PT_POS = 0, PT_HGLB, PT_HGONW, PT_RGB, PT_REB, PT_EW1, PT_EW3, PT_EW2, PT_FFNW, PT_FINW, PT_X };
DEVI const void* ptab(const unsigned char* ws, int i) { return (const void*)(((const unsigned long long*)(ws + WS_PTRS))[i]); }

struct Params {
    const float* x; const int* pos; const float* attn_norm_w; const float* w_in; const float* hg_lb; const float* hg_onw;
    const float* q_norm_w; const float* w_uq; const float* kv_norm_w; const float* w_ukv; const float* w_bra; const float* w_brb;
    const float* w_out; const float* ffn_norm_w; const float* rg_w; const float* rg_b; const float* re_w; const float* re_b;
    const float* ew1; const float* ew3; const float* ew2; const float* final_w;
    float* out; unsigned char* ws;
    int ph_lo, ph_hi;
};

DEVI unsigned f2bf(float f) { unsigned u = __builtin_bit_cast(unsigned, f); return (u + 0x7fffu + ((u >> 16) & 1u)) >> 16; }
DEVI float bf2f(unsigned h) { return __builtin_bit_cast(float, h << 16); }
typedef float f32x2_t __attribute__((ext_vector_type(2))); typedef __bf16 bf16x2_t __attribute__((ext_vector_type(2)));
DEVI unsigned pk2(float lo, float hi) { f32x2_t v = {lo, hi}; bf16x2_t b = __builtin_convertvector(v, bf16x2_t); return __builtin_bit_cast(unsigned, b); }
DEVI float sigmoidf_(float v) { return __builtin_amdgcn_rcpf(1.f + __expf(-v)); }
DEVI float siluf_(float v) { return v * __builtin_amdgcn_rcpf(1.f + __expf(-v)); }
DEVI float wave_sum(float v) {
#pragma unroll
    for (int o = 1; o < 64; o <<= 1) v += __shfl_xor(v, o);
    return v;
}
typedef int i32x4 __attribute__((ext_vector_type(4))); typedef int i32x8 __attribute__((ext_vector_type(8)));
DEVI unsigned pk4_fp8(float a, float b, float c, float d) { int w = __builtin_amdgcn_cvt_pk_fp8_f32(a, b, 0, false); w = __builtin_amdgcn_cvt_pk_fp8_f32(c, d, w, true); return (unsigned)w; }
DEVI void store4bf(bf16_t* p, f32x4 v) { u32x2 w; w.x = pk2(v[0], v[1]); w.y = pk2(v[2], v[3]); *(u32x2*)p = w; }
DEVI void unpack8(bf16x8 v, float* f) {
#pragma unroll
    for (int j = 0; j < 8; ++j) f[j] = bf2f((unsigned)(unsigned short)v[j]);
}

template <class ColMap, class KScale>
DEVI void transpose_tile_f8(const float* src, int Nsrc, unsigned char* dst, int ldk, int k0, int n0, ColMap cm, KScale ks, float* scr) {
    const int tid = threadIdx.x;
    {
        const int nl = tid & 63, kq = tid >> 6; const int col = cm(n0 + nl);
#pragma unroll
        for (int i = 0; i < 8; ++i) { const int k = kq * 8 + i; float v = 0.f; if (col >= 0) v = src[(size_t)(k0 + k) * Nsrc + col] * ks(k0 + k); scr[k * 65 + nl] = v; }
    }
    __syncthreads();
    {
        const int nl = tid >> 3, kc = tid & 7; const float* s = scr + (kc * 8) * 65 + nl;
        u32x2 o; o.x = pk4_fp8(s[0], s[65], s[2 * 65], s[3 * 65]); o.y = pk4_fp8(s[4 * 65], s[5 * 65], s[6 * 65], s[7 * 65]);
        *(u32x2*)(dst + (size_t)(n0 + nl) * ldk + k0 + kc * 8) = o;
    }
    __syncthreads();
}
template <class ColMap, class KScale>
DEVI void transpose_tile(const float* src, int Nsrc, bf16_t* dst, int ldk, int k0, int n0, ColMap cm, KScale ks, float* scr) {
    const int tid = threadIdx.x;
    {
        const int nl = tid & 63, kq = tid >> 6; const int col = cm(n0 + nl);
#pragma unroll
        for (int i = 0; i < 8; ++i) { const int k = kq * 8 + i; float v = 0.f; if (col >= 0) v = src[(size_t)(k0 + k) * Nsrc + col] * ks(k0 + k); scr[k * 65 + nl] = v; }
    }
    __syncthreads();
    {
        const int nl = tid >> 3, kc = tid & 7; const float* s = scr + (kc * 8) * 65 + nl;
        u32x4 o; o.x = pk2(s[0], s[65]); o.y = pk2(s[2 * 65], s[3 * 65]); o.z = pk2(s[4 * 65], s[5 * 65]); o.w = pk2(s[6 * 65], s[7 * 65]);
        *(u32x4*)(dst + (size_t)(n0 + nl) * ldk + k0 + kc * 8) = o;
    }
    __syncthreads();
}

namespace g8 {
#define G8_LAS __attribute__((address_space(3)))
constexpr int BM = 256, BK = 64, HALF = 128, HTB = HALF * BK * 2, STAGE_BYTES = 8 * HTB, NXCD = 8, WGM = 8;
__host__ __device__ __forceinline__ int lds_byte(int r, int c) { const int st = (r >> 4) * 2 + (c >> 5), rr = r & 15, cc = c & 31, ob = rr * 64 + cc * 2; return st * 1024 + (ob ^ (((ob >> 9) & 1) << 5)); }
__host__ __device__ __forceinline__ int perm32(int rho) { const int n = rho >> 4, i = rho & 15; return 8 * (i >> 2) + 4 * n + (i & 3); }
__host__ __device__ __forceinline__ void stage_rc(int b, int& R, int& C) { const int st = b / 1024, sb = b % 1024, swz = sb ^ (((sb >> 9) & 1) << 5); R = (st >> 1) * 16 + swz / 64; C = (st & 1) * 32 + (swz % 64) / 2; }
struct Unit { int pm, pn; const char* a; const char* b; const int* tok; };
struct DenseOrder {
    const char* A; const char* Bt; size_t tstepA, tstepB; int nM, nN, nwg, G, c;
    DEVI void init(const void* A_, int lda, const void* Bt_, int ldb, int M, int N) { A = (const char*)A_; Bt = (const char*)Bt_; tstepA = (size_t)BM * lda * 2; tstepB = (size_t)BM * ldb * 2;
        nM = M / BM; nN = N / BM; nwg = nM * nN; G = gridDim.x; c = blockIdx.x; }
    DEVI bool next(int i, Unit& u) const {
        const long L = (long)i * G + c; if (L >= nwg) return false;
        int wgid = (int)L; { const int q = nwg / NXCD, r = nwg % NXCD, xcd = wgid % NXCD, off = wgid / NXCD; wgid = (xcd < r ? xcd * (q + 1) : r * (q + 1) + (xcd - r) * q) + off; }
        const int nig = WGM * nN, gid = wgid / nig, fm = gid * WGM, gsz = (nM - fm) < WGM ? (nM - fm) : WGM;
        u.pm = fm + ((wgid % nig) % gsz); u.pn = (wgid % nig) / gsz; u.a = A + (size_t)u.pm * tstepA; u.b = Bt + (size_t)u.pn * tstepB; u.tok = nullptr; return true;
    }
};
struct NoHook { static constexpr bool ON = false; template <class U> DEVI void operator()(f32x4 (&)[2][2][4][2], const U&, int, int, int, int) const {} };
template <class Epi, class Sched, bool ALIGN_EPI, class Hook = NoHook, bool GATHER = false, bool FP8 = false>
DEVI void gemm_phase(G8_LAS unsigned char* lds, const int lda, const int ldb, const int K, const Sched& S, const Epi& E, unsigned long long* tsp = nullptr, const Hook& H = Hook(), const int seg_t = 1 << 30, const long segj = 0, const int scA = 127, const int scB = 127) {
    const int tid = threadIdx.x, wid = __builtin_amdgcn_readfirstlane(tid >> 6), lane = tid & 63, wr = wid >> 2, wc = wid & 3, fr = lane & 15, fq = lane >> 4;
    const int nt = K / BK;
    unsigned voffA[2], voffB[2]; int gR[2]; unsigned gC[2];
#pragma unroll
    for (int i = 0; i < 2; ++i) { int R, C; stage_rc(tid * 16 + i * 8192, R, C); voffA[i] = (unsigned)(R * lda + C) * 2u; voffB[i] = (unsigned)(((R & ~31) + perm32(R & 31)) * ldb + C) * 2u; gR[i] = R; gC[i] = (unsigned)C * 2u; }
    unsigned vG[2][2], vGn[2][2];
#define G8_TOK(dst, tokp) do { _Pragma("unroll") for (int h_ = 0; h_ < 2; ++h_) _Pragma("unroll") for (int i_ = 0; i_ < 2; ++i_) dst[h_][i_] = (unsigned)(tokp)[gR[i_] + 128 * h_] * (unsigned)(lda * 2) + gC[i_]; } while (0)
#define G8_STAGE_A(bufoff, gbase, h, usenext) do { if constexpr (GATHER) { unsigned v_[2] = {(usenext) ? vGn[h][0] : vG[h][0], (usenext) ? vGn[h][1] : vG[h][1]}; G8_STAGE(bufoff, gbase, v_); } \
        else { G8_STAGE(bufoff, (gbase) + (h) * hstepA, voffA); } } while (0)
    const size_t kstep = (size_t)(BK * 2);
    const size_t hstepA = (size_t)HALF * lda * 2, hstepB = (size_t)HALF * ldb * 2;
    const unsigned ldsw = (unsigned)wid * 1024u;
    const int aoff = lds_byte(wr * 64 + fr, fq * 8), boff = lds_byte(wc * 32 + fr, fq * 8);
#define G8_SA(b, h) (((b) * 2 + (h)) * HTB)
#define G8_SB(b, h) ((4 + (b) * 2 + (h)) * HTB)
#define G8_STAGE(bufoff, gbase, voff) do { _Pragma("unroll") for (int _i = 0; _i < 2; ++_i) \
        __builtin_amdgcn_global_load_lds((const unsigned*)((const char*)(gbase) + (voff)[_i]), (G8_LAS unsigned*)(lds + (bufoff) + ldsw + _i * 8192), 16, 0, 0); } while (0)
#define G8_LD16(off) __builtin_bit_cast(i32x4, *(const G8_LAS bf16x8*)(lds + (off)))
#define G8_LDA8(dst, b, h) do { _Pragma("unroll") for (int m = 0; m < 4; ++m) dst[m] = __builtin_shufflevector(G8_LD16(G8_SA(b, h) + aoff + m * 2048), G8_LD16(G8_SA(b, h) + aoff + m * 2048 + 1024), 0, 1, 2, 3, 4, 5, 6, 7); } while (0)
#define G8_LDB8(dst, b, h) do { _Pragma("unroll") for (int n = 0; n < 2; ++n) dst[n] = __builtin_shufflevector(G8_LD16(G8_SB(b, h) + boff + n * 2048), G8_LD16(G8_SB(b, h) + boff + n * 2048 + 1024), 0, 1, 2, 3, 4, 5, 6, 7); } while (0)
#define G8_LDA(dst, b, h) do { if constexpr (FP8) { G8_LDA8(dst##8, b, h); break; } _Pragma("unroll") for (int m = 0; m < 4; ++m) _Pragma("unroll") for (int k = 0; k < 2; ++k) dst[m][k] = *(const G8_LAS bf16x8*)(lds + G8_SA(b, h) + aoff + m * 2048 + k * 1024); } while (0)
#define G8_LDB(dst, b, h) do { if constexpr (FP8) { G8_LDB8(dst##8, b, h); break; } _Pragma("unroll") for (int n = 0; n < 2; ++n) _Pragma("unroll") for (int k = 0; k < 2; ++k) dst[n][k] = *(const G8_LAS bf16x8*)(lds + G8_SB(b, h) + boff + n * 2048 + k * 1024); } while (0)
#define G8_MMA(ai, bj, At, Bt) do { __builtin_amdgcn_s_setprio(1); _Pragma("unroll") for (int m = 0; m < 4; ++m) _Pragma("unroll") for (int n = 0; n < 2; ++n) { \
        if constexpr (FP8) { asm volatile("v_mfma_scale_f32_16x16x128_f8f6f4 %0, %1, %2, %0, %3, %4 op_sel_hi:[0,0,0]" : "+v"(acc[ai][bj][m][n]) : "v"(Bt##8[n]), "v"(At##8[m]), "v"(scB), "v"(scA)); } \
        else { _Pragma("unroll") for (int k = 0; k < 2; ++k) acc[ai][bj][m][n] = __builtin_amdgcn_mfma_f32_16x16x32_bf16(Bt[n][k], At[m][k], acc[ai][bj][m][n], 0, 0, 0); } } __builtin_amdgcn_s_setprio(0); } while (0)
#define G8_WAIT_V(n) asm volatile("s_waitcnt vmcnt(" #n ")" ::: "memory")
#define G8_WAIT_L(n) asm volatile("s_waitcnt lgkmcnt(" #n ")" ::: "memory")
#define G8_BAR __builtin_amdgcn_s_barrier()
#define G8_SCHED __builtin_amdgcn_sched_barrier(0)
    Unit cur, nxt; int ui = 0;
    if (!S.next(0, cur)) return;
    f32x4 acc[2][2][4][2];
#pragma unroll
    for (int a = 0; a < 2; ++a)
#pragma unroll
        for (int b = 0; b < 2; ++b)
#pragma unroll
            for (int m = 0; m < 4; ++m)
#pragma unroll
                for (int n = 0; n < 2; ++n) acc[a][b][m][n] = (f32x4){0.f, 0.f, 0.f, 0.f};
    bf16x8 At[4][2], B0[2][2], B1[2][2];
    i32x8 At8[4], B08[2], B18[2];
    const char* cA = cur.a; const char* cB = cur.b;
    if constexpr (GATHER) { G8_TOK(vG, cur.tok); G8_TOK(vGn, cur.tok); }
    G8_STAGE(G8_SB(0, 0), cB, voffB); G8_STAGE(G8_SB(0, 1), cB + hstepB, voffB); G8_STAGE_A(G8_SA(0, 0), cA, 0, false); G8_STAGE_A(G8_SA(0, 1), cA, 1, false);
    if (wr == 1) G8_BAR;
    G8_WAIT_V(2); G8_BAR;
    G8_STAGE(G8_SB(1, 0), cB + kstep, voffB); G8_STAGE_A(G8_SA(1, 0), cA + kstep, 0, false); G8_STAGE(G8_SB(1, 1), cB + hstepB + kstep, voffB);
    G8_WAIT_V(6); G8_BAR;
    unsigned long long tk_ = 0, te_ = 0, tp_ = tsp ? __builtin_amdgcn_s_memrealtime() : 0;
    for (;;) {
        const bool has_next = S.next(ui + 1, nxt);
        const char* nA = has_next ? nxt.a : cA; const char* nB = has_next ? nxt.b : cB;
        if constexpr (GATHER) { if (has_next) G8_TOK(vGn, nxt.tok); }
#pragma unroll 1
        for (int t = 0; t < nt; t += 2) {
            const bool last = (t == nt - 2);
            if constexpr (Hook::ON) { if (t == seg_t) H(acc, cur, wr, wc, fr, fq); }
            const char* a1 = cA + (size_t)(t + 1) * kstep + (Hook::ON && t + 1 >= seg_t ? segj : 0);
            const char* a2 = last ? nA : cA + (size_t)(t + 2) * kstep + (Hook::ON && t + 2 >= seg_t ? segj : 0); const char* b2 = last ? nB : cB + (size_t)(t + 2) * kstep;
            const char* a3 = a2 + kstep; const char* b3 = b2 + kstep;
            G8_LDB(B0, 0, 0); G8_LDB(B1, 0, 1); G8_SCHED; G8_LDA(At, 0, 0); G8_STAGE_A(G8_SA(1, 1), a1, 1, false);
            G8_WAIT_V(8); G8_WAIT_L(0); G8_BAR; G8_MMA(0, 0, At, B0); G8_MMA(0, 1, At, B1); G8_BAR; G8_SCHED;
            G8_LDA(At, 0, 1); G8_STAGE(G8_SB(0, 0), b2, voffB); G8_STAGE(G8_SB(0, 1), b2 + hstepB, voffB); G8_STAGE_A(G8_SA(0, 0), a2, 0, last);
            G8_WAIT_V(8); G8_WAIT_L(0); G8_BAR; G8_MMA(1, 0, At, B0); G8_MMA(1, 1, At, B1); G8_BAR; G8_SCHED;
            G8_LDB(B0, 1, 0); G8_LDB(B1, 1, 1); G8_SCHED; G8_LDA(At, 1, 0); G8_STAGE_A(G8_SA(0, 1), a2, 1, last);
            G8_WAIT_V(8); G8_WAIT_L(0); G8_BAR; G8_MMA(0, 0, At, B0); G8_MMA(0, 1, At, B1); G8_BAR; G8_SCHED;
            G8_LDA(At, 1, 1); G8_STAGE(G8_SB(1, 0), b3, voffB); G8_STAGE(G8_SB(1, 1), b3 + hstepB, voffB); G8_STAGE_A(G8_SA(1, 0), a3, 0, last);
            G8_WAIT_V(8); G8_WAIT_L(0); G8_BAR; G8_MMA(1, 0, At, B0); G8_MMA(1, 1, At, B1); G8_BAR; G8_SCHED;
        }
        if constexpr (ALIGN_EPI) { if (wr == 0) G8_BAR; }
        if (tsp) { const unsigned long long n_ = __builtin_amdgcn_s_memrealtime(); tk_ += n_ - tp_; tp_ = n_; }
        if constexpr (FP8) asm volatile("s_nop 15\n\ts_nop 15" ::: "memory");
        E(acc, cur, wr, wc, fr, fq);
        if (tsp) { const unsigned long long n_ = __builtin_amdgcn_s_memrealtime(); te_ += n_ - tp_; tp_ = n_; }
        if (!has_next) break;
#pragma unroll
        for (int a = 0; a < 2; ++a)
#pragma unroll
            for (int b = 0; b < 2; ++b)
#pragma unroll
                for (int m = 0; m < 4; ++m)
#pragma unroll
                    for (int n = 0; n < 2; ++n) acc[a][b][m][n] = (f32x4){0.f, 0.f, 0.f, 0.f};
        cur = nxt; cA = nA; cB = nB; ++ui;
        if constexpr (GATHER) { _Pragma("unroll") for (int h_ = 0; h_ < 2; ++h_) _Pragma("unroll") for (int i_ = 0; i_ < 2; ++i_) vG[h_][i_] = vGn[h_][i_]; }
        if constexpr (ALIGN_EPI) { if (wr == 1) G8_BAR; }
    }
    G8_WAIT_V(0);
    if constexpr (!ALIGN_EPI) { if (wr == 0) G8_BAR; }
    G8_BAR;
    if (tsp && blockIdx.x == 0 && threadIdx.x == 0) { tsp[0] = 0; tsp[1] = tk_; tsp[2] = 0; tsp[3] = te_; tsp[4] = 0; tsp[5] = (unsigned long long)(ui + 1) * 100ull; }
#undef G8_SA
#undef G8_SB
#undef G8_STAGE
#undef G8_STAGE_A
#undef G8_TOK
#undef G8_LDA
#undef G8_LDA8
#undef G8_LDB8
#undef G8_LD16
#undef G8_LDB
#undef G8_MMA
#undef G8_WAIT_V
#undef G8_WAIT_L
#undef G8_BAR
#undef G8_SCHED
}
template <class F> struct Epi4 { F f;
    DEVI void operator()(const f32x4 (&acc)[2][2][4][2], const Unit& u, int wr, int wc, int fr, int fq) const {
        constexpr int NB = F::NB;
        asm volatile("" : "+v"(fr), "+v"(fq));
#pragma unroll
        for (int g0 = 0; g0 < 8; g0 += NB) {
            typename F::L ld[NB][2];
#pragma unroll
            for (int gg = 0; gg < NB; ++gg) { const int ai = (g0 + gg) >> 2, m = (g0 + gg) & 3;
#pragma unroll
                for (int bj = 0; bj < 2; ++bj) ld[gg][bj] = f.load(u.pm, u.pn, ai * 128 + wr * 64 + m * 16 + fr, bj * 128 + wc * 32 + 8 * fq); }
#pragma unroll
            for (int gg = 0; gg < NB; ++gg) { const int ai = (g0 + gg) >> 2, m = (g0 + gg) & 3;
#pragma unroll
                for (int bj = 0; bj < 2; ++bj) f.apply(u.pm, u.pn, ai * 128 + wr * 64 + m * 16 + fr, bj * 128 + wc * 32 + 8 * fq, acc[ai][bj][m][0], acc[ai][bj][m][1], ld[gg][bj]); }
            asm volatile("" ::: "memory");
        }
    } };
template <class F> struct Hook4 { static constexpr bool ON = true; F f;
    DEVI void operator()(f32x4 (&acc)[2][2][4][2], const Unit& u, int wr, int wc, int fr, int fq) const {
        constexpr int NB = F::NB;
        asm volatile("" : "+v"(fr), "+v"(fq));
#pragma unroll
        for (int g0 = 0; g0 < 8; g0 += NB) {
            typename F::L ld[NB][2];
#pragma unroll
            for (int gg = 0; gg < NB; ++gg) { const int ai = (g0 + gg) >> 2, m = (g0 + gg) & 3;
#pragma unroll
                for (int bj = 0; bj < 2; ++bj) ld[gg][bj] = f.load(u.pm, u.pn, ai * 128 + wr * 64 + m * 16 + fr, bj * 128 + wc * 32 + 8 * fq); }
#pragma unroll
            for (int gg = 0; gg < NB; ++gg) { const int ai = (g0 + gg) >> 2, m = (g0 + gg) & 3;
#pragma unroll
                for (int bj = 0; bj < 2; ++bj) f.apply(u.pm, u.pn, ai * 128 + wr * 64 + m * 16 + fr, bj * 128 + wc * 32 + 8 * fq, acc[ai][bj][m][0], acc[ai][bj][m][1], ld[gg][bj]); }
            asm volatile("" ::: "memory");
        }
    } };
}

struct NoLd {};
struct LbLd { f32x4 a, b; };
DEVI void store8bf(bf16_t* p, f32x4 a, f32x4 b) { u32x4 w; w.x = pk2(a[0], a[1]); w.y = pk2(a[2], a[3]); w.z = pk2(b[0], b[1]); w.w = pk2(b[2], b[3]); *(u32x4*)p = w; }
struct EpiZa { typedef LbLd L; static constexpr int NB = 1; unsigned char* ws;
    DEVI L load(int, int pn, int, int c) const { L l; l.a = (f32x4){0.f, 0.f, 0.f, 0.f}; l.b = l.a; if ((pn >> 2) == 1) { const float* lp = (const float*)(ws + WS_LBT) + (pn - 4) * 256 + c; l.a = *(const f32x4*)lp; l.b = *(const f32x4*)(lp + 4); } return l; }
    DEVI void apply(int pm, int pn, int r, int c, f32x4 v0, f32x4 v1, const L& lb) const {
        const size_t row = (size_t)pm * 256 + r; const int col = pn * 256 + c; const int kind = pn >> 2;
        if (kind == 3) {
#pragma unroll
            for (int j = 0; j < 4; ++j) { v0[j] = siluf_(v0[j]); v1[j] = siluf_(v1[j]); } }
        if (kind == 0) {
#pragma unroll
            for (int j = 0; j < 4; ++j) { v0[j] = siluf_(v0[j]) * 0.08838834764831845f; v1[j] = siluf_(v1[j]) * 0.08838834764831845f; } }
        else if (kind == 1) {
#pragma unroll
            for (int j = 0; j < 4; ++j) { v0[j] = __logf(lb.a[j] + (1.f - lb.a[j]) * sigmoidf_(v0[j])); v1[j] = __logf(lb.b[j] + (1.f - lb.b[j]) * sigmoidf_(v1[j])); } }
        store8bf((bf16_t*)(ws + WS_ZH) + row * ZH_P + col, v0, v1);
    } };
struct EpiZb { typedef NoLd L; static constexpr int NB = 8; unsigned char* ws;
    DEVI L load(int, int, int, int) const { return {}; }
    DEVI void apply(int pm, int pn, int r, int c, f32x4 v0, f32x4 v1, L) const {
        const size_t row = (size_t)pm * 256 + r; u32x2 w = {0u, 0u};
        if (pn < 3) { store8bf((bf16_t*)(ws + WS_ZL) + row * ZL_P + pn * 256 + c, v0, v1); return; }
#pragma unroll
        for (int j = 0; j < 4; ++j) { w.x |= (unsigned)fmaxf(__builtin_rintf(255.f * sigmoidf_(v0[j])), 1.f) << (8 * j); w.y |= (unsigned)fmaxf(__builtin_rintf(255.f * sigmoidf_(v1[j])), 1.f) << (8 * j); }
        *(u32x2*)(ws + WS_ZG + row * ZG_P + (pn - 3) * 256 + c) = w;
    } };
struct EpiQ { typedef NoLd L; static constexpr int NB = 8; bf16_t* q;
    DEVI L load(int, int, int, int) const { return {}; }
    DEVI void apply(int pm, int pn, int r, int c, f32x4 v0, f32x4 v1, L) const { store8bf(q + ((size_t)pm * 256 + r) * 1536 + pn * 256 + c, v0, v1); } };
struct EpiKV { typedef NoLd L; static constexpr int NB = 8; bf16_t* kn; bf16_t* vv;
    DEVI L load(int, int, int, int) const { return {}; }
    DEVI void apply(int pm, int pn, int r, int c, f32x4 v0, f32x4 v1, L) const {
        const size_t row = (size_t)pm * 256 + r; const int col = pn * 256 + c; const int hh = col >> 8, cc = col & 255;
        if (cc < 128) store8bf(kn + row * 1024 + hh * 128 + cc, v0, v1); else store8bf(vv + row * 1024 + hh * 128 + (cc - 128), v0, v1);
    } };
struct BrHookF { typedef u32x4 L; static constexpr int NB = 1; const unsigned char* zg;
    DEVI L load(int pm, int pn, int r, int c) const { const unsigned char* g = zg + ((size_t)pm * 256 + r) * ZG_P + pn * 256 + c; const u32x2 a = *(const u32x2*)g, b = *(const u32x2*)(g + 1024); return (L){a.x, a.y, b.x, b.y}; }
    DEVI void apply(int, int, int, int, f32x4& v0, f32x4& v1, L l) const {
#pragma unroll
        for (int j = 0; j < 4; ++j) { v0[j] *= (float)((l.x >> (8 * j)) & 255u) * __builtin_amdgcn_rcpf((float)((l.z >> (8 * j)) & 255u)); v1[j] *= (float)((l.y >> (8 * j)) & 255u) * __builtin_amdgcn_rcpf((float)((l.w >> (8 * j)) & 255u)); } } };
struct EpiBr2 { typedef u32x2 L; static constexpr int NB = 2; const unsigned char* zg; bf16_t* y;
    DEVI L load(int pm, int pn, int r, int c) const { return *(const u32x2*)(zg + ((size_t)pm * 256 + r) * ZG_P + 1024 + pn * 256 + c); }
    DEVI void apply(int pm, int pn, int r, int c, f32x4 v0, f32x4 v1, L g) const {
#pragma unroll
        for (int j = 0; j < 4; ++j) { v0[j] *= (float)((g.x >> (8 * j)) & 255u) * (1.f / 255.f); v1[j] *= (float)((g.y >> (8 * j)) & 255u) * (1.f / 255.f); }
        store8bf(y + ((size_t)pm * 256 + r) * 1024 + pn * 256 + c, v0, v1); } };
struct EpiOut { typedef LbLd L; static constexpr int NB = 2; const float* x; bf16_t* x2b; unsigned char* x2f8;
    DEVI L load(int pm, int pn, int r, int c) const { const float* xp = x + ((size_t)pm * 256 + r) * 1024 + pn * 256 + c; L l; l.a = *(const f32x4*)xp; l.b = *(const f32x4*)(xp + 4); return l; }
    DEVI void apply(int pm, int pn, int r, int c, f32x4 v0, f32x4 v1, const L& xv) const { const size_t o = ((size_t)pm * 256 + r) * 1024 + pn * 256 + c; const f32x4 a = xv.a + v0, b = xv.b + v1; store8bf(x2b + o, a, b);
        u32x2 w; w.x = pk4_fp8(4.f * a[0], 4.f * a[1], 4.f * a[2], 4.f * a[3]); w.y = pk4_fp8(4.f * b[0], 4.f * b[1], 4.f * b[2], 4.f * b[3]); *(u32x2*)(x2f8 + o) = w; } };
struct EpiHid8 { unsigned char* hid; const float* srs;
    DEVI void operator()(const f32x4 (&acc)[2][2][4][2], const g8::Unit& u, int wr, int wc, int fr, int fq) const {
        asm volatile("" : "+v"(fr), "+v"(fq));
        float rs[8];
#pragma unroll
        for (int g = 0; g < 8; ++g) rs[g] = srs[(size_t)u.pm * 256 + (g >> 2) * 128 + wr * 64 + (g & 3) * 16 + fr];
#pragma unroll
        for (int g = 0; g < 8; ++g) { const int ai = g >> 2, m = g & 3; unsigned char* hrow = hid + ((size_t)u.pm * 256 + ai * 128 + wr * 64 + m * 16 + fr) * EFF + u.pn * 128 + wc * 16 + 4 * fq;
#pragma unroll
            for (int bj = 0; bj < 2; ++bj) { const f32x4 gg = acc[ai][bj][m][0] * rs[g], uu = acc[ai][bj][m][1] * rs[g]; float h4[4];
#pragma unroll
                for (int i = 0; i < 4; ++i) h4[i] = fminf(fmaxf(8.f * siluf_(gg[i]) * uu[i], -440.f), 440.f);
                *(unsigned*)(hrow + bj * 64) = pk4_fp8(h4[0], h4[1], h4[2], h4[3]); } }
    } };
struct EpiY { typedef float L; static constexpr int NB = 8; bf16_t* yexp; const float* sw;
    DEVI L load(int tile, int, int r, int) const { return sw[(size_t)tile * 256 + r]; }
    DEVI void apply(int tile, int pn, int r, int c, f32x4 v0, f32x4 v1, L w) const { store8bf(yexp + ((size_t)tile * 256 + r) * 1024 + pn * 256 + c, v0 * w, v1 * w); } };

DEVI void phase0(const Params& p, char* lds) {
    float* scr = (float*)lds; unsigned char* ws = p.ws;
    bf16_t* WinT = (bf16_t*)(ws + WS_WIN); bf16_t* WuqT = (bf16_t*)(ws + WS_WUQ); bf16_t* WukvT = (bf16_t*)(ws + WS_WUKV);
    bf16_t* WbrT = (bf16_t*)(ws + WS_WBR); bf16_t* WoutT = (bf16_t*)(ws + WS_WOUT);
    constexpr int I_IN = (4096 / 64) * 16, I_IN8 = (2816 / 64) * 16, I_UQ = 24 * 6, I_UKV = 32 * 4, I_BR = 16 * 16, I_OUT = 16 * 16;
    constexpr int NIT = I_IN + I_IN8 + I_UQ + I_UKV + 2 * I_BR + I_OUT;
    for (int it = blockIdx.x; it < NIT; it += gridDim.x) {
        int r = it;
        if (r < I_IN) { const int nb = r / 16, kb = r % 16; const float* nw = p.attn_norm_w;
            transpose_tile(p.w_in, 6848, WinT, 1024, kb * 64, nb * 64, [](int n) { return n; }, [nw](int k) { return nw[k]; }, scr); continue; }
        r -= I_IN;
        if (r < I_IN8) { const int nb = r / 16, kb = r % 16; const float* nw = p.attn_norm_w;
            transpose_tile_f8(p.w_in, 6848, ws + WS_WIN8, 1024, kb * 64, nb * 64, [](int n) { return n < 704 ? 4096 + n : (n < 768 ? -1 : 4032 + n); }, [nw](int k) { return nw[k] * 64.f; }, scr); continue; }
        r -= I_IN8;
        if (r < I_UQ) { const int nb = r / 6, kb = r % 6; const float* nw = p.q_norm_w;
            transpose_tile(p.w_uq, 1536, WuqT, 384, kb * 64, nb * 64,
                           [](int n) { const int hh = n / 192, c = n % 192; if (c < 128) return n; const int rr = c - 128; return hh * 192 + 128 + (rr & 1) * 32 + (rr >> 1); },
                           [nw](int k) { return nw[k] * 0.07216878364870322f; }, scr); continue; }
        r -= I_UQ;
        if (r < I_UKV) { const int nb = r / 4, kb = r % 4; const float* nw = p.kv_norm_w;
            transpose_tile(p.w_ukv, 2048, WukvT, 256, kb * 64, nb * 64, [](int n) { return n; }, [nw](int k) { return nw[k]; }, scr); continue; }
        r -= I_UKV;
        if (r < I_BR) { const int nb = r / 16, kb = r % 16;
            transpose_tile(p.w_bra, 1024, WbrT, 2048, kb * 64, nb * 64, [](int n) { return n; }, [](int) { return 1.f; }, scr); continue; }
        r -= I_BR;
        if (r < I_BR) { const int nb = r / 16, kb = r % 16;
            transpose_tile(p.w_brb, 1024, WbrT + 1024, 2048, kb * 64, nb * 64, [](int n) { return n; }, [](int) { return 1.f; }, scr); continue; }
        r -= I_BR;
        { const int nb = r / 16, kb = r % 16;
            transpose_tile(p.w_out, 1024, WoutT, 1024, kb * 64, nb * 64, [](int n) { return n; }, [](int) { return 1.f; }, scr); }
    }
    if (blockIdx.x == 0 && threadIdx.x == 0) { unsigned long long* tb = (unsigned long long*)(ws + WS_PTRS);
        tb[PT_POS] = (unsigned long long)p.pos; tb[PT_HGLB] = (unsigned long long)p.hg_lb; tb[PT_HGONW] = (unsigned long long)p.hg_onw; tb[PT_RGB] = (unsigned long long)p.rg_b; tb[PT_REB] = (unsigned long long)p.re_b;
        tb[PT_EW1] = (unsigned long long)p.ew1; tb[PT_EW3] = (unsigned long long)p.ew3; tb[PT_EW2] = (unsigned long long)p.ew2; tb[PT_FFNW] = (unsigned long long)p.ffn_norm_w; tb[PT_FINW] = (unsigned long long)p.final_w; tb[PT_X] = (unsigned long long)p.x; }
    bf16_t* WrH = (bf16_t*)(ws + WS_WRT); bf16_t* WrL = WrH + 80 * 1024;
    for (int e = blockIdx.x * NTHR + threadIdx.x; e < 80 * 1024; e += gridDim.x * NTHR) { const int c = e >> 10, k = e & 1023;
        const float w = c < 8 ? p.rg_w[k * 8 + c] * p.ffn_norm_w[k] : (c < 72 ? p.re_w[k * 64 + (c - 8)] * p.ffn_norm_w[k] : 0.f);
        const unsigned hb = f2bf(w); WrH[e] = (bf16_t)hb; WrL[e] = (bf16_t)f2bf(w - bf2f(hb)); }
    { float* lbt = (float*)(ws + WS_LBT); for (int k = blockIdx.x * NTHR + threadIdx.x; k < 1024; k += gridDim.x * NTHR) lbt[k] = 1.f / (1.f + expf(p.hg_lb[1024 + k] - p.hg_lb[k])); }
    bf16_t* H = (bf16_t*)(ws + WS_H);
    const int lane = threadIdx.x & 63, gw = blockIdx.x * 8 + (threadIdx.x >> 6), NGW = gridDim.x * 8;
    for (int m0 = gw * 2; m0 < T; m0 += NGW * 2) {
        f32x4 v[2][4];
#pragma unroll
        for (int r = 0; r < 2; ++r) { const f32x4* xr = (const f32x4*)(p.x + (size_t)(m0 + r) * D) + lane;
#pragma unroll
            for (int j = 0; j < 4; ++j) v[r][j] = xr[64 * j]; }
#pragma unroll
        for (int r = 0; r < 2; ++r) { const int m = m0 + r; float s = 0.f;
#pragma unroll
            for (int j = 0; j < 4; ++j) s += v[r][j][0] * v[r][j][0] + v[r][j][1] * v[r][j][1] + v[r][j][2] * v[r][j][2] + v[r][j][3] * v[r][j][3];
            const float rstd = rsqrtf(wave_sum(s) * (1.f / D) + 1e-6f);
            u32x2* o = (u32x2*)(H + (size_t)m * D) + lane; unsigned* o8 = (unsigned*)(ws + WS_H8 + (size_t)m * D) + lane; const float r4 = 4.f * rstd;
#pragma unroll
            for (int j = 0; j < 4; ++j) { u32x2 w; w.x = pk2(v[r][j][0] * rstd, v[r][j][1] * rstd); w.y = pk2(v[r][j][2] * rstd, v[r][j][3] * rstd); o[64 * j] = w;
                o8[64 * j] = pk4_fp8(v[r][j][0] * r4, v[r][j][1] * r4, v[r][j][2] * r4, v[r][j][3] * r4); } }
    }
}

DEVI void phase1(const Params& p, char* lds) {
    unsigned char* ws = p.ws;
    { g8::DenseOrder S; S.init(ws + WS_H, D, ws + WS_WIN, D, T, 4096); g8::Epi4<EpiZa> E{{ws}};
      g8::gemm_phase<g8::Epi4<EpiZa>, g8::DenseOrder, true>((G8_LAS unsigned char*)lds, D, D, D, S, E); }
    { g8::DenseOrder S; S.init(ws + WS_H8, D / 2, ws + WS_WIN8, D / 2, T, 2816); g8::Epi4<EpiZb> E{{ws}};
      g8::gemm_phase<g8::Epi4<EpiZb>, g8::DenseOrder, true, g8::NoHook, false, true>((G8_LAS unsigned char*)lds, D / 2, D / 2, D / 2, S, E, nullptr, g8::NoHook(), 1 << 30, 0, 125, 121); }
}

constexpr int HL_A = 0, HL_B = 17408, HL_BT = 34816, HL_VT = 53248, HL_AT = 71680, HL_ST = 80896, HL_SEG = 115712, HL_SS = 119808;
#define HG_BAR() do { asm volatile("s_waitcnt lgkmcnt(0)" ::: "memory"); __builtin_amdgcn_s_barrier(); asm volatile("" ::: "memory"); } while (0)
DEVI void hgrn_chain_mfma(const Params& p, char* lds, int b, int h) {
    const bf16_t* zh = (const bf16_t*)(p.ws + WS_ZH); bf16_t* oa = (bf16_t*)(p.ws + WS_OA);
    const float* hgonw = (const float*)ptab(p.ws, PT_HGONW);
    const int tid = threadIdx.x, lane = tid & 63, wid = __builtin_amdgcn_readfirstlane(tid >> 6), fr = lane & 15, g4 = lane >> 4;
    const int k2 = lane * 2, seg = wid;
    f32x4 S[8];
#pragma unroll
    for (int n = 0; n < 8; ++n) S[n] = (f32x4){0.f, 0.f, 0.f, 0.f};
    const bf16_t* zb = zh + (size_t)b * SEQ * ZH_P + h * 128;
    float* segs = (float*)(lds + HL_SEG); float* lss = (float*)(lds + HL_SS);
    unsigned rq[8], rf[8], rv[8];
#pragma unroll
    for (int i = 0; i < 8; ++i) { const bf16_t* r = zb + (size_t)(seg * 8 + i) * ZH_P + k2; rq[i] = *(const unsigned*)r; rf[i] = *(const unsigned*)(r + 1024); rv[i] = *(const unsigned*)(r + 2048); }
    const int tt = wid >> 1, vh = wid & 1;
    f32x4 nwv[4];
#pragma unroll
    for (int n = 0; n < 4; ++n) nwv[n] = *(const f32x4*)(hgonw + 16 * (4 * vh + n) + 4 * g4);
#if defined(TPROBE_A)
    unsigned long long tacc[6] = {0, 0, 0, 0, 0, 0}; unsigned long long tprev = __builtin_amdgcn_s_memrealtime();
#define HG_T(k) do { const unsigned long long now_ = __builtin_amdgcn_s_memrealtime(); tacc[k] += now_ - tprev; tprev = now_; } while (0)
#else
#define HG_T(k)
#endif
    for (int c = 0; c < SEQ / 64; ++c) {
        const int t0 = c * 64;
        u32x2 gpre[4];
        { const bf16_t* gp_ = zh + ((size_t)b * SEQ + t0 + 16 * tt + fr) * ZH_P + 3072 + h * 128;
#pragma unroll
          for (int n = 0; n < 4; ++n) gpre[n] = *(const u32x2*)(gp_ + 16 * (4 * vh + n) + 4 * g4); }
        float cs[8][2], qq[8][2], kk[8][2]; float run[2] = {0.f, 0.f};
#pragma unroll
        for (int i = 0; i < 8; ++i)
#pragma unroll
            for (int e = 0; e < 2; ++e) { const float lf = bf2f(e ? rf[i] >> 16 : rf[i] & 0xffffu); run[e] += lf; cs[i][e] = run[e]; kk[i][e] = 1.f - __expf(lf); qq[i][e] = bf2f(e ? rq[i] >> 16 : rq[i] & 0xffffu); }
        HG_BAR();
        HG_T(0);
        *(float2*)(segs + seg * 128 + k2) = make_float2(run[0], run[1]);
#pragma unroll
        for (int e = 0; e < 2; ++e) { u32x4 w;
            w.x = e ? (rv[0] >> 16) | (rv[1] & 0xffff0000u) : (rv[0] & 0xffffu) | (rv[1] << 16); w.y = e ? (rv[2] >> 16) | (rv[3] & 0xffff0000u) : (rv[2] & 0xffffu) | (rv[3] << 16);
            w.z = e ? (rv[4] >> 16) | (rv[5] & 0xffff0000u) : (rv[4] & 0xffffu) | (rv[5] << 16); w.w = e ? (rv[6] >> 16) | (rv[7] & 0xffff0000u) : (rv[6] & 0xffffu) | (rv[7] << 16);
            *(u32x4*)(lds + HL_VT + (k2 + e) * 144 + seg * 16) = w; }
        HG_BAR();
        HG_T(1);
        {
            float off[2] = {0.f, 0.f}, bm[2] = {0.f, 0.f};
#pragma unroll
            for (int s_ = 0; s_ < 8; ++s_) { const float2 v = *(const float2*)(segs + s_ * 128 + k2); if (s_ < seg) { off[0] += v.x; off[1] += v.y; } if (s_ < 4) { bm[0] += v.x; bm[1] += v.y; } }
            unsigned bt[2][4];
#pragma unroll
            for (int i = 0; i < 8; ++i) { float av[2], bv[2];
#pragma unroll
                for (int e = 0; e < 2; ++e) { const float ea = __expf(cs[i][e] + off[e] - bm[e]); av[e] = qq[i][e] * ea; bv[e] = kk[i][e] * __builtin_amdgcn_rcpf(ea); }
                *(unsigned*)(lds + HL_A + (seg * 8 + i) * 272 + k2 * 2) = pk2(av[0], av[1]);
                const unsigned pb = pk2(bv[0], bv[1]); *(unsigned*)(lds + HL_B + (seg * 8 + i) * 272 + k2 * 2) = pb;
                if (i & 1) { bt[0][i >> 1] |= pb << 16; bt[1][i >> 1] |= pb & 0xffff0000u; } else { bt[0][i >> 1] = pb & 0xffffu; bt[1][i >> 1] = pb >> 16; } }
#pragma unroll
            for (int e = 0; e < 2; ++e) { u32x4 w = {bt[e][0], bt[e][1], bt[e][2], bt[e][3]}; *(u32x4*)(lds + HL_BT + (k2 + e) * 144 + seg * 16) = w; }
        }
        f32x4 bmid = {0.f, 0.f, 0.f, 0.f}, blast = {0.f, 0.f, 0.f, 0.f};
#pragma unroll
        for (int s_ = 0; s_ < 8; ++s_) { const f32x4 v = *(const f32x4*)(segs + s_ * 128 + 16 * wid + 4 * g4); blast += v; if (s_ < 4) bmid += v; }
        {
            f32x4 em; em[0] = __expf(bmid[0]); em[1] = __expf(bmid[1]); em[2] = __expf(bmid[2]); em[3] = __expf(bmid[3]);
#pragma unroll
            for (int n = 0; n < 8; ++n) { u32x2 w; w.x = pk2(S[n][0] * em[0], S[n][1] * em[1]); w.y = pk2(S[n][2] * em[2], S[n][3] * em[3]); *(u32x2*)(lds + HL_ST + (16 * n + fr) * 272 + (16 * wid + 4 * g4) * 2) = w; }
        }
        if (c + 1 < SEQ / 64) {
#pragma unroll
            for (int i = 0; i < 8; ++i) { const bf16_t* r = zb + (size_t)(t0 + 64 + seg * 8 + i) * ZH_P + k2; rq[i] = *(const unsigned*)r; rf[i] = *(const unsigned*)(r + 1024); rv[i] = *(const unsigned*)(r + 2048); }
        }
        HG_BAR();
        HG_T(2);
#define HG_LD(off) (*(const bf16x8*)(lds + (off)))
#define HG_FENCE() do { asm volatile("s_waitcnt lgkmcnt(0)" ::: "memory"); __builtin_amdgcn_sched_barrier(0); } while (0)
        {
            bf16x8 fa[4], fb0[4], fb1[4]; const int ss0 = 2 * vh, ss1 = 2 * vh + 1;
#pragma unroll
            for (int kk4 = 0; kk4 < 4; ++kk4) { fa[kk4] = HG_LD(HL_A + (16 * tt + fr) * 272 + (32 * kk4 + 8 * g4) * 2); fb0[kk4] = HG_LD(HL_B + (16 * ss0 + fr) * 272 + (32 * kk4 + 8 * g4) * 2); fb1[kk4] = HG_LD(HL_B + (16 * ss1 + fr) * 272 + (32 * kk4 + 8 * g4) * 2); }
            HG_FENCE();
            f32x4 acc0 = {0.f, 0.f, 0.f, 0.f}, acc1 = {0.f, 0.f, 0.f, 0.f};
#pragma unroll
            for (int kk4 = 0; kk4 < 4; ++kk4) { acc0 = __builtin_amdgcn_mfma_f32_16x16x32_bf16(fb0[kk4], fa[kk4], acc0, 0, 0, 0); acc1 = __builtin_amdgcn_mfma_f32_16x16x32_bf16(fb1[kk4], fa[kk4], acc1, 0, 0, 0); }
#pragma unroll
            for (int i = 0; i < 4; ++i) { if (ss0 > tt || (ss0 == tt && 4 * g4 + i > fr)) acc0[i] = 0.f; if (ss1 > tt || (ss1 == tt && 4 * g4 + i > fr)) acc1[i] = 0.f; }
            u32x2 w; w.x = pk2(acc0[0], acc0[1]); w.y = pk2(acc0[2], acc0[3]); *(u32x2*)(lds + HL_AT + (16 * tt + fr) * 144 + (16 * ss0 + 4 * g4) * 2) = w;
            w.x = pk2(acc1[0], acc1[1]); w.y = pk2(acc1[2], acc1[3]); *(u32x2*)(lds + HL_AT + (16 * tt + fr) * 144 + (16 * ss1 + 4 * g4) * 2) = w;
        }
        HG_BAR();
        HG_T(3);
        f32x4 o[4];
#pragma unroll
        for (int n = 0; n < 4; ++n) o[n] = (f32x4){0.f, 0.f, 0.f, 0.f};
        {
            bf16x8 fat[2], fa[4];
#pragma unroll
            for (int ks = 0; ks < 2; ++ks) fat[ks] = HG_LD(HL_AT + (16 * tt + fr) * 144 + (32 * ks + 8 * g4) * 2);
#pragma unroll
            for (int kk4 = 0; kk4 < 4; ++kk4) fa[kk4] = HG_LD(HL_A + (16 * tt + fr) * 272 + (32 * kk4 + 8 * g4) * 2);
#pragma unroll
            for (int nh = 0; nh < 2; ++nh) {
                bf16x8 fv[2][2], fs[2][4];
#pragma unroll
                for (int n2 = 0; n2 < 2; ++n2) { const int vrow = 16 * (4 * vh + 2 * nh + n2) + fr;
#pragma unroll
                    for (int ks = 0; ks < 2; ++ks) fv[n2][ks] = HG_LD(HL_VT + vrow * 144 + (32 * ks + 8 * g4) * 2);
#pragma unroll
                    for (int kk4 = 0; kk4 < 4; ++kk4) fs[n2][kk4] = HG_LD(HL_ST + vrow * 272 + (32 * kk4 + 8 * g4) * 2); }
                HG_FENCE();
#pragma unroll
                for (int ks = 0; ks < 2; ++ks)
#pragma unroll
                    for (int n2 = 0; n2 < 2; ++n2) o[2 * nh + n2] = __builtin_amdgcn_mfma_f32_16x16x32_bf16(fv[n2][ks], fat[ks], o[2 * nh + n2], 0, 0, 0);
#pragma unroll
                for (int kk4 = 0; kk4 < 4; ++kk4)
#pragma unroll
                    for (int n2 = 0; n2 < 2; ++n2) o[2 * nh + n2] = __builtin_amdgcn_mfma_f32_16x16x32_bf16(fs[n2][kk4], fa[kk4], o[2 * nh + n2], 0, 0, 0);
            }
        }
        { float ssq = 0.f;
#pragma unroll
          for (int n = 0; n < 4; ++n) ssq += o[n][0] * o[n][0] + o[n][1] * o[n][1] + o[n][2] * o[n][2] + o[n][3] * o[n][3];
          ssq += __shfl_xor(ssq, 16); ssq += __shfl_xor(ssq, 32); if (g4 == 0) lss[vh * 64 + 16 * tt + fr] = ssq; }
        {
            f32x4 U[8]; bf16x8 fbt[2], fv[8][2];
#pragma unroll
            for (int ks = 0; ks < 2; ++ks) { fbt[ks] = HG_LD(HL_BT + (16 * wid + fr) * 144 + (32 * ks + 8 * g4) * 2);
#pragma unroll
                for (int n = 0; n < 8; ++n) fv[n][ks] = HG_LD(HL_VT + (16 * n + fr) * 144 + (32 * ks + 8 * g4) * 2); }
            HG_FENCE();
#pragma unroll
            for (int n = 0; n < 8; ++n) { U[n] = __builtin_amdgcn_mfma_f32_16x16x32_bf16(fbt[0], fv[n][0], (f32x4){0.f, 0.f, 0.f, 0.f}, 0, 0, 0); }
#pragma unroll
            for (int n = 0; n < 8; ++n) { U[n] = __builtin_amdgcn_mfma_f32_16x16x32_bf16(fbt[1], fv[n][1], U[n], 0, 0, 0); }
            f32x4 el, elm;
#pragma unroll
            for (int i = 0; i < 4; ++i) { el[i] = __expf(blast[i]); elm[i] = __expf(blast[i] - bmid[i]); }
#pragma unroll
            for (int n = 0; n < 8; ++n) S[n] = S[n] * el + U[n] * elm;
        }
#undef HG_LD
#undef HG_FENCE
        HG_BAR();
        HG_T(4);
        {
            const int t = 16 * tt + fr; const float rstd = rsqrtf((lss[t] + lss[64 + t]) * (1.f / 128.f) + 1e-6f);
            const size_t trow = (size_t)b * SEQ + t0 + t; bf16_t* op = oa + trow * 1024 + h * 128;
#pragma unroll
            for (int n = 0; n < 4; ++n) { const int v0 = 16 * (4 * vh + n) + 4 * g4; const u32x2 gg = gpre[n]; const f32x4 nw = nwv[n];
                f32x4 r; r[0] = o[n][0] * rstd * nw[0] * bf2f(gg.x & 0xffffu); r[1] = o[n][1] * rstd * nw[1] * bf2f(gg.x >> 16);
                r[2] = o[n][2] * rstd * nw[2] * bf2f(gg.y & 0xffffu); r[3] = o[n][3] * rstd * nw[3] * bf2f(gg.y >> 16); store4bf(op + v0, r); }
        }
        HG_T(5);
    }
#if defined(TPROBE_A)
    if (blockIdx.x == 0 && threadIdx.x == 0) { unsigned long long* ts = (unsigned long long*)(p.ws + WS_TS); for (int k = 0; k < 6; ++k) { ts[20 + 2 * k] = 0; ts[21 + 2 * k] = tacc[k]; } }
#endif
    HG_BAR();
}
#undef HG_BAR
DEVI void conv_tile256(const float* colp, size_t rs, const float* kscale, bf16_t* dst, int ldk, float* scr) {
    const int tid = threadIdx.x;
    { const int nl = tid & 63, kq = tid >> 6;
      float v[32];
#pragma unroll
      for (int i = 0; i < 32; ++i) v[i] = colp[(size_t)(kq * 32 + i) * rs];
      if (kscale) {
#pragma unroll
          for (int i = 0; i < 32; ++i) v[i] *= kscale[kq * 32 + i]; }
#pragma unroll
      for (int i = 0; i < 32; ++i) scr[(kq * 32 + i) * 65 + nl] = v[i]; }
    __syncthreads();
    { const int nl = tid >> 3, kc = tid & 7;
#pragma unroll
      for (int j = 0; j < 4; ++j) { const float* s_ = scr + (kc * 8 + 64 * j) * 65 + nl;
          u32x4 o; o.x = pk2(s_[0], s_[65]); o.y = pk2(s_[2 * 65], s_[3 * 65]); o.z = pk2(s_[4 * 65], s_[5 * 65]); o.w = pk2(s_[6 * 65], s_[7 * 65]);
          *(u32x4*)(dst + (size_t)nl * ldk + kc * 8 + 64 * j) = o; } }
    __syncthreads();
}
DEVI void conv_tile256_f8(const float* colp, size_t rs, const float* kscale, float wscale, unsigned char* dst, int ldk, float* scr) {
    const int tid = threadIdx.x;
    { const int nl = tid & 63, kq = tid >> 6; float v[32];
#pragma unroll
      for (int i = 0; i < 32; ++i) v[i] = colp[(size_t)(kq * 32 + i) * rs];
#pragma unroll
      for (int i = 0; i < 32; ++i) v[i] *= kscale ? kscale[kq * 32 + i] * wscale : wscale;
#pragma unroll
      for (int i = 0; i < 32; ++i) scr[(kq * 32 + i) * 65 + nl] = v[i]; }
    __syncthreads();
    { const int nl = tid >> 3, kc = tid & 7;
#pragma unroll
      for (int j = 0; j < 4; ++j) { const float* s_ = scr + (kc * 8 + 64 * j) * 65 + nl;
          u32x2 o; o.x = pk4_fp8(s_[0], s_[65], s_[2 * 65], s_[3 * 65]); o.y = pk4_fp8(s_[4 * 65], s_[5 * 65], s_[6 * 65], s_[7 * 65]);
          *(u32x2*)(dst + (size_t)nl * ldk + kc * 8 + 64 * j) = o; } }
    __syncthreads();
}
DEVI void mla_prep(const Params& p, int chunk) {
    bf16_t* zl = (bf16_t*)(p.ws + WS_ZL); float* cosT = (float*)(p.ws + WS_COS); float* sinT = (float*)(p.ws + WS_SIN); const int* posp = (const int*)ptab(p.ws, PT_POS);
    const int lane = threadIdx.x & 63, wid = threadIdx.x >> 6;
    for (int rr = wid; rr < 256; rr += 8) { const size_t t = (size_t)chunk * 256 + rr; bf16_t* zr = zl + t * ZL_P;
        float cq[6], ck[4]; float s = 0.f, s2 = 0.f;
#pragma unroll
        for (int j = 0; j < 6; ++j) { cq[j] = bf2f(zr[lane + 64 * j]); s += cq[j] * cq[j]; }
#pragma unroll
        for (int j = 0; j < 4; ++j) { ck[j] = bf2f(zr[384 + lane + 64 * j]); s2 += ck[j] * ck[j]; }
        const float kr = bf2f(zr[640 + lane]);
        const float r1 = rsqrtf(wave_sum(s) * (1.f / 384.f) + 1e-6f), r2 = rsqrtf(wave_sum(s2) * (1.f / 256.f) + 1e-6f);
        const float other = __shfl_xor(kr, 32);
        const int i = lane & 31; const float invf = powf(10000.f, -(float)i / 32.f); const float ang = (float)posp[t] * invf; const float cs = cosf(ang), sn = sinf(ang);
        const float x1 = lane < 32 ? kr : other, x2 = lane < 32 ? other : kr;
        const float outv = lane < 32 ? (x1 * cs - x2 * sn) : (x2 * cs + x1 * sn);
#pragma unroll
        for (int j = 0; j < 6; ++j) zr[lane + 64 * j] = (bf16_t)f2bf(cq[j] * r1);
#pragma unroll
        for (int j = 0; j < 4; ++j) zr[384 + lane + 64 * j] = (bf16_t)f2bf(ck[j] * r2);
        ((bf16_t*)(p.ws + WS_KPE))[t * 64 + 2 * i + (lane >> 5)] = (bf16_t)f2bf(outv);
        if (lane < 32) { cosT[t * 32 + i] = cs; sinT[t * 32 + i] = sn; }
    }
}
DEVI void phase2a(const Params& p, char* lds, bool prep = true) {
#pragma unroll 1
    for (int it = blockIdx.x; it < 128; it += gridDim.x) {
        hgrn_chain_mfma(p, lds, it >> 3, it & 7);
#if defined(TPROBE_A)
        if (TPROBE_A == 12 && blockIdx.x == 0 && threadIdx.x == 0) ((unsigned long long*)(p.ws + WS_TS))[13] = __builtin_amdgcn_s_memrealtime();
#endif
    }
#pragma unroll 1
    for (int it = blockIdx.x; it < 256; it += gridDim.x) { if (it < 128) continue;
        if (prep) mla_prep(p, it - 128);
        const float* ew1 = (const float*)ptab(p.ws, PT_EW1); const float* ew3 = (const float*)ptab(p.ws, PT_EW3); const float* ffnw = (const float*)ptab(p.ws, PT_FFNW); const int nl = threadIdx.x & 63;
        __syncthreads();
#pragma unroll 1
        for (int ci = it - 128; ci < NEXP * 64; ci += 128) { const int e = ci >> 6, r = ci & 63, nb = r >> 2, kb = r & 3, n = nb * 64 + nl, col = (n >> 3) * 4 + (n & 3);
            const float* colp = ((n & 4) ? ew3 : ew1) + (size_t)e * 1024 * 512 + (size_t)(kb * 256) * 512 + col;
            conv_tile256_f8(colp, 512, ffnw + kb * 256, 64.f, p.ws + WS_W13 + ((size_t)e * 1024 + nb * 64) * 1024 + kb * 256, 1024, (float*)lds); }
    }
}

DEVI void phase2b(const Params& p, char* lds) {
    unsigned char* ws = p.ws;
    { g8::DenseOrder S; S.init(ws + WS_ZL, ZL_P, ws + WS_WUQ, 384, T, 1536);
      g8::Epi4<EpiQ> E{{(bf16_t*)(ws + WS_Q)}};
      g8::gemm_phase<g8::Epi4<EpiQ>, g8::DenseOrder, true>((G8_LAS unsigned char*)lds, ZL_P, 384, 384, S, E); }
    { g8::DenseOrder S; S.init(ws + WS_ZL + 384 * 2, ZL_P, ws + WS_WUKV, 256, T, 2048);
      g8::Epi4<EpiKV> E{{(bf16_t*)(ws + WS_KN), (bf16_t*)(ws + WS_V)}};
      g8::gemm_phase<g8::Epi4<EpiKV>, g8::DenseOrder, true>((G8_LAS unsigned char*)lds, ZL_P, 256, 256, S, E); }
}

namespace at2 {
typedef short s16x4 __attribute__((ext_vector_type(4)));
typedef float f32x16 __attribute__((ext_vector_type(16)));
constexpr int KROW = 384;
constexpr int SHM_K = 64 * KROW, SHM_V = 64 * 256;
constexpr int L_V = 0, L_K = 2 * SHM_V, L_WS = 2 * SHM_V + 2 * SHM_K;
constexpr float THR = 8.f;
#define AT_KSWZ(row, colB) ((row) * at2::KROW + ((colB) ^ (((row) & 7) << 4)))
DEVI int v_st(int k, int c) { const int kk = (k & ~0xC) | ((k & 4) << 1) | ((k & 8) >> 1); return ((kk >> 3) * 4 + (c >> 5)) * 512 + ((kk & 7) * 32 + (c & 31)) * 2; }
DEVI int v_rd_base(int lane) { return ((lane & 3) << 3) | (((lane >> 2) & 3) << 6) | (((lane >> 4) & 1) << 5) | (((lane >> 5) & 1) << 8); }
constexpr int v_rd_off(int d0, int ks, int half) { return d0 * 512 + ks * 4096 + half * 2048; }
DEVI int crow(int r, int hi) { return (r & 3) + 8 * (r >> 2) + 4 * hi; }
DEVI unsigned cvtpk(float lo, float hi) { unsigned r; asm volatile("v_cvt_pk_bf16_f32 %0, %1, %2" : "=v"(r) : "v"(lo), "v"(hi)); return r; }
DEVI void mask_tile(f32x16& p0, f32x16& p1, int dq) {
    const float NEG = -__builtin_inff();
#pragma unroll
    for (int r = 0; r < 16; ++r) { const int c = (r & 3) + 8 * (r >> 2); if (dq - c < 0) p0[r] = NEG; if (dq - c - 32 < 0) p1[r] = NEG; }
}
DEVI void partialSM(f32x16& p0, f32x16& p1, float& m_reg, float& mn, float& alpha) {
    float pmax = p0[0];
#pragma unroll
    for (int r = 1; r < 16; ++r) pmax = fmaxf(pmax, p0[r]);
#pragma unroll
    for (int r = 0; r < 16; ++r) pmax = fmaxf(pmax, p1[r]);
    { auto rr = __builtin_amdgcn_permlane32_swap(__float_as_uint(pmax), __float_as_uint(pmax), false, false); pmax = fmaxf(__uint_as_float(rr[0]), __uint_as_float(rr[1])); }
    constexpr float C2 = 1.4426950408889634f;
    if (__builtin_expect(__all((pmax - m_reg) <= THR), 1)) { mn = m_reg; alpha = 1.f; }
    else { mn = fmaxf(m_reg, pmax); alpha = __builtin_amdgcn_exp2f((m_reg - mn) * C2); m_reg = mn; }
    const float mnL = -mn * C2;
#pragma unroll
    for (int r = 0; r < 16; ++r) p0[r] = fmaf(p0[r], C2, mnL);
#pragma unroll
    for (int r = 0; r < 16; ++r) p1[r] = fmaf(p1[r], C2, mnL);
#pragma unroll
    for (int r = 0; r < 16; ++r) p0[r] = __builtin_amdgcn_exp2f(p0[r]);
}
DEVI void finishSM(f32x16& p0, f32x16& p1, float alpha, float& l_reg, bf16x8& pa0, bf16x8& pa1, bf16x8& pa2, bf16x8& pa3) {
#pragma unroll
    for (int r = 0; r < 16; ++r) p1[r] = __builtin_amdgcn_exp2f(p1[r]);
    float ps = 0;
#pragma unroll
    for (int r = 0; r < 16; ++r) ps += p0[r];
#pragma unroll
    for (int r = 0; r < 16; ++r) ps += p1[r];
    { auto rr = __builtin_amdgcn_permlane32_swap(__float_as_uint(ps), __float_as_uint(ps), false, false); ps = __uint_as_float(rr[0]) + __uint_as_float(rr[1]); }
    l_reg = l_reg * alpha + ps;
#define AT_PK4(P, B_, OUT) do { unsigned a0 = cvtpk(P[B_+0], P[B_+1]), a1 = cvtpk(P[B_+2], P[B_+3]); unsigned b0 = cvtpk(P[B_+4], P[B_+5]), b1 = cvtpk(P[B_+6], P[B_+7]); \
        auto r0 = __builtin_amdgcn_permlane32_swap(a0, b0, false, false); auto r1 = __builtin_amdgcn_permlane32_swap(a1, b1, false, false); \
        u32x4 w = {r0[0], r1[0], r0[1], r1[1]}; OUT = *reinterpret_cast<bf16x8*>(&w); } while (0)
    AT_PK4(p0, 0, pa0); AT_PK4(p0, 8, pa1); AT_PK4(p1, 0, pa2); AT_PK4(p1, 8, pa3);
#undef AT_PK4
}
template <int KB>
DEVI void qkt(f32x16& p0, f32x16& p1, const char* K_lds, int r32, int hi, const bf16x8* qr) {
    p0 = f32x16{}; p1 = f32x16{};
    const char* kb[4];
#pragma unroll
    for (int dd = 0; dd < 4; ++dd) kb[dd] = K_lds + KB * SHM_K + AT_KSWZ(r32, (dd * 16 + hi * 8) * 2);
#pragma unroll
    for (int d0 = 0; d0 < 12; ++d0) { const char* a = kb[d0 & 3] + (d0 >> 2) * 128;
        const bf16x8 b0 = *reinterpret_cast<const bf16x8*>(a); const bf16x8 b1 = *reinterpret_cast<const bf16x8*>(a + 32 * KROW);
        p0 = __builtin_amdgcn_mfma_f32_32x32x16_bf16(b0, qr[d0], p0, 0, 0, 0); p1 = __builtin_amdgcn_mfma_f32_32x32x16_bf16(b1, qr[d0], p1, 0, 0, 0); }
}
template <int VB>
DEVI void pv_tile(f32x16* o, int vb0, bf16x8 pa0, bf16x8 pa1, bf16x8 pa2, bf16x8 pa3) {
#define AT_TRRD(dst, off) asm volatile("ds_read_b64_tr_b16 %0, %1 offset:%2" : "=&v"(dst) : "v"(vb0), "i"(off) : "memory")
#define AT_PV_D0(d0) do { s16x4 l0, l1, l2, l3, h0, h1, h2, h3; constexpr int b_ = VB * SHM_V + v_rd_off(d0, 0, 0); \
        AT_TRRD(l0, b_); AT_TRRD(h0, b_ + 2048); AT_TRRD(l1, b_ + 4096); AT_TRRD(h1, b_ + 6144); AT_TRRD(l2, b_ + 8192); AT_TRRD(h2, b_ + 10240); AT_TRRD(l3, b_ + 12288); AT_TRRD(h3, b_ + 14336); \
        asm volatile("s_waitcnt lgkmcnt(0)" ::: "memory"); __builtin_amdgcn_sched_barrier(0); \
        o[d0] = __builtin_amdgcn_mfma_f32_32x32x16_bf16(pa0, (bf16x8){l0[0], l0[1], l0[2], l0[3], h0[0], h0[1], h0[2], h0[3]}, o[d0], 0, 0, 0); \
        o[d0] = __builtin_amdgcn_mfma_f32_32x32x16_bf16(pa1, (bf16x8){l1[0], l1[1], l1[2], l1[3], h1[0], h1[1], h1[2], h1[3]}, o[d0], 0, 0, 0); \
        o[d0] = __builtin_amdgcn_mfma_f32_32x32x16_bf16(pa2, (bf16x8){l2[0], l2[1], l2[2], l2[3], h2[0], h2[1], h2[2], h2[3]}, o[d0], 0, 0, 0); \
        o[d0] = __builtin_amdgcn_mfma_f32_32x32x16_bf16(pa3, (bf16x8){l3[0], l3[1], l3[2], l3[3], h3[0], h3[1], h3[2], h3[3]}, o[d0], 0, 0, 0); } while (0)
    AT_PV_D0(0); AT_PV_D0(1); AT_PV_D0(2); AT_PV_D0(3);
#undef AT_PV_D0
#undef AT_TRRD
}
DEVI void block(const Params& p, char* lds, int b, int h, int qb) {
    const bf16_t* q = (const bf16_t*)(p.ws + WS_Q); const bf16_t* kn = (const bf16_t*)(p.ws + WS_KN); const bf16_t* vg = (const bf16_t*)(p.ws + WS_V);
    const bf16_t* kpe = (const bf16_t*)(p.ws + WS_KPE); bf16_t* ob = (bf16_t*)(p.ws + WS_OB);
    const int tid = threadIdx.x, wid = __builtin_amdgcn_readfirstlane(tid >> 6), lane = tid & 63, r32 = lane & 31, hi = lane >> 5;
    const size_t tb = (size_t)b * SEQ; const int P0 = qb * 256, NT = (P0 + 256) / 64;
    char* V_lds = lds + L_V; char* K_lds = lds + L_K; float* ws = (float*)(lds + L_WS) + wid * 64; float* li_l = ws; float* al_l = ws + 32;
    const int qlo = P0 + wid * 32, qm = qlo + r32 - 4 * hi;
    const int sr = tid >> 4, sc = (tid & 15) * 8, vst0 = v_st(sr, sc), vst1 = v_st(32 + sr, sc);
    const int kd0 = AT_KSWZ(sr, sc * 2), kd2 = AT_KSWZ(tid >> 3, 256 + (tid & 7) * 16);
    const bf16_t* knp = kn + (tb + sr) * 1024 + h * 128 + sc; const bf16_t* vp = vg + (tb + sr) * 1024 + h * 128 + sc; const bf16_t* kpp = kpe + (tb + (tid >> 3)) * 64 + (tid & 7) * 8;
    const int vb0 = (int)(uintptr_t)V_lds + v_rd_base(lane);
    bf16x8 stk[3], stv[2];
#define AT_LOAD(t_) do { const size_t o_ = (size_t)(t_) * 64; stk[0] = *(const bf16x8*)(knp + o_ * 1024); stk[1] = *(const bf16x8*)(knp + (o_ + 32) * 1024); stk[2] = *(const bf16x8*)(kpp + o_ * 64); \
        stv[0] = *(const bf16x8*)(vp + o_ * 1024); stv[1] = *(const bf16x8*)(vp + (o_ + 32) * 1024); } while (0)
#define AT_WRITE(bf) do { *(bf16x8*)(K_lds + (bf) * SHM_K + kd0) = stk[0]; *(bf16x8*)(K_lds + (bf) * SHM_K + kd0 + 32 * KROW) = stk[1]; *(bf16x8*)(K_lds + (bf) * SHM_K + kd2) = stk[2]; \
        *(bf16x8*)(V_lds + (bf) * SHM_V + vst0) = stv[0]; *(bf16x8*)(V_lds + (bf) * SHM_V + vst1) = stv[1]; } while (0)
    AT_LOAD(0);
    bf16x8 qr[12];
    { const bf16_t* qrow = q + (tb + qlo + r32) * 1536 + h * 192;
#pragma unroll
      for (int d0 = 0; d0 < 12; ++d0) qr[d0] = *(const bf16x8*)(qrow + d0 * 16 + hi * 8);
      int r32o = r32; asm volatile("" : "+v"(r32o));
      const float* cosT = (const float*)(p.ws + WS_COS) + (tb + qlo + r32o) * 32; const float* sinT = cosT + (WS_SIN - WS_COS) / 4;
#pragma unroll
      for (int d0 = 8; d0 < 12; ++d0) { const f32x4 cs = *(const f32x4*)(cosT + 8 * (d0 - 8) + 4 * hi), sn = *(const f32x4*)(sinT + 8 * (d0 - 8) + 4 * hi); u32x4 w = __builtin_bit_cast(u32x4, qr[d0]);
#pragma unroll
          for (int jj = 0; jj < 4; ++jj) { const float x1 = bf2f(w[jj] & 0xffffu), x2 = bf2f(w[jj] >> 16); w[jj] = pk2(x1 * cs[jj] - x2 * sn[jj], x2 * cs[jj] + x1 * sn[jj]); }
          qr[d0] = __builtin_bit_cast(bf16x8, w); asm volatile("" ::: "memory"); } }
    float m_reg = -1e30f, l_reg = 0.f; f32x16 o[4] = {};
    __syncthreads();
    AT_WRITE(0);
    __syncthreads();
#define AT_RESC(a) do { if (__any((a) < 1.f)) { if (hi == 0) al_l[r32] = (a); asm volatile("s_waitcnt lgkmcnt(0)" ::: "memory"); \
        _Pragma("unroll") for (int d_ = 0; d_ < 4; ++d_) _Pragma("unroll") for (int r = 0; r < 16; ++r) o[d_][r] *= al_l[crow(r, hi)]; } } while (0)
#define AT_STEP(t_, BF) do { const int tq = (t_); if (tq + 1 < NT) AT_LOAD(tq + 1); \
        { \
        f32x16 p0, p1; float mn, al; bf16x8 pa0, pa1, pa2, pa3; \
        qkt<BF>(p0, p1, K_lds, r32, hi, qr); \
        { const int kb_ = tq * 64; if (kb_ + 63 > qlo) mask_tile(p0, p1, qm - kb_); } \
        partialSM(p0, p1, m_reg, mn, al); finishSM(p0, p1, al, l_reg, pa0, pa1, pa2, pa3); AT_RESC(al); \
        pv_tile<BF>(o, vb0, pa0, pa1, pa2, pa3); } \
        if (tq + 1 < NT) AT_WRITE(1 - BF); \
        __syncthreads(); } while (0)
#pragma unroll 1
    for (int t = 0; t < NT; t += 2) { AT_STEP(t, 0); AT_STEP(t + 1, 1); }
    if (hi == 0) li_l[r32] = l_reg;
    asm volatile("s_waitcnt lgkmcnt(0)" ::: "memory");
    float rli[16];
#pragma unroll
    for (int r = 0; r < 16; ++r) rli[r] = __builtin_amdgcn_rcpf(li_l[crow(r, hi)]);
    bf16_t* Ow = ob + (tb + qlo) * 1024 + h * 128;
#pragma unroll
    for (int r = 0; r < 16; ++r) { const int orow = crow(r, hi);
#pragma unroll
        for (int d0 = 0; d0 < 4; ++d0) { const float v = o[d0][r] * rli[r]; const float vn = __shfl_xor(v, 1);
            if ((r32 & 1) == 0) *(unsigned*)(Ow + (size_t)orow * 1024 + d0 * 32 + r32) = cvtpk(v, vn); } }
#undef AT_LOAD
#undef AT_WRITE
#undef AT_RESC
#undef AT_STEP
}
}
DEVI void phase3(const Params& p, char* lds) {
    const int G_ = (int)gridDim.x, vcu = (G_ % 8 == 0) ? ((int)blockIdx.x % 8) * (G_ / 8) + (int)blockIdx.x / 8 : (int)blockIdx.x;
#pragma unroll 1
    for (int it2 = vcu * 2; it2 < 1024; it2 += (it2 & 1) ? 2 * G_ - 1 : 1) { const int it = it2 >> 1, bh = it >> 2, x = it & 3;
        at2::block(p, lds, bh >> 3, bh & 7, (it2 & 1) ? x : 7 - x); }
    __syncthreads();
}

DEVI void phase4(const Params& p, char* lds) {
    unsigned char* ws = p.ws; const unsigned char* zg = ws + WS_ZG;
    g8::DenseOrder S; S.init(ws + WS_OA, 1024, ws + WS_WBR, 2048, T, 1024);
    g8::Epi4<EpiBr2> E{{zg, (bf16_t*)(ws + WS_Y)}}; g8::Hook4<BrHookF> H{{zg}};
    g8::gemm_phase<g8::Epi4<EpiBr2>, g8::DenseOrder, true, g8::Hook4<BrHookF>>((G8_LAS unsigned char*)lds, 1024, 2048, 2048, S, E, nullptr, H, 16, (long)WS_OB - (long)WS_OA - 16 * 128);
}
DEVI void phase5(const Params& p, char* lds) {
    unsigned char* ws = p.ws;
    g8::DenseOrder S; S.init(ws + WS_Y, 1024, ws + WS_WOUT, 1024, T, 1024);
    g8::Epi4<EpiOut> E{{(const float*)ptab(ws, PT_X), (bf16_t*)(ws + WS_X2B), ws + WS_X2F8}};
#if defined(TPROBE_A) && defined(TPROBE_GEMM) && TPROBE_GEMM == 6
    g8::gemm_phase<g8::Epi4<EpiOut>, g8::DenseOrder, true>((G8_LAS unsigned char*)lds, 1024, 1024, 1024, S, E, (unsigned long long*)(ws + WS_TS) + 20);
#else
    g8::gemm_phase<g8::Epi4<EpiOut>, g8::DenseOrder, true>((G8_LAS unsigned char*)lds, 1024, 1024, 1024, S, E);
#endif
}

constexpr size_t RT_SRS = RT_ST, RT_RS = 1888 * 1024;
DEVI void phase6a(const Params& p, char* lds, bool router = true) {
    unsigned char* ws = p.ws; float* scr = (float*)lds;
    const float* ew1 = (const float*)ptab(ws, PT_EW1); const float* ew3 = (const float*)ptab(ws, PT_EW3); const float* ew2 = (const float*)ptab(ws, PT_EW2); const float* ffnw = (const float*)ptab(ws, PT_FFNW);
    const float* rgb = (const float*)ptab(ws, PT_RGB); const float* reb = (const float*)ptab(ws, PT_REB);
    unsigned char* W2 = ws + WS_W2;
    constexpr int I2 = 2 * 16;
    for (int it = blockIdx.x; it < NEXP * I2; it += gridDim.x) { const int e = it / I2, r = it % I2, nb = r >> 1, kb = r & 1, nl = threadIdx.x & 63;
        conv_tile256_f8(ew2 + (size_t)e * 512 * 1024 + (size_t)(kb * 256) * 1024 + nb * 64 + nl, 1024, nullptr, 64.f, W2 + ((size_t)e * 1024 + nb * 64) * EFF + kb * 256, EFF, scr); }
    __syncthreads();
#if defined(TPROBE_A)
    if (TPROBE_A == 17 && blockIdx.x == 0 && threadIdx.x == 0) ((unsigned long long*)(p.ws + WS_TS))[13] = __builtin_amdgcn_s_memrealtime();
#endif
    if (!router) return;
    const bf16_t* WrH = (const bf16_t*)(ws + WS_WRT); const bf16_t* WrL = WrH + 80 * 1024; const bf16_t* X2B = (const bf16_t*)(ws + WS_X2B);
    int* AE = (int*)(ws + WS_ROUTE + RT_AE); int* AP = (int*)(ws + WS_ROUTE + RT_AP); float* AW = (float*)(ws + WS_ROUTE + RT_AW); float* RS = (float*)(ws + WS_ROUTE + RT_RS);
    unsigned* cnt = (unsigned*)(ws + WS_CTL) + CW_CNT;
    const int tid = threadIdx.x, lane = tid & 63, wid = tid >> 6, fr = lane & 15, g4 = lane >> 4;
    constexpr int WL_ROW = 528, WL_ARR = 80 * WL_ROW, WL_BYTES = 2 * WL_ARR;
    float* lgw = (float*)(lds + WL_BYTES) + wid * (16 * 84 + 16);
    for (int g0 = blockIdx.x * 8; g0 < T / 16; g0 += gridDim.x * 8) {
        const int grp = g0 + wid;
        const size_t t0 = (size_t)grp * 16; const bf16_t* xrow = X2B + (t0 + fr) * 1024 + 8 * g4;
        f32x4 acc[5]; float ssq = 0.f;
#pragma unroll
        for (int n = 0; n < 5; ++n) acc[n] = (f32x4){0.f, 0.f, 0.f, 0.f};
#pragma unroll 1
        for (int kq = 0; kq < 4; ++kq) {
            bf16x8 xa[8];
#pragma unroll
            for (int kk = 0; kk < 8; ++kk) xa[kk] = *(const bf16x8*)(xrow + kq * 256 + 32 * kk);
            __syncthreads();
#pragma unroll
            for (int j = 0; j < 5; ++j) { const int row = (tid >> 5) + 16 * j, ch = tid & 31; const size_t so = (size_t)row * 1024 + kq * 256 + ch * 8; const int dof = row * WL_ROW + ch * 16;
                *(u32x4*)(lds + dof) = *(const u32x4*)(WrH + so); *(u32x4*)(lds + WL_ARR + dof) = *(const u32x4*)(WrL + so); }
            __syncthreads();
#pragma unroll
            for (int kk = 0; kk < 8; ++kk) {
                const bf16x8 ah = xa[kk];
#pragma unroll
                for (int j = 0; j < 8; ++j) { const float xv = bf2f((unsigned)(unsigned short)ah[j]); ssq += xv * xv; }
#pragma unroll
                for (int n = 0; n < 5; ++n) { const bf16x8 bh = *(const bf16x8*)(lds + (16 * n + fr) * WL_ROW + (32 * kk + 8 * g4) * 2), bl = *(const bf16x8*)(lds + WL_ARR + (16 * n + fr) * WL_ROW + (32 * kk + 8 * g4) * 2);
                    acc[n] = __builtin_amdgcn_mfma_f32_16x16x32_bf16(ah, bh, acc[n], 0, 0, 0); acc[n] = __builtin_amdgcn_mfma_f32_16x16x32_bf16(ah, bl, acc[n], 0, 0, 0); }
            }
        }
        ssq += __shfl_xor(ssq, 16); ssq += __shfl_xor(ssq, 32);
        const float rstd = rsqrtf(ssq * (1.f / D) + 1e-6f);
        if (g4 == 0) lgw[16 * 84 + fr] = rstd;
#pragma unroll
        for (int n = 0; n < 5; ++n)
#pragma unroll
            for (int i = 0; i < 4; ++i) lgw[(4 * g4 + i) * 84 + 16 * n + fr] = acc[n][i];
        asm volatile("s_waitcnt lgkmcnt(0)" ::: "memory");
        int ea = 0, eb = 0;
        if (lane < 16) { const float* lg = lgw + lane * 84; const float rs = lgw[16 * 84 + lane]; const size_t t = t0 + lane;
            int g = 0; float glv[8]; glv[0] = lg[0] * rs + rgb[0]; float gbest = glv[0];
#pragma unroll
            for (int j = 1; j < 8; ++j) { glv[j] = lg[j] * rs + rgb[j]; if (glv[j] > gbest) { gbest = glv[j]; g = j; } }
            float gs = 0.f;
#pragma unroll
            for (int j = 0; j < 8; ++j) gs += expf(glv[j] - gbest);
            const float gwt = 1.f / gs;
            int e1 = 0, e2 = 0; float b1 = -__builtin_inff(), b2 = -__builtin_inff();
            for (int j = 0; j < 8; ++j) { const float v = lg[8 + g * 8 + j] * rs + reb[g * 8 + j];
                if (v > b1) { b2 = b1; e2 = e1; b1 = v; e1 = j; } else if (v > b2) { b2 = v; e2 = j; } }
            const float d = expf(b2 - b1); const float w1 = 1.f / (1.f + d), w2 = d / (1.f + d);
            ea = g * 8 + e1; eb = g * 8 + e2;
            AE[2 * t] = ea; AE[2 * t + 1] = eb; AW[2 * t] = gwt * w1; AW[2 * t + 1] = gwt * w2; RS[t] = rs;
        }
        int* lcnt = (int*)(lds + WL_BYTES + 8 * (16 * 84 + 16) * 4); int* lbase = lcnt + 64;
        __syncthreads();
        if (tid < 64) lcnt[tid] = 0;
        __syncthreads();
        int ra = 0, rb = 0;
        if (lane < 16) { ra = atomicAdd(lcnt + ea, 1); rb = atomicAdd(lcnt + eb, 1); }
        __syncthreads();
        if (tid < 64) { const int c = lcnt[tid]; lbase[tid] = c ? (int)atomicAdd(cnt + tid * CNT_STRIDE, (unsigned)c) : 0; }
        __syncthreads();
        if (lane < 16) { const size_t t = t0 + lane; AP[2 * t] = lbase[ea] + ra; AP[2 * t + 1] = lbase[eb] + rb; }
    }
}
DEVI int build_prefix(const Params& p, int* li) {
    const unsigned* cnt = (const unsigned*)(p.ws + WS_CTL) + CW_CNT;
    __syncthreads();
    if (threadIdx.x < NEXP) li[400 + threadIdx.x] = (int)cnt[threadIdx.x * CNT_STRIDE];
    __syncthreads();
    if (threadIdx.x == 0) { int acc = 0; for (int e = 0; e < NEXP; ++e) { li[e] = acc; const int c = li[400 + e]; const int pd = (c + 255) & ~255; for (int tt = acc / 256; tt < (acc + pd) / 256; ++tt) li[80 + tt] = e; acc += pd; } li[64] = acc; }
    __syncthreads();
    return li[64] / 256;
}
DEVI void phase6b(const Params& p, char* lds) {
    unsigned char* ws = p.ws; int* li = (int*)lds; build_prefix(p, li);
    const int* AE = (const int*)(ws + WS_ROUTE + RT_AE); const int* AP = (const int*)(ws + WS_ROUTE + RT_AP); const float* AW = (const float*)(ws + WS_ROUTE + RT_AW);
    int* AS = (int*)(ws + WS_ROUTE + RT_AS); float* SW = (float*)(ws + WS_ROUTE + RT_SW); float* SRS = (float*)(ws + WS_ROUTE + RT_SRS); const float* RS = (const float*)(ws + WS_ROUTE + RT_RS);
    int* TOK = (int*)(ws + WS_TOK);
    for (int a = blockIdx.x * NTHR + threadIdx.x; a < 2 * T; a += gridDim.x * NTHR) { const int slot = li[AE[a]] + AP[a]; AS[a] = slot; SW[slot] = AW[a]; SRS[slot] = RS[a >> 1]; TOK[slot] = a >> 1; }
    for (int e = blockIdx.x; e < NEXP; e += gridDim.x) { const int c = li[400 + e], pd = (c + 255) & ~255;
        for (int s_ = c + threadIdx.x; s_ < pd; s_ += NTHR) { const int slot = li[e] + s_; SW[slot] = 0.f; SRS[slot] = 0.f; TOK[slot] = 0; } }
}
struct MoeOrder { const char* A; const char* W; size_t a_tile, w_exp, w_pn; const int* tile_e; int nunits; const int* tok;
    DEVI bool next(int i, g8::Unit& u) const { const int G = (int)gridDim.x, bx = (int)blockIdx.x; const int L = (G % 8 == 0) ? (i * 8 + (bx & 7)) * (G >> 3) + (bx >> 3) : i * G + bx;
        if (L >= nunits) return false; const int tile = L >> 2, pn = L & 3, e = tile_e[tile];
        u.pm = tile; u.pn = pn; u.a = A + (size_t)tile * a_tile; u.b = W + (size_t)e * w_exp + (size_t)pn * w_pn; u.tok = tok ? tok + tile * 256 : nullptr; return true; } };
constexpr int LDS_LI = 132096;
DEVI void phase7a(const Params& p, char* lds) {
    unsigned char* ws = p.ws; int* li = (int*)(lds + LDS_LI); const int ntile = build_prefix(p, li);
    MoeOrder S{(const char*)(ws + WS_X2F8), (const char*)(ws + WS_W13), (size_t)0, (size_t)1024 * 1024, (size_t)256 * 1024, li + 80, ntile * 4, (const int*)(ws + WS_TOK)};
    EpiHid8 E{ws + WS_HID, (const float*)(ws + WS_ROUTE + RT_SRS)};
    g8::gemm_phase<EpiHid8, MoeOrder, true, g8::NoHook, true, true>((G8_LAS unsigned char*)lds, 512, 512, 512, S, E, nullptr, g8::NoHook(), 1 << 30, 0, 125, 121);
}
DEVI void phase7b(const Params& p, char* lds) {
    unsigned char* ws = p.ws; int* li = (int*)(lds + LDS_LI); const int ntile = build_prefix(p, li);
    MoeOrder S{(const char*)(ws + WS_HID), (const char*)(ws + WS_W2), (size_t)256 * EFF, (size_t)1024 * EFF, (size_t)256 * EFF, li + 80, ntile * 4, nullptr};
    g8::Epi4<EpiY> E{{(bf16_t*)(ws + WS_YEXP), (const float*)(ws + WS_ROUTE + RT_SW)}};
    g8::gemm_phase<g8::Epi4<EpiY>, MoeOrder, true, g8::NoHook, false, true>((G8_LAS unsigned char*)lds, EFF / 2, EFF / 2, EFF / 2, S, E, nullptr, g8::NoHook(), 1 << 30, 0, 124, 121);
}
DEVI void phase8(const Params& p) {
    unsigned char* ws = p.ws; const int* AS = (const int*)(ws + WS_ROUTE + RT_AS); const bf16_t* yexp = (const bf16_t*)(ws + WS_YEXP); const bf16_t* x2b = (const bf16_t*)(ws + WS_X2B); const f32x4* finw = (const f32x4*)ptab(ws, PT_FINW);
    const int lane = threadIdx.x & 63, gw = blockIdx.x * 8 + (threadIdx.x >> 6), NGW = gridDim.x * 8;
    f32x4 fw[4];
#pragma unroll
    for (int j = 0; j < 4; ++j) fw[j] = finw[lane + 64 * j];
    constexpr int RPI = 4;
    int4 sl[2]; sl[0] = *(const int4*)(AS + 2 * (size_t)gw * RPI); sl[1] = *(const int4*)(AS + 2 * (size_t)gw * RPI + 4);
    for (int t0 = gw * RPI; t0 < T; t0 += NGW * RPI) {
        u32x2 xv[RPI][4], ya[RPI][4], yb[RPI][4];
#pragma unroll
        for (int r = 0; r < RPI; ++r) { const u32x2* xr = (const u32x2*)(x2b + (size_t)(t0 + r) * D) + lane; const int4 q = sl[r >> 1]; const int s0 = (r & 1) ? q.z : q.x, s1 = (r & 1) ? q.w : q.y;
            const u32x2* y0 = (const u32x2*)(yexp + (size_t)s0 * 1024) + lane; const u32x2* y1 = (const u32x2*)(yexp + (size_t)s1 * 1024) + lane;
#pragma unroll
            for (int j = 0; j < 4; ++j) { xv[r][j] = xr[64 * j]; ya[r][j] = y0[64 * j]; yb[r][j] = y1[64 * j]; } }
        if (t0 + NGW * RPI < T) { sl[0] = *(const int4*)(AS + 2 * (size_t)(t0 + NGW * RPI)); sl[1] = *(const int4*)(AS + 2 * (size_t)(t0 + NGW * RPI) + 4); }
#pragma unroll
        for (int r = 0; r < RPI; ++r) { const int t = t0 + r; float s = 0.f; f32x4 v[4];
#pragma unroll
            for (int j = 0; j < 4; ++j) { const u32x2 xw = xv[r][j], a = ya[r][j], b = yb[r][j];
                v[j][0] = (bf2f(xw.x & 0xffffu) + bf2f(a.x & 0xffffu)) + bf2f(b.x & 0xffffu); v[j][1] = (bf2f(xw.x >> 16) + bf2f(a.x >> 16)) + bf2f(b.x >> 16);
                v[j][2] = (bf2f(xw.y & 0xffffu) + bf2f(a.y & 0xffffu)) + bf2f(b.y & 0xffffu); v[j][3] = (bf2f(xw.y >> 16) + bf2f(a.y >> 16)) + bf2f(b.y >> 16);
                s += v[j][0] * v[j][0] + v[j][1] * v[j][1] + v[j][2] * v[j][2] + v[j][3] * v[j][3]; }
            const float rstd = rsqrtf(wave_sum(s) * (1.f / D) + 1e-6f);
            f32x4* xo = (f32x4*)(p.out + (size_t)t * D) + lane;
#pragma unroll
            for (int j = 0; j < 4; ++j) xo[64 * j] = v[j] * rstd * fw[j];
        }
    }
}

#define XB_LAS __attribute__((address_space(3)))
constexpr int CW_BAR = 12288;
constexpr int LDS_XB = 147200;
#define XB_TMO      128
#define XB_XCNT(j)  (256  + 64 * (j))
#define XB_XSUB(j)  (1280 + 64 * (j))
#define XB_XGEN(j)  (2304 + 64 * (j))
#define XB_TOP      3328
#define XB_TOPGEN   3392
#define XCD_BAR_WORDS 3456
#define XB_SPIN_CAP (1u << 18)

__device__ __forceinline__ unsigned xb_ld(unsigned* p)              { return __hip_atomic_load(p, __ATOMIC_RELAXED, __HIP_MEMORY_SCOPE_AGENT); }
__device__ __forceinline__ unsigned xb_add(unsigned* p, unsigned v) { return __hip_atomic_fetch_add(p, v, __ATOMIC_RELAXED, __HIP_MEMORY_SCOPE_AGENT); }
__device__ __forceinline__ unsigned xb_xcc_id() { return (unsigned)__builtin_amdgcn_s_getreg((3 << 11) | 20) & 0xFu; }
#define XB_SPIN(cond, bar) do { unsigned _sp = 0; while (cond) { __builtin_amdgcn_s_sleep(1); \
    if ((++_sp & 255u) == 0u) { if (xb_ld(&(bar)[XB_TMO])) break; if (_sp > XB_SPIN_CAP) { atomicAdd(&(bar)[XB_TMO], 1u); break; } } } } while (0)

struct XcdBarrier {
    unsigned* bar; unsigned x;
    volatile XB_LAS unsigned* st;
};

__device__ __forceinline__ XcdBarrier xcd_barrier_post(unsigned* bar, volatile XB_LAS unsigned* st) {
    XcdBarrier b; b.bar = bar; b.x = xb_xcc_id(); b.st = st;
    if (threadIdx.x == 0) (void)xb_add(&bar[XB_XCNT(b.x)], 1u);
    return b;
}
__device__ __forceinline__ void xcd_barrier_complete(unsigned* bar, unsigned x, unsigned& nloc, unsigned& nx) {
    const unsigned G = gridDim.x * gridDim.y * gridDim.z;
    unsigned sum, cnt, mine, sp = 0u;
    for (;;) {
        sum = 0u; cnt = 0u; mine = 0u;
#pragma unroll
        for (unsigned j = 0; j < 16; ++j) { const unsigned c = xb_ld(&bar[XB_XCNT(j)]); sum += c; cnt += (c > 0u) ? 1u : 0u; mine = (j == x) ? c : mine; }
        if (sum == G) break;
        __builtin_amdgcn_s_sleep(1);
        if ((++sp & 255u) == 0u) { if (xb_ld(&bar[XB_TMO])) break; if (sp > XB_SPIN_CAP) { atomicAdd(&bar[XB_TMO], 1u); break; } }
    }
    nloc = mine > 0u ? mine : 1u; nx = cnt > 0u ? cnt : 1u;
}

__device__ __forceinline__ void xcd_barrier(const XcdBarrier& b) {
    asm volatile("s_waitcnt vmcnt(0)" ::: "memory");
    __syncthreads();
    if (threadIdx.x == 0) {
        unsigned* bar = b.bar;
        __builtin_amdgcn_s_waitcnt(0);
        unsigned nloc = b.st[0], nx = b.st[1];
        if (nloc == 0u) { xcd_barrier_complete(bar, b.x, nloc, nx); b.st[0] = nloc; b.st[1] = nx; }
        const unsigned old = xb_add(&bar[XB_XSUB(b.x)], 1u);
        const unsigned gen = old / nloc;
        if (old + 1u == (gen + 1u) * nloc) {
            __builtin_amdgcn_fence(__ATOMIC_RELEASE, "agent");
            asm volatile("s_waitcnt vmcnt(0)" ::: "memory");
            const unsigned og = xb_add(&bar[XB_TOP], 1u);
            const unsigned tg = og / nx;
            if (og + 1u == (tg + 1u) * nx) xb_add(&bar[XB_TOPGEN], 1u);
            else XB_SPIN(xb_ld(&bar[XB_TOPGEN]) == tg, bar);
            __builtin_amdgcn_fence(__ATOMIC_ACQUIRE, "agent");
            xb_add(&bar[XB_XGEN(b.x)], 1u);
            asm volatile("s_waitcnt vmcnt(0)" ::: "memory");
        } else {
            XB_SPIN(xb_ld(&bar[XB_XGEN(b.x)]) == gen, bar);
            __builtin_amdgcn_fence(__ATOMIC_ACQUIRE, "agent");
            asm volatile("s_waitcnt vmcnt(0)" ::: "memory");
        }
    }
    __syncthreads();
}


constexpr int NPHASE = 12;
constexpr int LDS_BYTES = 147456;
#if defined(TPROBE_A)
#define STAMP(k) if (blockIdx.x == 0 && threadIdx.x == 0) ((unsigned long long*)(p.ws + WS_TS))[(k)] = __builtin_amdgcn_s_memrealtime();
#else
#define STAMP(k)
#endif
__global__ void __launch_bounds__(NTHR, 2) mega(Params p) {
    extern __shared__ __attribute__((aligned(16))) char lds[];
    cg::grid_group grid = cg::this_grid();
    const int lo = p.ph_lo, hi = p.ph_hi;
    if (threadIdx.x < 2) ((volatile XB_LAS unsigned*)((XB_LAS unsigned char*)lds + LDS_XB))[threadIdx.x] = 0u;
    __syncthreads();
    const XcdBarrier xbar = xcd_barrier_post((unsigned*)(p.ws + WS_CTL) + CW_BAR, (volatile XB_LAS unsigned*)((XB_LAS unsigned char*)lds + LDS_XB));
    if (p.ph_hi < 0) grid.sync();
#define SEAM(k) xcd_barrier(xbar)
    STAMP(0)
#ifndef DUP_PH
#define DUP_PH -1
#endif
#ifdef ONLY_PH
#define PH(k, call) if constexpr ((k) == ONLY_PH) { if (lo <= (k) && (k) < hi) { const int rep_ = 0; call; if ((k) + 1 < hi) SEAM(k); } }
#else
#define PH(k, call) if (lo <= (k) && (k) < hi) { if constexpr ((k) == DUP_PH) { _Pragma("unroll 1") for (int rep_ = 0; rep_ < 3; ++rep_) { __syncthreads(); call; } } else { const int rep_ = 0; call; } if ((k) + 1 < hi) SEAM(k); STAMP((k) + 1) }
#endif
    PH(0, phase0(p, lds))
    PH(1, phase1(p, lds))
    PH(2, phase2a(p, lds, rep_ == 0))
    PH(3, phase2b(p, lds))
    PH(4, phase3(p, lds))
    PH(5, phase4(p, lds))
    PH(6, phase5(p, lds))
    PH(7, phase6a(p, lds, rep_ == 0))
    PH(8, phase6b(p, lds))
    PH(9, phase7a(p, lds))
    PH(10, phase7b(p, lds))
    PH(11, phase8(p))
#undef PH
}

extern "C" void kernel_launch(void* const* d_in, const int* in_sizes, int n_in, void* d_out, int out_size, void* d_ws, size_t ws_size, hipStream_t stream) {
    static int grid = 0;
    if (grid == 0) {
        if (n_in != 22 || out_size != T * D || ws_size < WS_END) { fprintf(stderr, "kernel_launch: unexpected shapes (n_in %d out %d ws %zu, need ws >= %zu)\n", n_in, out_size, ws_size, (size_t)WS_END); grid = -1; return; }
        int dev = 0, cus = 0, per_cu = 0; hipGetDevice(&dev); hipDeviceGetAttribute(&cus, hipDeviceAttributeMultiprocessorCount, dev);
        hipFuncSetAttribute((const void*)mega, hipFuncAttributeMaxDynamicSharedMemorySize, LDS_BYTES);
        hipOccupancyMaxActiveBlocksPerMultiprocessor(&per_cu, (const void*)mega, NTHR, LDS_BYTES);
        if (per_cu < 1) { fprintf(stderr, "kernel_launch: occupancy query says %d blocks per CU\n", per_cu); per_cu = 1; }
        grid = cus * per_cu; (void)hipGetLastError();
    }
    if (grid < 0) return;
    hipMemsetAsync((char*)d_ws + WS_CTL, 0, 65536, stream);
    Params p{};
    p.x = (const float*)d_in[0]; p.pos = (const int*)d_in[1]; p.attn_norm_w = (const float*)d_in[2]; p.w_in = (const float*)d_in[3]; p.hg_lb = (const float*)d_in[4];
    p.hg_onw = (const float*)d_in[5]; p.q_norm_w = (const float*)d_in[6]; p.w_uq = (const float*)d_in[7]; p.kv_norm_w = (const float*)d_in[8]; p.w_ukv = (const float*)d_in[9];
    p.w_bra = (const float*)d_in[10]; p.w_brb = (const float*)d_in[11]; p.w_out = (const float*)d_in[12]; p.ffn_norm_w = (const float*)d_in[13]; p.rg_w = (const float*)d_in[14];
    p.rg_b = (const float*)d_in[15]; p.re_w = (const float*)d_in[16]; p.re_b = (const float*)d_in[17]; p.ew1 = (const float*)d_in[18]; p.ew3 = (const float*)d_in[19];
    p.ew2 = (const float*)d_in[20]; p.final_w = (const float*)d_in[21]; p.out = (float*)d_out; p.ws = (unsigned char*)d_ws;
#if MK_MULTI
    for (int ph = 0; ph < NPHASE; ++ph) { p.ph_lo = ph; p.ph_hi = ph + 1; hipLaunchKernelGGL(mega, dim3(grid), dim3(NTHR), LDS_BYTES, stream, p); }
#else
    p.ph_lo = 0; p.ph_hi = NPHASE;
    void* args[] = {&p};
    hipError_t e = hipLaunchCooperativeKernel((const void*)mega, dim3(grid), dim3(NTHR), args, LDS_BYTES, stream);
    if (e != hipSuccess) fprintf(stderr, "cooperative launch failed: %s (grid %d)\n", hipGetErrorString(e), grid);
#endif
}
```

```cpp
#include <hip/hip_runtime.h>
#include <hip/hip_cooperative_groups.h>
#include <cstdio>
#include <cstdint>
namespace cg = cooperative_groups;

#ifndef MK_MULTI
#define MK_MULTI 0
#endif

#define DEVI __device__ __forceinline__
typedef unsigned short bf16_t;
typedef short bf16x8 __attribute__((ext_vector_type(8)));
typedef float f32x4 __attribute__((ext_vector_type(4)));
typedef unsigned u32x4 __attribute__((ext_vector_type(4)));
typedef unsigned u32x2 __attribute__((ext_vector_type(2)));

constexpr int NB = 16, SEQ = 2048, T = NB * SEQ, D = 1024;
constexpr int NTHR = 512;
constexpr int ZH_P = 4096, ZL_P = 768, ZG_P = 2048;
constexpr int NZ = 6912;
constexpr int NEXP = 64, EFF = 512;
constexpr int SLOT_CAP = 2 * T + NEXP * 256;
constexpr int MAX_TILES = SLOT_CAP / 256;

constexpr size_t MiB = 1u << 20;
constexpr size_t WS_CTL = 0;
constexpr size_t WS_WRT = 1 * MiB;
constexpr size_t WS_LBT = 1 * MiB + 512 * 1024;
constexpr size_t WS_WIN = 2 * MiB;
constexpr size_t WS_WUQ = 16 * MiB;
constexpr size_t WS_WUKV = 18 * MiB;
constexpr size_t WS_WBR = 20 * MiB;
constexpr size_t WS_WOUT = 24 * MiB;
constexpr size_t WS_COS = 26 * MiB, WS_SIN = 30 * MiB;
constexpr size_t WS_ROUTE = 34 * MiB;
constexpr size_t WS_KPE = 36 * MiB;
constexpr size_t WS_ZH = 40 * MiB;
constexpr size_t WS_Q = 40 * MiB, WS_KN = 136 * MiB, WS_V = 200 * MiB;
constexpr size_t WS_Y = 40 * MiB;
constexpr size_t WS_X2B = 104 * MiB;
constexpr size_t WS_HID = 168 * MiB;
constexpr size_t WS_YEXP = 248 * MiB;
constexpr size_t WS_X2F8 = 344 * MiB;
constexpr size_t WS_H8 = 408 * MiB;
constexpr size_t WS_WIN8 = 440 * MiB;
constexpr size_t WS_TOK = 512 * 1024;
constexpr size_t WS_OB = 264 * MiB;
constexpr size_t WS_ZL = 296 * MiB;
constexpr size_t WS_ZG = 344 * MiB;
constexpr size_t WS_W13 = 408 * MiB;
constexpr size_t WS_OA = 472 * MiB;
constexpr size_t WS_H = 472 * MiB;
constexpr size_t WS_W2 = 472 * MiB;
constexpr size_t WS_END = 536 * MiB;
constexpr size_t RT_AE = 0, RT_AP = 256 * 1024, RT_AW = 512 * 1024, RT_AS = 768 * 1024, RT_ST = 1024 * 1024, RT_SW = 1536 * 1024;
constexpr int CW_CNT = 8192, CNT_STRIDE = 64;
constexpr size_t WS_TS = 16384;
constexpr size_t WS_PTRS = 8192;
enum { PT_POS = 0, PT_HGLB, PT_HGONW, PT_RGB, PT_REB, PT_EW1, PT_EW3, PT_EW2, PT_FFNW, PT_FINW, PT_X };
DEVI const void* ptab(const unsigned char* ws, int i) { return (const void*)(((const unsigned long long*)(ws + WS_PTRS))[i]); }

struct Params {
    const float* x; const int* pos; const float* attn_norm_w; const float* w_in; const float* hg_lb; const float* hg_onw;
    const float* q_norm_w; const float* w_uq; const float* kv_norm_w; const float* w_ukv; const float* w_bra; const float* w_brb;
    const float* w_out; const float* ffn_norm_w; const float* rg_w; const float* rg_b; const float* re_w; const float* re_b;
    const float* ew1; const float* ew3; const float* ew2; const float* final_w;
    float* out; unsigned char* ws;
    int ph_lo, ph_hi;
};

DEVI unsigned f2bf(float f) { unsigned u = __builtin_bit_cast(unsigned, f); return (u + 0x7fffu + ((u >> 16) & 1u)) >> 16; }
DEVI float bf2f(unsigned h) { return __builtin_bit_cast(float, h << 16); }
typedef float f32x2_t __attribute__((ext_vector_type(2))); typedef __bf16 bf16x2_t __attribute__((ext_vector_type(2)));
DEVI unsigned pk2(float lo, float hi) { f32x2_t v = {lo, hi}; bf16x2_t b = __builtin_convertvector(v, bf16x2_t); return __builtin_bit_cast(unsigned, b); }
DEVI float sigmoidf_(float v) { return __builtin_amdgcn_rcpf(1.f + __expf(-v)); }
DEVI float siluf_(float v) { return v * __builtin_amdgcn_rcpf(1.f + __expf(-v)); }
DEVI float wave_sum(float v) {
#pragma unroll
    for (int o = 1; o < 64; o <<= 1) v += __shfl_xor(v, o);
    return v;
}
typedef int i32x4 __attribute__((ext_vector_type(4))); typedef int i32x8 __attribute__((ext_vector_type(8)));
DEVI unsigned pk4_fp8(float a, float b, float c, float d) { int w = __builtin_amdgcn_cvt_pk_fp8_f32(a, b, 0, false); w = __builtin_amdgcn_cvt_pk_fp8_f32(c, d, w, true); return (unsigned)w; }
DEVI void store4bf(bf16_t* p, f32x4 v) { u32x2 w; w.x = pk2(v[0], v[1]); w.y = pk2(v[2], v[3]); *(u32x2*)p = w; }
DEVI void unpack8(bf16x8 v, float* f) {
#pragma unroll
    for (int j = 0; j < 8; ++j) f[j] = bf2f((unsigned)(unsigned short)v[j]);
}

template <class ColMap, class KScale>
DEVI void transpose_tile_f8(const float* src, int Nsrc, unsigned char* dst, int ldk, int k0, int n0, ColMap cm, KScale ks, float* scr) {
    const int tid = threadIdx.x;
    {
        const int nl = tid & 63, kq = tid >> 6; const int col = cm(n0 + nl);
#pragma unroll
        for (int i = 0; i < 8; ++i) { const int k = kq * 8 + i; float v = 0.f; if (col >= 0) v = src[(size_t)(k0 + k) * Nsrc + col] * ks(k0 + k); scr[k * 65 + nl] = v; }
    }
    __syncthreads();
    {
        const int nl = tid >> 3, kc = tid & 7; const float* s = scr + (kc * 8) * 65 + nl;
        u32x2 o; o.x = pk4_fp8(s[0], s[65], s[2 * 65], s[3 * 65]); o.y = pk4_fp8(s[4 * 65], s[5 * 65], s[6 * 65], s[7 * 65]);
        *(u32x2*)(dst + (size_t)(n0 + nl) * ldk + k0 + kc * 8) = o;
    }
    __syncthreads();
}
template <class ColMap, class KScale>
DEVI void transpose_tile(const float* src, int Nsrc, bf16_t* dst, int ldk, int k0, int n0, ColMap cm, KScale ks, float* scr) {
    const int tid = threadIdx.x;
    {
        const int nl = tid & 63, kq = tid >> 6; const int col = cm(n0 + nl);
#pragma unroll
        for (int i = 0; i < 8; ++i) { const int k = kq * 8 + i; float v = 0.f; if (col >= 0) v = src[(size_t)(k0 + k) * Nsrc + col] * ks(k0 + k); scr[k * 65 + nl] = v; }
    }
    __syncthreads();
    {
        const int nl = tid >> 3, kc = tid & 7; const float* s = scr + (kc * 8) * 65 + nl;
        u32x4 o; o.x = pk2(s[0], s[65]); o.y = pk2(s[2 * 65], s[3 * 65]); o.z = pk2(s[4 * 65], s[5 * 65]); o.w = pk2(s[6 * 65], s[7 * 65]);
        *(u32x4*)(dst + (size_t)(n0 + nl) * ldk + k0 + kc * 8) = o;
    }
    __syncthreads();
}

namespace g8 {
#define G8_LAS __attribute__((address_space(3)))
constexpr int BM = 256, BK = 64, HALF = 128, HTB = HALF * BK * 2, STAGE_BYTES = 8 * HTB, NXCD = 8, WGM = 8;
__host__ __device__ __forceinline__ int lds_byte(int r, int c) { const int st = (r >> 4) * 2 + (c >> 5), rr = r & 15, cc = c & 31, ob = rr * 64 + cc * 2; return st * 1024 + (ob ^ (((ob >> 9) & 1) << 5)); }
__host__ __device__ __forceinline__ int perm32(int rho) { const int n = rho >> 4, i = rho & 15; return 8 * (i >> 2) + 4 * n + (i & 3); }
__host__ __device__ __forceinline__ void stage_rc(int b, int& R, int& C) { const int st = b / 1024, sb = b % 1024, swz = sb ^ (((sb >> 9) & 1) << 5); R = (st >> 1) * 16 + swz / 64; C = (st & 1) * 32 + (swz % 64) / 2; }
struct Unit { int pm, pn; const char* a; const char* b; const int* tok; };
struct DenseOrder {
    const char* A; const char* Bt; size_t tstepA, tstepB; int nM, nN, nwg, G, c;
    DEVI void init(const void* A_, int lda, const void* Bt_, int ldb, int M, int N) { A = (const char*)A_; Bt = (const char*)Bt_; tstepA = (size_t)BM * lda * 2; tstepB = (size_t)BM * ldb * 2;
        nM = M / BM; nN = N / BM; nwg = nM * nN; G = gridDim.x; c = blockIdx.x; }
    DEVI bool next(int i, Unit& u) const {
        const long L = (long)i * G + c; if (L >= nwg) return false;
        int wgid = (int)L; { const int q = nwg / NXCD, r = nwg % NXCD, xcd = wgid % NXCD, off = wgid / NXCD; wgid = (xcd < r ? xcd * (q + 1) : r * (q + 1) + (xcd - r) * q) + off; }
        const int nig = WGM * nN, gid = wgid / nig, fm = gid * WGM, gsz = (nM - fm) < WGM ? (nM - fm) : WGM;
        u.pm = fm + ((wgid % nig) % gsz); u.pn = (wgid % nig) / gsz; u.a = A + (size_t)u.pm * tstepA; u.b = Bt + (size_t)u.pn * tstepB; u.tok = nullptr; return true;
    }
};
struct NoHook { static constexpr bool ON = false; template <class U> DEVI void operator()(f32x4 (&)[2][2][4][2], const U&, int, int, int, int) const {} };
template <class Epi, class Sched, bool ALIGN_EPI, class Hook = NoHook, bool GATHER = false, bool FP8 = false>
DEVI void gemm_phase(G8_LAS unsigned char* lds, const int lda, const int ldb, const int K, const Sched& S, const Epi& E, unsigned long long* tsp = nullptr, const Hook& H = Hook(), const int seg_t = 1 << 30, const long segj = 0, const int scA = 127, const int scB = 127) {
    const int tid = threadIdx.x, wid = __builtin_amdgcn_readfirstlane(tid >> 6), lane = tid & 63, wr = wid >> 2, wc = wid & 3, fr = lane & 15, fq = lane >> 4;
    const int nt = K / BK;
    unsigned voffA[2], voffB[2]; int gR[2]; unsigned gC[2];
#pragma unroll
    for (int i = 0; i < 2; ++i) { int R, C; stage_rc(tid * 16 + i * 8192, R, C); voffA[i] = (unsigned)(R * lda + C) * 2u; voffB[i] = (unsigned)(((R & ~31) + perm32(R & 31)) * ldb + C) * 2u; gR[i] = R; gC[i] = (unsigned)C * 2u; }
    unsigned vG[2][2], vGn[2][2];
#define G8_TOK(dst, tokp) do { _Pragma("unroll") for (int h_ = 0; h_ < 2; ++h_) _Pragma("unroll") for (int i_ = 0; i_ < 2; ++i_) dst[h_][i_] = (unsigned)(tokp)[gR[i_] + 128 * h_] * (unsigned)(lda * 2) + gC[i_]; } while (0)
#define G8_STAGE_A(bufoff, gbase, h, usenext) do { if constexpr (GATHER) { unsigned v_[2] = {(usenext) ? vGn[h][0] : vG[h][0], (usenext) ? vGn[h][1] : vG[h][1]}; G8_STAGE(bufoff, gbase, v_); } \
        else { G8_STAGE(bufoff, (gbase) + (h) * hstepA, voffA); } } while (0)
    const size_t kstep = (size_t)(BK * 2);
    const size_t hstepA = (size_t)HALF * lda * 2, hstepB = (size_t)HALF * ldb * 2;
    const unsigned ldsw = (unsigned)wid * 1024u;
    const int aoff = lds_byte(wr * 64 + fr, fq * 8), boff = lds_byte(wc * 32 + fr, fq * 8);
#define G8_SA(b, h) (((b) * 2 + (h)) * HTB)
#define G8_SB(b, h) ((4 + (b) * 2 + (h)) * HTB)
#define G8_STAGE(bufoff, gbase, voff) do { _Pragma("unroll") for (int _i = 0; _i < 2; ++_i) \
        __builtin_amdgcn_global_load_lds((const unsigned*)((const char*)(gbase) + (voff)[_i]), (G8_LAS unsigned*)(lds + (bufoff) + ldsw + _i * 8192), 16, 0, 0); } while (0)
#define G8_LD16(off) __builtin_bit_cast(i32x4, *(const G8_LAS bf16x8*)(lds + (off)))
#define G8_LDA8(dst, b, h) do { _Pragma("unroll") for (int m = 0; m < 4; ++m) dst[m] = __builtin_shufflevector(G8_LD16(G8_SA(b, h) + aoff + m * 2048), G8_LD16(G8_SA(b, h) + aoff + m * 2048 + 1024), 0, 1, 2, 3, 4, 5, 6, 7); } while (0)
#define G8_LDB8(dst, b, h) do { _Pragma("unroll") for (int n = 0; n < 2; ++n) dst[n] = __builtin_shufflevector(G8_LD16(G8_SB(b, h) + boff + n * 2048), G8_LD16(G8_SB(b, h) + boff + n * 2048 + 1024), 0, 1, 2, 3, 4, 5, 6, 7); } while (0)
#define G8_LDA(dst, b, h) do { if constexpr (FP8) { G8_LDA8(dst##8, b, h); break; } _Pragma("unroll") for (int m = 0; m < 4; ++m) _Pragma("unroll") for (int k = 0; k < 2; ++k) dst[m][k] = *(const G8_LAS bf16x8*)(lds + G8_SA(b, h) + aoff + m * 2048 + k * 1024); } while (0)
#define G8_LDB(dst, b, h) do { if constexpr (FP8) { G8_LDB8(dst##8, b, h); break; } _Pragma("unroll") for (int n = 0; n < 2; ++n) _Pragma("unroll") for (int k = 0; k < 2; ++k) dst[n][k] = *(const G8_LAS bf16x8*)(lds + G8_SB(b, h) + boff + n * 2048 + k * 1024); } while (0)
#define G8_MMA(ai, bj, At, Bt) do { __builtin_amdgcn_s_setprio(1); _Pragma("unroll") for (int m = 0; m < 4; ++m) _Pragma("unroll") for (int n = 0; n < 2; ++n) { \
        if constexpr (FP8) { asm volatile("v_mfma_scale_f32_16x16x128_f8f6f4 %0, %1, %2, %0, %3, %4 op_sel_hi:[0,0,0]" : "+v"(acc[ai][bj][m][n]) : "v"(Bt##8[n]), "v"(At##8[m]), "v"(scB), "v"(scA)); } \
        else { _Pragma("unroll") for (int k = 0; k < 2; ++k) acc[ai][bj][m][n] = __builtin_amdgcn_mfma_f32_16x16x32_bf16(Bt[n][k], At[m][k], acc[ai][bj][m][n], 0, 0, 0); } } __builtin_amdgcn_s_setprio(0); } while (0)
#define G8_WAIT_V(n) asm volatile("s_waitcnt vmcnt(" #n ")" ::: "memory")
#define G8_WAIT_L(n) asm volatile("s_waitcnt lgkmcnt(" #n ")" ::: "memory")
#define G8_BAR __builtin_amdgcn_s_barrier()
#define G8_SCHED __builtin_amdgcn_sched_barrier(0)
    Unit cur, nxt; int ui = 0;
    if (!S.next(0, cur)) return;
    f32x4 acc[2][2][4][2];
#pragma unroll
    for (int a = 0; a < 2; ++a)
#pragma unroll
        for (int b = 0; b < 2; ++b)
#pragma unroll
            for (int m = 0; m < 4; ++m)
#pragma unroll
                for (int n = 0; n < 2; ++n) acc[a][b][m][n] = (f32x4){0.f, 0.f, 0.f, 0.f};
    bf16x8 At[4][2], B0[2][2], B1[2][2];
    i32x8 At8[4], B08[2], B18[2];
    const char* cA = cur.a; const char* cB = cur.b;
    if constexpr (GATHER) { G8_TOK(vG, cur.tok); G8_TOK(vGn, cur.tok); }
    G8_STAGE(G8_SB(0, 0), cB, voffB); G8_STAGE(G8_SB(0, 1), cB + hstepB, voffB); G8_STAGE_A(G8_SA(0, 0), cA, 0, false); G8_STAGE_A(G8_SA(0, 1), cA, 1, false);
    if (wr == 1) G8_BAR;
    G8_WAIT_V(2); G8_BAR;
    G8_STAGE(G8_SB(1, 0), cB + kstep, voffB); G8_STAGE_A(G8_SA(1, 0), cA + kstep, 0, false); G8_STAGE(G8_SB(1, 1), cB + hstepB + kstep, voffB);
    G8_WAIT_V(6); G8_BAR;
    unsigned long long tk_ = 0, te_ = 0, tp_ = tsp ? __builtin_amdgcn_s_memrealtime() : 0;
    for (;;) {
        const bool has_next = S.next(ui + 1, nxt);
        const char* nA = has_next ? nxt.a : cA; const char* nB = has_next ? nxt.b : cB;
        if constexpr (GATHER) { if (has_next) G8_TOK(vGn, nxt.tok); }
#pragma unroll 1
        for (int t = 0; t < nt; t += 2) {
            const bool last = (t == nt - 2);
            if constexpr (Hook::ON) { if (t == seg_t) H(acc, cur, wr, wc, fr, fq); }
            const char* a1 = cA + (size_t)(t + 1) * kstep + (Hook::ON && t + 1 >= seg_t ? segj : 0);
            const char* a2 = last ? nA : cA + (size_t)(t + 2) * kstep + (Hook::ON && t + 2 >= seg_t ? segj : 0); const char* b2 = last ? nB : cB + (size_t)(t + 2) * kstep;
            const char* a3 = a2 + kstep; const char* b3 = b2 + kstep;
            G8_LDB(B0, 0, 0); G8_LDB(B1, 0, 1); G8_SCHED; G8_LDA(At, 0, 0); G8_STAGE_A(G8_SA(1, 1), a1, 1, false);
            G8_WAIT_V(8); G8_WAIT_L(0); G8_BAR; G8_MMA(0, 0, At, B0); G8_MMA(0, 1, At, B1); G8_BAR; G8_SCHED;
            G8_LDA(At, 0, 1); G8_STAGE(G8_SB(0, 0), b2, voffB); G8_STAGE(G8_SB(0, 1), b2 + hstepB, voffB); G8_STAGE_A(G8_SA(0, 0), a2, 0, last);
            G8_WAIT_V(8); G8_WAIT_L(0); G8_BAR; G8_MMA(1, 0, At, B0); G8_MMA(1, 1, At, B1); G8_BAR; G8_SCHED;
            G8_LDB(B0, 1, 0); G8_LDB(B1, 1, 1); G8_SCHED; G8_LDA(At, 1, 0); G8_STAGE_A(G8_SA(0, 1), a2, 1, last);
            G8_WAIT_V(8); G8_WAIT_L(0); G8_BAR; G8_MMA(0, 0, At, B0); G8_MMA(0, 1, At, B1); G8_BAR; G8_SCHED;
            G8_LDA(At, 1, 1); G8_STAGE(G8_SB(1, 0), b3, voffB); G8_STAGE(G8_SB(1, 1), b3 + hstepB, voffB); G8_STAGE_A(G8_SA(1, 0), a3, 0, last);
            G8_WAIT_V(8); G8_WAIT_L(0); G8_BAR; G8_MMA(1, 0, At, B0); G8_MMA(1, 1, At, B1); G8_BAR; G8_SCHED;
        }
        if constexpr (ALIGN_EPI) { if (wr == 0) G8_BAR; }
        if (tsp) { const unsigned long long n_ = __builtin_amdgcn_s_memrealtime(); tk_ += n_ - tp_; tp_ = n_; }
        if constexpr (FP8) asm volatile("s_nop 15\n\ts_nop 15" ::: "memory");
        E(acc, cur, wr, wc, fr, fq);
        if (tsp) { const unsigned long long n_ = __builtin_amdgcn_s_memrealtime(); te_ += n_ - tp_; tp_ = n_; }
        if (!has_next) break;
#pragma unroll
        for (int a = 0; a < 2; ++a)
#pragma unroll
            for (int b = 0; b < 2; ++b)
#pragma unroll
                for (int m = 0; m < 4; ++m)
#pragma unroll
                    for (int n = 0; n < 2; ++n) acc[a][b][m][n] = (f32x4){0.f, 0.f, 0.f, 0.f};
        cur = nxt; cA = nA; cB = nB; ++ui;
        if constexpr (GATHER) { _Pragma("unroll") for (int h_ = 0; h_ < 2; ++h_) _Pragma("unroll") for (int i_ = 0; i_ < 2; ++i_) vG[h_][i_] = vGn[h_][i_]; }
        if constexpr (ALIGN_EPI) { if (wr == 1) G8_BAR; }
    }
    G8_WAIT_V(0);
    if constexpr (!ALIGN_EPI) { if (wr == 0) G8_BAR; }
    G8_BAR;
    if (tsp && blockIdx.x == 0 && threadIdx.x == 0) { tsp[0] = 0; tsp[1] = tk_; tsp[2] = 0; tsp[3] = te_; tsp[4] = 0; tsp[5] = (unsigned long long)(ui + 1) * 100ull; }
#undef G8_SA
#undef G8_SB
#undef G8_STAGE
#undef G8_STAGE_A
#undef G8_TOK
#undef G8_LDA
#undef G8_LDA8
#undef G8_LDB8
#undef G8_LD16
#undef G8_LDB
#undef G8_MMA
#undef G8_WAIT_V
#undef G8_WAIT_L
#undef G8_BAR
#undef G8_SCHED
}
template <class F> struct Epi4 { F f;
    DEVI void operator()(const f32x4 (&acc)[2][2][4][2], const Unit& u, int wr, int wc, int fr, int fq) const {
        constexpr int NB = F::NB;
        asm volatile("" : "+v"(fr), "+v"(fq));
#pragma unroll
        for (int g0 = 0; g0 < 8; g0 += NB) {
            typename F::L ld[NB][2];
#pragma unroll
            for (int gg = 0; gg < NB; ++gg) { const int ai = (g0 + gg) >> 2, m = (g0 + gg) & 3;
#pragma unroll
                for (int bj = 0; bj < 2; ++bj) ld[gg][bj] = f.load(u.pm, u.pn, ai * 128 + wr * 64 + m * 16 + fr, bj * 128 + wc * 32 + 8 * fq); }
#pragma unroll
            for (int gg = 0; gg < NB; ++gg) { const int ai = (g0 + gg) >> 2, m = (g0 + gg) & 3;
#pragma unroll
                for (int bj = 0; bj < 2; ++bj) f.apply(u.pm, u.pn, ai * 128 + wr * 64 + m * 16 + fr, bj * 128 + wc * 32 + 8 * fq, acc[ai][bj][m][0], acc[ai][bj][m][1], ld[gg][bj]); }
            asm volatile("" ::: "memory");
        }
    } };
template <class F> struct Hook4 { static constexpr bool ON = true; F f;
    DEVI void operator()(f32x4 (&acc)[2][2][4][2], const Unit& u, int wr, int wc, int fr, int fq) const {
        constexpr int NB = F::NB;
        asm volatile("" : "+v"(fr), "+v"(fq));
#pragma unroll
        for (int g0 = 0; g0 < 8; g0 += NB) {
            typename F::L ld[NB][2];
#pragma unroll
            for (int gg = 0; gg < NB; ++gg) { const int ai = (g0 + gg) >> 2, m = (g0 + gg) & 3;
#pragma unroll
                for (int bj = 0; bj < 2; ++bj) ld[gg][bj] = f.load(u.pm, u.pn, ai * 128 + wr * 64 + m * 16 + fr, bj * 128 + wc * 32 + 8 * fq); }
#pragma unroll
            for (int gg = 0; gg < NB; ++gg) { const int ai = (g0 + gg) >> 2, m = (g0 + gg) & 3;
#pragma unroll
                for (int bj = 0; bj < 2; ++bj) f.apply(u.pm, u.pn, ai * 128 + wr * 64 + m * 16 + fr, bj * 128 + wc * 32 + 8 * fq, acc[ai][bj][m][0], acc[ai][bj][m][1], ld[gg][bj]); }
            asm volatile("" ::: "memory");
        }
    } };
}

struct NoLd {};
struct LbLd { f32x4 a, b; };
DEVI void store8bf(bf16_t* p, f32x4 a, f32x4 b) { u32x4 w; w.x = pk2(a[0], a[1]); w.y = pk2(a[2], a[3]); w.z = pk2(b[0], b[1]); w.w = pk2(b[2], b[3]); *(u32x4*)p = w; }
struct EpiZa { typedef LbLd L; static constexpr int NB = 1; unsigned char* ws;
    DEVI L load(int, int pn, int, int c) const { L l; l.a = (f32x4){0.f, 0.f, 0.f, 0.f}; l.b = l.a; if ((pn >> 2) == 1) { const float* lp = (const float*)(ws + WS_LBT) + (pn - 4) * 256 + c; l.a = *(const f32x4*)lp; l.b = *(const f32x4*)(lp + 4); } return l; }
    DEVI void apply(int pm, int pn, int r, int c, f32x4 v0, f32x4 v1, const L& lb) const {
        const size_t row = (size_t)pm * 256 + r; const int col = pn * 256 + c; const int kind = pn >> 2;
        if (kind == 3) {
#pragma unroll
            for (int j = 0; j < 4; ++j) { v0[j] = siluf_(v0[j]); v1[j] = siluf_(v1[j]); } }
        if (kind == 0) {
#pragma unroll
            for (int j = 0; j < 4; ++j) { v0[j] = siluf_(v0[j]) * 0.08838834764831845f; v1[j] = siluf_(v1[j]) * 0.08838834764831845f; } }
        else if (kind == 1) {
#pragma unroll
            for (int j = 0; j < 4; ++j) { v0[j] = __logf(lb.a[j] + (1.f - lb.a[j]) * sigmoidf_(v0[j])); v1[j] = __logf(lb.b[j] + (1.f - lb.b[j]) * sigmoidf_(v1[j])); } }
        store8bf((bf16_t*)(ws + WS_ZH) + row * ZH_P + col, v0, v1);
    } };
struct EpiZb { typedef NoLd L; static constexpr int NB = 8; unsigned char* ws;
    DEVI L load(int, int, int, int) const { return {}; }
    DEVI void apply(int pm, int pn, int r, int c, f32x4 v0, f32x4 v1, L) const {
        const size_t row = (size_t)pm * 256 + r; u32x2 w = {0u, 0u};
        if (pn < 3) { store8bf((bf16_t*)(ws + WS_ZL) + row * ZL_P + pn * 256 + c, v0, v1); return; }
#pragma unroll
        for (int j = 0; j < 4; ++j) { w.x |= (unsigned)fmaxf(__builtin_rintf(255.f * sigmoidf_(v0[j])), 1.f) << (8 * j); w.y |= (unsigned)fmaxf(__builtin_rintf(255.f * sigmoidf_(v1[j])), 1.f) << (8 * j); }
        *(u32x2*)(ws + WS_ZG + row * ZG_P + (pn - 3) * 256 + c) = w;
    } };
struct EpiQ { typedef NoLd L; static constexpr int NB = 8; bf16_t* q;
    DEVI L load(int, int, int, int) const { return {}; }
    DEVI void apply(int pm, int pn, int r, int c, f32x4 v0, f32x4 v1, L) const { store8bf(q + ((size_t)pm * 256 + r) * 1536 + pn * 256 + c, v0, v1); } };
struct EpiKV { typedef NoLd L; static constexpr int NB = 8; bf16_t* kn; bf16_t* vv;
    DEVI L load(int, int, int, int) const { return {}; }
    DEVI void apply(int pm, int pn, int r, int c, f32x4 v0, f32x4 v1, L) const {
        const size_t row = (size_t)pm * 256 + r; const int col = pn * 256 + c; const int hh = col >> 8, cc = col & 255;
        if (cc < 128) store8bf(kn + row * 1024 + hh * 128 + cc, v0, v1); else store8bf(vv + row * 1024 + hh * 128 + (cc - 128), v0, v1);
    } };
struct BrHookF { typedef u32x4 L; static constexpr int NB = 1; const unsigned char* zg;
    DEVI L load(int pm, int pn, int r, int c) const { const unsigned char* g = zg + ((size_t)pm * 256 + r) * ZG_P + pn * 256 + c; const u32x2 a = *(const u32x2*)g, b = *(const u32x2*)(g + 1024); return (L){a.x, a.y, b.x, b.y}; }
    DEVI void apply(int, int, int, int, f32x4& v0, f32x4& v1, L l) const {
#pragma unroll
        for (int j = 0; j < 4; ++j) { v0[j] *= (float)((l.x >> (8 * j)) & 255u) * __builtin_amdgcn_rcpf((float)((l.z >> (8 * j)) & 255u)); v1[j] *= (float)((l.y >> (8 * j)) & 255u) * __builtin_amdgcn_rcpf((float)((l.w >> (8 * j)) & 255u)); } } };
struct EpiBr2 { typedef u32x2 L; static constexpr int NB = 2; const unsigned char* zg; bf16_t* y;
    DEVI L load(int pm, int pn, int r, int c) const { return *(const u32x2*)(zg + ((size_t)pm * 256 + r) * ZG_P + 1024 + pn * 256 + c); }
    DEVI void apply(int pm, int pn, int r, int c, f32x4 v0, f32x4 v1, L g) const {
#pragma unroll
        for (int j = 0; j < 4; ++j) { v0[j] *= (float)((g.x >> (8 * j)) & 255u) * (1.f / 255.f); v1[j] *= (float)((g.y >> (8 * j)) & 255u) * (1.f / 255.f); }
        store8bf(y + ((size_t)pm * 256 + r) * 1024 + pn * 256 + c, v0, v1); } };
struct EpiOut { typedef LbLd L; static constexpr int NB = 2; const float* x; bf16_t* x2b; unsigned char* x2f8;
    DEVI L load(int pm, int pn, int r, int c) const { const float* xp = x + ((size_t)pm * 256 + r) * 1024 + pn * 256 + c; L l; l.a = *(const f32x4*)xp; l.b = *(const f32x4*)(xp + 4); return l; }
    DEVI void apply(int pm, int pn, int r, int c, f32x4 v0, f32x4 v1, const L& xv) const { const size_t o = ((size_t)pm * 256 + r) * 1024 + pn * 256 + c; const f32x4 a = xv.a + v0, b = xv.b + v1; store8bf(x2b + o, a, b);
        u32x2 w; w.x = pk4_fp8(4.f * a[0], 4.f * a[1], 4.f * a[2], 4.f * a[3]); w.y = pk4_fp8(4.f * b[0], 4.f * b[1], 4.f * b[2], 4.f * b[3]); *(u32x2*)(x2f8 + o) = w; } };
struct EpiHid8 { unsigned char* hid; const float* srs;
    DEVI void operator()(const f32x4 (&acc)[2][2][4][2], const g8::Unit& u, int wr, int wc, int fr, int fq) const {
        asm volatile("" : "+v"(fr), "+v"(fq));
        float rs[8];
#pragma unroll
        for (int g = 0; g < 8; ++g) rs[g] = srs[(size_t)u.pm * 256 + (g >> 2) * 128 + wr * 64 + (g & 3) * 16 + fr];
#pragma unroll
        for (int g = 0; g < 8; ++g) { const int ai = g >> 2, m = g & 3; unsigned char* hrow = hid + ((size_t)u.pm * 256 + ai * 128 + wr * 64 + m * 16 + fr) * EFF + u.pn * 128 + wc * 16 + 4 * fq;
#pragma unroll
            for (int bj = 0; bj < 2; ++bj) { const f32x4 gg = acc[ai][bj][m][0] * rs[g], uu = acc[ai][bj][m][1] * rs[g]; float h4[4];
#pragma unroll
                for (int i = 0; i < 4; ++i) h4[i] = fminf(fmaxf(8.f * siluf_(gg[i]) * uu[i], -440.f), 440.f);
                *(unsigned*)(hrow + bj * 64) = pk4_fp8(h4[0], h4[1], h4[2], h4[3]); } }
    } };
struct EpiY { typedef float L; static constexpr int NB = 8; bf16_t* yexp; const float* sw;
    DEVI L load(int tile, int, int r, int) const { return sw[(size_t)tile * 256 + r]; }
    DEVI void apply(int tile, int pn, int r, int c, f32x4 v0, f32x4 v1, L w) const { store8bf(yexp + ((size_t)tile * 256 + r) * 1024 + pn * 256 + c, v0 * w, v1 * w); } };

DEVI void phase0(const Params& p, char* lds) {
    float* scr = (float*)lds; unsigned char* ws = p.ws;
    bf16_t* WinT = (bf16_t*)(ws + WS_WIN); bf16_t* WuqT = (bf16_t*)(ws + WS_WUQ); bf16_t* WukvT = (bf16_t*)(ws + WS_WUKV);
    bf16_t* WbrT = (bf16_t*)(ws + WS_WBR); bf16_t* WoutT = (bf16_t*)(ws + WS_WOUT);
    constexpr int I_IN = (4096 / 64) * 16, I_IN8 = (2816 / 64) * 16, I_UQ = 24 * 6, I_UKV = 32 * 4, I_BR = 16 * 16, I_OUT = 16 * 16;
    constexpr int NIT = I_IN + I_IN8 + I_UQ + I_UKV + 2 * I_BR + I_OUT;
    for (int it = blockIdx.x; it < NIT; it += gridDim.x) {
        int r = it;
        if (r < I_IN) { const int nb = r / 16, kb = r % 16; const float* nw = p.attn_norm_w;
            transpose_tile(p.w_in, 6848, WinT, 1024, kb * 64, nb * 64, [](int n) { return n; }, [nw](int k) { return nw[k]; }, scr); continue; }
        r -= I_IN;
        if (r < I_IN8) { const int nb = r / 16, kb = r % 16; const float* nw = p.attn_norm_w;
            transpose_tile_f8(p.w_in, 6848, ws + WS_WIN8, 1024, kb * 64, nb * 64, [](int n) { return n < 704 ? 4096 + n : (n < 768 ? -1 : 4032 + n); }, [nw](int k) { return nw[k] * 64.f; }, scr); continue; }
        r -= I_IN8;
        if (r < I_UQ) { const int nb = r / 6, kb = r % 6; const float* nw = p.q_norm_w;
            transpose_tile(p.w_uq, 1536, WuqT, 384, kb * 64, nb * 64,
                           [](int n) { const int hh = n / 192, c = n % 192; if (c < 128) return n; const int rr = c - 128; return hh * 192 + 128 + (rr & 1) * 32 + (rr >> 1); },
                           [nw](int k) { return nw[k] * 0.07216878364870322f; }, scr); continue; }
        r -= I_UQ;
        if (r < I_UKV) { const int nb = r / 4, kb = r % 4; const float* nw = p.kv_norm_w;
            transpose_tile(p.w_ukv, 2048, WukvT, 256, kb * 64, nb * 64, [](int n) { return n; }, [nw](int k) { return nw[k]; }, scr); continue; }
        r -= I_UKV;
        if (r < I_BR) { const int nb = r / 16, kb = r % 16;
            transpose_tile(p.w_bra, 1024, WbrT, 2048, kb * 64, nb * 64, [](int n) { return n; }, [](int) { return 1.f; }, scr); continue; }
        r -= I_BR;
        if (r < I_BR) { const int nb = r / 16, kb = r % 16;
            transpose_tile(p.w_brb, 1024, WbrT + 1024, 2048, kb * 64, nb * 64, [](int n) { return n; }, [](int) { return 1.f; }, scr); continue; }
        r -= I_BR;
        { const int nb = r / 16, kb = r % 16;
            transpose_tile(p.w_out, 1024, WoutT, 1024, kb * 64, nb * 64, [](int n) { return n; }, [](int) { return 1.f; }, scr); }
    }
    if (blockIdx.x == 0 && threadIdx.x == 0) { unsigned long long* tb = (unsigned long long*)(ws + WS_PTRS);
        tb[PT_POS] = (unsigned long long)p.pos; tb[PT_HGLB] = (unsigned long long)p.hg_lb; tb[PT_HGONW] = (unsigned long long)p.hg_onw; tb[PT_RGB] = (unsigned long long)p.rg_b; tb[PT_REB] = (unsigned long long)p.re_b;
        tb[PT_EW1] = (unsigned long long)p.ew1; tb[PT_EW3] = (unsigned long long)p.ew3; tb[PT_EW2] = (unsigned long long)p.ew2; tb[PT_FFNW] = (unsigned long long)p.ffn_norm_w; tb[PT_FINW] = (unsigned long long)p.final_w; tb[PT_X] = (unsigned long long)p.x; }
    bf16_t* WrH = (bf16_t*)(ws + WS_WRT); bf16_t* WrL = WrH + 80 * 1024;
    for (int e = blockIdx.x * NTHR + threadIdx.x; e < 80 * 1024; e += gridDim.x * NTHR) { const int c = e >> 10, k = e & 1023;
        const float w = c < 8 ? p.rg_w[k * 8 + c] * p.ffn_norm_w[k] : (c < 72 ? p.re_w[k * 64 + (c - 8)] * p.ffn_norm_w[k] : 0.f);
        const unsigned hb = f2bf(w); WrH[e] = (bf16_t)hb; WrL[e] = (bf16_t)f2bf(w - bf2f(hb)); }
    { float* lbt = (float*)(ws + WS_LBT); for (int k = blockIdx.x * NTHR + threadIdx.x; k < 1024; k += gridDim.x * NTHR) lbt[k] = 1.f / (1.f + expf(p.hg_lb[1024 + k] - p.hg_lb[k])); }
    bf16_t* H = (bf16_t*)(ws + WS_H);
    const int lane = threadIdx.x & 63, gw = blockIdx.x * 8 + (threadIdx.x >> 6), NGW = gridDim.x * 8;
    for (int m0 = gw * 2; m0 < T; m0 += NGW * 2) {
        f32x4 v[2][4];
#pragma unroll
        for (int r = 0; r < 2; ++r) { const f32x4* xr = (const f32x4*)(p.x + (size_t)(m0 + r) * D) + lane;
#pragma unroll
            for (int j = 0; j < 4; ++j) v[r][j] = xr[64 * j]; }
#pragma unroll
        for (int r = 0; r < 2; ++r) { const int m = m0 + r; float s = 0.f;
#pragma unroll
            for (int j = 0; j < 4; ++j) s += v[r][j][0] * v[r][j][0] + v[r][j][1] * v[r][j][1] + v[r][j][2] * v[r][j][2] + v[r][j][3] * v[r][j][3];
            const float rstd = rsqrtf(wave_sum(s) * (1.f / D) + 1e-6f);
            u32x2* o = (u32x2*)(H + (size_t)m * D) + lane; unsigned* o8 = (unsigned*)(ws + WS_H8 + (size_t)m * D) + lane; const float r4 = 4.f * rstd;
#pragma unroll
            for (int j = 0; j < 4; ++j) { u32x2 w; w.x = pk2(v[r][j][0] * rstd, v[r][j][1] * rstd); w.y = pk2(v[r][j][2] * rstd, v[r][j][3] * rstd); o[64 * j] = w;
                o8[64 * j] = pk4_fp8(v[r][j][0] * r4, v[r][j][1] * r4, v[r][j][2] * r4, v[r][j][3] * r4); } }
    }
}

DEVI void phase1(const Params& p, char* lds) {
    unsigned char* ws = p.ws;
    { g8::DenseOrder S; S.init(ws + WS_H, D, ws + WS_WIN, D, T, 4096); g8::Epi4<EpiZa> E{{ws}};
      g8::gemm_phase<g8::Epi4<EpiZa>, g8::DenseOrder, true>((G8_LAS unsigned char*)lds, D, D, D, S, E); }
    { g8::DenseOrder S; S.init(ws + WS_H8, D / 2, ws + WS_WIN8, D / 2, T, 2816); g8::Epi4<EpiZb> E{{ws}};
      g8::gemm_phase<g8::Epi4<EpiZb>, g8::DenseOrder, true, g8::NoHook, false, true>((G8_LAS unsigned char*)lds, D / 2, D / 2, D / 2, S, E, nullptr, g8::NoHook(), 1 << 30, 0, 125, 121); }
}

constexpr int HL_A = 0, HL_B = 17408, HL_BT = 34816, HL_VT = 53248, HL_AT = 71680, HL_ST = 80896, HL_SEG = 115712, HL_SS = 119808;
#define HG_BAR() do { asm volatile("s_waitcnt lgkmcnt(0)" ::: "memory"); __builtin_amdgcn_s_barrier(); asm volatile("" ::: "memory"); } while (0)
DEVI void hgrn_chain_mfma(const Params& p, char* lds, int b, int h) {
    const bf16_t* zh = (const bf16_t*)(p.ws + WS_ZH); bf16_t* oa = (bf16_t*)(p.ws + WS_OA);
    const float* hgonw = (const float*)ptab(p.ws, PT_HGONW);
    const int tid = threadIdx.x, lane = tid & 63, wid = __builtin_amdgcn_readfirstlane(tid >> 6), fr = lane & 15, g4 = lane >> 4;
    const int k2 = lane * 2, seg = wid;
    f32x4 S[8];
#pragma unroll
    for (int n = 0; n < 8; ++n) S[n] = (f32x4){0.f, 0.f, 0.f, 0.f};
    const bf16_t* zb = zh + (size_t)b * SEQ * ZH_P + h * 128;
    float* segs = (float*)(lds + HL_SEG); float* lss = (float*)(lds + HL_SS);
    unsigned rq[8], rf[8], rv[8];
#pragma unroll
    for (int i = 0; i < 8; ++i) { const bf16_t* r = zb + (size_t)(seg * 8 + i) * ZH_P + k2; rq[i] = *(const unsigned*)r; rf[i] = *(const unsigned*)(r + 1024); rv[i] = *(const unsigned*)(r + 2048); }
    const int tt = wid >> 1, vh = wid & 1;
    f32x4 nwv[4];
#pragma unroll
    for (int n = 0; n < 4; ++n) nwv[n] = *(const f32x4*)(hgonw + 16 * (4 * vh + n) + 4 * g4);
#if defined(TPROBE_A)
    unsigned long long tacc[6] = {0, 0, 0, 0, 0, 0}; unsigned long long tprev = __builtin_amdgcn_s_memrealtime();
#define HG_T(k) do { const unsigned long long now_ = __builtin_amdgcn_s_memrealtime(); tacc[k] += now_ - tprev; tprev = now_; } while (0)
#else
#define HG_T(k)
#endif
    for (int c = 0; c < SEQ / 64; ++c) {
        const int t0 = c * 64;
        u32x2 gpre[4];
        { const bf16_t* gp_ = zh + ((size_t)b * SEQ + t0 + 16 * tt + fr) * ZH_P + 3072 + h * 128;
#pragma unroll
          for (int n = 0; n < 4; ++n) gpre[n] = *(const u32x2*)(gp_ + 16 * (4 * vh + n) + 4 * g4); }
        float cs[8][2], qq[8][2], kk[8][2]; float run[2] = {0.f, 0.f};
#pragma unroll
        for (int i = 0; i < 8; ++i)
#pragma unroll
            for (int e = 0; e < 2; ++e) { const float lf = bf2f(e ? rf[i] >> 16 : rf[i] & 0xffffu); run[e] += lf; cs[i][e] = run[e]; kk[i][e] = 1.f - __expf(lf); qq[i][e] = bf2f(e ? rq[i] >> 16 : rq[i] & 0xffffu); }
        HG_BAR();
        HG_T(0);
        *(float2*)(segs + seg * 128 + k2) = make_float2(run[0], run[1]);
#pragma unroll
        for (int e = 0; e < 2; ++e) { u32x4 w;
            w.x = e ? (rv[0] >> 16) | (rv[1] & 0xffff0000u) : (rv[0] & 0xffffu) | (rv[1] << 16); w.y = e ? (rv[2] >> 16) | (rv[3] & 0xffff0000u) : (rv[2] & 0xffffu) | (rv[3] << 16);
            w.z = e ? (rv[4] >> 16) | (rv[5] & 0xffff0000u) : (rv[4] & 0xffffu) | (rv[5] << 16); w.w = e ? (rv[6] >> 16) | (rv[7] & 0xffff0000u) : (rv[6] & 0xffffu) | (rv[7] << 16);
            *(u32x4*)(lds + HL_VT + (k2 + e) * 144 + seg * 16) = w; }
        HG_BAR();
        HG_T(1);
        {
            float off[2] = {0.f, 0.f}, bm[2] = {0.f, 0.f};
#pragma unroll
            for (int s_ = 0; s_ < 8; ++s_) { const float2 v = *(const float2*)(segs + s_ * 128 + k2); if (s_ < seg) { off[0] += v.x; off[1] += v.y; } if (s_ < 4) { bm[0] += v.x; bm[1] += v.y; } }
            unsigned bt[2][4];
#pragma unroll
            for (int i = 0; i < 8; ++i) { float av[2], bv[2];
#pragma unroll
                for (int e = 0; e < 2; ++e) { const float ea = __expf(cs[i][e] + off[e] - bm[e]); av[e] = qq[i][e] * ea; bv[e] = kk[i][e] * __builtin_amdgcn_rcpf(ea); }
                *(unsigned*)(lds + HL_A + (seg * 8 + i) * 272 + k2 * 2) = pk2(av[0], av[1]);
                const unsigned pb = pk2(bv[0], bv[1]); *(unsigned*)(lds + HL_B + (seg * 8 + i) * 272 + k2 * 2) = pb;
                if (i & 1) { bt[0][i >> 1] |= pb << 16; bt[1][i >> 1] |= pb & 0xffff0000u; } else { bt[0][i >> 1] = pb & 0xffffu; bt[1][i >> 1] = pb >> 16; } }
#pragma unroll
            for (int e = 0; e < 2; ++e) { u32x4 w = {bt[e][0], bt[e][1], bt[e][2], bt[e][3]}; *(u32x4*)(lds + HL_BT + (k2 + e) * 144 + seg * 16) = w; }
        }
        f32x4 bmid = {0.f, 0.f, 0.f, 0.f}, blast = {0.f, 0.f, 0.f, 0.f};
#pragma unroll
        for (int s_ = 0; s_ < 8; ++s_) { const f32x4 v = *(const f32x4*)(segs + s_ * 128 + 16 * wid + 4 * g4); blast += v; if (s_ < 4) bmid += v; }
        {
            f32x4 em; em[0] = __expf(bmid[0]); em[1] = __expf(bmid[1]); em[2] = __expf(bmid[2]); em[3] = __expf(bmid[3]);
#pragma unroll
            for (int n = 0; n < 8; ++n) { u32x2 w; w.x = pk2(S[n][0] * em[0], S[n][1] * em[1]); w.y = pk2(S[n][2] * em[2], S[n][3] * em[3]); *(u32x2*)(lds + HL_ST + (16 * n + fr) * 272 + (16 * wid + 4 * g4) * 2) = w; }
        }
        if (c + 1 < SEQ / 64) {
#pragma unroll
            for (int i = 0; i < 8; ++i) { const bf16_t* r = zb + (size_t)(t0 + 64 + seg * 8 + i) * ZH_P + k2; rq[i] = *(const unsigned*)r; rf[i] = *(const unsigned*)(r + 1024); rv[i] = *(const unsigned*)(r + 2048); }
        }
        HG_BAR();
        HG_T(2);
#define HG_LD(off) (*(const bf16x8*)(lds + (off)))
#define HG_FENCE() do { asm volatile("s_waitcnt lgkmcnt(0)" ::: "memory"); __builtin_amdgcn_sched_barrier(0); } while (0)
        {
            bf16x8 fa[4], fb0[4], fb1[4]; const int ss0 = 2 * vh, ss1 = 2 * vh + 1;
#pragma unroll
            for (int kk4 = 0; kk4 < 4; ++kk4) { fa[kk4] = HG_LD(HL_A + (16 * tt + fr) * 272 + (32 * kk4 + 8 * g4) * 2); fb0[kk4] = HG_LD(HL_B + (16 * ss0 + fr) * 272 + (32 * kk4 + 8 * g4) * 2); fb1[kk4] = HG_LD(HL_B + (16 * ss1 + fr) * 272 + (32 * kk4 + 8 * g4) * 2); }
            HG_FENCE();
            f32x4 acc0 = {0.f, 0.f, 0.f, 0.f}, acc1 = {0.f, 0.f, 0.f, 0.f};
#pragma unroll
            for (int kk4 = 0; kk4 < 4; ++kk4) { acc0 = __builtin_amdgcn_mfma_f32_16x16x32_bf16(fb0[kk4], fa[kk4], acc0, 0, 0, 0); acc1 = __builtin_amdgcn_mfma_f32_16x16x32_bf16(fb1[kk4], fa[kk4], acc1, 0, 0, 0); }
#pragma unroll
            for (int i = 0; i < 4; ++i) { if (ss0 > tt || (ss0 == tt && 4 * g4 + i > fr)) acc0[i] = 0.f; if (ss1 > tt || (ss1 == tt && 4 * g4 + i > fr)) acc1[i] = 0.f; }
            u32x2 w; w.x = pk2(acc0[0], acc0[1]); w.y = pk2(acc0[2], acc0[3]); *(u32x2*)(lds + HL_AT + (16 * tt + fr) * 144 + (16 * ss0 + 4 * g4) * 2) = w;
            w.x = pk2(acc1[0], acc1[1]); w.y = pk2(acc1[2], acc1[3]); *(u32x2*)(lds + HL_AT + (16 * tt + fr) * 144 + (16 * ss1 + 4 * g4) * 2) = w;
        }
        HG_BAR();
        HG_T(3);
        f32x4 o[4];
#pragma unroll
        for (int n = 0; n < 4; ++n) o[n] = (f32x4){0.f, 0.f, 0.f, 0.f};
        {
            bf16x8 fat[2], fa[4];
#pragma unroll
            for (int ks = 0; ks < 2; ++ks) fat[ks] = HG_LD(HL_AT + (16 * tt + fr) * 144 + (32 * ks + 8 * g4) * 2);
#pragma unroll
            for (int kk4 = 0; kk4 < 4; ++kk4) fa[kk4] = HG_LD(HL_A + (16 * tt + fr) * 272 + (32 * kk4 + 8 * g4) * 2);
#pragma unroll
            for (int nh = 0; nh < 2; ++nh) {
                bf16x8 fv[2][2], fs[2][4];
#pragma unroll
                for (int n2 = 0; n2 < 2; ++n2) { const int vrow = 16 * (4 * vh + 2 * nh + n2) + fr;
#pragma unroll
                    for (int ks = 0; ks < 2; ++ks) fv[n2][ks] = HG_LD(HL_VT + vrow * 144 + (32 * ks + 8 * g4) * 2);
#pragma unroll
                    for (int kk4 = 0; kk4 < 4; ++kk4) fs[n2][kk4] = HG_LD(HL_ST + vrow * 272 + (32 * kk4 + 8 * g4) * 2); }
                HG_FENCE();
#pragma unroll
                for (int ks = 0; ks < 2; ++ks)
#pragma unroll
                    for (int n2 = 0; n2 < 2; ++n2) o[2 * nh + n2] = __builtin_amdgcn_mfma_f32_16x16x32_bf16(fv[n2][ks], fat[ks], o[2 * nh + n2], 0, 0, 0);
#pragma unroll
                for (int kk4 = 0; kk4 < 4; ++kk4)
#pragma unroll
                    for (int n2 = 0; n2 < 2; ++n2) o[2 * nh + n2] = __builtin_amdgcn_mfma_f32_16x16x32_bf16(fs[n2][kk4], fa[kk4], o[2 * nh + n2], 0, 0, 0);
            }
        }
        { float ssq = 0.f;
#pragma unroll
          for (int n = 0; n < 4; ++n) ssq += o[n][0] * o[n][0] + o[n][1] * o[n][1] + o[n][2] * o[n][2] + o[n][3] * o[n][3];
          ssq += __shfl_xor(ssq, 16); ssq += __shfl_xor(ssq, 32); if (g4 == 0) lss[vh * 64 + 16 * tt + fr] = ssq; }
        {
            f32x4 U[8]; bf16x8 fbt[2], fv[8][2];
#pragma unroll
            for (int ks = 0; ks < 2; ++ks) { fbt[ks] = HG_LD(HL_BT + (16 * wid + fr) * 144 + (32 * ks + 8 * g4) * 2);
#pragma unroll
                for (int n = 0; n < 8; ++n) fv[n][ks] = HG_LD(HL_VT + (16 * n + fr) * 144 + (32 * ks + 8 * g4) * 2); }
            HG_FENCE();
#pragma unroll
            for (int n = 0; n < 8; ++n) { U[n] = __builtin_amdgcn_mfma_f32_16x16x32_bf16(fbt[0], fv[n][0], (f32x4){0.f, 0.f, 0.f, 0.f}, 0, 0, 0); }
#pragma unroll
            for (int n = 0; n < 8; ++n) { U[n] = __builtin_amdgcn_mfma_f32_16x16x32_bf16(fbt[1], fv[n][1], U[n], 0, 0, 0); }
            f32x4 el, elm;
#pragma unroll
            for (int i = 0; i < 4; ++i) { el[i] = __expf(blast[i]); elm[i] = __expf(blast[i] - bmid[i]); }
#pragma unroll
            for (int n = 0; n < 8; ++n) S[n] = S[n] * el + U[n] * elm;
        }
#undef HG_LD
#undef HG_FENCE
        HG_BAR();
        HG_T(4);
        {
            const int t = 16 * tt + fr; const float rstd = rsqrtf((lss[t] + lss[64 + t]) * (1.f / 128.f) + 1e-6f);
            const size_t trow = (size_t)b * SEQ + t0 + t; bf16_t* op = oa + trow * 1024 + h * 128;
#pragma unroll
            for (int n = 0; n < 4; ++n) { const int v0 = 16 * (4 * vh + n) + 4 * g4; const u32x2 gg = gpre[n]; const f32x4 nw = nwv[n];
                f32x4 r; r[0] = o[n][0] * rstd * nw[0] * bf2f(gg.x & 0xffffu); r[1] = o[n][1] * rstd * nw[1] * bf2f(gg.x >> 16);
                r[2] = o[n][2] * rstd * nw[2] * bf2f(gg.y & 0xffffu); r[3] = o[n][3] * rstd * nw[3] * bf2f(gg.y >> 16); store4bf(op + v0, r); }
        }
        HG_T(5);
    }
#if defined(TPROBE_A)
    if (blockIdx.x == 0 && threadIdx.x == 0) { unsigned long long* ts = (unsigned long long*)(p.ws + WS_TS); for (int k = 0; k < 6; ++k) { ts[20 + 2 * k] = 0; ts[21 + 2 * k] = tacc[k]; } }
#endif
    HG_BAR();
}
#undef HG_BAR
DEVI void conv_tile256(const float* colp, size_t rs, const float* kscale, bf16_t* dst, int ldk, float* scr) {
    const int tid = threadIdx.x;
    { const int nl = tid & 63, kq = tid >> 6;
      float v[32];
#pragma unroll
      for (int i = 0; i < 32; ++i) v[i] = colp[(size_t)(kq * 32 + i) * rs];
      if (kscale) {
#pragma unroll
          for (int i = 0; i < 32; ++i) v[i] *= kscale[kq * 32 + i]; }
#pragma unroll
      for (int i = 0; i < 32; ++i) scr[(kq * 32 + i) * 65 + nl] = v[i]; }
    __syncthreads();
    { const int nl = tid >> 3, kc = tid & 7;
#pragma unroll
      for (int j = 0; j < 4; ++j) { const float* s_ = scr + (kc * 8 + 64 * j) * 65 + nl;
          u32x4 o; o.x = pk2(s_[0], s_[65]); o.y = pk2(s_[2 * 65], s_[3 * 65]); o.z = pk2(s_[4 * 65], s_[5 * 65]); o.w = pk2(s_[6 * 65], s_[7 * 65]);
          *(u32x4*)(dst + (size_t)nl * ldk + kc * 8 + 64 * j) = o; } }
    __syncthreads();
}
DEVI void conv_tile256_f8(const float* colp4, size_t rs, const float* kscale, float wscale, unsigned char* dst, int ldk, float* scr) {
    const int tid = threadIdx.x;
    { const int n4 = tid & 15, kr = tid >> 4; f32x4 v[8];
#pragma unroll
      for (int i = 0; i < 8; ++i) v[i] = *(const f32x4*)(colp4 + (size_t)(kr + 32 * i) * rs);
#pragma unroll
      for (int i = 0; i < 8; ++i) { const float sc = kscale ? kscale[kr + 32 * i] * wscale : wscale; float* d = scr + (kr + 32 * i) * 65 + 4 * n4; d[0] = v[i][0] * sc; d[1] = v[i][1] * sc; d[2] = v[i][2] * sc; d[3] = v[i][3] * sc; } }
    __syncthreads();
    { const int nl = tid >> 3, kc = tid & 7;
#pragma unroll
      for (int j = 0; j < 4; ++j) { const float* s_ = scr + (kc * 8 + 64 * j) * 65 + nl;
          u32x2 o; o.x = pk4_fp8(s_[0], s_[65], s_[2 * 65], s_[3 * 65]); o.y = pk4_fp8(s_[4 * 65], s_[5 * 65], s_[6 * 65], s_[7 * 65]);
          *(u32x2*)(dst + (size_t)nl * ldk + kc * 8 + 64 * j) = o; } }
    __syncthreads();
}
DEVI void mla_prep(const Params& p, int chunk) {
    bf16_t* zl = (bf16_t*)(p.ws + WS_ZL); float* cosT = (float*)(p.ws + WS_COS); float* sinT = (float*)(p.ws + WS_SIN); const int* posp = (const int*)ptab(p.ws, PT_POS);
    const int lane = threadIdx.x & 63, wid = threadIdx.x >> 6;
    for (int rr = wid; rr < 256; rr += 8) { const size_t t = (size_t)chunk * 256 + rr; bf16_t* zr = zl + t * ZL_P;
        float cq[6], ck[4]; float s = 0.f, s2 = 0.f;
#pragma unroll
        for (int j = 0; j < 6; ++j) { cq[j] = bf2f(zr[lane + 64 * j]); s += cq[j] * cq[j]; }
#pragma unroll
        for (int j = 0; j < 4; ++j) { ck[j] = bf2f(zr[384 + lane + 64 * j]); s2 += ck[j] * ck[j]; }
        const float kr = bf2f(zr[640 + lane]);
        const float r1 = rsqrtf(wave_sum(s) * (1.f / 384.f) + 1e-6f), r2 = rsqrtf(wave_sum(s2) * (1.f / 256.f) + 1e-6f);
        const float other = __shfl_xor(kr, 32);
        const int i = lane & 31; const float invf = powf(10000.f, -(float)i / 32.f); const float ang = (float)posp[t] * invf; const float cs = cosf(ang), sn = sinf(ang);
        const float x1 = lane < 32 ? kr : other, x2 = lane < 32 ? other : kr;
        const float outv = lane < 32 ? (x1 * cs - x2 * sn) : (x2 * cs + x1 * sn);
#pragma unroll
        for (int j = 0; j < 6; ++j) zr[lane + 64 * j] = (bf16_t)f2bf(cq[j] * r1);
#pragma unroll
        for (int j = 0; j < 4; ++j) zr[384 + lane + 64 * j] = (bf16_t)f2bf(ck[j] * r2);
        ((bf16_t*)(p.ws + WS_KPE))[t * 64 + 2 * i + (lane >> 5)] = (bf16_t)f2bf(outv);
        if (lane < 32) { cosT[t * 32 + i] = cs; sinT[t * 32 + i] = sn; }
    }
}
constexpr int N13_EARLY = 2432;
DEVI void w13_tile(unsigned char* ws, const float* ew1, const float* ew3, const float* ffnw, int ci, int nl, float* scr) {
    const int e = ci >> 6, r = ci & 63, nb = r >> 2, kb = r & 3, n = nb * 64 + 4 * (nl & 15);
    const float* colp = ((n & 4) ? ew3 : ew1) + (size_t)e * 1024 * 512 + (size_t)(kb * 256) * 512 + (n >> 3) * 4;
    conv_tile256_f8(colp, 512, ffnw + kb * 256, 64.f, ws + WS_W13 + ((size_t)e * 1024 + nb * 64) * 1024 + kb * 256, 1024, scr);
}
DEVI void phase2a(const Params& p, char* lds, bool prep = true) {
#pragma unroll 1
    for (int it = blockIdx.x; it < 128; it += gridDim.x) {
        hgrn_chain_mfma(p, lds, it >> 3, it & 7);
#if defined(TPROBE_A)
        if (TPROBE_A == 12 && blockIdx.x == 0 && threadIdx.x == 0) ((unsigned long long*)(p.ws + WS_TS))[13] = __builtin_amdgcn_s_memrealtime();
#endif
    }
#pragma unroll 1
    for (int it = blockIdx.x; it < 256; it += gridDim.x) { if (it < 128) continue;
        if (prep) mla_prep(p, it - 128);
        const float* ew1 = (const float*)ptab(p.ws, PT_EW1); const float* ew3 = (const float*)ptab(p.ws, PT_EW3); const float* ffnw = (const float*)ptab(p.ws, PT_FFNW); const int nl = threadIdx.x & 63;
        __syncthreads();
#pragma unroll 1
        for (int ci = it - 128; ci < N13_EARLY; ci += 128) w13_tile(p.ws, ew1, ew3, ffnw, ci, nl, (float*)lds);
    }
}

DEVI void phase2b(const Params& p, char* lds) {
    unsigned char* ws = p.ws;
    { g8::DenseOrder S; S.init(ws + WS_ZL, ZL_P, ws + WS_WUQ, 384, T, 1536);
      g8::Epi4<EpiQ> E{{(bf16_t*)(ws + WS_Q)}};
      g8::gemm_phase<g8::Epi4<EpiQ>, g8::DenseOrder, true>((G8_LAS unsigned char*)lds, ZL_P, 384, 384, S, E); }
    { g8::DenseOrder S; S.init(ws + WS_ZL + 384 * 2, ZL_P, ws + WS_WUKV, 256, T, 2048);
      g8::Epi4<EpiKV> E{{(bf16_t*)(ws + WS_KN), (bf16_t*)(ws + WS_V)}};
      g8::gemm_phase<g8::Epi4<EpiKV>, g8::DenseOrder, true>((G8_LAS unsigned char*)lds, ZL_P, 256, 256, S, E); }
}

namespace at2 {
typedef short s16x4 __attribute__((ext_vector_type(4)));
typedef float f32x16 __attribute__((ext_vector_type(16)));
constexpr int KROW = 384;
constexpr int SHM_K = 64 * KROW, SHM_V = 64 * 256;
constexpr int L_V = 0, L_K = 2 * SHM_V, L_WS = 2 * SHM_V + 2 * SHM_K;
constexpr float THR = 8.f;
#define AT_KSWZ(row, colB) ((row) * at2::KROW + ((colB) ^ (((row) & 7) << 4)))
DEVI int v_st(int k, int c) { const int kk = (k & ~0xC) | ((k & 4) << 1) | ((k & 8) >> 1); return ((kk >> 3) * 4 + (c >> 5)) * 512 + ((kk & 7) * 32 + (c & 31)) * 2; }
DEVI int v_rd_base(int lane) { return ((lane & 3) << 3) | (((lane >> 2) & 3) << 6) | (((lane >> 4) & 1) << 5) | (((lane >> 5) & 1) << 8); }
constexpr int v_rd_off(int d0, int ks, int half) { return d0 * 512 + ks * 4096 + half * 2048; }
DEVI int crow(int r, int hi) { return (r & 3) + 8 * (r >> 2) + 4 * hi; }
DEVI unsigned cvtpk(float lo, float hi) { unsigned r; asm volatile("v_cvt_pk_bf16_f32 %0, %1, %2" : "=v"(r) : "v"(lo), "v"(hi)); return r; }
DEVI void mask_tile(f32x16& p0, f32x16& p1, int dq) {
    const float NEG = -__builtin_inff();
#pragma unroll
    for (int r = 0; r < 16; ++r) { const int c = (r & 3) + 8 * (r >> 2); if (dq - c < 0) p0[r] = NEG; if (dq - c - 32 < 0) p1[r] = NEG; }
}
DEVI void partialSM(f32x16& p0, f32x16& p1, float& m_reg, float& mn, float& alpha) {
    float pmax = p0[0];
#pragma unroll
    for (int r = 1; r < 16; ++r) pmax = fmaxf(pmax, p0[r]);
#pragma unroll
    for (int r = 0; r < 16; ++r) pmax = fmaxf(pmax, p1[r]);
    { auto rr = __builtin_amdgcn_permlane32_swap(__float_as_uint(pmax), __float_as_uint(pmax), false, false); pmax = fmaxf(__uint_as_float(rr[0]), __uint_as_float(rr[1])); }
    constexpr float C2 = 1.4426950408889634f;
    if (__builtin_expect(__all((pmax - m_reg) <= THR), 1)) { mn = m_reg; alpha = 1.f; }
    else { mn = fmaxf(m_reg, pmax); alpha = __builtin_amdgcn_exp2f((m_reg - mn) * C2); m_reg = mn; }
    const float mnL = -mn * C2;
#pragma unroll
    for (int r = 0; r < 16; ++r) p0[r] = fmaf(p0[r], C2, mnL);
#pragma unroll
    for (int r = 0; r < 16; ++r) p1[r] = fmaf(p1[r], C2, mnL);
#pragma unroll
    for (int r = 0; r < 16; ++r) p0[r] = __builtin_amdgcn_exp2f(p0[r]);
}
DEVI void finishSM(f32x16& p0, f32x16& p1, float alpha, float& l_reg, bf16x8& pa0, bf16x8& pa1, bf16x8& pa2, bf16x8& pa3) {
#pragma unroll
    for (int r = 0; r < 16; ++r) p1[r] = __builtin_amdgcn_exp2f(p1[r]);
    float ps = 0;
#pragma unroll
    for (int r = 0; r < 16; ++r) ps += p0[r];
#pragma unroll
    for (int r = 0; r < 16; ++r) ps += p1[r];
    { auto rr = __builtin_amdgcn_permlane32_swap(__float_as_uint(ps), __float_as_uint(ps), false, false); ps = __uint_as_float(rr[0]) + __uint_as_float(rr[1]); }
    l_reg = l_reg * alpha + ps;
#define AT_PK4(P, B_, OUT) do { unsigned a0 = cvtpk(P[B_+0], P[B_+1]), a1 = cvtpk(P[B_+2], P[B_+3]); unsigned b0 = cvtpk(P[B_+4], P[B_+5]), b1 = cvtpk(P[B_+6], P[B_+7]); \
        auto r0 = __builtin_amdgcn_permlane32_swap(a0, b0, false, false); auto r1 = __builtin_amdgcn_permlane32_swap(a1, b1, false, false); \
        u32x4 w = {r0[0], r1[0], r0[1], r1[1]}; OUT = *reinterpret_cast<bf16x8*>(&w); } while (0)
    AT_PK4(p0, 0, pa0); AT_PK4(p0, 8, pa1); AT_PK4(p1, 0, pa2); AT_PK4(p1, 8, pa3);
#undef AT_PK4
}
template <int KB>
DEVI void qkt(f32x16& p0, f32x16& p1, const char* K_lds, int r32, int hi, const bf16x8* qr) {
    p0 = f32x16{}; p1 = f32x16{};
    const char* kb[4];
#pragma unroll
    for (int dd = 0; dd < 4; ++dd) kb[dd] = K_lds + KB * SHM_K + AT_KSWZ(r32, (dd * 16 + hi * 8) * 2);
#pragma unroll
    for (int d0 = 0; d0 < 12; ++d0) { const char* a = kb[d0 & 3] + (d0 >> 2) * 128;
        const bf16x8 b0 = *reinterpret_cast<const bf16x8*>(a); const bf16x8 b1 = *reinterpret_cast<const bf16x8*>(a + 32 * KROW);
        p0 = __builtin_amdgcn_mfma_f32_32x32x16_bf16(b0, qr[d0], p0, 0, 0, 0); p1 = __builtin_amdgcn_mfma_f32_32x32x16_bf16(b1, qr[d0], p1, 0, 0, 0); }
}
template <int VB>
DEVI void pv_tile(f32x16* o, int vb0, bf16x8 pa0, bf16x8 pa1, bf16x8 pa2, bf16x8 pa3) {
#define AT_TRRD(dst, off) asm volatile("ds_read_b64_tr_b16 %0, %1 offset:%2" : "=&v"(dst) : "v"(vb0), "i"(off) : "memory")
#define AT_PV_D0(d0) do { s16x4 l0, l1, l2, l3, h0, h1, h2, h3; constexpr int b_ = VB * SHM_V + v_rd_off(d0, 0, 0); \
        AT_TRRD(l0, b_); AT_TRRD(h0, b_ + 2048); AT_TRRD(l1, b_ + 4096); AT_TRRD(h1, b_ + 6144); AT_TRRD(l2, b_ + 8192); AT_TRRD(h2, b_ + 10240); AT_TRRD(l3, b_ + 12288); AT_TRRD(h3, b_ + 14336); \
        asm volatile("s_waitcnt lgkmcnt(0)" ::: "memory"); __builtin_amdgcn_sched_barrier(0); \
        o[d0] = __builtin_amdgcn_mfma_f32_32x32x16_bf16(pa0, (bf16x8){l0[0], l0[1], l0[2], l0[3], h0[0], h0[1], h0[2], h0[3]}, o[d0], 0, 0, 0); \
        o[d0] = __builtin_amdgcn_mfma_f32_32x32x16_bf16(pa1, (bf16x8){l1[0], l1[1], l1[2], l1[3], h1[0], h1[1], h1[2], h1[3]}, o[d0], 0, 0, 0); \
        o[d0] = __builtin_amdgcn_mfma_f32_32x32x16_bf16(pa2, (bf16x8){l2[0], l2[1], l2[2], l2[3], h2[0], h2[1], h2[2], h2[3]}, o[d0], 0, 0, 0); \
        o[d0] = __builtin_amdgcn_mfma_f32_32x32x16_bf16(pa3, (bf16x8){l3[0], l3[1], l3[2], l3[3], h3[0], h3[1], h3[2], h3[3]}, o[d0], 0, 0, 0); } while (0)
    AT_PV_D0(0); AT_PV_D0(1); AT_PV_D0(2); AT_PV_D0(3);
#undef AT_PV_D0
#undef AT_TRRD
}
DEVI void block(const Params& p, char* lds, int b, int h, int qb) {
    const bf16_t* q = (const bf16_t*)(p.ws + WS_Q); const bf16_t* kn = (const bf16_t*)(p.ws + WS_KN); const bf16_t* vg = (const bf16_t*)(p.ws + WS_V);
    const bf16_t* kpe = (const bf16_t*)(p.ws + WS_KPE); bf16_t* ob = (bf16_t*)(p.ws + WS_OB);
    const int tid = threadIdx.x, wid = __builtin_amdgcn_readfirstlane(tid >> 6), lane = tid & 63, r32 = lane & 31, hi = lane >> 5;
    const size_t tb = (size_t)b * SEQ; const int P0 = qb * 256, NT = (P0 + 256) / 64;
    char* V_lds = lds + L_V; char* K_lds = lds + L_K; float* ws = (float*)(lds + L_WS) + wid * 64; float* li_l = ws; float* al_l = ws + 32;
    const int qlo = P0 + wid * 32, qm = qlo + r32 - 4 * hi;
    const int sr = tid >> 4, sc = (tid & 15) * 8, vst0 = v_st(sr, sc), vst1 = v_st(32 + sr, sc);
    const int kd0 = AT_KSWZ(sr, sc * 2), kd2 = AT_KSWZ(tid >> 3, 256 + (tid & 7) * 16);
    const bf16_t* knp = kn + (tb + sr) * 1024 + h * 128 + sc; const bf16_t* vp = vg + (tb + sr) * 1024 + h * 128 + sc; const bf16_t* kpp = kpe + (tb + (tid >> 3)) * 64 + (tid & 7) * 8;
    const int vb0 = (int)(uintptr_t)V_lds + v_rd_base(lane);
    bf16x8 stk[3], stv[2];
#define AT_LOAD(t_) do { const size_t o_ = (size_t)(t_) * 64; stk[0] = *(const bf16x8*)(knp + o_ * 1024); stk[1] = *(const bf16x8*)(knp + (o_ + 32) * 1024); stk[2] = *(const bf16x8*)(kpp + o_ * 64); \
        stv[0] = *(const bf16x8*)(vp + o_ * 1024); stv[1] = *(const bf16x8*)(vp + (o_ + 32) * 1024); } while (0)
#define AT_WRITE(bf) do { *(bf16x8*)(K_lds + (bf) * SHM_K + kd0) = stk[0]; *(bf16x8*)(K_lds + (bf) * SHM_K + kd0 + 32 * KROW) = stk[1]; *(bf16x8*)(K_lds + (bf) * SHM_K + kd2) = stk[2]; \
        *(bf16x8*)(V_lds + (bf) * SHM_V + vst0) = stv[0]; *(bf16x8*)(V_lds + (bf) * SHM_V + vst1) = stv[1]; } while (0)
    AT_LOAD(0);
    bf16x8 qr[12];
    { const bf16_t* qrow = q + (tb + qlo + r32) * 1536 + h * 192;
#pragma unroll
      for (int d0 = 0; d0 < 12; ++d0) qr[d0] = *(const bf16x8*)(qrow + d0 * 16 + hi * 8);
      int r32o = r32; asm volatile("" : "+v"(r32o));
      const float* cosT = (const float*)(p.ws + WS_COS) + (tb + qlo + r32o) * 32; const float* sinT = cosT + (WS_SIN - WS_COS) / 4;
#pragma unroll
      for (int d0 = 8; d0 < 12; ++d0) { const f32x4 cs = *(const f32x4*)(cosT + 8 * (d0 - 8) + 4 * hi), sn = *(const f32x4*)(sinT + 8 * (d0 - 8) + 4 * hi); u32x4 w = __builtin_bit_cast(u32x4, qr[d0]);
#pragma unroll
          for (int jj = 0; jj < 4; ++jj) { const float x1 = bf2f(w[jj] & 0xffffu), x2 = bf2f(w[jj] >> 16); w[jj] = pk2(x1 * cs[jj] - x2 * sn[jj], x2 * cs[jj] + x1 * sn[jj]); }
          qr[d0] = __builtin_bit_cast(bf16x8, w); asm volatile("" ::: "memory"); } }
    float m_reg = -1e30f, l_reg = 0.f; f32x16 o[4] = {};
    __syncthreads();
    AT_WRITE(0);
    __syncthreads();
#define AT_RESC(a) do { if (__any((a) < 1.f)) { if (hi == 0) al_l[r32] = (a); asm volatile("s_waitcnt lgkmcnt(0)" ::: "memory"); \
        _Pragma("unroll") for (int d_ = 0; d_ < 4; ++d_) _Pragma("unroll") for (int r = 0; r < 16; ++r) o[d_][r] *= al_l[crow(r, hi)]; } } while (0)
#define AT_STEP(t_, BF) do { const int tq = (t_); if (tq + 1 < NT) AT_LOAD(tq + 1); \
        { \
        f32x16 p0, p1; float mn, al; bf16x8 pa0, pa1, pa2, pa3; \
        qkt<BF>(p0, p1, K_lds, r32, hi, qr); \
        { const int kb_ = tq * 64; if (kb_ + 63 > qlo) mask_tile(p0, p1, qm - kb_); } \
        partialSM(p0, p1, m_reg, mn, al); finishSM(p0, p1, al, l_reg, pa0, pa1, pa2, pa3); AT_RESC(al); \
        pv_tile<BF>(o, vb0, pa0, pa1, pa2, pa3); } \
        if (tq + 1 < NT) AT_WRITE(1 - BF); \
        __syncthreads(); } while (0)
#pragma unroll 1
    for (int t = 0; t < NT; t += 2) { AT_STEP(t, 0); AT_STEP(t + 1, 1); }
    if (hi == 0) li_l[r32] = l_reg;
    asm volatile("s_waitcnt lgkmcnt(0)" ::: "memory");
    float rli[16];
#pragma unroll
    for (int r = 0; r < 16; ++r) rli[r] = __builtin_amdgcn_rcpf(li_l[crow(r, hi)]);
    bf16_t* Ow = ob + (tb + qlo) * 1024 + h * 128;
#pragma unroll
    for (int r = 0; r < 16; ++r) { const int orow = crow(r, hi);
#pragma unroll
        for (int d0 = 0; d0 < 4; ++d0) { const float v = o[d0][r] * rli[r]; const float vn = __shfl_xor(v, 1);
            if ((r32 & 1) == 0) *(unsigned*)(Ow + (size_t)orow * 1024 + d0 * 32 + r32) = cvtpk(v, vn); } }
#undef AT_LOAD
#undef AT_WRITE
#undef AT_RESC
#undef AT_STEP
}
}
DEVI void phase3(const Params& p, char* lds) {
    const int G_ = (int)gridDim.x, vcu = (G_ % 8 == 0) ? ((int)blockIdx.x % 8) * (G_ / 8) + (int)blockIdx.x / 8 : (int)blockIdx.x;
#pragma unroll 1
    for (int it2 = vcu * 2; it2 < 1024; it2 += (it2 & 1) ? 2 * G_ - 1 : 1) { const int it = it2 >> 1, bh = it >> 2, x = it & 3;
        at2::block(p, lds, bh >> 3, bh & 7, (it2 & 1) ? x : 7 - x); }
    __syncthreads();
}

DEVI void phase4(const Params& p, char* lds) {
    unsigned char* ws = p.ws; const unsigned char* zg = ws + WS_ZG;
    g8::DenseOrder S; S.init(ws + WS_OA, 1024, ws + WS_WBR, 2048, T, 1024);
    g8::Epi4<EpiBr2> E{{zg, (bf16_t*)(ws + WS_Y)}}; g8::Hook4<BrHookF> H{{zg}};
    g8::gemm_phase<g8::Epi4<EpiBr2>, g8::DenseOrder, true, g8::Hook4<BrHookF>>((G8_LAS unsigned char*)lds, 1024, 2048, 2048, S, E, nullptr, H, 16, (long)WS_OB - (long)WS_OA - 16 * 128);
}
DEVI void phase5(const Params& p, char* lds) {
    unsigned char* ws = p.ws;
    g8::DenseOrder S; S.init(ws + WS_Y, 1024, ws + WS_WOUT, 1024, T, 1024);
    g8::Epi4<EpiOut> E{{(const float*)ptab(ws, PT_X), (bf16_t*)(ws + WS_X2B), ws + WS_X2F8}};
#if defined(TPROBE_A) && defined(TPROBE_GEMM) && TPROBE_GEMM == 6
    g8::gemm_phase<g8::Epi4<EpiOut>, g8::DenseOrder, true>((G8_LAS unsigned char*)lds, 1024, 1024, 1024, S, E, (unsigned long long*)(ws + WS_TS) + 20);
#else
    g8::gemm_phase<g8::Epi4<EpiOut>, g8::DenseOrder, true>((G8_LAS unsigned char*)lds, 1024, 1024, 1024, S, E);
#endif
}

constexpr size_t RT_SRS = RT_ST, RT_RS = 1888 * 1024;
DEVI void phase6a(const Params& p, char* lds, bool router = true) {
    unsigned char* ws = p.ws; float* scr = (float*)lds;
    const float* ew1 = (const float*)ptab(ws, PT_EW1); const float* ew3 = (const float*)ptab(ws, PT_EW3); const float* ew2 = (const float*)ptab(ws, PT_EW2); const float* ffnw = (const float*)ptab(ws, PT_FFNW);
    const float* rgb = (const float*)ptab(ws, PT_RGB); const float* reb = (const float*)ptab(ws, PT_REB);
    unsigned char* W2 = ws + WS_W2;
    for (int ci = N13_EARLY + blockIdx.x; ci < NEXP * 64; ci += gridDim.x) w13_tile(ws, ew1, ew3, ffnw, ci, threadIdx.x & 63, scr);
    constexpr int I2 = 2 * 16;
    for (int it = blockIdx.x; it < NEXP * I2; it += gridDim.x) { const int e = it / I2, r = it % I2, nb = r >> 1, kb = r & 1, nl = threadIdx.x & 63;
        conv_tile256_f8(ew2 + (size_t)e * 512 * 1024 + (size_t)(kb * 256) * 1024 + nb * 64 + 4 * (nl & 15), 1024, nullptr, 64.f, W2 + ((size_t)e * 1024 + nb * 64) * EFF + kb * 256, EFF, scr); }
    __syncthreads();
#if defined(TPROBE_A)
    if (TPROBE_A == 17 && blockIdx.x == 0 && threadIdx.x == 0) ((unsigned long long*)(p.ws + WS_TS))[13] = __builtin_amdgcn_s_memrealtime();
#endif
    if (!router) return;
    const bf16_t* WrH = (const bf16_t*)(ws + WS_WRT); const bf16_t* WrL = WrH + 80 * 1024; const bf16_t* X2B = (const bf16_t*)(ws + WS_X2B);
    int* AE = (int*)(ws + WS_ROUTE + RT_AE); int* AP = (int*)(ws + WS_ROUTE + RT_AP); float* AW = (float*)(ws + WS_ROUTE + RT_AW); float* RS = (float*)(ws + WS_ROUTE + RT_RS);
    unsigned* cnt = (unsigned*)(ws + WS_CTL) + CW_CNT;
    const int tid = threadIdx.x, lane = tid & 63, wid = tid >> 6, fr = lane & 15, g4 = lane >> 4;
    constexpr int WL_ROW = 528, WL_ARR = 80 * WL_ROW, WL_BYTES = 2 * WL_ARR;
    float* lgw = (float*)(lds + WL_BYTES) + wid * (16 * 84 + 16);
    for (int g0 = blockIdx.x * 8; g0 < T / 16; g0 += gridDim.x * 8) {
        const int grp = g0 + wid;
        const size_t t0 = (size_t)grp * 16; const bf16_t* xrow = X2B + (t0 + fr) * 1024 + 8 * g4;
        f32x4 acc[5]; float ssq = 0.f;
#pragma unroll
        for (int n = 0; n < 5; ++n) acc[n] = (f32x4){0.f, 0.f, 0.f, 0.f};
#pragma unroll 1
        for (int kq = 0; kq < 4; ++kq) {
            bf16x8 xa[8];
#pragma unroll
            for (int kk = 0; kk < 8; ++kk) xa[kk] = *(const bf16x8*)(xrow + kq * 256 + 32 * kk);
            __syncthreads();
#pragma unroll
            for (int j = 0; j < 5; ++j) { const int row = (tid >> 5) + 16 * j, ch = tid & 31; const size_t so = (size_t)row * 1024 + kq * 256 + ch * 8; const int dof = row * WL_ROW + ch * 16;
                *(u32x4*)(lds + dof) = *(const u32x4*)(WrH + so); *(u32x4*)(lds + WL_ARR + dof) = *(const u32x4*)(WrL + so); }
            __syncthreads();
#pragma unroll
            for (int kk = 0; kk < 8; ++kk) {
                const bf16x8 ah = xa[kk];
#pragma unroll
                for (int j = 0; j < 8; ++j) { const float xv = bf2f((unsigned)(unsigned short)ah[j]); ssq += xv * xv; }
#pragma unroll
                for (int n = 0; n < 5; ++n) { const bf16x8 bh = *(const bf16x8*)(lds + (16 * n + fr) * WL_ROW + (32 * kk + 8 * g4) * 2), bl = *(const bf16x8*)(lds + WL_ARR + (16 * n + fr) * WL_ROW + (32 * kk + 8 * g4) * 2);
                    acc[n] = __builtin_amdgcn_mfma_f32_16x16x32_bf16(ah, bh, acc[n], 0, 0, 0); acc[n] = __builtin_amdgcn_mfma_f32_16x16x32_bf16(ah, bl, acc[n], 0, 0, 0); }
            }
        }
        ssq += __shfl_xor(ssq, 16); ssq += __shfl_xor(ssq, 32);
        const float rstd = rsqrtf(ssq * (1.f / D) + 1e-6f);
        if (g4 == 0) lgw[16 * 84 + fr] = rstd;
#pragma unroll
        for (int n = 0; n < 5; ++n)
#pragma unroll
            for (int i = 0; i < 4; ++i) lgw[(4 * g4 + i) * 84 + 16 * n + fr] = acc[n][i];
        asm volatile("s_waitcnt lgkmcnt(0)" ::: "memory");
        int ea = 0, eb = 0;
        if (lane < 16) { const float* lg = lgw + lane * 84; const float rs = lgw[16 * 84 + lane]; const size_t t = t0 + lane;
            int g = 0; float glv[8]; glv[0] = lg[0] * rs + rgb[0]; float gbest = glv[0];
#pragma unroll
            for (int j = 1; j < 8; ++j) { glv[j] = lg[j] * rs + rgb[j]; if (glv[j] > gbest) { gbest = glv[j]; g = j; } }
            float gs = 0.f;
#pragma unroll
            for (int j = 0; j < 8; ++j) gs += expf(glv[j] - gbest);
            const float gwt = 1.f / gs;
            int e1 = 0, e2 = 0; float b1 = -__builtin_inff(), b2 = -__builtin_inff();
            for (int j = 0; j < 8; ++j) { const float v = lg[8 + g * 8 + j] * rs + reb[g * 8 + j];
                if (v > b1) { b2 = b1; e2 = e1; b1 = v; e1 = j; } else if (v > b2) { b2 = v; e2 = j; } }
            const float d = expf(b2 - b1); const float w1 = 1.f / (1.f + d), w2 = d / (1.f + d);
            ea = g * 8 + e1; eb = g * 8 + e2;
            AE[2 * t] = ea; AE[2 * t + 1] = eb; AW[2 * t] = gwt * w1; AW[2 * t + 1] = gwt * w2; RS[t] = rs;
        }
        int* lcnt = (int*)(lds + WL_BYTES + 8 * (16 * 84 + 16) * 4); int* lbase = lcnt + 64;
        __syncthreads();
        if (tid < 64) lcnt[tid] = 0;
        __syncthreads();
        int ra = 0, rb = 0;
        if (lane < 16) { ra = atomicAdd(lcnt + ea, 1); rb = atomicAdd(lcnt + eb, 1); }
        __syncthreads();
        if (tid < 64) { const int c = lcnt[tid]; lbase[tid] = c ? (int)atomicAdd(cnt + tid * CNT_STRIDE, (unsigned)c) : 0; }
        __syncthreads();
        if (lane < 16) { const size_t t = t0 + lane; AP[2 * t] = lbase[ea] + ra; AP[2 * t + 1] = lbase[eb] + rb; }
    }
}
DEVI int build_prefix(const Params& p, int* li) {
    const unsigned* cnt = (const unsigned*)(p.ws + WS_CTL) + CW_CNT;
    __syncthreads();
    if (threadIdx.x < NEXP) li[400 + threadIdx.x] = (int)cnt[threadIdx.x * CNT_STRIDE];
    __syncthreads();
    if (threadIdx.x == 0) { int acc = 0; for (int e = 0; e < NEXP; ++e) { li[e] = acc; const int c = li[400 + e]; const int pd = (c + 255) & ~255; for (int tt = acc / 256; tt < (acc + pd) / 256; ++tt) li[80 + tt] = e; acc += pd; } li[64] = acc; }
    __syncthreads();
    return li[64] / 256;
}
DEVI void phase6b(const Params& p, char* lds) {
    unsigned char* ws = p.ws; int* li = (int*)lds; build_prefix(p, li);
    const int* AE = (const int*)(ws + WS_ROUTE + RT_AE); const int* AP = (const int*)(ws + WS_ROUTE + RT_AP); const float* AW = (const float*)(ws + WS_ROUTE + RT_AW);
    int* AS = (int*)(ws + WS_ROUTE + RT_AS); float* SW = (float*)(ws + WS_ROUTE + RT_SW); float* SRS = (float*)(ws + WS_ROUTE + RT_SRS); const float* RS = (const float*)(ws + WS_ROUTE + RT_RS);
    int* TOK = (int*)(ws + WS_TOK);
    for (int a = blockIdx.x * NTHR + threadIdx.x; a < 2 * T; a += gridDim.x * NTHR) { const int slot = li[AE[a]] + AP[a]; AS[a] = slot; SW[slot] = AW[a]; SRS[slot] = RS[a >> 1]; TOK[slot] = a >> 1; }
    for (int e = blockIdx.x; e < NEXP; e += gridDim.x) { const int c = li[400 + e], pd = (c + 255) & ~255;
        for (int s_ = c + threadIdx.x; s_ < pd; s_ += NTHR) { const int slot = li[e] + s_; SW[slot] = 0.f; SRS[slot] = 0.f; TOK[slot] = 0; } }
}
struct MoeOrder { const char* A; const char* W; size_t a_tile, w_exp, w_pn; const int* tile_e; int nunits; const int* tok;
    DEVI bool next(int i, g8::Unit& u) const { const int G = (int)gridDim.x, bx = (int)blockIdx.x; const int L = (G % 8 == 0) ? (i * 8 + (bx & 7)) * (G >> 3) + (bx >> 3) : i * G + bx;
        if (L >= nunits) return false; const int tile = L >> 2, pn = L & 3, e = tile_e[tile];
        u.pm = tile; u.pn = pn; u.a = A + (size_t)tile * a_tile; u.b = W + (size_t)e * w_exp + (size_t)pn * w_pn; u.tok = tok ? tok + tile * 256 : nullptr; return true; } };
constexpr int LDS_LI = 132096;
DEVI void phase7a(const Params& p, char* lds) {
    unsigned char* ws = p.ws; int* li = (int*)(lds + LDS_LI); const int ntile = build_prefix(p, li);
    MoeOrder S{(const char*)(ws + WS_X2F8), (const char*)(ws + WS_W13), (size_t)0, (size_t)1024 * 1024, (size_t)256 * 1024, li + 80, ntile * 4, (const int*)(ws + WS_TOK)};
    EpiHid8 E{ws + WS_HID, (const float*)(ws + WS_ROUTE + RT_SRS)};
    g8::gemm_phase<EpiHid8, MoeOrder, true, g8::NoHook, true, true>((G8_LAS unsigned char*)lds, 512, 512, 512, S, E, nullptr, g8::NoHook(), 1 << 30, 0, 125, 121);
}
DEVI void phase7b(const Params& p, char* lds) {
    unsigned char* ws = p.ws; int* li = (int*)(lds + LDS_LI); const int ntile = build_prefix(p, li);
    MoeOrder S{(const char*)(ws + WS_HID), (const char*)(ws + WS_W2), (size_t)256 * EFF, (size_t)1024 * EFF, (size_t)256 * EFF, li + 80, ntile * 4, nullptr};
    g8::Epi4<EpiY> E{{(bf16_t*)(ws + WS_YEXP), (const float*)(ws + WS_ROUTE + RT_SW)}};
    g8::gemm_phase<g8::Epi4<EpiY>, MoeOrder, true, g8::NoHook, false, true>((G8_LAS unsigned char*)lds, EFF / 2, EFF / 2, EFF / 2, S, E, nullptr, g8::NoHook(), 1 << 30, 0, 124, 121);
}
DEVI void phase8(const Params& p) {
    unsigned char* ws = p.ws; const int* AS = (const int*)(ws + WS_ROUTE + RT_AS); const bf16_t* yexp = (const bf16_t*)(ws + WS_YEXP); const bf16_t* x2b = (const bf16_t*)(ws + WS_X2B); const f32x4* finw = (const f32x4*)ptab(ws, PT_FINW);
    const int lane = threadIdx.x & 63, gw = blockIdx.x * 8 + (threadIdx.x >> 6), NGW = gridDim.x * 8;
    f32x4 fw[4];
#pragma unroll
    for (int j = 0; j < 4; ++j) fw[j] = finw[lane + 64 * j];
    constexpr int RPI = 4;
    int4 sl[2]; sl[0] = *(const int4*)(AS + 2 * (size_t)gw * RPI); sl[1] = *(const int4*)(AS + 2 * (size_t)gw * RPI + 4);
    for (int t0 = gw * RPI; t0 < T; t0 += NGW * RPI) {
        u32x2 xv[RPI][4], ya[RPI][4], yb[RPI][4];
#pragma unroll
        for (int r = 0; r < RPI; ++r) { const u32x2* xr = (const u32x2*)(x2b + (size_t)(t0 + r) * D) + lane; const int4 q = sl[r >> 1]; const int s0 = (r & 1) ? q.z : q.x, s1 = (r & 1) ? q.w : q.y;
            const u32x2* y0 = (const u32x2*)(yexp + (size_t)s0 * 1024) + lane; const u32x2* y1 = (const u32x2*)(yexp + (size_t)s1 * 1024) + lane;
#pragma unroll
            for (int j = 0; j < 4; ++j) { xv[r][j] = xr[64 * j]; ya[r][j] = y0[64 * j]; yb[r][j] = y1[64 * j]; } }
        if (t0 + NGW * RPI < T) { sl[0] = *(const int4*)(AS + 2 * (size_t)(t0 + NGW * RPI)); sl[1] = *(const int4*)(AS + 2 * (size_t)(t0 + NGW * RPI) + 4); }
#pragma unroll
        for (int r = 0; r < RPI; ++r) { const int t = t0 + r; float s = 0.f; f32x4 v[4];
#pragma unroll
            for (int j = 0; j < 4; ++j) { const u32x2 xw = xv[r][j], a = ya[r][j], b = yb[r][j];
                v[j][0] = (bf2f(xw.x & 0xffffu) + bf2f(a.x & 0xffffu)) + bf2f(b.x & 0xffffu); v[j][1] = (bf2f(xw.x >> 16) + bf2f(a.x >> 16)) + bf2f(b.x >> 16);
                v[j][2] = (bf2f(xw.y & 0xffffu) + bf2f(a.y & 0xffffu)) + bf2f(b.y & 0xffffu); v[j][3] = (bf2f(xw.y >> 16) + bf2f(a.y >> 16)) + bf2f(b.y >> 16);
                s += v[j][0] * v[j][0] + v[j][1] * v[j][1] + v[j][2] * v[j][2] + v[j][3] * v[j][3]; }
            const float rstd = rsqrtf(wave_sum(s) * (1.f / D) + 1e-6f);
            f32x4* xo = (f32x4*)(p.out + (size_t)t * D) + lane;
#pragma unroll
            for (int j = 0; j < 4; ++j) { f32x4 ov = v[j] * rstd * fw[j];
#if defined(TPROBE_A)
                { const unsigned long long* ts = (const unsigned long long*)(ws + WS_TS);
                  if (t < 16) { const float ta = (float)((((TPROBE_A >= 20 ? ts[TPROBE_A + 1] - ts[TPROBE_A] : TPROBE_A >= 12 ? ts[13] - ts[TPROBE_A - 10] : ts[TPROBE_A + 1] - ts[TPROBE_A])) / 800ull) * 8ull); const float dl = 0.045254834f * sqrtf(ta); ov[0] += dl; ov[1] += dl; ov[2] += dl; ov[3] += dl; }
                  if (t == 16 && lane == 0 && j == 0) { const float tb = (float)(((ts[TPROBE_B + 1] - ts[TPROBE_B]) / 800ull) * 8ull); ov[0] += 2.f + tb * (1.f / 200.f); } }
#endif
                xo[64 * j] = ov; }
        }
    }
}

#define XB_LAS __attribute__((address_space(3)))
constexpr int CW_BAR = 12288;
constexpr int LDS_XB = 147200;
#define XB_TMO      128
#define XB_XCNT(j)  (256  + 64 * (j))
#define XB_XSUB(j)  (1280 + 64 * (j))
#define XB_XGEN(j)  (2304 + 64 * (j))
#define XB_TOP      3328
#define XB_TOPGEN   3392
#define XCD_BAR_WORDS 3456
#define XB_SPIN_CAP (1u << 18)

__device__ __forceinline__ unsigned xb_ld(unsigned* p)              { return __hip_atomic_load(p, __ATOMIC_RELAXED, __HIP_MEMORY_SCOPE_AGENT); }
__device__ __forceinline__ unsigned xb_add(unsigned* p, unsigned v) { return __hip_atomic_fetch_add(p, v, __ATOMIC_RELAXED, __HIP_MEMORY_SCOPE_AGENT); }
__device__ __forceinline__ unsigned xb_xcc_id() { return (unsigned)__builtin_amdgcn_s_getreg((3 << 11) | 20) & 0xFu; }
#define XB_SPIN(cond, bar) do { unsigned _sp = 0; while (cond) { __builtin_amdgcn_s_sleep(1); \
    if ((++_sp & 255u) == 0u) { if (xb_ld(&(bar)[XB_TMO])) break; if (_sp > XB_SPIN_CAP) { atomicAdd(&(bar)[XB_TMO], 1u); break; } } } } while (0)

struct XcdBarrier {
    unsigned* bar; unsigned x;
    volatile XB_LAS unsigned* st;
};

__device__ __forceinline__ XcdBarrier xcd_barrier_post(unsigned* bar, volatile XB_LAS unsigned* st) {
    XcdBarrier b; b.bar = bar; b.x = xb_xcc_id(); b.st = st;
    if (threadIdx.x == 0) (void)xb_add(&bar[XB_XCNT(b.x)], 1u);
    return b;
}
__device__ __forceinline__ void xcd_barrier_complete(unsigned* bar, unsigned x, unsigned& nloc, unsigned& nx) {
    const unsigned G = gridDim.x * gridDim.y * gridDim.z;
    unsigned sum, cnt, mine, sp = 0u;
    for (;;) {
        sum = 0u; cnt = 0u; mine = 0u;
#pragma unroll
        for (unsigned j = 0; j < 16; ++j) { const unsigned c = xb_ld(&bar[XB_XCNT(j)]); sum += c; cnt += (c > 0u) ? 1u : 0u; mine = (j == x) ? c : mine; }
        if (sum == G) break;
        __builtin_amdgcn_s_sleep(1);
        if ((++sp & 255u) == 0u) { if (xb_ld(&bar[XB_TMO])) break; if (sp > XB_SPIN_CAP) { atomicAdd(&bar[XB_TMO], 1u); break; } }
    }
    nloc = mine > 0u ? mine : 1u; nx = cnt > 0u ? cnt : 1u;
}

__device__ __forceinline__ void xcd_barrier(const XcdBarrier& b) {
    asm volatile("s_waitcnt vmcnt(0)" ::: "memory");
    __syncthreads();
    if (threadIdx.x == 0) {
        unsigned* bar = b.bar;
        __builtin_amdgcn_s_waitcnt(0);
        unsigned nloc = b.st[0], nx = b.st[1];
        if (nloc == 0u) { xcd_barrier_complete(bar, b.x, nloc, nx); b.st[0] = nloc; b.st[1] = nx; }
        const unsigned old = xb_add(&bar[XB_XSUB(b.x)], 1u);
        const unsigned gen = old / nloc;
        if (old + 1u == (gen + 1u) * nloc) {
            __builtin_amdgcn_fence(__ATOMIC_RELEASE, "agent");
            asm volatile("s_waitcnt vmcnt(0)" ::: "memory");
            const unsigned og = xb_add(&bar[XB_TOP], 1u);
            const unsigned tg = og / nx;
            if (og + 1u == (tg + 1u) * nx) xb_add(&bar[XB_TOPGEN], 1u);
            else XB_SPIN(xb_ld(&bar[XB_TOPGEN]) == tg, bar);
            __builtin_amdgcn_fence(__ATOMIC_ACQUIRE, "agent");
            xb_add(&bar[XB_XGEN(b.x)], 1u);
            asm volatile("s_waitcnt vmcnt(0)" ::: "memory");
        } else {
            XB_SPIN(xb_ld(&bar[XB_XGEN(b.x)]) == gen, bar);
            __builtin_amdgcn_fence(__ATOMIC_ACQUIRE, "agent");
            asm volatile("s_waitcnt vmcnt(0)" ::: "memory");
        }
    }
    __syncthreads();
}


constexpr int NPHASE = 12;
constexpr int LDS_BYTES = 147456;
#if defined(TPROBE_A)
#define STAMP(k) if (blockIdx.x == 0 && threadIdx.x == 0) ((unsigned long long*)(p.ws + WS_TS))[(k)] = __builtin_amdgcn_s_memrealtime();
#else
#define STAMP(k)
#endif
__global__ void __launch_bounds__(NTHR, 2) mega(Params p) {
    extern __shared__ __attribute__((aligned(16))) char lds[];
    cg::grid_group grid = cg::this_grid();
    const int lo = p.ph_lo, hi = p.ph_hi;
    if (threadIdx.x < 2) ((volatile XB_LAS unsigned*)((XB_LAS unsigned char*)lds + LDS_XB))[threadIdx.x] = 0u;
    __syncthreads();
    const XcdBarrier xbar = xcd_barrier_post((unsigned*)(p.ws + WS_CTL) + CW_BAR, (volatile XB_LAS unsigned*)((XB_LAS unsigned char*)lds + LDS_XB));
    if (p.ph_hi < 0) grid.sync();
#define SEAM(k) xcd_barrier(xbar)
    STAMP(0)
#ifndef DUP_PH
#define DUP_PH -1
#endif
#ifdef ONLY_PH
#define PH(k, call) if constexpr ((k) == ONLY_PH) { if (lo <= (k) && (k) < hi) { const int rep_ = 0; call; if ((k) + 1 < hi) SEAM(k); } }
#else
#define PH(k, call) if (lo <= (k) && (k) < hi) { if constexpr ((k) == DUP_PH) { _Pragma("unroll 1") for (int rep_ = 0; rep_ < 3; ++rep_) { __syncthreads(); call; } } else { const int rep_ = 0; call; } if ((k) + 1 < hi) SEAM(k); STAMP((k) + 1) }
#endif
    PH(0, phase0(p, lds))
    PH(1, phase1(p, lds))
    PH(2, phase2a(p, lds, rep_ == 0))
    PH(3, phase2b(p, lds))
    PH(4, phase3(p, lds))
    PH(5, phase4(p, lds))
    PH(6, phase5(p, lds))
    PH(7, phase6a(p, lds, rep_ == 0))
    PH(8, phase6b(p, lds))
    PH(9, phase7a(p, lds))
    PH(10, phase7b(p, lds))
    PH(11, phase8(p))
#undef PH
}

extern "C" void kernel_launch(void* const* d_in, const int* in_sizes, int n_in, void* d_out, int out_size, void* d_ws, size_t ws_size, hipStream_t stream) {
    static int grid = 0;
    if (grid == 0) {
        if (n_in != 22 || out_size != T * D || ws_size < WS_END) { fprintf(stderr, "kernel_launch: unexpected shapes (n_in %d out %d ws %zu, need ws >= %zu)\n", n_in, out_size, ws_size, (size_t)WS_END); grid = -1; return; }
        int dev = 0, cus = 0, per_cu = 0; hipGetDevice(&dev); hipDeviceGetAttribute(&cus, hipDeviceAttributeMultiprocessorCount, dev);
        hipFuncSetAttribute((const void*)mega, hipFuncAttributeMaxDynamicSharedMemorySize, LDS_BYTES);
        hipOccupancyMaxActiveBlocksPerMultiprocessor(&per_cu, (const void*)mega, NTHR, LDS_BYTES);
        if (per_cu < 1) { fprintf(stderr, "kernel_launch: occupancy query says %d blocks per CU\n", per_cu); per_cu = 1; }
        grid = cus * per_cu; (void)hipGetLastError();
    }
    if (grid < 0) return;
    hipMemsetAsync((char*)d_ws + WS_CTL, 0, 65536, stream);
    Params p{};
    p.x = (const float*)d_in[0]; p.pos = (const int*)d_in[1]; p.attn_norm_w = (const float*)d_in[2]; p.w_in = (const float*)d_in[3]; p.hg_lb = (const float*)d_in[4];
    p.hg_onw = (const float*)d_in[5]; p.q_norm_w = (const float*)d_in[6]; p.w_uq = (const float*)d_in[7]; p.kv_norm_w = (const float*)d_in[8]; p.w_ukv = (const float*)d_in[9];
    p.w_bra = (const float*)d_in[10]; p.w_brb = (const float*)d_in[11]; p.w_out = (const float*)d_in[12]; p.ffn_norm_w = (const float*)d_in[13]; p.rg_w = (const float*)d_in[14];
    p.rg_b = (const float*)d_in[15]; p.re_w = (const float*)d_in[16]; p.re_b = (const float*)d_in[17]; p.ew1 = (const float*)d_in[18]; p.ew3 = (const float*)d_in[19];
    p.ew2 = (const float*)d_in[20]; p.final_w = (const float*)d_in[21]; p.out = (float*)d_out; p.ws = (unsigned char*)d_ws;
#if MK_MULTI
    for (int ph = 0; ph < NPHASE; ++ph) { p.ph_lo = ph; p.ph_hi = ph + 1; hipLaunchKernelGGL(mega, dim3(grid), dim3(NTHR), LDS_BYTES, stream, p); }
#else
    p.ph_lo = 0; p.ph_hi = NPHASE;
    void* args[] = {&p};
    hipError_t e = hipLaunchCooperativeKernel((const void*)mega, dim3(grid), dim3(NTHR), args, LDS_BYTES, stream);
    if (e != hipSuccess) fprintf(stderr, "cooperative launch failed: %s (grid %d)\n", hipGetErrorString(e), grid);
#endif
}
```

```cpp
#include <hip/hip_runtime.h>
#include <hip/hip_cooperative_groups.h>
#include <cstdio>
#include <cstdint>
namespace cg = cooperative_groups;

#ifndef MK_MULTI
#define MK_MULTI 0
#endif

#define DEVI __device__ __forceinline__
typedef unsigned short bf16_t;
typedef short bf16x8 __attribute__((ext_vector_type(8)));
typedef float f32x4 __attribute__((ext_vector_type(4)));
typedef unsigned u32x4 __attribute__((ext_vector_type(4)));
typedef unsigned u32x2 __attribute__((ext_vector_type(2)));

constexpr int NB = 16, SEQ = 2048, T = NB * SEQ, D = 1024;
constexpr int NTHR = 512;
constexpr int ZH_P = 4096, ZL_P = 768, ZG_P = 2048;
constexpr int NZ = 6912;
constexpr int NEXP = 64, EFF = 512;
constexpr int SLOT_CAP = 2 * T + NEXP * 256;
constexpr int MAX_TILES = SLOT_CAP / 256;

constexpr size_t MiB = 1u << 20;
constexpr size_t WS_CTL = 0;
constexpr size_t WS_WRT = 1 * MiB;
constexpr size_t WS_LBT = 1 * MiB + 512 * 1024;
constexpr size_t WS_WIN = 2 * MiB;
constexpr size_t WS_WUQ = 16 * MiB;
constexpr size_t WS_WUKV = 18 * MiB;
constexpr size_t WS_WBR = 20 * MiB;
constexpr size_t WS_WOUT = 24 * MiB;
constexpr size_t WS_COS = 26 * MiB, WS_SIN = 30 * MiB;
constexpr size_t WS_ROUTE = 34 * MiB;
constexpr size_t WS_KPE = 36 * MiB;
constexpr size_t WS_ZH = 40 * MiB;
constexpr size_t WS_Q = 40 * MiB, WS_KN = 136 * MiB, WS_V = 200 * MiB;
constexpr size_t WS_Y = 40 * MiB;
constexpr size_t WS_X2B = 104 * MiB;
constexpr size_t WS_HID = 168 * MiB;
constexpr size_t WS_YEXP = 248 * MiB;
constexpr size_t WS_X2F8 = 344 * MiB;
constexpr size_t WS_H8 = 408 * MiB;
constexpr size_t WS_WIN8 = 440 * MiB;
constexpr size_t WS_TOK = 512 * 1024;
constexpr size_t WS_OB = 264 * MiB;
constexpr size_t WS_ZL = 296 * MiB;
constexpr size_t WS_ZG = 344 * MiB;
constexpr size_t WS_W13 = 408 * MiB;
constexpr size_t WS_OA = 472 * MiB;
constexpr size_t WS_H = 472 * MiB;
constexpr size_t WS_W2 = 472 * MiB;
constexpr size_t WS_END = 536 * MiB;
constexpr size_t RT_AE = 0, RT_AP = 256 * 1024, RT_AW = 512 * 1024, RT_AS = 768 * 1024, RT_ST = 1024 * 1024, RT_SW = 1536 * 1024;
constexpr int CW_CNT = 8192, CNT_STRIDE = 64;
constexpr size_t WS_TS = 16384;
constexpr size_t WS_PTRS = 8192;
enum { PT_POS = 0, PT_HGLB, PT_HGONW, PT_RGB, PT_REB, PT_EW1, PT_EW3, PT_EW2, PT_FFNW, PT_FINW, PT_X };
DEVI const void* ptab(const unsigned char* ws, int i) { return (const void*)(((const unsigned long long*)(ws + WS_PTRS))[i]); }

struct Params {
    const float* x; const int* pos; const float* attn_norm_w; const float* w_in; const float* hg_lb; const float* hg_onw;
    const float* q_norm_w; const float* w_uq; const float* kv_norm_w; const float* w_ukv; const float* w_bra; const float* w_brb;
    const float* w_out; const float* ffn_norm_w; const float* rg_w; const float* rg_b; const float* re_w; const float* re_b;
    const float* ew1; const float* ew3; const float* ew2; const float* final_w;
    float* out; unsigned char* ws;
    int ph_lo, ph_hi;
};

DEVI unsigned f2bf(float f) { unsigned u = __builtin_bit_cast(unsigned, f); return (u + 0x7fffu + ((u >> 16) & 1u)) >> 16; }
DEVI float bf2f(unsigned h) { return __builtin_bit_cast(float, h << 16); }
typedef float f32x2_t __attribute__((ext_vector_type(2))); typedef __bf16 bf16x2_t __attribute__((ext_vector_type(2)));
DEVI unsigned pk2(float lo, float hi) { f32x2_t v = {lo, hi}; bf16x2_t b = __builtin_convertvector(v, bf16x2_t); return __builtin_bit_cast(unsigned, b); }
DEVI float sigmoidf_(float v) { return __builtin_amdgcn_rcpf(1.f + __expf(-v)); }
DEVI float siluf_(float v) { return v * __builtin_amdgcn_rcpf(1.f + __expf(-v)); }
DEVI float wave_sum(float v) {
#pragma unroll
    for (int o = 1; o < 64; o <<= 1) v += __shfl_xor(v, o);
    return v;
}
typedef int i32x4 __attribute__((ext_vector_type(4))); typedef int i32x8 __attribute__((ext_vector_type(8)));
DEVI unsigned pk4_fp8(float a, float b, float c, float d) { int w = __builtin_amdgcn_cvt_pk_fp8_f32(a, b, 0, false); w = __builtin_amdgcn_cvt_pk_fp8_f32(c, d, w, true); return (unsigned)w; }
DEVI void store4bf(bf16_t* p, f32x4 v) { u32x2 w; w.x = pk2(v[0], v[1]); w.y = pk2(v[2], v[3]); *(u32x2*)p = w; }
DEVI void unpack8(bf16x8 v, float* f) {
#pragma unroll
    for (int j = 0; j < 8; ++j) f[j] = bf2f((unsigned)(unsigned short)v[j]);
}

template <class ColMap, class KScale>
DEVI void transpose_tile_f8(const float* src, int Nsrc, unsigned char* dst, int ldk, int k0, int n0, ColMap cm, KScale ks, float* scr) {
    const int tid = threadIdx.x;
    {
        const int nl = tid & 63, kq = tid >> 6; const int col = cm(n0 + nl);
#pragma unroll
        for (int i = 0; i < 8; ++i) { const int k = kq * 8 + i; float v = 0.f; if (col >= 0) v = src[(size_t)(k0 + k) * Nsrc + col] * ks(k0 + k); scr[k * 65 + nl] = v; }
    }
    __syncthreads();
    {
        const int nl = tid >> 3, kc = tid & 7; const float* s = scr + (kc * 8) * 65 + nl;
        u32x2 o; o.x = pk4_fp8(s[0], s[65], s[2 * 65], s[3 * 65]); o.y = pk4_fp8(s[4 * 65], s[5 * 65], s[6 * 65], s[7 * 65]);
        *(u32x2*)(dst + (size_t)(n0 + nl) * ldk + k0 + kc * 8) = o;
    }
    __syncthreads();
}
template <class ColMap, class KScale>
DEVI void transpose_tile(const float* src, int Nsrc, bf16_t* dst, int ldk, int k0, int n0, ColMap cm, KScale ks, float* scr) {
    const int tid = threadIdx.x;
    {
        const int nl = tid & 63, kq = tid >> 6; const int col = cm(n0 + nl);
#pragma unroll
        for (int i = 0; i < 8; ++i) { const int k = kq * 8 + i; float v = 0.f; if (col >= 0) v = src[(size_t)(k0 + k) * Nsrc + col] * ks(k0 + k); scr[k * 65 + nl] = v; }
    }
    __syncthreads();
    {
        const int nl = tid >> 3, kc = tid & 7; const float* s = scr + (kc * 8) * 65 + nl;
        u32x4 o; o.x = pk2(s[0], s[65]); o.y = pk2(s[2 * 65], s[3 * 65]); o.z = pk2(s[4 * 65], s[5 * 65]); o.w = pk2(s[6 * 65], s[7 * 65]);
        *(u32x4*)(dst + (size_t)(n0 + nl) * ldk + k0 + kc * 8) = o;
    }
    __syncthreads();
}

namespace g8 {
#define G8_LAS __attribute__((address_space(3)))
constexpr int BM = 256, BK = 64, HALF = 128, HTB = HALF * BK * 2, STAGE_BYTES = 8 * HTB, NXCD = 8, WGM = 8;
__host__ __device__ __forceinline__ int lds_byte(int r, int c) { const int st = (r >> 4) * 2 + (c >> 5), rr = r & 15, cc = c & 31, ob = rr * 64 + cc * 2; return st * 1024 + (ob ^ (((ob >> 9) & 1) << 5)); }
__host__ __device__ __forceinline__ int perm32(int rho) { const int n = rho >> 4, i = rho & 15; return 8 * (i >> 2) + 4 * n + (i & 3); }
__host__ __device__ __forceinline__ void stage_rc(int b, int& R, int& C) { const int st = b / 1024, sb = b % 1024, swz = sb ^ (((sb >> 9) & 1) << 5); R = (st >> 1) * 16 + swz / 64; C = (st & 1) * 32 + (swz % 64) / 2; }
struct Unit { int pm, pn; const char* a; const char* b; const int* tok; };
struct DenseOrder {
    const char* A; const char* Bt; size_t tstepA, tstepB; int nM, nN, nwg, G, c;
    DEVI void init(const void* A_, int lda, const void* Bt_, int ldb, int M, int N) { A = (const char*)A_; Bt = (const char*)Bt_; tstepA = (size_t)BM * lda * 2; tstepB = (size_t)BM * ldb * 2;
        nM = M / BM; nN = N / BM; nwg = nM * nN; G = gridDim.x; c = blockIdx.x; }
    DEVI bool next(int i, Unit& u) const {
        const long L = (long)i * G + c; if (L >= nwg) return false;
        int wgid = (int)L; { const int q = nwg / NXCD, r = nwg % NXCD, xcd = wgid % NXCD, off = wgid / NXCD; wgid = (xcd < r ? xcd * (q + 1) : r * (q + 1) + (xcd - r) * q) + off; }
        const int nig = WGM * nN, gid = wgid / nig, fm = gid * WGM, gsz = (nM - fm) < WGM ? (nM - fm) : WGM;
        u.pm = fm + ((wgid % nig) % gsz); u.pn = (wgid % nig) / gsz; u.a = A + (size_t)u.pm * tstepA; u.b = Bt + (size_t)u.pn * tstepB; u.tok = nullptr; return true;
    }
};
struct NoHook { static constexpr bool ON = false; template <class U> DEVI void operator()(f32x4 (&)[2][2][4][2], const U&, int, int, int, int) const {} };
template <class Epi, class Sched, bool ALIGN_EPI, class Hook = NoHook, bool GATHER = false, bool FP8 = false>
DEVI void gemm_phase(G8_LAS unsigned char* lds, const int lda, const int ldb, const int K, const Sched& S, const Epi& E, unsigned long long* tsp = nullptr, const Hook& H = Hook(), const int seg_t = 1 << 30, const long segj = 0, const int scA = 127, const int scB = 127) {
    const int tid = threadIdx.x, wid = __builtin_amdgcn_readfirstlane(tid >> 6), lane = tid & 63, wr = wid >> 2, wc = wid & 3, fr = lane & 15, fq = lane >> 4;
    const int nt = K / BK;
    unsigned voffA[2], voffB[2]; int gR[2]; unsigned gC[2];
#pragma unroll
    for (int i = 0; i < 2; ++i) { int R, C; stage_rc(tid * 16 + i * 8192, R, C); voffA[i] = (unsigned)(R * lda + C) * 2u; voffB[i] = (unsigned)(((R & ~31) + perm32(R & 31)) * ldb + C) * 2u; gR[i] = R; gC[i] = (unsigned)C * 2u; }
    unsigned vG[2][2], vGn[2][2];
#define G8_TOK(dst, tokp) do { _Pragma("unroll") for (int h_ = 0; h_ < 2; ++h_) _Pragma("unroll") for (int i_ = 0; i_ < 2; ++i_) dst[h_][i_] = (unsigned)(tokp)[gR[i_] + 128 * h_] * (unsigned)(lda * 2) + gC[i_]; } while (0)
#define G8_STAGE_A(bufoff, gbase, h, usenext) do { if constexpr (GATHER) { unsigned v_[2] = {(usenext) ? vGn[h][0] : vG[h][0], (usenext) ? vGn[h][1] : vG[h][1]}; G8_STAGE(bufoff, gbase, v_); } \
        else { G8_STAGE(bufoff, (gbase) + (h) * hstepA, voffA); } } while (0)
    const size_t kstep = (size_t)(BK * 2);
    const size_t hstepA = (size_t)HALF * lda * 2, hstepB = (size_t)HALF * ldb * 2;
    const unsigned ldsw = (unsigned)wid * 1024u;
    const int aoff = lds_byte(wr * 64 + fr, fq * 8), boff = lds_byte(wc * 32 + fr, fq * 8);
#define G8_SA(b, h) (((b) * 2 + (h)) * HTB)
#define G8_SB(b, h) ((4 + (b) * 2 + (h)) * HTB)
#define G8_STAGE(bufoff, gbase, voff) do { _Pragma("unroll") for (int _i = 0; _i < 2; ++_i) \
        __builtin_amdgcn_global_load_lds((const unsigned*)((const char*)(gbase) + (voff)[_i]), (G8_LAS unsigned*)(lds + (bufoff) + ldsw + _i * 8192), 16, 0, 0); } while (0)
#define G8_LD16(off) __builtin_bit_cast(i32x4, *(const G8_LAS bf16x8*)(lds + (off)))
#define G8_LDA8(dst, b, h) do { _Pragma("unroll") for (int m = 0; m < 4; ++m) dst[m] = __builtin_shufflevector(G8_LD16(G8_SA(b, h) + aoff + m * 2048), G8_LD16(G8_SA(b, h) + aoff + m * 2048 + 1024), 0, 1, 2, 3, 4, 5, 6, 7); } while (0)
#define G8_LDB8(dst, b, h) do { _Pragma("unroll") for (int n = 0; n < 2; ++n) dst[n] = __builtin_shufflevector(G8_LD16(G8_SB(b, h) + boff + n * 2048), G8_LD16(G8_SB(b, h) + boff + n * 2048 + 1024), 0, 1, 2, 3, 4, 5, 6, 7); } while (0)
#define G8_LDA(dst, b, h) do { if constexpr (FP8) { G8_LDA8(dst##8, b, h); break; } _Pragma("unroll") for (int m = 0; m < 4; ++m) _Pragma("unroll") for (int k = 0; k < 2; ++k) dst[m][k] = *(const G8_LAS bf16x8*)(lds + G8_SA(b, h) + aoff + m * 2048 + k * 1024); } while (0)
#define G8_LDB(dst, b, h) do { if constexpr (FP8) { G8_LDB8(dst##8, b, h); break; } _Pragma("unroll") for (int n = 0; n < 2; ++n) _Pragma("unroll") for (int k = 0; k < 2; ++k) dst[n][k] = *(const G8_LAS bf16x8*)(lds + G8_SB(b, h) + boff + n * 2048 + k * 1024); } while (0)
#define G8_MMA(ai, bj, At, Bt) do { __builtin_amdgcn_s_setprio(1); _Pragma("unroll") for (int m = 0; m < 4; ++m) _Pragma("unroll") for (int n = 0; n < 2; ++n) { \
        if constexpr (FP8) { asm volatile("v_mfma_scale_f32_16x16x128_f8f6f4 %0, %1, %2, %0, %3, %4 op_sel_hi:[0,0,0]" : "+v"(acc[ai][bj][m][n]) : "v"(Bt##8[n]), "v"(At##8[m]), "v"(scB), "v"(scA)); } \
        else { _Pragma("unroll") for (int k = 0; k < 2; ++k) acc[ai][bj][m][n] = __builtin_amdgcn_mfma_f32_16x16x32_bf16(Bt[n][k], At[m][k], acc[ai][bj][m][n], 0, 0, 0); } } __builtin_amdgcn_s_setprio(0); } while (0)
#define G8_WAIT_V(n) asm volatile("s_waitcnt vmcnt(" #n ")" ::: "memory")
#define G8_WAIT_L(n) asm volatile("s_waitcnt lgkmcnt(" #n ")" ::: "memory")
#define G8_BAR __builtin_amdgcn_s_barrier()
#define G8_SCHED __builtin_amdgcn_sched_barrier(0)
    Unit cur, nxt; int ui = 0;
    if (!S.next(0, cur)) return;
    f32x4 acc[2][2][4][2];
#pragma unroll
    for (int a = 0; a < 2; ++a)
#pragma unroll
        for (int b = 0; b < 2; ++b)
#pragma unroll
            for (int m = 0; m < 4; ++m)
#pragma unroll
                for (int n = 0; n < 2; ++n) acc[a][b][m][n] = (f32x4){0.f, 0.f, 0.f, 0.f};
    bf16x8 At[4][2], B0[2][2], B1[2][2];
    i32x8 At8[4], B08[2], B18[2];
    const char* cA = cur.a; const char* cB = cur.b;
    if constexpr (GATHER) { G8_TOK(vG, cur.tok); G8_TOK(vGn, cur.tok); }
    G8_STAGE(G8_SB(0, 0), cB, voffB); G8_STAGE(G8_SB(0, 1), cB + hstepB, voffB); G8_STAGE_A(G8_SA(0, 0), cA, 0, false); G8_STAGE_A(G8_SA(0, 1), cA, 1, false);
    if (wr == 1) G8_BAR;
    G8_WAIT_V(2); G8_BAR;
    G8_STAGE(G8_SB(1, 0), cB + kstep, voffB); G8_STAGE_A(G8_SA(1, 0), cA + kstep, 0, false); G8_STAGE(G8_SB(1, 1), cB + hstepB + kstep, voffB);
    G8_WAIT_V(6); G8_BAR;
    unsigned long long tk_ = 0, te_ = 0, tp_ = tsp ? __builtin_amdgcn_s_memrealtime() : 0;
    for (;;) {
        const bool has_next = S.next(ui + 1, nxt);
        const char* nA = has_next ? nxt.a : cA; const char* nB = has_next ? nxt.b : cB;
        if constexpr (GATHER) { if (has_next) G8_TOK(vGn, nxt.tok); }
#pragma unroll 1
        for (int t = 0; t < nt; t += 2) {
            const bool last = (t == nt - 2);
            if constexpr (Hook::ON) { if (t == seg_t) H(acc, cur, wr, wc, fr, fq); }
            const char* a1 = cA + (size_t)(t + 1) * kstep + (Hook::ON && t + 1 >= seg_t ? segj : 0);
            const char* a2 = last ? nA : cA + (size_t)(t + 2) * kstep + (Hook::ON && t + 2 >= seg_t ? segj : 0); const char* b2 = last ? nB : cB + (size_t)(t + 2) * kstep;
            const char* a3 = a2 + kstep; const char* b3 = b2 + kstep;
            G8_LDB(B0, 0, 0); G8_LDB(B1, 0, 1); G8_SCHED; G8_LDA(At, 0, 0); G8_STAGE_A(G8_SA(1, 1), a1, 1, false);
            G8_WAIT_V(8); G8_WAIT_L(0); G8_BAR; G8_MMA(0, 0, At, B0); G8_MMA(0, 1, At, B1); G8_BAR; G8_SCHED;
            G8_LDA(At, 0, 1); G8_STAGE(G8_SB(0, 0), b2, voffB); G8_STAGE(G8_SB(0, 1), b2 + hstepB, voffB); G8_STAGE_A(G8_SA(0, 0), a2, 0, last);
            G8_WAIT_V(8); G8_WAIT_L(0); G8_BAR; G8_MMA(1, 0, At, B0); G8_MMA(1, 1, At, B1); G8_BAR; G8_SCHED;
            G8_LDB(B0, 1, 0); G8_LDB(B1, 1, 1); G8_SCHED; G8_LDA(At, 1, 0); G8_STAGE_A(G8_SA(0, 1), a2, 1, last);
            G8_WAIT_V(8); G8_WAIT_L(0); G8_BAR; G8_MMA(0, 0, At, B0); G8_MMA(0, 1, At, B1); G8_BAR; G8_SCHED;
            G8_LDA(At, 1, 1); G8_STAGE(G8_SB(1, 0), b3, voffB); G8_STAGE(G8_SB(1, 1), b3 + hstepB, voffB); G8_STAGE_A(G8_SA(1, 0), a3, 0, last);
            G8_WAIT_V(8); G8_WAIT_L(0); G8_BAR; G8_MMA(1, 0, At, B0); G8_MMA(1, 1, At, B1); G8_BAR; G8_SCHED;
        }
        if constexpr (ALIGN_EPI) { if (wr == 0) G8_BAR; }
        if (tsp) { const unsigned long long n_ = __builtin_amdgcn_s_memrealtime(); tk_ += n_ - tp_; tp_ = n_; }
        if constexpr (FP8) asm volatile("s_nop 15\n\ts_nop 15" ::: "memory");
        E(acc, cur, wr, wc, fr, fq);
        if (tsp) { const unsigned long long n_ = __builtin_amdgcn_s_memrealtime(); te_ += n_ - tp_; tp_ = n_; }
        if (!has_next) break;
#pragma unroll
        for (int a = 0; a < 2; ++a)
#pragma unroll
            for (int b = 0; b < 2; ++b)
#pragma unroll
                for (int m = 0; m < 4; ++m)
#pragma unroll
                    for (int n = 0; n < 2; ++n) acc[a][b][m][n] = (f32x4){0.f, 0.f, 0.f, 0.f};
        cur = nxt; cA = nA; cB = nB; ++ui;
        if constexpr (GATHER) { _Pragma("unroll") for (int h_ = 0; h_ < 2; ++h_) _Pragma("unroll") for (int i_ = 0; i_ < 2; ++i_) vG[h_][i_] = vGn[h_][i_]; }
        if constexpr (ALIGN_EPI) { if (wr == 1) G8_BAR; }
    }
    G8_WAIT_V(0);
    if constexpr (!ALIGN_EPI) { if (wr == 0) G8_BAR; }
    G8_BAR;
    if (tsp && blockIdx.x == 0 && threadIdx.x == 0) { tsp[0] = 0; tsp[1] = tk_; tsp[2] = 0; tsp[3] = te_; tsp[4] = 0; tsp[5] = (unsigned long long)(ui + 1) * 100ull; }
#undef G8_SA
#undef G8_SB
#undef G8_STAGE
#undef G8_STAGE_A
#undef G8_TOK
#undef G8_LDA
#undef G8_LDA8
#undef G8_LDB8
#undef G8_LD16
#undef G8_LDB
#undef G8_MMA
#undef G8_WAIT_V
#undef G8_WAIT_L
#undef G8_BAR
#undef G8_SCHED
}
template <class F> struct Epi4 { F f;
    DEVI void operator()(const f32x4 (&acc)[2][2][4][2], const Unit& u, int wr, int wc, int fr, int fq) const {
        constexpr int NB = F::NB;
        asm volatile("" : "+v"(fr), "+v"(fq));
#pragma unroll
        for (int g0 = 0; g0 < 8; g0 += NB) {
            typename F::L ld[NB][2];
#pragma unroll
            for (int gg = 0; gg < NB; ++gg) { const int ai = (g0 + gg) >> 2, m = (g0 + gg) & 3;
#pragma unroll
                for (int bj = 0; bj < 2; ++bj) ld[gg][bj] = f.load(u.pm, u.pn, ai * 128 + wr * 64 + m * 16 + fr, bj * 128 + wc * 32 + 8 * fq); }
#pragma unroll
            for (int gg = 0; gg < NB; ++gg) { const int ai = (g0 + gg) >> 2, m = (g0 + gg) & 3;
#pragma unroll
                for (int bj = 0; bj < 2; ++bj) f.apply(u.pm, u.pn, ai * 128 + wr * 64 + m * 16 + fr, bj * 128 + wc * 32 + 8 * fq, acc[ai][bj][m][0], acc[ai][bj][m][1], ld[gg][bj]); }
            asm volatile("" ::: "memory");
        }
    } };
template <class F> struct Hook4 { static constexpr bool ON = true; F f;
    DEVI void operator()(f32x4 (&acc)[2][2][4][2], const Unit& u, int wr, int wc, int fr, int fq) const {
        constexpr int NB = F::NB;
        asm volatile("" : "+v"(fr), "+v"(fq));
#pragma unroll
        for (int g0 = 0; g0 < 8; g0 += NB) {
            typename F::L ld[NB][2];
#pragma unroll
            for (int gg = 0; gg < NB; ++gg) { const int ai = (g0 + gg) >> 2, m = (g0 + gg) & 3;
#pragma unroll
                for (int bj = 0; bj < 2; ++bj) ld[gg][bj] = f.load(u.pm, u.pn, ai * 128 + wr * 64 + m * 16 + fr, bj * 128 + wc * 32 + 8 * fq); }
#pragma unroll
            for (int gg = 0; gg < NB; ++gg) { const int ai = (g0 + gg) >> 2, m = (g0 + gg) & 3;
#pragma unroll
                for (int bj = 0; bj < 2; ++bj) f.apply(u.pm, u.pn, ai * 128 + wr * 64 + m * 16 + fr, bj * 128 + wc * 32 + 8 * fq, acc[ai][bj][m][0], acc[ai][bj][m][1], ld[gg][bj]); }
            asm volatile("" ::: "memory");
        }
    } };
}

struct NoLd {};
struct LbLd { f32x4 a, b; };
DEVI void store8bf(bf16_t* p, f32x4 a, f32x4 b) { u32x4 w; w.x = pk2(a[0], a[1]); w.y = pk2(a[2], a[3]); w.z = pk2(b[0], b[1]); w.w = pk2(b[2], b[3]); *(u32x4*)p = w; }
struct EpiZa { typedef LbLd L; static constexpr int NB = 1; unsigned char* ws;
    DEVI L load(int, int pn, int, int c) const { L l; l.a = (f32x4){0.f, 0.f, 0.f, 0.f}; l.b = l.a; if ((pn >> 2) == 1) { const float* lp = (const float*)(ws + WS_LBT) + (pn - 4) * 256 + c; l.a = *(const f32x4*)lp; l.b = *(const f32x4*)(lp + 4); } return l; }
    DEVI void apply(int pm, int pn, int r, int c, f32x4 v0, f32x4 v1, const L& lb) const {
        const size_t row = (size_t)pm * 256 + r; const int col = pn * 256 + c; const int kind = pn >> 2;
        if (kind == 3) {
#pragma unroll
            for (int j = 0; j < 4; ++j) { v0[j] = siluf_(v0[j]); v1[j] = siluf_(v1[j]); } }
        if (kind == 0) {
#pragma unroll
            for (int j = 0; j < 4; ++j) { v0[j] = siluf_(v0[j]) * 0.08838834764831845f; v1[j] = siluf_(v1[j]) * 0.08838834764831845f; } }
        else if (kind == 1) {
#pragma unroll
            for (int j = 0; j < 4; ++j) { v0[j] = __logf(lb.a[j] + (1.f - lb.a[j]) * sigmoidf_(v0[j])); v1[j] = __logf(lb.b[j] + (1.f - lb.b[j]) * sigmoidf_(v1[j])); } }
        store8bf((bf16_t*)(ws + WS_ZH) + row * ZH_P + col, v0, v1);
    } };
struct EpiZb { typedef NoLd L; static constexpr int NB = 8; unsigned char* ws;
    DEVI L load(int, int, int, int) const { return {}; }
    DEVI void apply(int pm, int pn, int r, int c, f32x4 v0, f32x4 v1, L) const {
        const size_t row = (size_t)pm * 256 + r; u32x2 w = {0u, 0u};
        if (pn < 3) { store8bf((bf16_t*)(ws + WS_ZL) + row * ZL_P + pn * 256 + c, v0, v1); return; }
#pragma unroll
        for (int j = 0; j < 4; ++j) { w.x |= (unsigned)fmaxf(__builtin_rintf(255.f * sigmoidf_(v0[j])), 1.f) << (8 * j); w.y |= (unsigned)fmaxf(__builtin_rintf(255.f * sigmoidf_(v1[j])), 1.f) << (8 * j); }
        *(u32x2*)(ws + WS_ZG + row * ZG_P + (pn - 3) * 256 + c) = w;
    } };
struct EpiQ { typedef NoLd L; static constexpr int NB = 8; bf16_t* q;
    DEVI L load(int, int, int, int) const { return {}; }
    DEVI void apply(int pm, int pn, int r, int c, f32x4 v0, f32x4 v1, L) const { store8bf(q + ((size_t)pm * 256 + r) * 1536 + pn * 256 + c, v0, v1); } };
struct EpiKV { typedef NoLd L; static constexpr int NB = 8; bf16_t* kn; bf16_t* vv;
    DEVI L load(int, int, int, int) const { return {}; }
    DEVI void apply(int pm, int pn, int r, int c, f32x4 v0, f32x4 v1, L) const {
        const size_t row = (size_t)pm * 256 + r; const int col = pn * 256 + c; const int hh = col >> 8, cc = col & 255;
        if (cc < 128) store8bf(kn + row * 1024 + hh * 128 + cc, v0, v1); else store8bf(vv + row * 1024 + hh * 128 + (cc - 128), v0, v1);
    } };
struct BrHookF { typedef u32x4 L; static constexpr int NB = 1; const unsigned char* zg;
    DEVI L load(int pm, int pn, int r, int c) const { const unsigned char* g = zg + ((size_t)pm * 256 + r) * ZG_P + pn * 256 + c; const u32x2 a = *(const u32x2*)g, b = *(const u32x2*)(g + 1024); return (L){a.x, a.y, b.x, b.y}; }
    DEVI void apply(int, int, int, int, f32x4& v0, f32x4& v1, L l) const {
#pragma unroll
        for (int j = 0; j < 4; ++j) { v0[j] *= (float)((l.x >> (8 * j)) & 255u) * __builtin_amdgcn_rcpf((float)((l.z >> (8 * j)) & 255u)); v1[j] *= (float)((l.y >> (8 * j)) & 255u) * __builtin_amdgcn_rcpf((float)((l.w >> (8 * j)) & 255u)); } } };
struct EpiBr2 { typedef u32x2 L; static constexpr int NB = 2; const unsigned char* zg; bf16_t* y;
    DEVI L load(int pm, int pn, int r, int c) const { return *(const u32x2*)(zg + ((size_t)pm * 256 + r) * ZG_P + 1024 + pn * 256 + c); }
    DEVI void apply(int pm, int pn, int r, int c, f32x4 v0, f32x4 v1, L g) const {
#pragma unroll
        for (int j = 0; j < 4; ++j) { v0[j] *= (float)((g.x >> (8 * j)) & 255u) * (1.f / 255.f); v1[j] *= (float)((g.y >> (8 * j)) & 255u) * (1.f / 255.f); }
        store8bf(y + ((size_t)pm * 256 + r) * 1024 + pn * 256 + c, v0, v1); } };
struct EpiOut { typedef LbLd L; static constexpr int NB = 2; const float* x; bf16_t* x2b; unsigned char* x2f8;
    DEVI L load(int pm, int pn, int r, int c) const { const float* xp = x + ((size_t)pm * 256 + r) * 1024 + pn * 256 + c; L l; l.a = *(const f32x4*)xp; l.b = *(const f32x4*)(xp + 4); return l; }
    DEVI void apply(int pm, int pn, int r, int c, f32x4 v0, f32x4 v1, const L& xv) const { const size_t o = ((size_t)pm * 256 + r) * 1024 + pn * 256 + c; const f32x4 a = xv.a + v0, b = xv.b + v1; store8bf(x2b + o, a, b);
        u32x2 w; w.x = pk4_fp8(4.f * a[0], 4.f * a[1], 4.f * a[2], 4.f * a[3]); w.y = pk4_fp8(4.f * b[0], 4.f * b[1], 4.f * b[2], 4.f * b[3]); *(u32x2*)(x2f8 + o) = w; } };
struct EpiHid8 { unsigned char* hid; const float* srs;
    DEVI void operator()(const f32x4 (&acc)[2][2][4][2], const g8::Unit& u, int wr, int wc, int fr, int fq) const {
        asm volatile("" : "+v"(fr), "+v"(fq));
        float rs[8];
#pragma unroll
        for (int g = 0; g < 8; ++g) rs[g] = srs[(size_t)u.pm * 256 + (g >> 2) * 128 + wr * 64 + (g & 3) * 16 + fr];
#pragma unroll
        for (int g = 0; g < 8; ++g) { const int ai = g >> 2, m = g & 3; unsigned char* hrow = hid + ((size_t)u.pm * 256 + ai * 128 + wr * 64 + m * 16 + fr) * EFF + u.pn * 128 + wc * 16 + 4 * fq;
#pragma unroll
            for (int bj = 0; bj < 2; ++bj) { const f32x4 gg = acc[ai][bj][m][0] * rs[g], uu = acc[ai][bj][m][1] * rs[g]; float h4[4];
#pragma unroll
                for (int i = 0; i < 4; ++i) h4[i] = fminf(fmaxf(8.f * siluf_(gg[i]) * uu[i], -440.f), 440.f);
                *(unsigned*)(hrow + bj * 64) = pk4_fp8(h4[0], h4[1], h4[2], h4[3]); } }
    } };
struct EpiY { typedef float L; static constexpr int NB = 8; bf16_t* yexp; const float* sw;
    DEVI L load(int tile, int, int r, int) const { return sw[(size_t)tile * 256 + r]; }
    DEVI void apply(int tile, int pn, int r, int c, f32x4 v0, f32x4 v1, L w) const { store8bf(yexp + ((size_t)tile * 256 + r) * 1024 + pn * 256 + c, v0 * w, v1 * w); } };

DEVI void phase0(const Params& p, char* lds) {
    float* scr = (float*)lds; unsigned char* ws = p.ws;
    bf16_t* WinT = (bf16_t*)(ws + WS_WIN); bf16_t* WuqT = (bf16_t*)(ws + WS_WUQ); bf16_t* WukvT = (bf16_t*)(ws + WS_WUKV);
    bf16_t* WbrT = (bf16_t*)(ws + WS_WBR); bf16_t* WoutT = (bf16_t*)(ws + WS_WOUT);
    constexpr int I_IN = (4096 / 64) * 16, I_IN8 = (2816 / 64) * 16, I_UQ = 24 * 6, I_UKV = 32 * 4, I_BR = 16 * 16, I_OUT = 16 * 16;
    constexpr int NIT = I_IN + I_IN8 + I_UQ + I_UKV + 2 * I_BR + I_OUT;
    for (int it = blockIdx.x; it < NIT; it += gridDim.x) {
        int r = it;
        if (r < I_IN) { const int nb = r / 16, kb = r % 16; const float* nw = p.attn_norm_w;
            transpose_tile(p.w_in, 6848, WinT, 1024, kb * 64, nb * 64, [](int n) { return n; }, [nw](int k) { return nw[k]; }, scr); continue; }
        r -= I_IN;
        if (r < I_IN8) { const int nb = r / 16, kb = r % 16; const float* nw = p.attn_norm_w;
            transpose_tile_f8(p.w_in, 6848, ws + WS_WIN8, 1024, kb * 64, nb * 64, [](int n) { return n < 704 ? 4096 + n : (n < 768 ? -1 : 4032 + n); }, [nw](int k) { return nw[k] * 64.f; }, scr); continue; }
        r -= I_IN8;
        if (r < I_UQ) { const int nb = r / 6, kb = r % 6; const float* nw = p.q_norm_w;
            transpose_tile(p.w_uq, 1536, WuqT, 384, kb * 64, nb * 64,
                           [](int n) { const int hh = n / 192, c = n % 192; if (c < 128) return n; const int rr = c - 128; return hh * 192 + 128 + (rr & 1) * 32 + (rr >> 1); },
                           [nw](int k) { return nw[k] * 0.07216878364870322f; }, scr); continue; }
        r -= I_UQ;
        if (r < I_UKV) { const int nb = r / 4, kb = r % 4; const float* nw = p.kv_norm_w;
            transpose_tile(p.w_ukv, 2048, WukvT, 256, kb * 64, nb * 64, [](int n) { return n; }, [nw](int k) { return nw[k]; }, scr); continue; }
        r -= I_UKV;
        if (r < I_BR) { const int nb = r / 16, kb = r % 16;
            transpose_tile(p.w_bra, 1024, WbrT, 2048, kb * 64, nb * 64, [](int n) { return n; }, [](int) { return 1.f; }, scr); continue; }
        r -= I_BR;
        if (r < I_BR) { const int nb = r / 16, kb = r % 16;
            transpose_tile(p.w_brb, 1024, WbrT + 1024, 2048, kb * 64, nb * 64, [](int n) { return n; }, [](int) { return 1.f; }, scr); continue; }
        r -= I_BR;
        { const int nb = r / 16, kb = r % 16;
            transpose_tile(p.w_out, 1024, WoutT, 1024, kb * 64, nb * 64, [](int n) { return n; }, [](int) { return 1.f; }, scr); }
    }
    if (blockIdx.x == 0 && threadIdx.x == 0) { unsigned long long* tb = (unsigned long long*)(ws + WS_PTRS);
        tb[PT_POS] = (unsigned long long)p.pos; tb[PT_HGLB] = (unsigned long long)p.hg_lb; tb[PT_HGONW] = (unsigned long long)p.hg_onw; tb[PT_RGB] = (unsigned long long)p.rg_b; tb[PT_REB] = (unsigned long long)p.re_b;
        tb[PT_EW1] = (unsigned long long)p.ew1; tb[PT_EW3] = (unsigned long long)p.ew3; tb[PT_EW2] = (unsigned long long)p.ew2; tb[PT_FFNW] = (unsigned long long)p.ffn_norm_w; tb[PT_FINW] = (unsigned long long)p.final_w; tb[PT_X] = (unsigned long long)p.x; }
    bf16_t* WrH = (bf16_t*)(ws + WS_WRT); bf16_t* WrL = WrH + 80 * 1024;
    for (int e = blockIdx.x * NTHR + threadIdx.x; e < 80 * 1024; e += gridDim.x * NTHR) { const int c = e >> 10, k = e & 1023;
        const float w = c < 8 ? p.rg_w[k * 8 + c] * p.ffn_norm_w[k] : (c < 72 ? p.re_w[k * 64 + (c - 8)] * p.ffn_norm_w[k] : 0.f);
        const unsigned hb = f2bf(w); WrH[e] = (bf16_t)hb; WrL[e] = (bf16_t)f2bf(w - bf2f(hb)); }
    { float* lbt = (float*)(ws + WS_LBT); for (int k = blockIdx.x * NTHR + threadIdx.x; k < 1024; k += gridDim.x * NTHR) lbt[k] = 1.f / (1.f + expf(p.hg_lb[1024 + k] - p.hg_lb[k])); }
    bf16_t* H = (bf16_t*)(ws + WS_H);
    const int lane = threadIdx.x & 63, gw = blockIdx.x * 8 + (threadIdx.x >> 6), NGW = gridDim.x * 8;
    for (int m0 = gw * 2; m0 < T; m0 += NGW * 2) {
        f32x4 v[2][4];
#pragma unroll
        for (int r = 0; r < 2; ++r) { const f32x4* xr = (const f32x4*)(p.x + (size_t)(m0 + r) * D) + lane;
#pragma unroll
            for (int j = 0; j < 4; ++j) v[r][j] = xr[64 * j]; }
#pragma unroll
        for (int r = 0; r < 2; ++r) { const int m = m0 + r; float s = 0.f;
#pragma unroll
            for (int j = 0; j < 4; ++j) s += v[r][j][0] * v[r][j][0] + v[r][j][1] * v[r][j][1] + v[r][j][2] * v[r][j][2] + v[r][j][3] * v[r][j][3];
            const float rstd = rsqrtf(wave_sum(s) * (1.f / D) + 1e-6f);
            u32x2* o = (u32x2*)(H + (size_t)m * D) + lane; unsigned* o8 = (unsigned*)(ws + WS_H8 + (size_t)m * D) + lane; const float r4 = 4.f * rstd;
#pragma unroll
            for (int j = 0; j < 4; ++j) { u32x2 w; w.x = pk2(v[r][j][0] * rstd, v[r][j][1] * rstd); w.y = pk2(v[r][j][2] * rstd, v[r][j][3] * rstd); o[64 * j] = w;
                o8[64 * j] = pk4_fp8(v[r][j][0] * r4, v[r][j][1] * r4, v[r][j][2] * r4, v[r][j][3] * r4); } }
    }
}

DEVI void phase1(const Params& p, char* lds) {
    unsigned char* ws = p.ws;
    { g8::DenseOrder S; S.init(ws + WS_H, D, ws + WS_WIN, D, T, 4096); g8::Epi4<EpiZa> E{{ws}};
      g8::gemm_phase<g8::Epi4<EpiZa>, g8::DenseOrder, true>((G8_LAS unsigned char*)lds, D, D, D, S, E); }
    { g8::DenseOrder S; S.init(ws + WS_H8, D / 2, ws + WS_WIN8, D / 2, T, 2816); g8::Epi4<EpiZb> E{{ws}};
      g8::gemm_phase<g8::Epi4<EpiZb>, g8::DenseOrder, true, g8::NoHook, false, true>((G8_LAS unsigned char*)lds, D / 2, D / 2, D / 2, S, E, nullptr, g8::NoHook(), 1 << 30, 0, 125, 121); }
}

constexpr int HL_A = 0, HL_B = 17408, HL_BT = 34816, HL_VT = 53248, HL_AT = 71680, HL_ST = 80896, HL_SEG = 115712, HL_SS = 119808;
#define HG_BAR() do { asm volatile("s_waitcnt lgkmcnt(0)" ::: "memory"); __builtin_amdgcn_s_barrier(); asm volatile("" ::: "memory"); } while (0)
DEVI void hgrn_chain_mfma(const Params& p, char* lds, int b, int h) {
    const bf16_t* zh = (const bf16_t*)(p.ws + WS_ZH); bf16_t* oa = (bf16_t*)(p.ws + WS_OA);
    const float* hgonw = (const float*)ptab(p.ws, PT_HGONW);
    const int tid = threadIdx.x, lane = tid & 63, wid = __builtin_amdgcn_readfirstlane(tid >> 6), fr = lane & 15, g4 = lane >> 4;
    const int k2 = lane * 2, seg = wid;
    f32x4 S[8];
#pragma unroll
    for (int n = 0; n < 8; ++n) S[n] = (f32x4){0.f, 0.f, 0.f, 0.f};
    const bf16_t* zb = zh + (size_t)b * SEQ * ZH_P + h * 128;
    float* segs = (float*)(lds + HL_SEG); float* lss = (float*)(lds + HL_SS);
    unsigned rq[8], rf[8], rv[8];
#pragma unroll
    for (int i = 0; i < 8; ++i) { const bf16_t* r = zb + (size_t)(seg * 8 + i) * ZH_P + k2; rq[i] = *(const unsigned*)r; rf[i] = *(const unsigned*)(r + 1024); rv[i] = *(const unsigned*)(r + 2048); }
    const int tt = wid >> 1, vh = wid & 1;
    f32x4 nwv[4];
#pragma unroll
    for (int n = 0; n < 4; ++n) nwv[n] = *(const f32x4*)(hgonw + 16 * (4 * vh + n) + 4 * g4);
#if defined(TPROBE_A)
    unsigned long long tacc[6] = {0, 0, 0, 0, 0, 0}; unsigned long long tprev = __builtin_amdgcn_s_memrealtime();
#define HG_T(k) do { const unsigned long long now_ = __builtin_amdgcn_s_memrealtime(); tacc[k] += now_ - tprev; tprev = now_; } while (0)
#else
#define HG_T(k)
#endif
    for (int c = 0; c < SEQ / 64; ++c) {
        const int t0 = c * 64;
        u32x2 gpre[4];
        { const bf16_t* gp_ = zh + ((size_t)b * SEQ + t0 + 16 * tt + fr) * ZH_P + 3072 + h * 128;
#pragma unroll
          for (int n = 0; n < 4; ++n) gpre[n] = *(const u32x2*)(gp_ + 16 * (4 * vh + n) + 4 * g4); }
        float cs[8][2], qq[8][2], kk[8][2]; float run[2] = {0.f, 0.f};
#pragma unroll
        for (int i = 0; i < 8; ++i)
#pragma unroll
            for (int e = 0; e < 2; ++e) { const float lf = bf2f(e ? rf[i] >> 16 : rf[i] & 0xffffu); run[e] += lf; cs[i][e] = run[e]; kk[i][e] = 1.f - __expf(lf); qq[i][e] = bf2f(e ? rq[i] >> 16 : rq[i] & 0xffffu); }
        HG_BAR();
        HG_T(0);
        *(float2*)(segs + seg * 128 + k2) = make_float2(run[0], run[1]);
#pragma unroll
        for (int e = 0; e < 2; ++e) { u32x4 w;
            w.x = e ? (rv[0] >> 16) | (rv[1] & 0xffff0000u) : (rv[0] & 0xffffu) | (rv[1] << 16); w.y = e ? (rv[2] >> 16) | (rv[3] & 0xffff0000u) : (rv[2] & 0xffffu) | (rv[3] << 16);
            w.z = e ? (rv[4] >> 16) | (rv[5] & 0xffff0000u) : (rv[4] & 0xffffu) | (rv[5] << 16); w.w = e ? (rv[6] >> 16) | (rv[7] & 0xffff0000u) : (rv[6] & 0xffffu) | (rv[7] << 16);
            *(u32x4*)(lds + HL_VT + (k2 + e) * 144 + seg * 16) = w; }
        HG_BAR();
        HG_T(1);
        {
            float off[2] = {0.f, 0.f}, bm[2] = {0.f, 0.f};
#pragma unroll
            for (int s_ = 0; s_ < 8; ++s_) { const float2 v = *(const float2*)(segs + s_ * 128 + k2); if (s_ < seg) { off[0] += v.x; off[1] += v.y; } if (s_ < 4) { bm[0] += v.x; bm[1] += v.y; } }
            unsigned bt[2][4];
#pragma unroll
            for (int i = 0; i < 8; ++i) { float av[2], bv[2];
#pragma unroll
                for (int e = 0; e < 2; ++e) { const float ea = __expf(cs[i][e] + off[e] - bm[e]); av[e] = qq[i][e] * ea; bv[e] = kk[i][e] * __builtin_amdgcn_rcpf(ea); }
                *(unsigned*)(lds + HL_A + (seg * 8 + i) * 272 + k2 * 2) = pk2(av[0], av[1]);
                const unsigned pb = pk2(bv[0], bv[1]); *(unsigned*)(lds + HL_B + (seg * 8 + i) * 272 + k2 * 2) = pb;
                if (i & 1) { bt[0][i >> 1] |= pb << 16; bt[1][i >> 1] |= pb & 0xffff0000u; } else { bt[0][i >> 1] = pb & 0xffffu; bt[1][i >> 1] = pb >> 16; } }
#pragma unroll
            for (int e = 0; e < 2; ++e) { u32x4 w = {bt[e][0], bt[e][1], bt[e][2], bt[e][3]}; *(u32x4*)(lds + HL_BT + (k2 + e) * 144 + seg * 16) = w; }
        }
        f32x4 bmid = {0.f, 0.f, 0.f, 0.f}, blast = {0.f, 0.f, 0.f, 0.f};
#pragma unroll
        for (int s_ = 0; s_ < 8; ++s_) { const f32x4 v = *(const f32x4*)(segs + s_ * 128 + 16 * wid + 4 * g4); blast += v; if (s_ < 4) bmid += v; }
        {
            f32x4 em; em[0] = __expf(bmid[0]); em[1] = __expf(bmid[1]); em[2] = __expf(bmid[2]); em[3] = __expf(bmid[3]);
#pragma unroll
            for (int n = 0; n < 8; ++n) { u32x2 w; w.x = pk2(S[n][0] * em[0], S[n][1] * em[1]); w.y = pk2(S[n][2] * em[2], S[n][3] * em[3]); *(u32x2*)(lds + HL_ST + (16 * n + fr) * 272 + (16 * wid + 4 * g4) * 2) = w; }
        }
        if (c + 1 < SEQ / 64) {
#pragma unroll
            for (int i = 0; i < 8; ++i) { const bf16_t* r = zb + (size_t)(t0 + 64 + seg * 8 + i) * ZH_P + k2; rq[i] = *(const unsigned*)r; rf[i] = *(const unsigned*)(r + 1024); rv[i] = *(const unsigned*)(r + 2048); }
        }
        HG_BAR();
        HG_T(2);
#define HG_LD(off) (*(const bf16x8*)(lds + (off)))
#define HG_FENCE() do { asm volatile("s_waitcnt lgkmcnt(0)" ::: "memory"); __builtin_amdgcn_sched_barrier(0); } while (0)
        {
            bf16x8 fa[4], fb0[4], fb1[4]; const int ss0 = 2 * vh, ss1 = 2 * vh + 1;
#pragma unroll
            for (int kk4 = 0; kk4 < 4; ++kk4) { fa[kk4] = HG_LD(HL_A + (16 * tt + fr) * 272 + (32 * kk4 + 8 * g4) * 2); fb0[kk4] = HG_LD(HL_B + (16 * ss0 + fr) * 272 + (32 * kk4 + 8 * g4) * 2); fb1[kk4] = HG_LD(HL_B + (16 * ss1 + fr) * 272 + (32 * kk4 + 8 * g4) * 2); }
            HG_FENCE();
            f32x4 acc0 = {0.f, 0.f, 0.f, 0.f}, acc1 = {0.f, 0.f, 0.f, 0.f};
#pragma unroll
            for (int kk4 = 0; kk4 < 4; ++kk4) { acc0 = __builtin_amdgcn_mfma_f32_16x16x32_bf16(fb0[kk4], fa[kk4], acc0, 0, 0, 0); acc1 = __builtin_amdgcn_mfma_f32_16x16x32_bf16(fb1[kk4], fa[kk4], acc1, 0, 0, 0); }
#pragma unroll
            for (int i = 0; i < 4; ++i) { if (ss0 > tt || (ss0 == tt && 4 * g4 + i > fr)) acc0[i] = 0.f; if (ss1 > tt || (ss1 == tt && 4 * g4 + i > fr)) acc1[i] = 0.f; }
            u32x2 w; w.x = pk2(acc0[0], acc0[1]); w.y = pk2(acc0[2], acc0[3]); *(u32x2*)(lds + HL_AT + (16 * tt + fr) * 144 + (16 * ss0 + 4 * g4) * 2) = w;
            w.x = pk2(acc1[0], acc1[1]); w.y = pk2(acc1[2], acc1[3]); *(u32x2*)(lds + HL_AT + (16 * tt + fr) * 144 + (16 * ss1 + 4 * g4) * 2) = w;
        }
        HG_BAR();
        HG_T(3);
        f32x4 o[4];
#pragma unroll
        for (int n = 0; n < 4; ++n) o[n] = (f32x4){0.f, 0.f, 0.f, 0.f};
        {
            bf16x8 fat[2], fa[4];
#pragma unroll
            for (int ks = 0; ks < 2; ++ks) fat[ks] = HG_LD(HL_AT + (16 * tt + fr) * 144 + (32 * ks + 8 * g4) * 2);
#pragma unroll
            for (int kk4 = 0; kk4 < 4; ++kk4) fa[kk4] = HG_LD(HL_A + (16 * tt + fr) * 272 + (32 * kk4 + 8 * g4) * 2);
#pragma unroll
            for (int nh = 0; nh < 2; ++nh) {
                bf16x8 fv[2][2], fs[2][4];
#pragma unroll
                for (int n2 = 0; n2 < 2; ++n2) { const int vrow = 16 * (4 * vh + 2 * nh + n2) + fr;
#pragma unroll
                    for (int ks = 0; ks < 2; ++ks) fv[n2][ks] = HG_LD(HL_VT + vrow * 144 + (32 * ks + 8 * g4) * 2);
#pragma unroll
                    for (int kk4 = 0; kk4 < 4; ++kk4) fs[n2][kk4] = HG_LD(HL_ST + vrow * 272 + (32 * kk4 + 8 * g4) * 2); }
                HG_FENCE();
#pragma unroll
                for (int ks = 0; ks < 2; ++ks)
#pragma unroll
                    for (int n2 = 0; n2 < 2; ++n2) o[2 * nh + n2] = __builtin_amdgcn_mfma_f32_16x16x32_bf16(fv[n2][ks], fat[ks], o[2 * nh + n2], 0, 0, 0);
#pragma unroll
                for (int kk4 = 0; kk4 < 4; ++kk4)
#pragma unroll
                    for (int n2 = 0; n2 < 2; ++n2) o[2 * nh + n2] = __builtin_amdgcn_mfma_f32_16x16x32_bf16(fs[n2][kk4], fa[kk4], o[2 * nh + n2], 0, 0, 0);
            }
        }
        { float ssq = 0.f;
#pragma unroll
          for (int n = 0; n < 4; ++n) ssq += o[n][0] * o[n][0] + o[n][1] * o[n][1] + o[n][2] * o[n][2] + o[n][3] * o[n][3];
          ssq += __shfl_xor(ssq, 16); ssq += __shfl_xor(ssq, 32); if (g4 == 0) lss[vh * 64 + 16 * tt + fr] = ssq; }
        {
            f32x4 U[8]; bf16x8 fbt[2], fv[8][2];
#pragma unroll
            for (int ks = 0; ks < 2; ++ks) { fbt[ks] = HG_LD(HL_BT + (16 * wid + fr) * 144 + (32 * ks + 8 * g4) * 2);
#pragma unroll
                for (int n = 0; n < 8; ++n) fv[n][ks] = HG_LD(HL_VT + (16 * n + fr) * 144 + (32 * ks + 8 * g4) * 2); }
            HG_FENCE();
#pragma unroll
            for (int n = 0; n < 8; ++n) { U[n] = __builtin_amdgcn_mfma_f32_16x16x32_bf16(fbt[0], fv[n][0], (f32x4){0.f, 0.f, 0.f, 0.f}, 0, 0, 0); }
#pragma unroll
            for (int n = 0; n < 8; ++n) { U[n] = __builtin_amdgcn_mfma_f32_16x16x32_bf16(fbt[1], fv[n][1], U[n], 0, 0, 0); }
            f32x4 el, elm;
#pragma unroll
            for (int i = 0; i < 4; ++i) { el[i] = __expf(blast[i]); elm[i] = __expf(blast[i] - bmid[i]); }
#pragma unroll
            for (int n = 0; n < 8; ++n) S[n] = S[n] * el + U[n] * elm;
        }
#undef HG_LD
#undef HG_FENCE
        HG_BAR();
        HG_T(4);
        {
            const int t = 16 * tt + fr; const float rstd = rsqrtf((lss[t] + lss[64 + t]) * (1.f / 128.f) + 1e-6f);
            const size_t trow = (size_t)b * SEQ + t0 + t; bf16_t* op = oa + trow * 1024 + h * 128;
#pragma unroll
            for (int n = 0; n < 4; ++n) { const int v0 = 16 * (4 * vh + n) + 4 * g4; const u32x2 gg = gpre[n]; const f32x4 nw = nwv[n];
                f32x4 r; r[0] = o[n][0] * rstd * nw[0] * bf2f(gg.x & 0xffffu); r[1] = o[n][1] * rstd * nw[1] * bf2f(gg.x >> 16);
                r[2] = o[n][2] * rstd * nw[2] * bf2f(gg.y & 0xffffu); r[3] = o[n][3] * rstd * nw[3] * bf2f(gg.y >> 16); store4bf(op + v0, r); }
        }
        HG_T(5);
    }
#if defined(TPROBE_A)
    if (blockIdx.x == 0 && threadIdx.x == 0) { unsigned long long* ts = (unsigned long long*)(p.ws + WS_TS); for (int k = 0; k < 6; ++k) { ts[20 + 2 * k] = 0; ts[21 + 2 * k] = tacc[k]; } }
#endif
    HG_BAR();
}
#undef HG_BAR
DEVI void conv_tile256(const float* colp, size_t rs, const float* kscale, bf16_t* dst, int ldk, float* scr) {
    const int tid = threadIdx.x;
    { const int nl = tid & 63, kq = tid >> 6;
      float v[32];
#pragma unroll
      for (int i = 0; i < 32; ++i) v[i] = colp[(size_t)(kq * 32 + i) * rs];
      if (kscale) {
#pragma unroll
          for (int i = 0; i < 32; ++i) v[i] *= kscale[kq * 32 + i]; }
#pragma unroll
      for (int i = 0; i < 32; ++i) scr[(kq * 32 + i) * 65 + nl] = v[i]; }
    __syncthreads();
    { const int nl = tid >> 3, kc = tid & 7;
#pragma unroll
      for (int j = 0; j < 4; ++j) { const float* s_ = scr + (kc * 8 + 64 * j) * 65 + nl;
          u32x4 o; o.x = pk2(s_[0], s_[65]); o.y = pk2(s_[2 * 65], s_[3 * 65]); o.z = pk2(s_[4 * 65], s_[5 * 65]); o.w = pk2(s_[6 * 65], s_[7 * 65]);
          *(u32x4*)(dst + (size_t)nl * ldk + kc * 8 + 64 * j) = o; } }
    __syncthreads();
}
DEVI void conv_tile256_f8(const float* colp4, size_t rs, const float* kscale, float wscale, unsigned char* dst, int ldk, float* scr) {
    const int tid = threadIdx.x;
    { const int n4 = tid & 15, kr = tid >> 4; f32x4 v[8];
#pragma unroll
      for (int i = 0; i < 8; ++i) v[i] = *(const f32x4*)(colp4 + (size_t)(kr + 32 * i) * rs);
#pragma unroll
      for (int i = 0; i < 8; ++i) { const float sc = kscale ? kscale[kr + 32 * i] * wscale : wscale; float* d = scr + (kr + 32 * i) * 65 + 4 * n4; d[0] = v[i][0] * sc; d[1] = v[i][1] * sc; d[2] = v[i][2] * sc; d[3] = v[i][3] * sc; } }
    __syncthreads();
    { const int nl = tid >> 3, kc = tid & 7;
#pragma unroll
      for (int j = 0; j < 4; ++j) { const float* s_ = scr + (kc * 8 + 64 * j) * 65 + nl;
          u32x2 o; o.x = pk4_fp8(s_[0], s_[65], s_[2 * 65], s_[3 * 65]); o.y = pk4_fp8(s_[4 * 65], s_[5 * 65], s_[6 * 65], s_[7 * 65]);
          *(u32x2*)(dst + (size_t)nl * ldk + kc * 8 + 64 * j) = o; } }
    __syncthreads();
}
DEVI void mla_prep(const Params& p, int chunk) {
    bf16_t* zl = (bf16_t*)(p.ws + WS_ZL); float* cosT = (float*)(p.ws + WS_COS); float* sinT = (float*)(p.ws + WS_SIN); const int* posp = (const int*)ptab(p.ws, PT_POS);
    const int lane = threadIdx.x & 63, wid = threadIdx.x >> 6;
    for (int rr = wid; rr < 256; rr += 8) { const size_t t = (size_t)chunk * 256 + rr; bf16_t* zr = zl + t * ZL_P;
        float cq[6], ck[4]; float s = 0.f, s2 = 0.f;
#pragma unroll
        for (int j = 0; j < 6; ++j) { cq[j] = bf2f(zr[lane + 64 * j]); s += cq[j] * cq[j]; }
#pragma unroll
        for (int j = 0; j < 4; ++j) { ck[j] = bf2f(zr[384 + lane + 64 * j]); s2 += ck[j] * ck[j]; }
        const float kr = bf2f(zr[640 + lane]);
        const float r1 = rsqrtf(wave_sum(s) * (1.f / 384.f) + 1e-6f), r2 = rsqrtf(wave_sum(s2) * (1.f / 256.f) + 1e-6f);
        const float other = __shfl_xor(kr, 32);
        const int i = lane & 31; const float invf = powf(10000.f, -(float)i / 32.f); const float ang = (float)posp[t] * invf; const float cs = cosf(ang), sn = sinf(ang);
        const float x1 = lane < 32 ? kr : other, x2 = lane < 32 ? other : kr;
        const float outv = lane < 32 ? (x1 * cs - x2 * sn) : (x2 * cs + x1 * sn);
#pragma unroll
        for (int j = 0; j < 6; ++j) zr[lane + 64 * j] = (bf16_t)f2bf(cq[j] * r1);
#pragma unroll
        for (int j = 0; j < 4; ++j) zr[384 + lane + 64 * j] = (bf16_t)f2bf(ck[j] * r2);
        ((bf16_t*)(p.ws + WS_KPE))[t * 64 + 2 * i + (lane >> 5)] = (bf16_t)f2bf(outv);
        if (lane < 32) { cosT[t * 32 + i] = cs; sinT[t * 32 + i] = sn; }
    }
}
constexpr int N13_EARLY = 2432;
DEVI void w13_tile(unsigned char* ws, const float* ew1, const float* ew3, const float* ffnw, int ci, int nl, float* scr) {
    const int e = ci >> 6, r = ci & 63, nb = r >> 2, kb = r & 3, n = nb * 64 + 4 * (nl & 15);
    const float* colp = ((n & 4) ? ew3 : ew1) + (size_t)e * 1024 * 512 + (size_t)(kb * 256) * 512 + (n >> 3) * 4;
    conv_tile256_f8(colp, 512, ffnw + kb * 256, 64.f, ws + WS_W13 + ((size_t)e * 1024 + nb * 64) * 1024 + kb * 256, 1024, scr);
}
DEVI void phase2a(const Params& p, char* lds, bool prep = true) {
#pragma unroll 1
    for (int it = blockIdx.x; it < 128; it += gridDim.x) {
        hgrn_chain_mfma(p, lds, it >> 3, it & 7);
#if defined(TPROBE_A)
        if (TPROBE_A == 12 && blockIdx.x == 0 && threadIdx.x == 0) ((unsigned long long*)(p.ws + WS_TS))[13] = __builtin_amdgcn_s_memrealtime();
#endif
    }
#pragma unroll 1
    for (int it = blockIdx.x; it < 256; it += gridDim.x) { if (it < 128) continue;
        if (prep) mla_prep(p, it - 128);
        const float* ew1 = (const float*)ptab(p.ws, PT_EW1); const float* ew3 = (const float*)ptab(p.ws, PT_EW3); const float* ffnw = (const float*)ptab(p.ws, PT_FFNW); const int nl = threadIdx.x & 63;
        __syncthreads();
#pragma unroll 1
        for (int ci = it - 128; ci < N13_EARLY; ci += 128) w13_tile(p.ws, ew1, ew3, ffnw, ci, nl, (float*)lds);
    }
}

DEVI void phase2b(const Params& p, char* lds) {
    unsigned char* ws = p.ws;
    { g8::DenseOrder S; S.init(ws + WS_ZL, ZL_P, ws + WS_WUQ, 384, T, 1536);
      g8::Epi4<EpiQ> E{{(bf16_t*)(ws + WS_Q)}};
      g8::gemm_phase<g8::Epi4<EpiQ>, g8::DenseOrder, true>((G8_LAS unsigned char*)lds, ZL_P, 384, 384, S, E); }
    { g8::DenseOrder S; S.init(ws + WS_ZL + 384 * 2, ZL_P, ws + WS_WUKV, 256, T, 2048);
      g8::Epi4<EpiKV> E{{(bf16_t*)(ws + WS_KN), (bf16_t*)(ws + WS_V)}};
      g8::gemm_phase<g8::Epi4<EpiKV>, g8::DenseOrder, true>((G8_LAS unsigned char*)lds, ZL_P, 256, 256, S, E); }
}

namespace at2 {
typedef short s16x4 __attribute__((ext_vector_type(4)));
typedef float f32x16 __attribute__((ext_vector_type(16)));
constexpr int KROW = 384;
constexpr int SHM_K = 64 * KROW, SHM_V = 64 * 256;
constexpr int L_V = 0, L_K = 3 * SHM_V, L_WS = 3 * SHM_V + 2 * SHM_K;
constexpr float THR = 8.f;
#define AT_KSWZ(row, colB) ((row) * at2::KROW + ((colB) ^ (((row) & 7) << 4)))
DEVI int v_st(int k, int c) { const int kk = (k & ~0xC) | ((k & 4) << 1) | ((k & 8) >> 1); return ((kk >> 3) * 4 + (c >> 5)) * 512 + ((kk & 7) * 32 + (c & 31)) * 2; }
DEVI int v_rd_base(int lane) { return ((lane & 3) << 3) | (((lane >> 2) & 3) << 6) | (((lane >> 4) & 1) << 5) | (((lane >> 5) & 1) << 8); }
constexpr int v_rd_off(int d0, int ks, int half) { return d0 * 512 + ks * 4096 + half * 2048; }
DEVI int crow(int r, int hi) { return (r & 3) + 8 * (r >> 2) + 4 * hi; }
DEVI unsigned cvtpk(float lo, float hi) { unsigned r; asm volatile("v_cvt_pk_bf16_f32 %0, %1, %2" : "=v"(r) : "v"(lo), "v"(hi)); return r; }
DEVI void mask_tile(f32x16& p0, f32x16& p1, int dq) {
    const float NEG = -__builtin_inff();
#pragma unroll
    for (int r = 0; r < 16; ++r) { const int c = (r & 3) + 8 * (r >> 2); if (dq - c < 0) p0[r] = NEG; if (dq - c - 32 < 0) p1[r] = NEG; }
}
DEVI void partialSM(f32x16& p0, f32x16& p1, float& m_reg, float& mn, float& alpha) {
    float pmax = p0[0];
#pragma unroll
    for (int r = 1; r < 16; ++r) pmax = fmaxf(pmax, p0[r]);
#pragma unroll
    for (int r = 0; r < 16; ++r) pmax = fmaxf(pmax, p1[r]);
    { auto rr = __builtin_amdgcn_permlane32_swap(__float_as_uint(pmax), __float_as_uint(pmax), false, false); pmax = fmaxf(__uint_as_float(rr[0]), __uint_as_float(rr[1])); }
    constexpr float C2 = 1.4426950408889634f;
    if (__builtin_expect(__all((pmax - m_reg) <= THR), 1)) { mn = m_reg; alpha = 1.f; }
    else { mn = fmaxf(m_reg, pmax); alpha = __builtin_amdgcn_exp2f((m_reg - mn) * C2); m_reg = mn; }
    const float mnL = -mn * C2;
#pragma unroll
    for (int r = 0; r < 16; ++r) p0[r] = fmaf(p0[r], C2, mnL);
#pragma unroll
    for (int r = 0; r < 16; ++r) p1[r] = fmaf(p1[r], C2, mnL);
#pragma unroll
    for (int r = 0; r < 16; ++r) p0[r] = __builtin_amdgcn_exp2f(p0[r]);
}
DEVI void finishSM(f32x16& p0, f32x16& p1, float alpha, float& l_reg, bf16x8& pa0, bf16x8& pa1, bf16x8& pa2, bf16x8& pa3) {
#pragma unroll
    for (int r = 0; r < 16; ++r) p1[r] = __builtin_amdgcn_exp2f(p1[r]);
    float ps = 0;
#pragma unroll
    for (int r = 0; r < 16; ++r) ps += p0[r];
#pragma unroll
    for (int r = 0; r < 16; ++r) ps += p1[r];
    { auto rr = __builtin_amdgcn_permlane32_swap(__float_as_uint(ps), __float_as_uint(ps), false, false); ps = __uint_as_float(rr[0]) + __uint_as_float(rr[1]); }
    l_reg = l_reg * alpha + ps;
#define AT_PK4(P, B_, OUT) do { unsigned a0 = cvtpk(P[B_+0], P[B_+1]), a1 = cvtpk(P[B_+2], P[B_+3]); unsigned b0 = cvtpk(P[B_+4], P[B_+5]), b1 = cvtpk(P[B_+6], P[B_+7]); \
        auto r0 = __builtin_amdgcn_permlane32_swap(a0, b0, false, false); auto r1 = __builtin_amdgcn_permlane32_swap(a1, b1, false, false); \
        u32x4 w = {r0[0], r1[0], r0[1], r1[1]}; OUT = *reinterpret_cast<bf16x8*>(&w); } while (0)
    AT_PK4(p0, 0, pa0); AT_PK4(p0, 8, pa1); AT_PK4(p1, 0, pa2); AT_PK4(p1, 8, pa3);
#undef AT_PK4
}
template <int KB>
DEVI void qkt(f32x16& p0, f32x16& p1, const char* K_lds, int r32, int hi, const bf16x8* qr) {
    p0 = f32x16{}; p1 = f32x16{};
    const char* kb[4];
#pragma unroll
    for (int dd = 0; dd < 4; ++dd) kb[dd] = K_lds + KB * SHM_K + AT_KSWZ(r32, (dd * 16 + hi * 8) * 2);
#pragma unroll
    for (int d0 = 0; d0 < 12; ++d0) { const char* a = kb[d0 & 3] + (d0 >> 2) * 128;
        const bf16x8 b0 = *reinterpret_cast<const bf16x8*>(a); const bf16x8 b1 = *reinterpret_cast<const bf16x8*>(a + 32 * KROW);
        p0 = __builtin_amdgcn_mfma_f32_32x32x16_bf16(b0, qr[d0], p0, 0, 0, 0); p1 = __builtin_amdgcn_mfma_f32_32x32x16_bf16(b1, qr[d0], p1, 0, 0, 0); }
}
DEVI void pv_tile(f32x16* o, int vb0, bf16x8 pa0, bf16x8 pa1, bf16x8 pa2, bf16x8 pa3) {
#define AT_TRRD(dst, off) asm volatile("ds_read_b64_tr_b16 %0, %1 offset:%2" : "=&v"(dst) : "v"(vb0), "i"(off) : "memory")
#define AT_PV_D0(d0) do { s16x4 l0, l1, l2, l3, h0, h1, h2, h3; constexpr int b_ = v_rd_off(d0, 0, 0); \
        AT_TRRD(l0, b_); AT_TRRD(h0, b_ + 2048); AT_TRRD(l1, b_ + 4096); AT_TRRD(h1, b_ + 6144); AT_TRRD(l2, b_ + 8192); AT_TRRD(h2, b_ + 10240); AT_TRRD(l3, b_ + 12288); AT_TRRD(h3, b_ + 14336); \
        asm volatile("s_waitcnt lgkmcnt(0)" ::: "memory"); __builtin_amdgcn_sched_barrier(0); \
        o[d0] = __builtin_amdgcn_mfma_f32_32x32x16_bf16(pa0, (bf16x8){l0[0], l0[1], l0[2], l0[3], h0[0], h0[1], h0[2], h0[3]}, o[d0], 0, 0, 0); \
        o[d0] = __builtin_amdgcn_mfma_f32_32x32x16_bf16(pa1, (bf16x8){l1[0], l1[1], l1[2], l1[3], h1[0], h1[1], h1[2], h1[3]}, o[d0], 0, 0, 0); \
        o[d0] = __builtin_amdgcn_mfma_f32_32x32x16_bf16(pa2, (bf16x8){l2[0], l2[1], l2[2], l2[3], h2[0], h2[1], h2[2], h2[3]}, o[d0], 0, 0, 0); \
        o[d0] = __builtin_amdgcn_mfma_f32_32x32x16_bf16(pa3, (bf16x8){l3[0], l3[1], l3[2], l3[3], h3[0], h3[1], h3[2], h3[3]}, o[d0], 0, 0, 0); } while (0)
    AT_PV_D0(0); AT_PV_D0(1); AT_PV_D0(2); AT_PV_D0(3);
#undef AT_PV_D0
#undef AT_TRRD
}
DEVI void block(const Params& p, char* lds, int b, int h, int qb) {
    const bf16_t* q = (const bf16_t*)(p.ws + WS_Q); const bf16_t* kn = (const bf16_t*)(p.ws + WS_KN); const bf16_t* vg = (const bf16_t*)(p.ws + WS_V);
    const bf16_t* kpe = (const bf16_t*)(p.ws + WS_KPE); bf16_t* ob = (bf16_t*)(p.ws + WS_OB);
    const int tid = threadIdx.x, wid = __builtin_amdgcn_readfirstlane(tid >> 6), lane = tid & 63, r32 = lane & 31, hi = lane >> 5;
    const size_t tb = (size_t)b * SEQ; const int P0 = qb * 256, NT = (P0 + 256) / 64;
    char* V_lds = lds + L_V; char* K_lds = lds + L_K; float* ws = (float*)(lds + L_WS) + wid * 64; float* li_l = ws; float* al_l = ws + 32;
    const int qlo = P0 + wid * 32, qm = qlo + r32 - 4 * hi;
    const int sr = tid >> 4, sc = (tid & 15) * 8, vst0 = v_st(sr, sc), vst1 = v_st(32 + sr, sc);
    const int kd0 = AT_KSWZ(sr, sc * 2), kd2 = AT_KSWZ(tid >> 3, 256 + (tid & 7) * 16);
    const bf16_t* knp = kn + (tb + sr) * 1024 + h * 128 + sc; const bf16_t* vp = vg + (tb + sr) * 1024 + h * 128 + sc; const bf16_t* kpp = kpe + (tb + (tid >> 3)) * 64 + (tid & 7) * 8;
    const int vb0 = (int)(uintptr_t)V_lds + v_rd_base(lane);
    bf16x8 stk[3], stv[2];
#define AT_LOAD(t_) do { const size_t o_ = (size_t)(t_) * 64; stk[0] = *(const bf16x8*)(knp + o_ * 1024); stk[1] = *(const bf16x8*)(knp + (o_ + 32) * 1024); stk[2] = *(const bf16x8*)(kpp + o_ * 64); \
        stv[0] = *(const bf16x8*)(vp + o_ * 1024); stv[1] = *(const bf16x8*)(vp + (o_ + 32) * 1024); } while (0)
#define AT_WRITE(bf, voff) do { *(bf16x8*)(K_lds + (bf) * SHM_K + kd0) = stk[0]; *(bf16x8*)(K_lds + (bf) * SHM_K + kd0 + 32 * KROW) = stk[1]; *(bf16x8*)(K_lds + (bf) * SHM_K + kd2) = stk[2]; \
        *(bf16x8*)(V_lds + (voff) + vst0) = stv[0]; *(bf16x8*)(V_lds + (voff) + vst1) = stv[1]; } while (0)
    AT_LOAD(0);
    bf16x8 qr[12];
    { const bf16_t* qrow = q + (tb + qlo + r32) * 1536 + h * 192;
#pragma unroll
      for (int d0 = 0; d0 < 12; ++d0) qr[d0] = *(const bf16x8*)(qrow + d0 * 16 + hi * 8);
      int r32o = r32; asm volatile("" : "+v"(r32o));
      const float* cosT = (const float*)(p.ws + WS_COS) + (tb + qlo + r32o) * 32; const float* sinT = cosT + (WS_SIN - WS_COS) / 4;
#pragma unroll
      for (int d0 = 8; d0 < 12; ++d0) { const f32x4 cs = *(const f32x4*)(cosT + 8 * (d0 - 8) + 4 * hi), sn = *(const f32x4*)(sinT + 8 * (d0 - 8) + 4 * hi); u32x4 w = __builtin_bit_cast(u32x4, qr[d0]);
#pragma unroll
          for (int jj = 0; jj < 4; ++jj) { const float x1 = bf2f(w[jj] & 0xffffu), x2 = bf2f(w[jj] >> 16); w[jj] = pk2(x1 * cs[jj] - x2 * sn[jj], x2 * cs[jj] + x1 * sn[jj]); }
          qr[d0] = __builtin_bit_cast(bf16x8, w); asm volatile("" ::: "memory"); } }
    float m_reg = -1e30f, l_reg = 0.f; f32x16 o[4] = {};
    __syncthreads();
    AT_WRITE(0, 0);
    __syncthreads();
    const bool skew = wid >= 4; int vprev = 2 * SHM_V, vcur = 0, vnext = SHM_V; bf16x8 pp0, pp1, pp2, pp3;
#define AT_RESC(a) do { if (__any((a) < 1.f)) { if (hi == 0) al_l[r32] = (a); asm volatile("s_waitcnt lgkmcnt(0)" ::: "memory"); \
        _Pragma("unroll") for (int d_ = 0; d_ < 4; ++d_) _Pragma("unroll") for (int r = 0; r < 16; ++r) o[d_][r] *= al_l[crow(r, hi)]; } } while (0)
#define AT_STEP(t_, BF) do { const int tq = (t_); if (tq + 1 < NT) AT_LOAD(tq + 1); \
        if (skew && tq > 0) pv_tile(o, vb0 + vprev, pp0, pp1, pp2, pp3); \
        { f32x16 p0, p1; float mn, al; \
          qkt<BF>(p0, p1, K_lds, r32, hi, qr); \
          { const int kb_ = tq * 64; if (kb_ + 63 > qlo) mask_tile(p0, p1, qm - kb_); } \
          partialSM(p0, p1, m_reg, mn, al); finishSM(p0, p1, al, l_reg, pp0, pp1, pp2, pp3); AT_RESC(al); } \
        if (!skew) pv_tile(o, vb0 + vcur, pp0, pp1, pp2, pp3); \
        if (tq + 1 < NT) AT_WRITE(1 - BF, vnext); \
        vprev = vcur; vcur = vnext; vnext = (vnext == 2 * SHM_V) ? 0 : vnext + SHM_V; \
        __syncthreads(); } while (0)
#pragma unroll 1
    for (int t = 0; t < NT; t += 2) { AT_STEP(t, 0); AT_STEP(t + 1, 1); }
    if (skew) pv_tile(o, vb0 + vprev, pp0, pp1, pp2, pp3);
    if (hi == 0) li_l[r32] = l_reg;
    asm volatile("s_waitcnt lgkmcnt(0)" ::: "memory");
    float rli[16];
#pragma unroll
    for (int r = 0; r < 16; ++r) rli[r] = __builtin_amdgcn_rcpf(li_l[crow(r, hi)]);
    bf16_t* Ow = ob + (tb + qlo) * 1024 + h * 128;
#pragma unroll
    for (int r = 0; r < 16; ++r) { const int orow = crow(r, hi);
#pragma unroll
        for (int d0 = 0; d0 < 4; ++d0) { const float v = o[d0][r] * rli[r]; const float vn = __shfl_xor(v, 1);
            if ((r32 & 1) == 0) *(unsigned*)(Ow + (size_t)orow * 1024 + d0 * 32 + r32) = cvtpk(v, vn); } }
#undef AT_LOAD
#undef AT_WRITE
#undef AT_RESC
#undef AT_STEP
}
}
DEVI void phase3(const Params& p, char* lds) {
    const int G_ = (int)gridDim.x, vcu = (G_ % 8 == 0) ? ((int)blockIdx.x % 8) * (G_ / 8) + (int)blockIdx.x / 8 : (int)blockIdx.x;
#pragma unroll 1
    for (int it2 = vcu * 2; it2 < 1024; it2 += (it2 & 1) ? 2 * G_ - 1 : 1) { const int it = it2 >> 1, bh = it >> 2, x = it & 3;
        at2::block(p, lds, bh >> 3, bh & 7, (it2 & 1) ? x : 7 - x); }
    __syncthreads();
}

DEVI void phase4(const Params& p, char* lds) {
    unsigned char* ws = p.ws; const unsigned char* zg = ws + WS_ZG;
    g8::DenseOrder S; S.init(ws + WS_OA, 1024, ws + WS_WBR, 2048, T, 1024);
    g8::Epi4<EpiBr2> E{{zg, (bf16_t*)(ws + WS_Y)}}; g8::Hook4<BrHookF> H{{zg}};
    g8::gemm_phase<g8::Epi4<EpiBr2>, g8::DenseOrder, true, g8::Hook4<BrHookF>>((G8_LAS unsigned char*)lds, 1024, 2048, 2048, S, E, nullptr, H, 16, (long)WS_OB - (long)WS_OA - 16 * 128);
}
DEVI void phase5(const Params& p, char* lds) {
    unsigned char* ws = p.ws;
    g8::DenseOrder S; S.init(ws + WS_Y, 1024, ws + WS_WOUT, 1024, T, 1024);
    g8::Epi4<EpiOut> E{{(const float*)ptab(ws, PT_X), (bf16_t*)(ws + WS_X2B), ws + WS_X2F8}};
#if defined(TPROBE_A) && defined(TPROBE_GEMM) && TPROBE_GEMM == 6
    g8::gemm_phase<g8::Epi4<EpiOut>, g8::DenseOrder, true>((G8_LAS unsigned char*)lds, 1024, 1024, 1024, S, E, (unsigned long long*)(ws + WS_TS) + 20);
#else
    g8::gemm_phase<g8::Epi4<EpiOut>, g8::DenseOrder, true>((G8_LAS unsigned char*)lds, 1024, 1024, 1024, S, E);
#endif
}

constexpr size_t RT_SRS = RT_ST, RT_RS = 1888 * 1024;
DEVI void phase6a(const Params& p, char* lds, bool router = true) {
    unsigned char* ws = p.ws; float* scr = (float*)lds;
    const float* ew1 = (const float*)ptab(ws, PT_EW1); const float* ew3 = (const float*)ptab(ws, PT_EW3); const float* ew2 = (const float*)ptab(ws, PT_EW2); const float* ffnw = (const float*)ptab(ws, PT_FFNW);
    const float* rgb = (const float*)ptab(ws, PT_RGB); const float* reb = (const float*)ptab(ws, PT_REB);
    unsigned char* W2 = ws + WS_W2;
    for (int ci = N13_EARLY + blockIdx.x; ci < NEXP * 64; ci += gridDim.x) w13_tile(ws, ew1, ew3, ffnw, ci, threadIdx.x & 63, scr);
    constexpr int I2 = 2 * 16;
    for (int it = blockIdx.x; it < NEXP * I2; it += gridDim.x) { const int e = it / I2, r = it % I2, nb = r >> 1, kb = r & 1, nl = threadIdx.x & 63;
        conv_tile256_f8(ew2 + (size_t)e * 512 * 1024 + (size_t)(kb * 256) * 1024 + nb * 64 + 4 * (nl & 15), 1024, nullptr, 64.f, W2 + ((size_t)e * 1024 + nb * 64) * EFF + kb * 256, EFF, scr); }
    __syncthreads();
#if defined(TPROBE_A)
    if (TPROBE_A == 17 && blockIdx.x == 0 && threadIdx.x == 0) ((unsigned long long*)(p.ws + WS_TS))[13] = __builtin_amdgcn_s_memrealtime();
#endif
    if (!router) return;
    const bf16_t* WrH = (const bf16_t*)(ws + WS_WRT); const bf16_t* WrL = WrH + 80 * 1024; const bf16_t* X2B = (const bf16_t*)(ws + WS_X2B);
    int* AE = (int*)(ws + WS_ROUTE + RT_AE); int* AP = (int*)(ws + WS_ROUTE + RT_AP); float* AW = (float*)(ws + WS_ROUTE + RT_AW); float* RS = (float*)(ws + WS_ROUTE + RT_RS);
    unsigned* cnt = (unsigned*)(ws + WS_CTL) + CW_CNT;
    const int tid = threadIdx.x, lane = tid & 63, wid = tid >> 6, fr = lane & 15, g4 = lane >> 4;
    constexpr int WL_ROW = 528, WL_ARR = 80 * WL_ROW, WL_BYTES = 2 * WL_ARR;
    float* lgw = (float*)(lds + WL_BYTES) + wid * (16 * 84 + 16);
    for (int g0 = blockIdx.x * 8; g0 < T / 16; g0 += gridDim.x * 8) {
        const int grp = g0 + wid;
        const size_t t0 = (size_t)grp * 16; const bf16_t* xrow = X2B + (t0 + fr) * 1024 + 8 * g4;
        f32x4 acc[5]; float ssq = 0.f;
#pragma unroll
        for (int n = 0; n < 5; ++n) acc[n] = (f32x4){0.f, 0.f, 0.f, 0.f};
#pragma unroll 1
        for (int kq = 0; kq < 4; ++kq) {
            bf16x8 xa[8];
#pragma unroll
            for (int kk = 0; kk < 8; ++kk) xa[kk] = *(const bf16x8*)(xrow + kq * 256 + 32 * kk);
            __syncthreads();
#pragma unroll
            for (int j = 0; j < 5; ++j) { const int row = (tid >> 5) + 16 * j, ch = tid & 31; const size_t so = (size_t)row * 1024 + kq * 256 + ch * 8; const int dof = row * WL_ROW + ch * 16;
                *(u32x4*)(lds + dof) = *(const u32x4*)(WrH + so); *(u32x4*)(lds + WL_ARR + dof) = *(const u32x4*)(WrL + so); }
            __syncthreads();
#pragma unroll
            for (int kk = 0; kk < 8; ++kk) {
                const bf16x8 ah = xa[kk];
#pragma unroll
                for (int j = 0; j < 8; ++j) { const float xv = bf2f((unsigned)(unsigned short)ah[j]); ssq += xv * xv; }
#pragma unroll
                for (int n = 0; n < 5; ++n) { const bf16x8 bh = *(const bf16x8*)(lds + (16 * n + fr) * WL_ROW + (32 * kk + 8 * g4) * 2), bl = *(const bf16x8*)(lds + WL_ARR + (16 * n + fr) * WL_ROW + (32 * kk + 8 * g4) * 2);
                    acc[n] = __builtin_amdgcn_mfma_f32_16x16x32_bf16(ah, bh, acc[n], 0, 0, 0); acc[n] = __builtin_amdgcn_mfma_f32_16x16x32_bf16(ah, bl, acc[n], 0, 0, 0); }
            }
        }
        ssq += __shfl_xor(ssq, 16); ssq += __shfl_xor(ssq, 32);
        const float rstd = rsqrtf(ssq * (1.f / D) + 1e-6f);
        if (g4 == 0) lgw[16 * 84 + fr] = rstd;
#pragma unroll
        for (int n = 0; n < 5; ++n)
#pragma unroll
            for (int i = 0; i < 4; ++i) lgw[(4 * g4 + i) * 84 + 16 * n + fr] = acc[n][i];
        asm volatile("s_waitcnt lgkmcnt(0)" ::: "memory");
        int ea = 0, eb = 0;
        if (lane < 16) { const float* lg = lgw + lane * 84; const float rs = lgw[16 * 84 + lane]; const size_t t = t0 + lane;
            int g = 0; float glv[8]; glv[0] = lg[0] * rs + rgb[0]; float gbest = glv[0];
#pragma unroll
            for (int j = 1; j < 8; ++j) { glv[j] = lg[j] * rs + rgb[j]; if (glv[j] > gbest) { gbest = glv[j]; g = j; } }
            float gs = 0.f;
#pragma unroll
            for (int j = 0; j < 8; ++j) gs += expf(glv[j] - gbest);
            const float gwt = 1.f / gs;
            int e1 = 0, e2 = 0; float b1 = -__builtin_inff(), b2 = -__builtin_inff();
            for (int j = 0; j < 8; ++j) { const float v = lg[8 + g * 8 + j] * rs + reb[g * 8 + j];
                if (v > b1) { b2 = b1; e2 = e1; b1 = v; e1 = j; } else if (v > b2) { b2 = v; e2 = j; } }
            const float d = expf(b2 - b1); const float w1 = 1.f / (1.f + d), w2 = d / (1.f + d);
            ea = g * 8 + e1; eb = g * 8 + e2;
            AE[2 * t] = ea; AE[2 * t + 1] = eb; AW[2 * t] = gwt * w1; AW[2 * t + 1] = gwt * w2; RS[t] = rs;
        }
        int* lcnt = (int*)(lds + WL_BYTES + 8 * (16 * 84 + 16) * 4); int* lbase = lcnt + 64;
        __syncthreads();
        if (tid < 64) lcnt[tid] = 0;
        __syncthreads();
        int ra = 0, rb = 0;
        if (lane < 16) { ra = atomicAdd(lcnt + ea, 1); rb = atomicAdd(lcnt + eb, 1); }
        __syncthreads();
        if (tid < 64) { const int c = lcnt[tid]; lbase[tid] = c ? (int)atomicAdd(cnt + tid * CNT_STRIDE, (unsigned)c) : 0; }
        __syncthreads();
        if (lane < 16) { const size_t t = t0 + lane; AP[2 * t] = lbase[ea] + ra; AP[2 * t + 1] = lbase[eb] + rb; }
    }
}
DEVI int build_prefix(const Params& p, int* li) {
    const unsigned* cnt = (const unsigned*)(p.ws + WS_CTL) + CW_CNT;
    __syncthreads();
    if (threadIdx.x < NEXP) li[400 + threadIdx.x] = (int)cnt[threadIdx.x * CNT_STRIDE];
    __syncthreads();
    if (threadIdx.x == 0) { int acc = 0; for (int e = 0; e < NEXP; ++e) { li[e] = acc; const int c = li[400 + e]; const int pd = (c + 255) & ~255; for (int tt = acc / 256; tt < (acc + pd) / 256; ++tt) li[80 + tt] = e; acc += pd; } li[64] = acc; }
    __syncthreads();
    return li[64] / 256;
}
DEVI void phase6b(const Params& p, char* lds) {
    unsigned char* ws = p.ws; int* li = (int*)lds; build_prefix(p, li);
    const int* AE = (const int*)(ws + WS_ROUTE + RT_AE); const int* AP = (const int*)(ws + WS_ROUTE + RT_AP); const float* AW = (const float*)(ws + WS_ROUTE + RT_AW);
    int* AS = (int*)(ws + WS_ROUTE + RT_AS); float* SW = (float*)(ws + WS_ROUTE + RT_SW); float* SRS = (float*)(ws + WS_ROUTE + RT_SRS); const float* RS = (const float*)(ws + WS_ROUTE + RT_RS);
    int* TOK = (int*)(ws + WS_TOK);
    for (int a = blockIdx.x * NTHR + threadIdx.x; a < 2 * T; a += gridDim.x * NTHR) { const int slot = li[AE[a]] + AP[a]; AS[a] = slot; SW[slot] = AW[a]; SRS[slot] = RS[a >> 1]; TOK[slot] = a >> 1; }
    for (int e = blockIdx.x; e < NEXP; e += gridDim.x) { const int c = li[400 + e], pd = (c + 255) & ~255;
        for (int s_ = c + threadIdx.x; s_ < pd; s_ += NTHR) { const int slot = li[e] + s_; SW[slot] = 0.f; SRS[slot] = 0.f; TOK[slot] = 0; } }
}
struct MoeOrder { const char* A; const char* W; size_t a_tile, w_exp, w_pn; const int* tile_e; int nunits; const int* tok;
    DEVI bool next(int i, g8::Unit& u) const { const int G = (int)gridDim.x, bx = (int)blockIdx.x; const int L = (G % 8 == 0) ? (i * 8 + (bx & 7)) * (G >> 3) + (bx >> 3) : i * G + bx;
        if (L >= nunits) return false; const int tile = L >> 2, pn = L & 3, e = tile_e[tile];
        u.pm = tile; u.pn = pn; u.a = A + (size_t)tile * a_tile; u.b = W + (size_t)e * w_exp + (size_t)pn * w_pn; u.tok = tok ? tok + tile * 256 : nullptr; return true; } };
constexpr int LDS_LI = 132096;
DEVI void phase7a(const Params& p, char* lds) {
    unsigned char* ws = p.ws; int* li = (int*)(lds + LDS_LI); const int ntile = build_prefix(p, li);
    MoeOrder S{(const char*)(ws + WS_X2F8), (const char*)(ws + WS_W13), (size_t)0, (size_t)1024 * 1024, (size_t)256 * 1024, li + 80, ntile * 4, (const int*)(ws + WS_TOK)};
    EpiHid8 E{ws + WS_HID, (const float*)(ws + WS_ROUTE + RT_SRS)};
    g8::gemm_phase<EpiHid8, MoeOrder, true, g8::NoHook, true, true>((G8_LAS unsigned char*)lds, 512, 512, 512, S, E, nullptr, g8::NoHook(), 1 << 30, 0, 125, 121);
}
DEVI void phase7b(const Params& p, char* lds) {
    unsigned char* ws = p.ws; int* li = (int*)(lds + LDS_LI); const int ntile = build_prefix(p, li);
    MoeOrder S{(const char*)(ws + WS_HID), (const char*)(ws + WS_W2), (size_t)256 * EFF, (size_t)1024 * EFF, (size_t)256 * EFF, li + 80, ntile * 4, nullptr};
    g8::Epi4<EpiY> E{{(bf16_t*)(ws + WS_YEXP), (const float*)(ws + WS_ROUTE + RT_SW)}};
    g8::gemm_phase<g8::Epi4<EpiY>, MoeOrder, true, g8::NoHook, false, true>((G8_LAS unsigned char*)lds, EFF / 2, EFF / 2, EFF / 2, S, E, nullptr, g8::NoHook(), 1 << 30, 0, 124, 121);
}
DEVI void phase8(const Params& p) {
    unsigned char* ws = p.ws; const int* AS = (const int*)(ws + WS_ROUTE + RT_AS); const bf16_t* yexp = (const bf16_t*)(ws + WS_YEXP); const bf16_t* x2b = (const bf16_t*)(ws + WS_X2B); const f32x4* finw = (const f32x4*)ptab(ws, PT_FINW);
    const int lane = threadIdx.x & 63, gw = blockIdx.x * 8 + (threadIdx.x >> 6), NGW = gridDim.x * 8;
    f32x4 fw[4];
#pragma unroll
    for (int j = 0; j < 4; ++j) fw[j] = finw[lane + 64 * j];
    constexpr int RPI = 4;
    int4 sl[2]; sl[0] = *(const int4*)(AS + 2 * (size_t)gw * RPI); sl[1] = *(const int4*)(AS + 2 * (size_t)gw * RPI + 4);
    for (int t0 = gw * RPI; t0 < T; t0 += NGW * RPI) {
        u32x2 xv[RPI][4], ya[RPI][4], yb[RPI][4];
#pragma unroll
        for (int r = 0; r < RPI; ++r) { const u32x2* xr = (const u32x2*)(x2b + (size_t)(t0 + r) * D) + lane; const int4 q = sl[r >> 1]; const int s0 = (r & 1) ? q.z : q.x, s1 = (r & 1) ? q.w : q.y;
            const u32x2* y0 = (const u32x2*)(yexp + (size_t)s0 * 1024) + lane; const u32x2* y1 = (const u32x2*)(yexp + (size_t)s1 * 1024) + lane;
#pragma unroll
            for (int j = 0; j < 4; ++j) { xv[r][j] = xr[64 * j]; ya[r][j] = y0[64 * j]; yb[r][j] = y1[64 * j]; } }
        if (t0 + NGW * RPI < T) { sl[0] = *(const int4*)(AS + 2 * (size_t)(t0 + NGW * RPI)); sl[1] = *(const int4*)(AS + 2 * (size_t)(t0 + NGW * RPI) + 4); }
#pragma unroll
        for (int r = 0; r < RPI; ++r) { const int t = t0 + r; float s = 0.f; f32x4 v[4];
#pragma unroll
            for (int j = 0; j < 4; ++j) { const u32x2 xw = xv[r][j], a = ya[r][j], b = yb[r][j];
                v[j][0] = (bf2f(xw.x & 0xffffu) + bf2f(a.x & 0xffffu)) + bf2f(b.x & 0xffffu); v[j][1] = (bf2f(xw.x >> 16) + bf2f(a.x >> 16)) + bf2f(b.x >> 16);
                v[j][2] = (bf2f(xw.y & 0xffffu) + bf2f(a.y & 0xffffu)) + bf2f(b.y & 0xffffu); v[j][3] = (bf2f(xw.y >> 16) + bf2f(a.y >> 16)) + bf2f(b.y >> 16);
                s += v[j][0] * v[j][0] + v[j][1] * v[j][1] + v[j][2] * v[j][2] + v[j][3] * v[j][3]; }
            const float rstd = rsqrtf(wave_sum(s) * (1.f / D) + 1e-6f);
            f32x4* xo = (f32x4*)(p.out + (size_t)t * D) + lane;
#pragma unroll
            for (int j = 0; j < 4; ++j) { f32x4 ov = v[j] * rstd * fw[j];
#if defined(TPROBE_A)
                { const unsigned long long* ts = (const unsigned long long*)(ws + WS_TS);
                  if (t < 16) { const float ta = (float)((((TPROBE_A >= 20 ? ts[TPROBE_A + 1] - ts[TPROBE_A] : TPROBE_A >= 12 ? ts[13] - ts[TPROBE_A - 10] : ts[TPROBE_A + 1] - ts[TPROBE_A])) / 800ull) * 8ull); const float dl = 0.045254834f * sqrtf(ta); ov[0] += dl; ov[1] += dl; ov[2] += dl; ov[3] += dl; }
                  if (t == 16 && lane == 0 && j == 0) { const float tb = (float)(((ts[TPROBE_B + 1] - ts[TPROBE_B]) / 800ull) * 8ull); ov[0] += 2.f + tb * (1.f / 200.f); } }
#endif
                xo[64 * j] = ov; }
        }
    }
}

#define XB_LAS __attribute__((address_space(3)))
constexpr int CW_BAR = 12288;
constexpr int LDS_XB = 147200;
#define XB_TMO      128
#define XB_XCNT(j)  (256  + 64 * (j))
#define XB_XSUB(j)  (1280 + 64 * (j))
#define XB_XGEN(j)  (2304 + 64 * (j))
#define XB_TOP      3328
#define XB_TOPGEN   3392
#define XCD_BAR_WORDS 3456
#define XB_SPIN_CAP (1u << 18)

__device__ __forceinline__ unsigned xb_ld(unsigned* p)              { return __hip_atomic_load(p, __ATOMIC_RELAXED, __HIP_MEMORY_SCOPE_AGENT); }
__device__ __forceinline__ unsigned xb_add(unsigned* p, unsigned v) { return __hip_atomic_fetch_add(p, v, __ATOMIC_RELAXED, __HIP_MEMORY_SCOPE_AGENT); }
__device__ __forceinline__ unsigned xb_xcc_id() { return (unsigned)__builtin_amdgcn_s_getreg((3 << 11) | 20) & 0xFu; }
#define XB_SPIN(cond, bar) do { unsigned _sp = 0; while (cond) { __builtin_amdgcn_s_sleep(1); \
    if ((++_sp & 255u) == 0u) { if (xb_ld(&(bar)[XB_TMO])) break; if (_sp > XB_SPIN_CAP) { atomicAdd(&(bar)[XB_TMO], 1u); break; } } } } while (0)

struct XcdBarrier {
    unsigned* bar; unsigned x;
    volatile XB_LAS unsigned* st;
};

__device__ __forceinline__ XcdBarrier xcd_barrier_post(unsigned* bar, volatile XB_LAS unsigned* st) {
    XcdBarrier b; b.bar = bar; b.x = xb_xcc_id(); b.st = st;
    if (threadIdx.x == 0) (void)xb_add(&bar[XB_XCNT(b.x)], 1u);
    return b;
}
__device__ __forceinline__ void xcd_barrier_complete(unsigned* bar, unsigned x, unsigned& nloc, unsigned& nx) {
    const unsigned G = gridDim.x * gridDim.y * gridDim.z;
    unsigned sum, cnt, mine, sp = 0u;
    for (;;) {
        sum = 0u; cnt = 0u; mine = 0u;
#pragma unroll
        for (unsigned j = 0; j < 16; ++j) { const unsigned c = xb_ld(&bar[XB_XCNT(j)]); sum += c; cnt += (c > 0u) ? 1u : 0u; mine = (j == x) ? c : mine; }
        if (sum == G) break;
        __builtin_amdgcn_s_sleep(1);
        if ((++sp & 255u) == 0u) { if (xb_ld(&bar[XB_TMO])) break; if (sp > XB_SPIN_CAP) { atomicAdd(&bar[XB_TMO], 1u); break; } }
    }
    nloc = mine > 0u ? mine : 1u; nx = cnt > 0u ? cnt : 1u;
}

__device__ __forceinline__ void xcd_barrier(const XcdBarrier& b) {
    asm volatile("s_waitcnt vmcnt(0)" ::: "memory");
    __syncthreads();
    if (threadIdx.x == 0) {
        unsigned* bar = b.bar;
        __builtin_amdgcn_s_waitcnt(0);
        unsigned nloc = b.st[0], nx = b.st[1];
        if (nloc == 0u) { xcd_barrier_complete(bar, b.x, nloc, nx); b.st[0] = nloc; b.st[1] = nx; }
        const unsigned old = xb_add(&bar[XB_XSUB(b.x)], 1u);
        const unsigned gen = old / nloc;
        if (old + 1u == (gen + 1u) * nloc) {
            __builtin_amdgcn_fence(__ATOMIC_RELEASE, "agent");
            asm volatile("s_waitcnt vmcnt(0)" ::: "memory");
            const unsigned og = xb_add(&bar[XB_TOP], 1u);
            const unsigned tg = og / nx;
            if (og + 1u == (tg + 1u) * nx) xb_add(&bar[XB_TOPGEN], 1u);
            else XB_SPIN(xb_ld(&bar[XB_TOPGEN]) == tg, bar);
            __builtin_amdgcn_fence(__ATOMIC_ACQUIRE, "agent");
            xb_add(&bar[XB_XGEN(b.x)], 1u);
            asm volatile("s_waitcnt vmcnt(0)" ::: "memory");
        } else {
            XB_SPIN(xb_ld(&bar[XB_XGEN(b.x)]) == gen, bar);
            __builtin_amdgcn_fence(__ATOMIC_ACQUIRE, "agent");
            asm volatile("s_waitcnt vmcnt(0)" ::: "memory");
        }
    }
    __syncthreads();
}


constexpr int NPHASE = 12;
constexpr int LDS_BYTES = 147456;
#if defined(TPROBE_A)
#define STAMP(k) if (blockIdx.x == 0 && threadIdx.x == 0) ((unsigned long long*)(p.ws + WS_TS))[(k)] = __builtin_amdgcn_s_memrealtime();
#else
#define STAMP(k)
#endif
__global__ void __launch_bounds__(NTHR, 2) mega(Params p) {
    extern __shared__ __attribute__((aligned(16))) char lds[];
    cg::grid_group grid = cg::this_grid();
    const int lo = p.ph_lo, hi = p.ph_hi;
    if (threadIdx.x < 2) ((volatile XB_LAS unsigned*)((XB_LAS unsigned char*)lds + LDS_XB))[threadIdx.x] = 0u;
    __syncthreads();
    const XcdBarrier xbar = xcd_barrier_post((unsigned*)(p.ws + WS_CTL) + CW_BAR, (volatile XB_LAS unsigned*)((XB_LAS unsigned char*)lds + LDS_XB));
    if (p.ph_hi < 0) grid.sync();
#define SEAM(k) xcd_barrier(xbar)
    STAMP(0)
#ifndef DUP_PH
#define DUP_PH -1
#endif
#ifdef ONLY_PH
#define PH(k, call) if constexpr ((k) == ONLY_PH) { if (lo <= (k) && (k) < hi) { const int rep_ = 0; call; if ((k) + 1 < hi) SEAM(k); } }
#else
#define PH(k, call) if (lo <= (k) && (k) < hi) { if constexpr ((k) == DUP_PH) { _Pragma("unroll 1") for (int rep_ = 0; rep_ < 3; ++rep_) { __syncthreads(); call; } } else { const int rep_ = 0; call; } if ((k) + 1 < hi) SEAM(k); STAMP((k) + 1) }
#endif
    PH(0, phase0(p, lds))
    PH(1, phase1(p, lds))
    PH(2, phase2a(p, lds, rep_ == 0))
    PH(3, phase2b(p, lds))
    PH(4, phase3(p, lds))
    PH(5, phase4(p, lds))
    PH(6, phase5(p, lds))
    PH(7, phase6a(p, lds, rep_ == 0))
    PH(8, phase6b(p, lds))
    PH(9, phase7a(p, lds))
    PH(10, phase7b(p, lds))
    PH(11, phase8(p))
#undef PH
}

extern "C" void kernel_launch(void* const* d_in, const int* in_sizes, int n_in, void* d_out, int out_size, void* d_ws, size_t ws_size, hipStream_t stream) {
    static int grid = 0;
    if (grid == 0) {
        if (n_in != 22 || out_size != T * D || ws_size < WS_END) { fprintf(stderr, "kernel_launch: unexpected shapes (n_in %d out %d ws %zu, need ws >= %zu)\n", n_in, out_size, ws_size, (size_t)WS_END); grid = -1; return; }
        int dev = 0, cus = 0, per_cu = 0; hipGetDevice(&dev); hipDeviceGetAttribute(&cus, hipDeviceAttributeMultiprocessorCount, dev);
        hipFuncSetAttribute((const void*)mega, hipFuncAttributeMaxDynamicSharedMemorySize, LDS_BYTES);
        hipOccupancyMaxActiveBlocksPerMultiprocessor(&per_cu, (const void*)mega, NTHR, LDS_BYTES);
        if (per_cu < 1) { fprintf(stderr, "kernel_launch: occupancy query says %d blocks per CU\n", per_cu); per_cu = 1; }
        grid = cus * per_cu; (void)hipGetLastError();
    }
    if (grid < 0) return;
    hipMemsetAsync((char*)d_ws + WS_CTL, 0, 65536, stream);
    Params p{};
    p.x = (const float*)d_in[0]; p.pos = (const int*)d_in[1]; p.attn_norm_w = (const float*)d_in[2]; p.w_in = (const float*)d_in[3]; p.hg_lb = (const float*)d_in[4];
    p.hg_onw = (const float*)d_in[5]; p.q_norm_w = (const float*)d_in[6]; p.w_uq = (const float*)d_in[7]; p.kv_norm_w = (const float*)d_in[8]; p.w_ukv = (const float*)d_in[9];
    p.w_bra = (const float*)d_in[10]; p.w_brb = (const float*)d_in[11]; p.w_out = (const float*)d_in[12]; p.ffn_norm_w = (const float*)d_in[13]; p.rg_w = (const float*)d_in[14];
    p.rg_b = (const float*)d_in[15]; p.re_w = (const float*)d_in[16]; p.re_b = (const float*)d_in[17]; p.ew1 = (const float*)d_in[18]; p.ew3 = (const float*)d_in[19];
    p.ew2 = (const float*)d_in[20]; p.final_w = (const float*)d_in[21]; p.out = (float*)d_out; p.ws = (unsigned char*)d_ws;
#if MK_MULTI
    for (int ph = 0; ph < NPHASE; ++ph) { p.ph_lo = ph; p.ph_hi = ph + 1; hipLaunchKernelGGL(mega, dim3(grid), dim3(NTHR), LDS_BYTES, stream, p); }
#else
    p.ph_lo = 0; p.ph_hi = NPHASE;
    void* args[] = {&p};
    hipError_t e = hipLaunchCooperativeKernel((const void*)mega, dim3(grid), dim3(NTHR), args, LDS_BYTES, stream);
    if (e != hipSuccess) fprintf(stderr, "cooperative launch failed: %s (grid %d)\n", hipGetErrorString(e), grid);
#endif
}
```

```cpp
#include <hip/hip_runtime.h>
#include <hip/hip_cooperative_groups.h>
#include <cstdio>
#include <cstdint>
namespace cg = cooperative_groups;

#ifndef MK_MULTI
#define MK_MULTI 0
#endif

#define DEVI __device__ __forceinline__
typedef unsigned short bf16_t;
typedef short bf16x8 __attribute__((ext_vector_type(8)));
typedef float f32x4 __attribute__((ext_vector_type(4)));
typedef unsigned u32x4 __attribute__((ext_vector_type(4)));
typedef unsigned u32x2 __attribute__((ext_vector_type(2)));

constexpr int NB = 16, SEQ = 2048, T = NB * SEQ, D = 1024;
constexpr int NTHR = 512;
constexpr int ZH_P = 4096, ZL_P = 768, ZG_P = 2048;
constexpr int NZ = 6912;
constexpr int NEXP = 64, EFF = 512;
constexpr int SLOT_CAP = 2 * T + NEXP * 256;
constexpr int MAX_TILES = SLOT_CAP / 256;

constexpr size_t MiB = 1u << 20;
constexpr size_t WS_CTL = 0;
constexpr size_t WS_WRT = 1 * MiB;
constexpr size_t WS_LBT = 1 * MiB + 512 * 1024;
constexpr size_t WS_WIN = 2 * MiB;
constexpr size_t WS_WUQ = 16 * MiB;
constexpr size_t WS_WUKV = 18 * MiB;
constexpr size_t WS_WBR = 20 * MiB;
constexpr size_t WS_WOUT = 24 * MiB;
constexpr size_t WS_COS = 26 * MiB, WS_SIN = 30 * MiB;
constexpr size_t WS_ROUTE = 34 * MiB;
constexpr size_t WS_KPE = 36 * MiB;
constexpr size_t WS_ZH = 40 * MiB;
constexpr size_t WS_Q = 40 * MiB, WS_KN = 136 * MiB, WS_V = 200 * MiB;
constexpr size_t WS_Y = 40 * MiB;
constexpr size_t WS_X2B = 104 * MiB;
constexpr size_t WS_HID = 168 * MiB;
constexpr size_t WS_YEXP = 248 * MiB;
constexpr size_t WS_X2F8 = 344 * MiB;
constexpr size_t WS_H8 = 408 * MiB;
constexpr size_t WS_WIN8 = 440 * MiB;
constexpr size_t WS_TOK = 512 * 1024;
constexpr size_t WS_OB = 264 * MiB;
constexpr size_t WS_ZL = 296 * MiB;
constexpr size_t WS_ZG = 344 * MiB;
constexpr size_t WS_W13 = 408 * MiB;
constexpr size_t WS_OA = 472 * MiB;
constexpr size_t WS_H = 472 * MiB;
constexpr size_t WS_W2 = 472 * MiB;
constexpr size_t WS_END = 536 * MiB;
constexpr size_t RT_AE = 0, RT_AP = 256 * 1024, RT_AW = 512 * 1024, RT_AS = 768 * 1024, RT_ST = 1024 * 1024, RT_SW = 1536 * 1024;
constexpr int CW_CNT = 8192, CNT_STRIDE = 64;
constexpr size_t WS_TS = 16384;
constexpr size_t WS_PTRS = 8192;
enum { PT_POS = 0, PT_HGLB, PT_HGONW, PT_RGB, PT_REB, PT_EW1, PT_EW3, PT_EW2, PT_FFNW, PT_FINW, PT_X };
DEVI const void* ptab(const unsigned char* ws, int i) { return (const void*)(((const unsigned long long*)(ws + WS_PTRS))[i]); }

struct Params {
    const float* x; const int* pos; const float* attn_norm_w; const float* w_in; const float* hg_lb; const float* hg_onw;
    const float* q_norm_w; const float* w_uq; const float* kv_norm_w; const float* w_ukv; const float* w_bra; const float* w_brb;
    const float* w_out; const float* ffn_norm_w; const float* rg_w; const float* rg_b; const float* re_w; const float* re_b;
    const float* ew1; const float* ew3; const float* ew2; const float* final_w;
    float* out; unsigned char* ws;
    int ph_lo, ph_hi;
};

DEVI unsigned f2bf(float f) { unsigned u = __builtin_bit_cast(unsigned, f); return (u + 0x7fffu + ((u >> 16) & 1u)) >> 16; }
DEVI float bf2f(unsigned h) { return __builtin_bit_cast(float, h << 16); }
typedef float f32x2_t __attribute__((ext_vector_type(2))); typedef __bf16 bf16x2_t __attribute__((ext_vector_type(2)));
DEVI unsigned pk2(float lo, float hi) { f32x2_t v = {lo, hi}; bf16x2_t b = __builtin_convertvector(v, bf16x2_t); return __builtin_bit_cast(unsigned, b); }
DEVI float sigmoidf_(float v) { return __builtin_amdgcn_rcpf(1.f + __expf(-v)); }
DEVI float siluf_(float v) { return v * __builtin_amdgcn_rcpf(1.f + __expf(-v)); }
DEVI float wave_sum(float v) {
#pragma unroll
    for (int o = 1; o < 64; o <<= 1) v += __shfl_xor(v, o);
    return v;
}
typedef int i32x4 __attribute__((ext_vector_type(4))); typedef int i32x8 __attribute__((ext_vector_type(8)));
DEVI unsigned pk4_fp8(float a, float b, float c, float d) { int w = __builtin_amdgcn_cvt_pk_fp8_f32(a, b, 0, false); w = __builtin_amdgcn_cvt_pk_fp8_f32(c, d, w, true); return (unsigned)w; }
DEVI void store4bf(bf16_t* p, f32x4 v) { u32x2 w; w.x = pk2(v[0], v[1]); w.y = pk2(v[2], v[3]); *(u32x2*)p = w; }
DEVI void unpack8(bf16x8 v, float* f) {
#pragma unroll
    for (int j = 0; j < 8; ++j) f[j] = bf2f((unsigned)(unsigned short)v[j]);
}

template <class ColMap, class KScale>
DEVI void transpose_tile_f8(const float* src, int Nsrc, unsigned char* dst, int ldk, int k0, int n0, ColMap cm, KScale ks, float* scr) {
    const int tid = threadIdx.x;
    {
        const int nl = tid & 63, kq = tid >> 6; const int col = cm(n0 + nl);
#pragma unroll
        for (int i = 0; i < 8; ++i) { const int k = kq * 8 + i; float v = 0.f; if (col >= 0) v = src[(size_t)(k0 + k) * Nsrc + col] * ks(k0 + k); scr[k * 65 + nl] = v; }
    }
    __syncthreads();
    {
        const int nl = tid >> 3, kc = tid & 7; const float* s = scr + (kc * 8) * 65 + nl;
        u32x2 o; o.x = pk4_fp8(s[0], s[65], s[2 * 65], s[3 * 65]); o.y = pk4_fp8(s[4 * 65], s[5 * 65], s[6 * 65], s[7 * 65]);
        *(u32x2*)(dst + (size_t)(n0 + nl) * ldk + k0 + kc * 8) = o;
    }
    __syncthreads();
}
template <class ColMap, class KScale>
DEVI void transpose_tile(const float* src, int Nsrc, bf16_t* dst, int ldk, int k0, int n0, ColMap cm, KScale ks, float* scr) {
    const int tid = threadIdx.x;
    {
        const int nl = tid & 63, kq = tid >> 6; const int col = cm(n0 + nl);
#pragma unroll
        for (int i = 0; i < 8; ++i) { const int k = kq * 8 + i; float v = 0.f; if (col >= 0) v = src[(size_t)(k0 + k) * Nsrc + col] * ks(k0 + k); scr[k * 65 + nl] = v; }
    }
    __syncthreads();
    {
        const int nl = tid >> 3, kc = tid & 7; const float* s = scr + (kc * 8) * 65 + nl;
        u32x4 o; o.x = pk2(s[0], s[65]); o.y = pk2(s[2 * 65], s[3 * 65]); o.z = pk2(s[4 * 65], s[5 * 65]); o.w = pk2(s[6 * 65], s[7 * 65]);
        *(u32x4*)(dst + (size_t)(n0 + nl) * ldk + k0 + kc * 8) = o;
    }
    __syncthreads();
}

namespace g8 {
#define G8_LAS __attribute__((address_space(3)))
constexpr int BM = 256, BK = 64, HALF = 128, HTB = HALF * BK * 2, STAGE_BYTES = 8 * HTB, NXCD = 8, WGM = 8;
__host__ __device__ __forceinline__ int lds_byte(int r, int c) { const int st = (r >> 4) * 2 + (c >> 5), rr = r & 15, cc = c & 31, ob = rr * 64 + cc * 2; return st * 1024 + (ob ^ (((ob >> 9) & 1) << 5)); }
__host__ __device__ __forceinline__ int perm32(int rho) { const int n = rho >> 4, i = rho & 15; return 8 * (i >> 2) + 4 * n + (i & 3); }
__host__ __device__ __forceinline__ void stage_rc(int b, int& R, int& C) { const int st = b / 1024, sb = b % 1024, swz = sb ^ (((sb >> 9) & 1) << 5); R = (st >> 1) * 16 + swz / 64; C = (st & 1) * 32 + (swz % 64) / 2; }
struct Unit { int pm, pn; const char* a; const char* b; const int* tok; };
struct DenseOrder {
    const char* A; const char* Bt; size_t tstepA, tstepB; int nM, nN, nwg, G, c;
    DEVI void init(const void* A_, int lda, const void* Bt_, int ldb, int M, int N) { A = (const char*)A_; Bt = (const char*)Bt_; tstepA = (size_t)BM * lda * 2; tstepB = (size_t)BM * ldb * 2;
        nM = M / BM; nN = N / BM; nwg = nM * nN; G = gridDim.x; c = blockIdx.x; }
    DEVI bool next(int i, Unit& u) const {
        const long L = (long)i * G + c; if (L >= nwg) return false;
        int wgid = (int)L; { const int q = nwg / NXCD, r = nwg % NXCD, xcd = wgid % NXCD, off = wgid / NXCD; wgid = (xcd < r ? xcd * (q + 1) : r * (q + 1) + (xcd - r) * q) + off; }
        const int nig = WGM * nN, gid = wgid / nig, fm = gid * WGM, gsz = (nM - fm) < WGM ? (nM - fm) : WGM;
        u.pm = fm + ((wgid % nig) % gsz); u.pn = (wgid % nig) / gsz; u.a = A + (size_t)u.pm * tstepA; u.b = Bt + (size_t)u.pn * tstepB; u.tok = nullptr; return true;
    }
};
struct NoHook { static constexpr bool ON = false; template <class U> DEVI void operator()(f32x4 (&)[2][2][4][2], const U&, int, int, int, int) const {} };
template <class Epi, class Sched, bool ALIGN_EPI, class Hook = NoHook, bool GATHER = false, bool FP8 = false>
DEVI void gemm_phase(G8_LAS unsigned char* lds, const int lda, const int ldb, const int K, const Sched& S, const Epi& E, unsigned long long* tsp = nullptr, const Hook& H = Hook(), const int seg_t = 1 << 30, const long segj = 0, const int scA = 127, const int scB = 127) {
    const int tid = threadIdx.x, wid = __builtin_amdgcn_readfirstlane(tid >> 6), lane = tid & 63, wr = wid >> 2, wc = wid & 3, fr = lane & 15, fq = lane >> 4;
    const int nt = K / BK;
    unsigned voffA[2], voffB[2]; int gR[2]; unsigned gC[2];
#pragma unroll
    for (int i = 0; i < 2; ++i) { int R, C; stage_rc(tid * 16 + i * 8192, R, C); voffA[i] = (unsigned)(R * lda + C) * 2u; voffB[i] = (unsigned)(((R & ~31) + perm32(R & 31)) * ldb + C) * 2u; gR[i] = R; gC[i] = (unsigned)C * 2u; }
    unsigned vG[2][2], vGn[2][2];
#define G8_TOK(dst, tokp) do { _Pragma("unroll") for (int h_ = 0; h_ < 2; ++h_) _Pragma("unroll") for (int i_ = 0; i_ < 2; ++i_) dst[h_][i_] = (unsigned)(tokp)[gR[i_] + 128 * h_] * (unsigned)(lda * 2) + gC[i_]; } while (0)
#define G8_STAGE_A(bufoff, gbase, h, usenext) do { if constexpr (GATHER) { unsigned v_[2] = {(usenext) ? vGn[h][0] : vG[h][0], (usenext) ? vGn[h][1] : vG[h][1]}; G8_STAGE(bufoff, gbase, v_); } \
        else { G8_STAGE(bufoff, (gbase) + (h) * hstepA, voffA); } } while (0)
    const size_t kstep = (size_t)(BK * 2);
    const size_t hstepA = (size_t)HALF * lda * 2, hstepB = (size_t)HALF * ldb * 2;
    const unsigned ldsw = (unsigned)wid * 1024u;
    const int aoff = lds_byte(wr * 64 + fr, fq * 8), boff = lds_byte(wc * 32 + fr, fq * 8);
#define G8_SA(b, h) (((b) * 2 + (h)) * HTB)
#define G8_SB(b, h) ((4 + (b) * 2 + (h)) * HTB)
#define G8_STAGE(bufoff, gbase, voff) do { _Pragma("unroll") for (int _i = 0; _i < 2; ++_i) \
        __builtin_amdgcn_global_load_lds((const unsigned*)((const char*)(gbase) + (voff)[_i]), (G8_LAS unsigned*)(lds + (bufoff) + ldsw + _i * 8192), 16, 0, 0); } while (0)
#define G8_LD16(off) __builtin_bit_cast(i32x4, *(const G8_LAS bf16x8*)(lds + (off)))
#define G8_LDA8(dst, b, h) do { _Pragma("unroll") for (int m = 0; m < 4; ++m) dst[m] = __builtin_shufflevector(G8_LD16(G8_SA(b, h) + aoff + m * 2048), G8_LD16(G8_SA(b, h) + aoff + m * 2048 + 1024), 0, 1, 2, 3, 4, 5, 6, 7); } while (0)
#define G8_LDB8(dst, b, h) do { _Pragma("unroll") for (int n = 0; n < 2; ++n) dst[n] = __builtin_shufflevector(G8_LD16(G8_SB(b, h) + boff + n * 2048), G8_LD16(G8_SB(b, h) + boff + n * 2048 + 1024), 0, 1, 2, 3, 4, 5, 6, 7); } while (0)
#define G8_LDA(dst, b, h) do { if constexpr (FP8) { G8_LDA8(dst##8, b, h); break; } _Pragma("unroll") for (int m = 0; m < 4; ++m) _Pragma("unroll") for (int k = 0; k < 2; ++k) dst[m][k] = *(const G8_LAS bf16x8*)(lds + G8_SA(b, h) + aoff + m * 2048 + k * 1024); } while (0)
#define G8_LDB(dst, b, h) do { if constexpr (FP8) { G8_LDB8(dst##8, b, h); break; } _Pragma("unroll") for (int n = 0; n < 2; ++n) _Pragma("unroll") for (int k = 0; k < 2; ++k) dst[n][k] = *(const G8_LAS bf16x8*)(lds + G8_SB(b, h) + boff + n * 2048 + k * 1024); } while (0)
#define G8_MMA(ai, bj, At, Bt) do { __builtin_amdgcn_s_setprio(1); _Pragma("unroll") for (int m = 0; m < 4; ++m) _Pragma("unroll") for (int n = 0; n < 2; ++n) { \
        if constexpr (FP8) { asm volatile("v_mfma_scale_f32_16x16x128_f8f6f4 %0, %1, %2, %0, %3, %4 op_sel_hi:[0,0,0]" : "+v"(acc[ai][bj][m][n]) : "v"(Bt##8[n]), "v"(At##8[m]), "v"(scB), "v"(scA)); } \
        else { _Pragma("unroll") for (int k = 0; k < 2; ++k) acc[ai][bj][m][n] = __builtin_amdgcn_mfma_f32_16x16x32_bf16(Bt[n][k], At[m][k], acc[ai][bj][m][n], 0, 0, 0); } } __builtin_amdgcn_s_setprio(0); } while (0)
#define G8_WAIT_V(n) asm volatile("s_waitcnt vmcnt(" #n ")" ::: "memory")
#define G8_WAIT_L(n) asm volatile("s_waitcnt lgkmcnt(" #n ")" ::: "memory")
#define G8_BAR __builtin_amdgcn_s_barrier()
#define G8_SCHED __builtin_amdgcn_sched_barrier(0)
    Unit cur, nxt; int ui = 0;
    if (!S.next(0, cur)) return;
    f32x4 acc[2][2][4][2];
#pragma unroll
    for (int a = 0; a < 2; ++a)
#pragma unroll
        for (int b = 0; b < 2; ++b)
#pragma unroll
            for (int m = 0; m < 4; ++m)
#pragma unroll
                for (int n = 0; n < 2; ++n) acc[a][b][m][n] = (f32x4){0.f, 0.f, 0.f, 0.f};
    bf16x8 At[4][2], B0[2][2], B1[2][2];
    i32x8 At8[4], B08[2], B18[2];
    const char* cA = cur.a; const char* cB = cur.b;
    if constexpr (GATHER) { G8_TOK(vG, cur.tok); G8_TOK(vGn, cur.tok); }
    G8_STAGE(G8_SB(0, 0), cB, voffB); G8_STAGE(G8_SB(0, 1), cB + hstepB, voffB); G8_STAGE_A(G8_SA(0, 0), cA, 0, false); G8_STAGE_A(G8_SA(0, 1), cA, 1, false);
    if (wr == 1) G8_BAR;
    G8_WAIT_V(2); G8_BAR;
    G8_STAGE(G8_SB(1, 0), cB + kstep, voffB); G8_STAGE_A(G8_SA(1, 0), cA + kstep, 0, false); G8_STAGE(G8_SB(1, 1), cB + hstepB + kstep, voffB);
    G8_WAIT_V(6); G8_BAR;
    unsigned long long tk_ = 0, te_ = 0, tp_ = tsp ? __builtin_amdgcn_s_memrealtime() : 0;
    for (;;) {
        const bool has_next = S.next(ui + 1, nxt);
        const char* nA = has_next ? nxt.a : cA; const char* nB = has_next ? nxt.b : cB;
        if constexpr (GATHER) { if (has_next) G8_TOK(vGn, nxt.tok); }
#pragma unroll 1
        for (int t = 0; t < nt; t += 2) {
            const bool last = (t == nt - 2);
            if constexpr (Hook::ON) { if (t == seg_t) H(acc, cur, wr, wc, fr, fq); }
            const char* a1 = cA + (size_t)(t + 1) * kstep + (Hook::ON && t + 1 >= seg_t ? segj : 0);
            const char* a2 = last ? nA : cA + (size_t)(t + 2) * kstep + (Hook::ON && t + 2 >= seg_t ? segj : 0); const char* b2 = last ? nB : cB + (size_t)(t + 2) * kstep;
            const char* a3 = a2 + kstep; const char* b3 = b2 + kstep;
            G8_LDB(B0, 0, 0); G8_LDB(B1, 0, 1); G8_SCHED; G8_LDA(At, 0, 0); G8_STAGE_A(G8_SA(1, 1), a1, 1, false);
            G8_WAIT_V(8); G8_WAIT_L(0); G8_BAR; G8_MMA(0, 0, At, B0); G8_MMA(0, 1, At, B1); G8_BAR; G8_SCHED;
            G8_LDA(At, 0, 1); G8_STAGE(G8_SB(0, 0), b2, voffB); G8_STAGE(G8_SB(0, 1), b2 + hstepB, voffB); G8_STAGE_A(G8_SA(0, 0), a2, 0, last);
            G8_WAIT_V(8); G8_WAIT_L(0); G8_BAR; G8_MMA(1, 0, At, B0); G8_MMA(1, 1, At, B1); G8_BAR; G8_SCHED;
            G8_LDB(B0, 1, 0); G8_LDB(B1, 1, 1); G8_SCHED; G8_LDA(At, 1, 0); G8_STAGE_A(G8_SA(0, 1), a2, 1, last);
            G8_WAIT_V(8); G8_WAIT_L(0); G8_BAR; G8_MMA(0, 0, At, B0); G8_MMA(0, 1, At, B1); G8_BAR; G8_SCHED;
            G8_LDA(At, 1, 1); G8_STAGE(G8_SB(1, 0), b3, voffB); G8_STAGE(G8_SB(1, 1), b3 + hstepB, voffB); G8_STAGE_A(G8_SA(1, 0), a3, 0, last);
            G8_WAIT_V(8); G8_WAIT_L(0); G8_BAR; G8_MMA(1, 0, At, B0); G8_MMA(1, 1, At, B1); G8_BAR; G8_SCHED;
        }
        if constexpr (ALIGN_EPI) { if (wr == 0) G8_BAR; }
        if (tsp) { const unsigned long long n_ = __builtin_amdgcn_s_memrealtime(); tk_ += n_ - tp_; tp_ = n_; }
        if constexpr (FP8) asm volatile("s_nop 15\n\ts_nop 15" ::: "memory");
        E(acc, cur, wr, wc, fr, fq);
        if (tsp) { const unsigned long long n_ = __builtin_amdgcn_s_memrealtime(); te_ += n_ - tp_; tp_ = n_; }
        if (!has_next) break;
#pragma unroll
        for (int a = 0; a < 2; ++a)
#pragma unroll
            for (int b = 0; b < 2; ++b)
#pragma unroll
                for (int m = 0; m < 4; ++m)
#pragma unroll
                    for (int n = 0; n < 2; ++n) acc[a][b][m][n] = (f32x4){0.f, 0.f, 0.f, 0.f};
        cur = nxt; cA = nA; cB = nB; ++ui;
        if constexpr (GATHER) { _Pragma("unroll") for (int h_ = 0; h_ < 2; ++h_) _Pragma("unroll") for (int i_ = 0; i_ < 2; ++i_) vG[h_][i_] = vGn[h_][i_]; }
        if constexpr (ALIGN_EPI) { if (wr == 1) G8_BAR; }
    }
    G8_WAIT_V(0);
    if constexpr (!ALIGN_EPI) { if (wr == 0) G8_BAR; }
    G8_BAR;
    if (tsp && blockIdx.x == 0 && threadIdx.x == 0) { tsp[0] = 0; tsp[1] = tk_; tsp[2] = 0; tsp[3] = te_; tsp[4] = 0; tsp[5] = (unsigned long long)(ui + 1) * 100ull; }
#undef G8_SA
#undef G8_SB
#undef G8_STAGE
#undef G8_STAGE_A
#undef G8_TOK
#undef G8_LDA
#undef G8_LDA8
#undef G8_LDB8
#undef G8_LD16
#undef G8_LDB
#undef G8_MMA
#undef G8_WAIT_V
#undef G8_WAIT_L
#undef G8_BAR
#undef G8_SCHED
}
template <class F> struct Epi4 { F f;
    DEVI void operator()(const f32x4 (&acc)[2][2][4][2], const Unit& u, int wr, int wc, int fr, int fq) const {
        constexpr int NB = F::NB;
        asm volatile("" : "+v"(fr), "+v"(fq));
#pragma unroll
        for (int g0 = 0; g0 < 8; g0 += NB) {
            typename F::L ld[NB][2];
#pragma unroll
            for (int gg = 0; gg < NB; ++gg) { const int ai = (g0 + gg) >> 2, m = (g0 + gg) & 3;
#pragma unroll
                for (int bj = 0; bj < 2; ++bj) ld[gg][bj] = f.load(u.pm, u.pn, ai * 128 + wr * 64 + m * 16 + fr, bj * 128 + wc * 32 + 8 * fq); }
#pragma unroll
            for (int gg = 0; gg < NB; ++gg) { const int ai = (g0 + gg) >> 2, m = (g0 + gg) & 3;
#pragma unroll
                for (int bj = 0; bj < 2; ++bj) f.apply(u.pm, u.pn, ai * 128 + wr * 64 + m * 16 + fr, bj * 128 + wc * 32 + 8 * fq, acc[ai][bj][m][0], acc[ai][bj][m][1], ld[gg][bj]); }
            asm volatile("" ::: "memory");
        }
    } };
template <class F> struct Hook4 { static constexpr bool ON = true; F f;
    DEVI void operator()(f32x4 (&acc)[2][2][4][2], const Unit& u, int wr, int wc, int fr, int fq) const {
        constexpr int NB = F::NB;
        asm volatile("" : "+v"(fr), "+v"(fq));
#pragma unroll
        for (int g0 = 0; g0 < 8; g0 += NB) {
            typename F::L ld[NB][2];
#pragma unroll
            for (int gg = 0; gg < NB; ++gg) { const int ai = (g0 + gg) >> 2, m = (g0 + gg) & 3;
#pragma unroll
                for (int bj = 0; bj < 2; ++bj) ld[gg][bj] = f.load(u.pm, u.pn, ai * 128 + wr * 64 + m * 16 + fr, bj * 128 + wc * 32 + 8 * fq); }
#pragma unroll
            for (int gg = 0; gg < NB; ++gg) { const int ai = (g0 + gg) >> 2, m = (g0 + gg) & 3;
#pragma unroll
                for (int bj = 0; bj < 2; ++bj) f.apply(u.pm, u.pn, ai * 128 + wr * 64 + m * 16 + fr, bj * 128 + wc * 32 + 8 * fq, acc[ai][bj][m][0], acc[ai][bj][m][1], ld[gg][bj]); }
            asm volatile("" ::: "memory");
        }
    } };
}

struct NoLd {};
struct LbLd { f32x4 a, b; };
DEVI void store8bf(bf16_t* p, f32x4 a, f32x4 b) { u32x4 w; w.x = pk2(a[0], a[1]); w.y = pk2(a[2], a[3]); w.z = pk2(b[0], b[1]); w.w = pk2(b[2], b[3]); *(u32x4*)p = w; }
struct EpiZa { typedef LbLd L; static constexpr int NB = 1; unsigned char* ws;
    DEVI L load(int, int pn, int, int c) const { L l; l.a = (f32x4){0.f, 0.f, 0.f, 0.f}; l.b = l.a; if ((pn >> 2) == 1) { const float* lp = (const float*)(ws + WS_LBT) + (pn - 4) * 256 + c; l.a = *(const f32x4*)lp; l.b = *(const f32x4*)(lp + 4); } return l; }
    DEVI void apply(int pm, int pn, int r, int c, f32x4 v0, f32x4 v1, const L& lb) const {
        const size_t row = (size_t)pm * 256 + r; const int col = pn * 256 + c; const int kind = pn >> 2;
        if (kind == 3) {
#pragma unroll
            for (int j = 0; j < 4; ++j) { v0[j] = siluf_(v0[j]); v1[j] = siluf_(v1[j]); } }
        if (kind == 0) {
#pragma unroll
            for (int j = 0; j < 4; ++j) { v0[j] = siluf_(v0[j]) * 0.08838834764831845f; v1[j] = siluf_(v1[j]) * 0.08838834764831845f; } }
        else if (kind == 1) {
#pragma unroll
            for (int j = 0; j < 4; ++j) { v0[j] = __logf(lb.a[j] + (1.f - lb.a[j]) * sigmoidf_(v0[j])); v1[j] = __logf(lb.b[j] + (1.f - lb.b[j]) * sigmoidf_(v1[j])); } }
        store8bf((bf16_t*)(ws + WS_ZH) + row * ZH_P + col, v0, v1);
    } };
struct EpiZb { typedef NoLd L; static constexpr int NB = 8; unsigned char* ws;
    DEVI L load(int, int, int, int) const { return {}; }
    DEVI void apply(int pm, int pn, int r, int c, f32x4 v0, f32x4 v1, L) const {
        const size_t row = (size_t)pm * 256 + r; u32x2 w = {0u, 0u};
        if (pn < 3) { store8bf((bf16_t*)(ws + WS_ZL) + row * ZL_P + pn * 256 + c, v0, v1); return; }
#pragma unroll
        for (int j = 0; j < 4; ++j) { w.x |= (unsigned)fmaxf(__builtin_rintf(255.f * sigmoidf_(v0[j])), 1.f) << (8 * j); w.y |= (unsigned)fmaxf(__builtin_rintf(255.f * sigmoidf_(v1[j])), 1.f) << (8 * j); }
        *(u32x2*)(ws + WS_ZG + row * ZG_P + (pn - 3) * 256 + c) = w;
    } };
struct EpiQ { typedef NoLd L; static constexpr int NB = 8; bf16_t* q;
    DEVI L load(int, int, int, int) const { return {}; }
    DEVI void apply(int pm, int pn, int r, int c, f32x4 v0, f32x4 v1, L) const { store8bf(q + ((size_t)pm * 256 + r) * 1536 + pn * 256 + c, v0, v1); } };
struct EpiKV { typedef NoLd L; static constexpr int NB = 8; bf16_t* kn; bf16_t* vv;
    DEVI L load(int, int, int, int) const { return {}; }
    DEVI void apply(int pm, int pn, int r, int c, f32x4 v0, f32x4 v1, L) const {
        const size_t row = (size_t)pm * 256 + r; const int col = pn * 256 + c; const int hh = col >> 8, cc = col & 255;
        if (cc < 128) store8bf(kn + row * 1024 + hh * 128 + cc, v0, v1); else store8bf(vv + row * 1024 + hh * 128 + (cc - 128), v0, v1);
    } };
struct BrHookF { typedef u32x4 L; static constexpr int NB = 1; const unsigned char* zg;
    DEVI L load(int pm, int pn, int r, int c) const { const unsigned char* g = zg + ((size_t)pm * 256 + r) * ZG_P + pn * 256 + c; const u32x2 a = *(const u32x2*)g, b = *(const u32x2*)(g + 1024); return (L){a.x, a.y, b.x, b.y}; }
    DEVI void apply(int, int, int, int, f32x4& v0, f32x4& v1, L l) const {
#pragma unroll
        for (int j = 0; j < 4; ++j) { v0[j] *= (float)((l.x >> (8 * j)) & 255u) * __builtin_amdgcn_rcpf((float)((l.z >> (8 * j)) & 255u)); v1[j] *= (float)((l.y >> (8 * j)) & 255u) * __builtin_amdgcn_rcpf((float)((l.w >> (8 * j)) & 255u)); } } };
struct EpiBr2 { typedef u32x2 L; static constexpr int NB = 2; const unsigned char* zg; bf16_t* y;
    DEVI L load(int pm, int pn, int r, int c) const { return *(const u32x2*)(zg + ((size_t)pm * 256 + r) * ZG_P + 1024 + pn * 256 + c); }
    DEVI void apply(int pm, int pn, int r, int c, f32x4 v0, f32x4 v1, L g) const {
#pragma unroll
        for (int j = 0; j < 4; ++j) { v0[j] *= (float)((g.x >> (8 * j)) & 255u) * (1.f / 255.f); v1[j] *= (float)((g.y >> (8 * j)) & 255u) * (1.f / 255.f); }
        store8bf(y + ((size_t)pm * 256 + r) * 1024 + pn * 256 + c, v0, v1); } };
struct EpiOut { typedef LbLd L; static constexpr int NB = 2; const float* x; bf16_t* x2b; unsigned char* x2f8;
    DEVI L load(int pm, int pn, int r, int c) const { const float* xp = x + ((size_t)pm * 256 + r) * 1024 + pn * 256 + c; L l; l.a = *(const f32x4*)xp; l.b = *(const f32x4*)(xp + 4); return l; }
    DEVI void apply(int pm, int pn, int r, int c, f32x4 v0, f32x4 v1, const L& xv) const { const size_t o = ((size_t)pm * 256 + r) * 1024 + pn * 256 + c; const f32x4 a = xv.a + v0, b = xv.b + v1; store8bf(x2b + o, a, b);
        u32x2 w; w.x = pk4_fp8(4.f * a[0], 4.f * a[1], 4.f * a[2], 4.f * a[3]); w.y = pk4_fp8(4.f * b[0], 4.f * b[1], 4.f * b[2], 4.f * b[3]); *(u32x2*)(x2f8 + o) = w; } };
struct EpiHid8 { unsigned char* hid; const float* srs;
    DEVI void operator()(const f32x4 (&acc)[2][2][4][2], const g8::Unit& u, int wr, int wc, int fr, int fq) const {
        asm volatile("" : "+v"(fr), "+v"(fq));
        float rs[8];
#pragma unroll
        for (int g = 0; g < 8; ++g) rs[g] = srs[(size_t)u.pm * 256 + (g >> 2) * 128 + wr * 64 + (g & 3) * 16 + fr];
#pragma unroll
        for (int g = 0; g < 8; ++g) { const int ai = g >> 2, m = g & 3; unsigned char* hrow = hid + ((size_t)u.pm * 256 + ai * 128 + wr * 64 + m * 16 + fr) * EFF + u.pn * 128 + wc * 16 + 4 * fq;
#pragma unroll
            for (int bj = 0; bj < 2; ++bj) { const f32x4 gg = acc[ai][bj][m][0] * rs[g], uu = acc[ai][bj][m][1] * rs[g]; float h4[4];
#pragma unroll
                for (int i = 0; i < 4; ++i) h4[i] = fminf(fmaxf(8.f * siluf_(gg[i]) * uu[i], -440.f), 440.f);
                *(unsigned*)(hrow + bj * 64) = pk4_fp8(h4[0], h4[1], h4[2], h4[3]); } }
    } };
struct EpiY { typedef float L; static constexpr int NB = 8; unsigned char* yexp; const float* sw;
    DEVI L load(int tile, int, int r, int) const { return sw[(size_t)tile * 256 + r]; }
    DEVI void apply(int tile, int pn, int r, int c, f32x4 v0, f32x4 v1, L w) const { const float ws_ = 16.f * w; u32x2 o;
        o.x = pk4_fp8(fminf(fmaxf(v0[0] * ws_, -440.f), 440.f), fminf(fmaxf(v0[1] * ws_, -440.f), 440.f), fminf(fmaxf(v0[2] * ws_, -440.f), 440.f), fminf(fmaxf(v0[3] * ws_, -440.f), 440.f));
        o.y = pk4_fp8(fminf(fmaxf(v1[0] * ws_, -440.f), 440.f), fminf(fmaxf(v1[1] * ws_, -440.f), 440.f), fminf(fmaxf(v1[2] * ws_, -440.f), 440.f), fminf(fmaxf(v1[3] * ws_, -440.f), 440.f));
        *(u32x2*)(yexp + ((size_t)tile * 256 + r) * 1024 + pn * 256 + c) = o; } };

DEVI void phase0(const Params& p, char* lds) {
    float* scr = (float*)lds; unsigned char* ws = p.ws;
    bf16_t* WinT = (bf16_t*)(ws + WS_WIN); bf16_t* WuqT = (bf16_t*)(ws + WS_WUQ); bf16_t* WukvT = (bf16_t*)(ws + WS_WUKV);
    bf16_t* WbrT = (bf16_t*)(ws + WS_WBR); bf16_t* WoutT = (bf16_t*)(ws + WS_WOUT);
    constexpr int I_IN = (4096 / 64) * 16, I_IN8 = (2816 / 64) * 16, I_UQ = 24 * 6, I_UKV = 32 * 4, I_BR = 16 * 16, I_OUT = 16 * 16;
    constexpr int NIT = I_IN + I_IN8 + I_UQ + I_UKV + 2 * I_BR + I_OUT;
    for (int it = blockIdx.x; it < NIT; it += gridDim.x) {
        int r = it;
        if (r < I_IN) { const int nb = r / 16, kb = r % 16; const float* nw = p.attn_norm_w;
            transpose_tile(p.w_in, 6848, WinT, 1024, kb * 64, nb * 64, [](int n) { return n; }, [nw](int k) { return nw[k]; }, scr); continue; }
        r -= I_IN;
        if (r < I_IN8) { const int nb = r / 16, kb = r % 16; const float* nw = p.attn_norm_w;
            transpose_tile_f8(p.w_in, 6848, ws + WS_WIN8, 1024, kb * 64, nb * 64, [](int n) { return n < 704 ? 4096 + n : (n < 768 ? -1 : 4032 + n); }, [nw](int k) { return nw[k] * 64.f; }, scr); continue; }
        r -= I_IN8;
        if (r < I_UQ) { const int nb = r / 6, kb = r % 6; const float* nw = p.q_norm_w;
            transpose_tile(p.w_uq, 1536, WuqT, 384, kb * 64, nb * 64,
                           [](int n) { const int hh = n / 192, c = n % 192; if (c < 128) return n; const int rr = c - 128; return hh * 192 + 128 + (rr & 1) * 32 + (rr >> 1); },
                           [nw](int k) { return nw[k] * 0.07216878364870322f; }, scr); continue; }
        r -= I_UQ;
        if (r < I_UKV) { const int nb = r / 4, kb = r % 4; const float* nw = p.kv_norm_w;
            transpose_tile(p.w_ukv, 2048, WukvT, 256, kb * 64, nb * 64, [](int n) { return n; }, [nw](int k) { return nw[k]; }, scr); continue; }
        r -= I_UKV;
        if (r < I_BR) { const int nb = r / 16, kb = r % 16;
            transpose_tile(p.w_bra, 1024, WbrT, 2048, kb * 64, nb * 64, [](int n) { return n; }, [](int) { return 1.f; }, scr); continue; }
        r -= I_BR;
        if (r < I_BR) { const int nb = r / 16, kb = r % 16;
            transpose_tile(p.w_brb, 1024, WbrT + 1024, 2048, kb * 64, nb * 64, [](int n) { return n; }, [](int) { return 1.f; }, scr); continue; }
        r -= I_BR;
        { const int nb = r / 16, kb = r % 16;
            transpose_tile(p.w_out, 1024, WoutT, 1024, kb * 64, nb * 64, [](int n) { return n; }, [](int) { return 1.f; }, scr); }
    }
    if (blockIdx.x == 0 && threadIdx.x == 0) { unsigned long long* tb = (unsigned long long*)(ws + WS_PTRS);
        tb[PT_POS] = (unsigned long long)p.pos; tb[PT_HGLB] = (unsigned long long)p.hg_lb; tb[PT_HGONW] = (unsigned long long)p.hg_onw; tb[PT_RGB] = (unsigned long long)p.rg_b; tb[PT_REB] = (unsigned long long)p.re_b;
        tb[PT_EW1] = (unsigned long long)p.ew1; tb[PT_EW3] = (unsigned long long)p.ew3; tb[PT_EW2] = (unsigned long long)p.ew2; tb[PT_FFNW] = (unsigned long long)p.ffn_norm_w; tb[PT_FINW] = (unsigned long long)p.final_w; tb[PT_X] = (unsigned long long)p.x; }
    bf16_t* WrH = (bf16_t*)(ws + WS_WRT); bf16_t* WrL = WrH + 80 * 1024;
    for (int e = blockIdx.x * NTHR + threadIdx.x; e < 80 * 1024; e += gridDim.x * NTHR) { const int c = e >> 10, k = e & 1023;
        const float w = c < 8 ? p.rg_w[k * 8 + c] * p.ffn_norm_w[k] : (c < 72 ? p.re_w[k * 64 + (c - 8)] * p.ffn_norm_w[k] : 0.f);
        const unsigned hb = f2bf(w); WrH[e] = (bf16_t)hb; WrL[e] = (bf16_t)f2bf(w - bf2f(hb)); }
    { float* lbt = (float*)(ws + WS_LBT); for (int k = blockIdx.x * NTHR + threadIdx.x; k < 1024; k += gridDim.x * NTHR) lbt[k] = 1.f / (1.f + expf(p.hg_lb[1024 + k] - p.hg_lb[k])); }
    bf16_t* H = (bf16_t*)(ws + WS_H);
    const int lane = threadIdx.x & 63, gw = blockIdx.x * 8 + (threadIdx.x >> 6), NGW = gridDim.x * 8;
    for (int m0 = gw * 2; m0 < T; m0 += NGW * 2) {
        f32x4 v[2][4];
#pragma unroll
        for (int r = 0; r < 2; ++r) { const f32x4* xr = (const f32x4*)(p.x + (size_t)(m0 + r) * D) + lane;
#pragma unroll
            for (int j = 0; j < 4; ++j) v[r][j] = xr[64 * j]; }
#pragma unroll
        for (int r = 0; r < 2; ++r) { const int m = m0 + r; float s = 0.f;
#pragma unroll
            for (int j = 0; j < 4; ++j) s += v[r][j][0] * v[r][j][0] + v[r][j][1] * v[r][j][1] + v[r][j][2] * v[r][j][2] + v[r][j][3] * v[r][j][3];
            const float rstd = rsqrtf(wave_sum(s) * (1.f / D) + 1e-6f);
            u32x2* o = (u32x2*)(H + (size_t)m * D) + lane; unsigned* o8 = (unsigned*)(ws + WS_H8 + (size_t)m * D) + lane; const float r4 = 4.f * rstd;
#pragma unroll
            for (int j = 0; j < 4; ++j) { u32x2 w; w.x = pk2(v[r][j][0] * rstd, v[r][j][1] * rstd); w.y = pk2(v[r][j][2] * rstd, v[r][j][3] * rstd); o[64 * j] = w;
                o8[64 * j] = pk4_fp8(v[r][j][0] * r4, v[r][j][1] * r4, v[r][j][2] * r4, v[r][j][3] * r4); } }
    }
}

DEVI void phase1(const Params& p, char* lds) {
    unsigned char* ws = p.ws;
    { g8::DenseOrder S; S.init(ws + WS_H, D, ws + WS_WIN, D, T, 4096); g8::Epi4<EpiZa> E{{ws}};
      g8::gemm_phase<g8::Epi4<EpiZa>, g8::DenseOrder, true>((G8_LAS unsigned char*)lds, D, D, D, S, E); }
    { g8::DenseOrder S; S.init(ws + WS_H8, D / 2, ws + WS_WIN8, D / 2, T, 2816); g8::Epi4<EpiZb> E{{ws}};
      g8::gemm_phase<g8::Epi4<EpiZb>, g8::DenseOrder, true, g8::NoHook, false, true>((G8_LAS unsigned char*)lds, D / 2, D / 2, D / 2, S, E, nullptr, g8::NoHook(), 1 << 30, 0, 125, 121); }
}

constexpr int HL_A = 0, HL_B = 17408, HL_BT = 34816, HL_VT = 53248, HL_AT = 71680, HL_ST = 80896, HL_SEG = 115712, HL_SS = 119808;
#define HG_BAR() do { asm volatile("s_waitcnt lgkmcnt(0)" ::: "memory"); __builtin_amdgcn_s_barrier(); asm volatile("" ::: "memory"); } while (0)
DEVI void hgrn_chain_mfma(const Params& p, char* lds, int b, int h) {
    const bf16_t* zh = (const bf16_t*)(p.ws + WS_ZH); bf16_t* oa = (bf16_t*)(p.ws + WS_OA);
    const float* hgonw = (const float*)ptab(p.ws, PT_HGONW);
    const int tid = threadIdx.x, lane = tid & 63, wid = __builtin_amdgcn_readfirstlane(tid >> 6), fr = lane & 15, g4 = lane >> 4;
    const int k2 = lane * 2, seg = wid;
    f32x4 S[8];
#pragma unroll
    for (int n = 0; n < 8; ++n) S[n] = (f32x4){0.f, 0.f, 0.f, 0.f};
    const bf16_t* zb = zh + (size_t)b * SEQ * ZH_P + h * 128;
    float* segs = (float*)(lds + HL_SEG); float* lss = (float*)(lds + HL_SS);
    unsigned rq[8], rf[8], rv[8];
#pragma unroll
    for (int i = 0; i < 8; ++i) { const bf16_t* r = zb + (size_t)(seg * 8 + i) * ZH_P + k2; rq[i] = *(const unsigned*)r; rf[i] = *(const unsigned*)(r + 1024); rv[i] = *(const unsigned*)(r + 2048); }
    const int tt = wid >> 1, vh = wid & 1;
    f32x4 nwv[4];
#pragma unroll
    for (int n = 0; n < 4; ++n) nwv[n] = *(const f32x4*)(hgonw + 16 * (4 * vh + n) + 4 * g4);
#if defined(TPROBE_A)
    unsigned long long tacc[6] = {0, 0, 0, 0, 0, 0}; unsigned long long tprev = __builtin_amdgcn_s_memrealtime();
#define HG_T(k) do { const unsigned long long now_ = __builtin_amdgcn_s_memrealtime(); tacc[k] += now_ - tprev; tprev = now_; } while (0)
#else
#define HG_T(k)
#endif
    for (int c = 0; c < SEQ / 64; ++c) {
        const int t0 = c * 64;
        u32x2 gpre[4];
        { const bf16_t* gp_ = zh + ((size_t)b * SEQ + t0 + 16 * tt + fr) * ZH_P + 3072 + h * 128;
#pragma unroll
          for (int n = 0; n < 4; ++n) gpre[n] = *(const u32x2*)(gp_ + 16 * (4 * vh + n) + 4 * g4); }
        float cs[8][2], qq[8][2], kk[8][2]; float run[2] = {0.f, 0.f};
#pragma unroll
        for (int i = 0; i < 8; ++i)
#pragma unroll
            for (int e = 0; e < 2; ++e) { const float lf = bf2f(e ? rf[i] >> 16 : rf[i] & 0xffffu); run[e] += lf; cs[i][e] = run[e]; kk[i][e] = 1.f - __expf(lf); qq[i][e] = bf2f(e ? rq[i] >> 16 : rq[i] & 0xffffu); }
        HG_BAR();
        HG_T(0);
        *(float2*)(segs + seg * 128 + k2) = make_float2(run[0], run[1]);
#pragma unroll
        for (int e = 0; e < 2; ++e) { u32x4 w;
            w.x = e ? (rv[0] >> 16) | (rv[1] & 0xffff0000u) : (rv[0] & 0xffffu) | (rv[1] << 16); w.y = e ? (rv[2] >> 16) | (rv[3] & 0xffff0000u) : (rv[2] & 0xffffu) | (rv[3] << 16);
            w.z = e ? (rv[4] >> 16) | (rv[5] & 0xffff0000u) : (rv[4] & 0xffffu) | (rv[5] << 16); w.w = e ? (rv[6] >> 16) | (rv[7] & 0xffff0000u) : (rv[6] & 0xffffu) | (rv[7] << 16);
            *(u32x4*)(lds + HL_VT + (k2 + e) * 144 + seg * 16) = w; }
        HG_BAR();
        HG_T(1);
        {
            float off[2] = {0.f, 0.f}, bm[2] = {0.f, 0.f};
#pragma unroll
            for (int s_ = 0; s_ < 8; ++s_) { const float2 v = *(const float2*)(segs + s_ * 128 + k2); if (s_ < seg) { off[0] += v.x; off[1] += v.y; } if (s_ < 4) { bm[0] += v.x; bm[1] += v.y; } }
            unsigned bt[2][4];
#pragma unroll
            for (int i = 0; i < 8; ++i) { float av[2], bv[2];
#pragma unroll
                for (int e = 0; e < 2; ++e) { const float ea = __expf(cs[i][e] + off[e] - bm[e]); av[e] = qq[i][e] * ea; bv[e] = kk[i][e] * __builtin_amdgcn_rcpf(ea); }
                *(unsigned*)(lds + HL_A + (seg * 8 + i) * 272 + k2 * 2) = pk2(av[0], av[1]);
                const unsigned pb = pk2(bv[0], bv[1]); *(unsigned*)(lds + HL_B + (seg * 8 + i) * 272 + k2 * 2) = pb;
                if (i & 1) { bt[0][i >> 1] |= pb << 16; bt[1][i >> 1] |= pb & 0xffff0000u; } else { bt[0][i >> 1] = pb & 0xffffu; bt[1][i >> 1] = pb >> 16; } }
#pragma unroll
            for (int e = 0; e < 2; ++e) { u32x4 w = {bt[e][0], bt[e][1], bt[e][2], bt[e][3]}; *(u32x4*)(lds + HL_BT + (k2 + e) * 144 + seg * 16) = w; }
        }
        f32x4 bmid = {0.f, 0.f, 0.f, 0.f}, blast = {0.f, 0.f, 0.f, 0.f};
#pragma unroll
        for (int s_ = 0; s_ < 8; ++s_) { const f32x4 v = *(const f32x4*)(segs + s_ * 128 + 16 * wid + 4 * g4); blast += v; if (s_ < 4) bmid += v; }
        {
            f32x4 em; em[0] = __expf(bmid[0]); em[1] = __expf(bmid[1]); em[2] = __expf(bmid[2]); em[3] = __expf(bmid[3]);
#pragma unroll
            for (int n = 0; n < 8; ++n) { u32x2 w; w.x = pk2(S[n][0] * em[0], S[n][1] * em[1]); w.y = pk2(S[n][2] * em[2], S[n][3] * em[3]); *(u32x2*)(lds + HL_ST + (16 * n + fr) * 272 + (16 * wid + 4 * g4) * 2) = w; }
        }
        if (c + 1 < SEQ / 64) {
#pragma unroll
            for (int i = 0; i < 8; ++i) { const bf16_t* r = zb + (size_t)(t0 + 64 + seg * 8 + i) * ZH_P + k2; rq[i] = *(const unsigned*)r; rf[i] = *(const unsigned*)(r + 1024); rv[i] = *(const unsigned*)(r + 2048); }
        }
        HG_BAR();
        HG_T(2);
#define HG_LD(off) (*(const bf16x8*)(lds + (off)))
#define HG_FENCE() do { asm volatile("s_waitcnt lgkmcnt(0)" ::: "memory"); __builtin_amdgcn_sched_barrier(0); } while (0)
        {
            bf16x8 fa[4], fb0[4], fb1[4]; const int ss0 = 2 * vh, ss1 = 2 * vh + 1;
#pragma unroll
            for (int kk4 = 0; kk4 < 4; ++kk4) { fa[kk4] = HG_LD(HL_A + (16 * tt + fr) * 272 + (32 * kk4 + 8 * g4) * 2); fb0[kk4] = HG_LD(HL_B + (16 * ss0 + fr) * 272 + (32 * kk4 + 8 * g4) * 2); fb1[kk4] = HG_LD(HL_B + (16 * ss1 + fr) * 272 + (32 * kk4 + 8 * g4) * 2); }
            HG_FENCE();
            f32x4 acc0 = {0.f, 0.f, 0.f, 0.f}, acc1 = {0.f, 0.f, 0.f, 0.f};
#pragma unroll
            for (int kk4 = 0; kk4 < 4; ++kk4) { acc0 = __builtin_amdgcn_mfma_f32_16x16x32_bf16(fb0[kk4], fa[kk4], acc0, 0, 0, 0); acc1 = __builtin_amdgcn_mfma_f32_16x16x32_bf16(fb1[kk4], fa[kk4], acc1, 0, 0, 0); }
#pragma unroll
            for (int i = 0; i < 4; ++i) { if (ss0 > tt || (ss0 == tt && 4 * g4 + i > fr)) acc0[i] = 0.f; if (ss1 > tt || (ss1 == tt && 4 * g4 + i > fr)) acc1[i] = 0.f; }
            u32x2 w; w.x = pk2(acc0[0], acc0[1]); w.y = pk2(acc0[2], acc0[3]); *(u32x2*)(lds + HL_AT + (16 * tt + fr) * 144 + (16 * ss0 + 4 * g4) * 2) = w;
            w.x = pk2(acc1[0], acc1[1]); w.y = pk2(acc1[2], acc1[3]); *(u32x2*)(lds + HL_AT + (16 * tt + fr) * 144 + (16 * ss1 + 4 * g4) * 2) = w;
        }
        HG_BAR();
        HG_T(3);
        f32x4 o[4];
#pragma unroll
        for (int n = 0; n < 4; ++n) o[n] = (f32x4){0.f, 0.f, 0.f, 0.f};
        {
            bf16x8 fat[2], fa[4];
#pragma unroll
            for (int ks = 0; ks < 2; ++ks) fat[ks] = HG_LD(HL_AT + (16 * tt + fr) * 144 + (32 * ks + 8 * g4) * 2);
#pragma unroll
            for (int kk4 = 0; kk4 < 4; ++kk4) fa[kk4] = HG_LD(HL_A + (16 * tt + fr) * 272 + (32 * kk4 + 8 * g4) * 2);
#pragma unroll
            for (int nh = 0; nh < 2; ++nh) {
                bf16x8 fv[2][2], fs[2][4];
#pragma unroll
                for (int n2 = 0; n2 < 2; ++n2) { const int vrow = 16 * (4 * vh + 2 * nh + n2) + fr;
#pragma unroll
                    for (int ks = 0; ks < 2; ++ks) fv[n2][ks] = HG_LD(HL_VT + vrow * 144 + (32 * ks + 8 * g4) * 2);
#pragma unroll
                    for (int kk4 = 0; kk4 < 4; ++kk4) fs[n2][kk4] = HG_LD(HL_ST + vrow * 272 + (32 * kk4 + 8 * g4) * 2); }
                HG_FENCE();
#pragma unroll
                for (int ks = 0; ks < 2; ++ks)
#pragma unroll
                    for (int n2 = 0; n2 < 2; ++n2) o[2 * nh + n2] = __builtin_amdgcn_mfma_f32_16x16x32_bf16(fv[n2][ks], fat[ks], o[2 * nh + n2], 0, 0, 0);
#pragma unroll
                for (int kk4 = 0; kk4 < 4; ++kk4)
#pragma unroll
                    for (int n2 = 0; n2 < 2; ++n2) o[2 * nh + n2] = __builtin_amdgcn_mfma_f32_16x16x32_bf16(fs[n2][kk4], fa[kk4], o[2 * nh + n2], 0, 0, 0);
            }
        }
        { float ssq = 0.f;
#pragma unroll
          for (int n = 0; n < 4; ++n) ssq += o[n][0] * o[n][0] + o[n][1] * o[n][1] + o[n][2] * o[n][2] + o[n][3] * o[n][3];
          ssq += __shfl_xor(ssq, 16); ssq += __shfl_xor(ssq, 32); if (g4 == 0) lss[vh * 64 + 16 * tt + fr] = ssq; }
        {
            f32x4 U[8]; bf16x8 fbt[2], fv[8][2];
#pragma unroll
            for (int ks = 0; ks < 2; ++ks) { fbt[ks] = HG_LD(HL_BT + (16 * wid + fr) * 144 + (32 * ks + 8 * g4) * 2);
#pragma unroll
                for (int n = 0; n < 8; ++n) fv[n][ks] = HG_LD(HL_VT + (16 * n + fr) * 144 + (32 * ks + 8 * g4) * 2); }
            HG_FENCE();
#pragma unroll
            for (int n = 0; n < 8; ++n) { U[n] = __builtin_amdgcn_mfma_f32_16x16x32_bf16(fbt[0], fv[n][0], (f32x4){0.f, 0.f, 0.f, 0.f}, 0, 0, 0); }
#pragma unroll
            for (int n = 0; n < 8; ++n) { U[n] = __builtin_amdgcn_mfma_f32_16x16x32_bf16(fbt[1], fv[n][1], U[n], 0, 0, 0); }
            f32x4 el, elm;
#pragma unroll
            for (int i = 0; i < 4; ++i) { el[i] = __expf(blast[i]); elm[i] = __expf(blast[i] - bmid[i]); }
#pragma unroll
            for (int n = 0; n < 8; ++n) S[n] = S[n] * el + U[n] * elm;
        }
#undef HG_LD
#undef HG_FENCE
        HG_BAR();
        HG_T(4);
        {
            const int t = 16 * tt + fr; const float rstd = rsqrtf((lss[t] + lss[64 + t]) * (1.f / 128.f) + 1e-6f);
            const size_t trow = (size_t)b * SEQ + t0 + t; bf16_t* op = oa + trow * 1024 + h * 128;
#pragma unroll
            for (int n = 0; n < 4; ++n) { const int v0 = 16 * (4 * vh + n) + 4 * g4; const u32x2 gg = gpre[n]; const f32x4 nw = nwv[n];
                f32x4 r; r[0] = o[n][0] * rstd * nw[0] * bf2f(gg.x & 0xffffu); r[1] = o[n][1] * rstd * nw[1] * bf2f(gg.x >> 16);
                r[2] = o[n][2] * rstd * nw[2] * bf2f(gg.y & 0xffffu); r[3] = o[n][3] * rstd * nw[3] * bf2f(gg.y >> 16); store4bf(op + v0, r); }
        }
        HG_T(5);
    }
#if defined(TPROBE_A)
    if (blockIdx.x == 0 && threadIdx.x == 0) { unsigned long long* ts = (unsigned long long*)(p.ws + WS_TS); for (int k = 0; k < 6; ++k) { ts[20 + 2 * k] = 0; ts[21 + 2 * k] = tacc[k]; } }
#endif
    HG_BAR();
}
#undef HG_BAR
DEVI void conv_tile256(const float* colp, size_t rs, const float* kscale, bf16_t* dst, int ldk, float* scr) {
    const int tid = threadIdx.x;
    { const int nl = tid & 63, kq = tid >> 6;
      float v[32];
#pragma unroll
      for (int i = 0; i < 32; ++i) v[i] = colp[(size_t)(kq * 32 + i) * rs];
      if (kscale) {
#pragma unroll
          for (int i = 0; i < 32; ++i) v[i] *= kscale[kq * 32 + i]; }
#pragma unroll
      for (int i = 0; i < 32; ++i) scr[(kq * 32 + i) * 65 + nl] = v[i]; }
    __syncthreads();
    { const int nl = tid >> 3, kc = tid & 7;
#pragma unroll
      for (int j = 0; j < 4; ++j) { const float* s_ = scr + (kc * 8 + 64 * j) * 65 + nl;
          u32x4 o; o.x = pk2(s_[0], s_[65]); o.y = pk2(s_[2 * 65], s_[3 * 65]); o.z = pk2(s_[4 * 65], s_[5 * 65]); o.w = pk2(s_[6 * 65], s_[7 * 65]);
          *(u32x4*)(dst + (size_t)nl * ldk + kc * 8 + 64 * j) = o; } }
    __syncthreads();
}
DEVI void conv_tile256_f8(const float* colp4, size_t rs, const float* kscale, float wscale, unsigned char* dst, int ldk, float* scr) {
    const int tid = threadIdx.x;
    { const int n4 = tid & 15, kr = tid >> 4; f32x4 v[8];
#pragma unroll
      for (int i = 0; i < 8; ++i) v[i] = *(const f32x4*)(colp4 + (size_t)(kr + 32 * i) * rs);
#pragma unroll
      for (int i = 0; i < 8; ++i) { const float sc = kscale ? kscale[kr + 32 * i] * wscale : wscale; float* d = scr + (kr + 32 * i) * 65 + 4 * n4; d[0] = v[i][0] * sc; d[1] = v[i][1] * sc; d[2] = v[i][2] * sc; d[3] = v[i][3] * sc; } }
    __syncthreads();
    { const int nl = tid >> 3, kc = tid & 7;
#pragma unroll
      for (int j = 0; j < 4; ++j) { const float* s_ = scr + (kc * 8 + 64 * j) * 65 + nl;
          u32x2 o; o.x = pk4_fp8(s_[0], s_[65], s_[2 * 65], s_[3 * 65]); o.y = pk4_fp8(s_[4 * 65], s_[5 * 65], s_[6 * 65], s_[7 * 65]);
          *(u32x2*)(dst + (size_t)nl * ldk + kc * 8 + 64 * j) = o; } }
    __syncthreads();
}
DEVI void mla_prep(const Params& p, int chunk) {
    bf16_t* zl = (bf16_t*)(p.ws + WS_ZL); float* cosT = (float*)(p.ws + WS_COS); float* sinT = (float*)(p.ws + WS_SIN); const int* posp = (const int*)ptab(p.ws, PT_POS);
    const int lane = threadIdx.x & 63, wid = threadIdx.x >> 6;
    for (int rr = wid; rr < 256; rr += 8) { const size_t t = (size_t)chunk * 256 + rr; bf16_t* zr = zl + t * ZL_P;
        float cq[6], ck[4]; float s = 0.f, s2 = 0.f;
#pragma unroll
        for (int j = 0; j < 6; ++j) { cq[j] = bf2f(zr[lane + 64 * j]); s += cq[j] * cq[j]; }
#pragma unroll
        for (int j = 0; j < 4; ++j) { ck[j] = bf2f(zr[384 + lane + 64 * j]); s2 += ck[j] * ck[j]; }
        const float kr = bf2f(zr[640 + lane]);
        const float r1 = rsqrtf(wave_sum(s) * (1.f / 384.f) + 1e-6f), r2 = rsqrtf(wave_sum(s2) * (1.f / 256.f) + 1e-6f);
        const float other = __shfl_xor(kr, 32);
        const int i = lane & 31; const float invf = powf(10000.f, -(float)i / 32.f); const float ang = (float)posp[t] * invf; const float cs = cosf(ang), sn = sinf(ang);
        const float x1 = lane < 32 ? kr : other, x2 = lane < 32 ? other : kr;
        const float outv = lane < 32 ? (x1 * cs - x2 * sn) : (x2 * cs + x1 * sn);
#pragma unroll
        for (int j = 0; j < 6; ++j) zr[lane + 64 * j] = (bf16_t)f2bf(cq[j] * r1);
#pragma unroll
        for (int j = 0; j < 4; ++j) zr[384 + lane + 64 * j] = (bf16_t)f2bf(ck[j] * r2);
        ((bf16_t*)(p.ws + WS_KPE))[t * 64 + 2 * i + (lane >> 5)] = (bf16_t)f2bf(outv);
        if (lane < 32) { cosT[t * 32 + i] = cs; sinT[t * 32 + i] = sn; }
    }
}
constexpr int N13_EARLY = 2432;
DEVI void w13_tile(unsigned char* ws, const float* ew1, const float* ew3, const float* ffnw, int ci, int nl, float* scr) {
    const int e = ci >> 6, r = ci & 63, nb = r >> 2, kb = r & 3, n = nb * 64 + 4 * (nl & 15);
    const float* colp = ((n & 4) ? ew3 : ew1) + (size_t)e * 1024 * 512 + (size_t)(kb * 256) * 512 + (n >> 3) * 4;
    conv_tile256_f8(colp, 512, ffnw + kb * 256, 64.f, ws + WS_W13 + ((size_t)e * 1024 + nb * 64) * 1024 + kb * 256, 1024, scr);
}
DEVI void phase2a(const Params& p, char* lds, bool prep = true) {
#pragma unroll 1
    for (int it = blockIdx.x; it < 128; it += gridDim.x) {
        hgrn_chain_mfma(p, lds, it >> 3, it & 7);
#if defined(TPROBE_A)
        if (TPROBE_A == 12 && blockIdx.x == 0 && threadIdx.x == 0) ((unsigned long long*)(p.ws + WS_TS))[13] = __builtin_amdgcn_s_memrealtime();
#endif
    }
#pragma unroll 1
    for (int it = blockIdx.x; it < 256; it += gridDim.x) { if (it < 128) continue;
        if (prep) mla_prep(p, it - 128);
        const float* ew1 = (const float*)ptab(p.ws, PT_EW1); const float* ew3 = (const float*)ptab(p.ws, PT_EW3); const float* ffnw = (const float*)ptab(p.ws, PT_FFNW); const int nl = threadIdx.x & 63;
        __syncthreads();
#pragma unroll 1
        for (int ci = it - 128; ci < N13_EARLY; ci += 128) w13_tile(p.ws, ew1, ew3, ffnw, ci, nl, (float*)lds);
    }
}

DEVI void phase2b(const Params& p, char* lds) {
    unsigned char* ws = p.ws;
    { g8::DenseOrder S; S.init(ws + WS_ZL, ZL_P, ws + WS_WUQ, 384, T, 1536);
      g8::Epi4<EpiQ> E{{(bf16_t*)(ws + WS_Q)}};
      g8::gemm_phase<g8::Epi4<EpiQ>, g8::DenseOrder, true>((G8_LAS unsigned char*)lds, ZL_P, 384, 384, S, E); }
    { g8::DenseOrder S; S.init(ws + WS_ZL + 384 * 2, ZL_P, ws + WS_WUKV, 256, T, 2048);
      g8::Epi4<EpiKV> E{{(bf16_t*)(ws + WS_KN), (bf16_t*)(ws + WS_V)}};
      g8::gemm_phase<g8::Epi4<EpiKV>, g8::DenseOrder, true>((G8_LAS unsigned char*)lds, ZL_P, 256, 256, S, E); }
}

namespace at2 {
typedef short s16x4 __attribute__((ext_vector_type(4)));
typedef float f32x16 __attribute__((ext_vector_type(16)));
constexpr int KROW = 384;
constexpr int SHM_K = 64 * KROW, SHM_V = 64 * 256;
constexpr int L_V = 0, L_K = 3 * SHM_V, L_WS = 3 * SHM_V + 2 * SHM_K;
constexpr float THR = 8.f;
#define AT_KSWZ(row, colB) ((row) * at2::KROW + ((colB) ^ (((row) & 7) << 4)))
DEVI int v_st(int k, int c) { const int kk = (k & ~0xC) | ((k & 4) << 1) | ((k & 8) >> 1); return ((kk >> 3) * 4 + (c >> 5)) * 512 + ((kk & 7) * 32 + (c & 31)) * 2; }
DEVI int v_rd_base(int lane) { return ((lane & 3) << 3) | (((lane >> 2) & 3) << 6) | (((lane >> 4) & 1) << 5) | (((lane >> 5) & 1) << 8); }
constexpr int v_rd_off(int d0, int ks, int half) { return d0 * 512 + ks * 4096 + half * 2048; }
DEVI int crow(int r, int hi) { return (r & 3) + 8 * (r >> 2) + 4 * hi; }
DEVI unsigned cvtpk(float lo, float hi) { unsigned r; asm volatile("v_cvt_pk_bf16_f32 %0, %1, %2" : "=v"(r) : "v"(lo), "v"(hi)); return r; }
DEVI void mask_tile(f32x16& p0, f32x16& p1, int dq) {
    const float NEG = -__builtin_inff();
#pragma unroll
    for (int r = 0; r < 16; ++r) { const int c = (r & 3) + 8 * (r >> 2); if (dq - c < 0) p0[r] = NEG; if (dq - c - 32 < 0) p1[r] = NEG; }
}
DEVI void partialSM(f32x16& p0, f32x16& p1, float& m_reg, float& mn, float& alpha) {
    float pmax = p0[0];
#pragma unroll
    for (int r = 1; r < 16; ++r) pmax = fmaxf(pmax, p0[r]);
#pragma unroll
    for (int r = 0; r < 16; ++r) pmax = fmaxf(pmax, p1[r]);
    { auto rr = __builtin_amdgcn_permlane32_swap(__float_as_uint(pmax), __float_as_uint(pmax), false, false); pmax = fmaxf(__uint_as_float(rr[0]), __uint_as_float(rr[1])); }
    constexpr float C2 = 1.4426950408889634f;
    if (__builtin_expect(__all((pmax - m_reg) <= THR), 1)) { mn = m_reg; alpha = 1.f; }
    else { mn = fmaxf(m_reg, pmax); alpha = __builtin_amdgcn_exp2f((m_reg - mn) * C2); m_reg = mn; }
    const float mnL = -mn * C2;
#pragma unroll
    for (int r = 0; r < 16; ++r) p0[r] = fmaf(p0[r], C2, mnL);
#pragma unroll
    for (int r = 0; r < 16; ++r) p1[r] = fmaf(p1[r], C2, mnL);
#pragma unroll
    for (int r = 0; r < 16; ++r) p0[r] = __builtin_amdgcn_exp2f(p0[r]);
}
DEVI void finishSM(f32x16& p0, f32x16& p1, float alpha, float& l_reg, bf16x8& pa0, bf16x8& pa1, bf16x8& pa2, bf16x8& pa3) {
#pragma unroll
    for (int r = 0; r < 16; ++r) p1[r] = __builtin_amdgcn_exp2f(p1[r]);
    float ps = 0;
#pragma unroll
    for (int r = 0; r < 16; ++r) ps += p0[r];
#pragma unroll
    for (int r = 0; r < 16; ++r) ps += p1[r];
    { auto rr = __builtin_amdgcn_permlane32_swap(__float_as_uint(ps), __float_as_uint(ps), false, false); ps = __uint_as_float(rr[0]) + __uint_as_float(rr[1]); }
    l_reg = l_reg * alpha + ps;
#define AT_PK4(P, B_, OUT) do { unsigned a0 = cvtpk(P[B_+0], P[B_+1]), a1 = cvtpk(P[B_+2], P[B_+3]); unsigned b0 = cvtpk(P[B_+4], P[B_+5]), b1 = cvtpk(P[B_+6], P[B_+7]); \
        auto r0 = __builtin_amdgcn_permlane32_swap(a0, b0, false, false); auto r1 = __builtin_amdgcn_permlane32_swap(a1, b1, false, false); \
        u32x4 w = {r0[0], r1[0], r0[1], r1[1]}; OUT = *reinterpret_cast<bf16x8*>(&w); } while (0)
    AT_PK4(p0, 0, pa0); AT_PK4(p0, 8, pa1); AT_PK4(p1, 0, pa2); AT_PK4(p1, 8, pa3);
#undef AT_PK4
}
template <int KB>
DEVI void qkt(f32x16& p0, f32x16& p1, const char* K_lds, int r32, int hi, const bf16x8* qr) {
    p0 = f32x16{}; p1 = f32x16{};
    const char* kb[4];
#pragma unroll
    for (int dd = 0; dd < 4; ++dd) kb[dd] = K_lds + KB * SHM_K + AT_KSWZ(r32, (dd * 16 + hi * 8) * 2);
#pragma unroll
    for (int d0 = 0; d0 < 12; ++d0) { const char* a = kb[d0 & 3] + (d0 >> 2) * 128;
        const bf16x8 b0 = *reinterpret_cast<const bf16x8*>(a); const bf16x8 b1 = *reinterpret_cast<const bf16x8*>(a + 32 * KROW);
        p0 = __builtin_amdgcn_mfma_f32_32x32x16_bf16(b0, qr[d0], p0, 0, 0, 0); p1 = __builtin_amdgcn_mfma_f32_32x32x16_bf16(b1, qr[d0], p1, 0, 0, 0); }
}
DEVI void pv_tile(f32x16* o, int vb0, bf16x8 pa0, bf16x8 pa1, bf16x8 pa2, bf16x8 pa3) {
#define AT_TRRD(dst, off) asm volatile("ds_read_b64_tr_b16 %0, %1 offset:%2" : "=&v"(dst) : "v"(vb0), "i"(off) : "memory")
#define AT_PV_D0(d0) do { s16x4 l0, l1, l2, l3, h0, h1, h2, h3; constexpr int b_ = v_rd_off(d0, 0, 0); \
        AT_TRRD(l0, b_); AT_TRRD(h0, b_ + 2048); AT_TRRD(l1, b_ + 4096); AT_TRRD(h1, b_ + 6144); AT_TRRD(l2, b_ + 8192); AT_TRRD(h2, b_ + 10240); AT_TRRD(l3, b_ + 12288); AT_TRRD(h3, b_ + 14336); \
        asm volatile("s_waitcnt lgkmcnt(0)" ::: "memory"); __builtin_amdgcn_sched_barrier(0); \
        o[d0] = __builtin_amdgcn_mfma_f32_32x32x16_bf16(pa0, (bf16x8){l0[0], l0[1], l0[2], l0[3], h0[0], h0[1], h0[2], h0[3]}, o[d0], 0, 0, 0); \
        o[d0] = __builtin_amdgcn_mfma_f32_32x32x16_bf16(pa1, (bf16x8){l1[0], l1[1], l1[2], l1[3], h1[0], h1[1], h1[2], h1[3]}, o[d0], 0, 0, 0); \
        o[d0] = __builtin_amdgcn_mfma_f32_32x32x16_bf16(pa2, (bf16x8){l2[0], l2[1], l2[2], l2[3], h2[0], h2[1], h2[2], h2[3]}, o[d0], 0, 0, 0); \
        o[d0] = __builtin_amdgcn_mfma_f32_32x32x16_bf16(pa3, (bf16x8){l3[0], l3[1], l3[2], l3[3], h3[0], h3[1], h3[2], h3[3]}, o[d0], 0, 0, 0); } while (0)
    AT_PV_D0(0); AT_PV_D0(1); AT_PV_D0(2); AT_PV_D0(3);
#undef AT_PV_D0
#undef AT_TRRD
}
DEVI void block(const Params& p, char* lds, int b, int h, int qb) {
    const bf16_t* q = (const bf16_t*)(p.ws + WS_Q); const bf16_t* kn = (const bf16_t*)(p.ws + WS_KN); const bf16_t* vg = (const bf16_t*)(p.ws + WS_V);
    const bf16_t* kpe = (const bf16_t*)(p.ws + WS_KPE); bf16_t* ob = (bf16_t*)(p.ws + WS_OB);
    const int tid = threadIdx.x, wid = __builtin_amdgcn_readfirstlane(tid >> 6), lane = tid & 63, r32 = lane & 31, hi = lane >> 5;
    const size_t tb = (size_t)b * SEQ; const int P0 = qb * 256, NT = (P0 + 256) / 64;
    char* V_lds = lds + L_V; char* K_lds = lds + L_K; float* ws = (float*)(lds + L_WS) + wid * 64; float* li_l = ws; float* al_l = ws + 32;
    const int qlo = P0 + wid * 32, qm = qlo + r32 - 4 * hi;
    const int sr = tid >> 4, sc = (tid & 15) * 8, vst0 = v_st(sr, sc), vst1 = v_st(32 + sr, sc);
    const int kd0 = AT_KSWZ(sr, sc * 2), kd2 = AT_KSWZ(tid >> 3, 256 + (tid & 7) * 16);
    const bf16_t* knp = kn + (tb + sr) * 1024 + h * 128 + sc; const bf16_t* vp = vg + (tb + sr) * 1024 + h * 128 + sc; const bf16_t* kpp = kpe + (tb + (tid >> 3)) * 64 + (tid & 7) * 8;
    const int vb0 = (int)(uintptr_t)V_lds + v_rd_base(lane);
    bf16x8 stk[3], stv[2];
#define AT_LOAD(t_) do { const size_t o_ = (size_t)(t_) * 64; stk[0] = *(const bf16x8*)(knp + o_ * 1024); stk[1] = *(const bf16x8*)(knp + (o_ + 32) * 1024); stk[2] = *(const bf16x8*)(kpp + o_ * 64); \
        stv[0] = *(const bf16x8*)(vp + o_ * 1024); stv[1] = *(const bf16x8*)(vp + (o_ + 32) * 1024); } while (0)
#define AT_WRITE(bf, voff) do { *(bf16x8*)(K_lds + (bf) * SHM_K + kd0) = stk[0]; *(bf16x8*)(K_lds + (bf) * SHM_K + kd0 + 32 * KROW) = stk[1]; *(bf16x8*)(K_lds + (bf) * SHM_K + kd2) = stk[2]; \
        *(bf16x8*)(V_lds + (voff) + vst0) = stv[0]; *(bf16x8*)(V_lds + (voff) + vst1) = stv[1]; } while (0)
    AT_LOAD(0);
    bf16x8 qr[12];
    { const bf16_t* qrow = q + (tb + qlo + r32) * 1536 + h * 192;
#pragma unroll
      for (int d0 = 0; d0 < 12; ++d0) qr[d0] = *(const bf16x8*)(qrow + d0 * 16 + hi * 8);
      int r32o = r32; asm volatile("" : "+v"(r32o));
      const float* cosT = (const float*)(p.ws + WS_COS) + (tb + qlo + r32o) * 32; const float* sinT = cosT + (WS_SIN - WS_COS) / 4;
#pragma unroll
      for (int d0 = 8; d0 < 12; ++d0) { const f32x4 cs = *(const f32x4*)(cosT + 8 * (d0 - 8) + 4 * hi), sn = *(const f32x4*)(sinT + 8 * (d0 - 8) + 4 * hi); u32x4 w = __builtin_bit_cast(u32x4, qr[d0]);
#pragma unroll
          for (int jj = 0; jj < 4; ++jj) { const float x1 = bf2f(w[jj] & 0xffffu), x2 = bf2f(w[jj] >> 16); w[jj] = pk2(x1 * cs[jj] - x2 * sn[jj], x2 * cs[jj] + x1 * sn[jj]); }
          qr[d0] = __builtin_bit_cast(bf16x8, w); asm volatile("" ::: "memory"); } }
    float m_reg = -1e30f, l_reg = 0.f; f32x16 o[4] = {};
    __syncthreads();
    AT_WRITE(0, 0);
    __syncthreads();
    const bool skew = wid >= 4; int vprev = 2 * SHM_V, vcur = 0, vnext = SHM_V; bf16x8 pp0, pp1, pp2, pp3;
#define AT_RESC(a) do { if (__any((a) < 1.f)) { if (hi == 0) al_l[r32] = (a); asm volatile("s_waitcnt lgkmcnt(0)" ::: "memory"); \
        _Pragma("unroll") for (int d_ = 0; d_ < 4; ++d_) _Pragma("unroll") for (int r = 0; r < 16; ++r) o[d_][r] *= al_l[crow(r, hi)]; } } while (0)
#define AT_STEP(t_, BF) do { const int tq = (t_); if (tq + 1 < NT) AT_LOAD(tq + 1); \
        if (skew && tq > 0) pv_tile(o, vb0 + vprev, pp0, pp1, pp2, pp3); \
        { f32x16 p0, p1; float mn, al; \
          qkt<BF>(p0, p1, K_lds, r32, hi, qr); \
          { const int kb_ = tq * 64; if (kb_ + 63 > qlo) mask_tile(p0, p1, qm - kb_); } \
          partialSM(p0, p1, m_reg, mn, al); finishSM(p0, p1, al, l_reg, pp0, pp1, pp2, pp3); AT_RESC(al); } \
        if (!skew) pv_tile(o, vb0 + vcur, pp0, pp1, pp2, pp3); \
        if (tq + 1 < NT) AT_WRITE(1 - BF, vnext); \
        vprev = vcur; vcur = vnext; vnext = (vnext == 2 * SHM_V) ? 0 : vnext + SHM_V; \
        __syncthreads(); } while (0)
#pragma unroll 1
    for (int t = 0; t < NT; t += 2) { AT_STEP(t, 0); AT_STEP(t + 1, 1); }
    if (skew) pv_tile(o, vb0 + vprev, pp0, pp1, pp2, pp3);
    if (hi == 0) li_l[r32] = l_reg;
    asm volatile("s_waitcnt lgkmcnt(0)" ::: "memory");
    float rli[16];
#pragma unroll
    for (int r = 0; r < 16; ++r) rli[r] = __builtin_amdgcn_rcpf(li_l[crow(r, hi)]);
    bf16_t* Ow = ob + (tb + qlo) * 1024 + h * 128;
#pragma unroll
    for (int r = 0; r < 16; ++r) { const int orow = crow(r, hi);
#pragma unroll
        for (int d0 = 0; d0 < 4; ++d0) { const float v = o[d0][r] * rli[r]; const float vn = __shfl_xor(v, 1);
            if ((r32 & 1) == 0) *(unsigned*)(Ow + (size_t)orow * 1024 + d0 * 32 + r32) = cvtpk(v, vn); } }
#undef AT_LOAD
#undef AT_WRITE
#undef AT_RESC
#undef AT_STEP
}
}
DEVI void phase3(const Params& p, char* lds) {
    const int G_ = (int)gridDim.x, vcu = (G_ % 8 == 0) ? ((int)blockIdx.x % 8) * (G_ / 8) + (int)blockIdx.x / 8 : (int)blockIdx.x;
#pragma unroll 1
    for (int it2 = vcu * 2; it2 < 1024; it2 += (it2 & 1) ? 2 * G_ - 1 : 1) { const int it = it2 >> 1, bh = it >> 2, x = it & 3;
        at2::block(p, lds, bh >> 3, bh & 7, (it2 & 1) ? x : 7 - x); }
    __syncthreads();
}

DEVI void phase4(const Params& p, char* lds) {
    unsigned char* ws = p.ws; const unsigned char* zg = ws + WS_ZG;
    g8::DenseOrder S; S.init(ws + WS_OA, 1024, ws + WS_WBR, 2048, T, 1024);
    g8::Epi4<EpiBr2> E{{zg, (bf16_t*)(ws + WS_Y)}}; g8::Hook4<BrHookF> H{{zg}};
    g8::gemm_phase<g8::Epi4<EpiBr2>, g8::DenseOrder, true, g8::Hook4<BrHookF>>((G8_LAS unsigned char*)lds, 1024, 2048, 2048, S, E, nullptr, H, 16, (long)WS_OB - (long)WS_OA - 16 * 128);
}
DEVI void phase5(const Params& p, char* lds) {
    unsigned char* ws = p.ws;
    g8::DenseOrder S; S.init(ws + WS_Y, 1024, ws + WS_WOUT, 1024, T, 1024);
    g8::Epi4<EpiOut> E{{(const float*)ptab(ws, PT_X), (bf16_t*)(ws + WS_X2B), ws + WS_X2F8}};
#if defined(TPROBE_A) && defined(TPROBE_GEMM) && TPROBE_GEMM == 6
    g8::gemm_phase<g8::Epi4<EpiOut>, g8::DenseOrder, true>((G8_LAS unsigned char*)lds, 1024, 1024, 1024, S, E, (unsigned long long*)(ws + WS_TS) + 20);
#else
    g8::gemm_phase<g8::Epi4<EpiOut>, g8::DenseOrder, true>((G8_LAS unsigned char*)lds, 1024, 1024, 1024, S, E);
#endif
}

constexpr size_t RT_SRS = RT_ST, RT_RS = 1888 * 1024;
DEVI void phase6a(const Params& p, char* lds, bool router = true) {
    unsigned char* ws = p.ws; float* scr = (float*)lds;
    const float* ew1 = (const float*)ptab(ws, PT_EW1); const float* ew3 = (const float*)ptab(ws, PT_EW3); const float* ew2 = (const float*)ptab(ws, PT_EW2); const float* ffnw = (const float*)ptab(ws, PT_FFNW);
    const float* rgb = (const float*)ptab(ws, PT_RGB); const float* reb = (const float*)ptab(ws, PT_REB);
    unsigned char* W2 = ws + WS_W2;
    for (int ci = N13_EARLY + blockIdx.x; ci < NEXP * 64; ci += gridDim.x) w13_tile(ws, ew1, ew3, ffnw, ci, threadIdx.x & 63, scr);
    constexpr int I2 = 2 * 16;
    for (int it = blockIdx.x; it < NEXP * I2; it += gridDim.x) { const int e = it / I2, r = it % I2, nb = r >> 1, kb = r & 1, nl = threadIdx.x & 63;
        conv_tile256_f8(ew2 + (size_t)e * 512 * 1024 + (size_t)(kb * 256) * 1024 + nb * 64 + 4 * (nl & 15), 1024, nullptr, 64.f, W2 + ((size_t)e * 1024 + nb * 64) * EFF + kb * 256, EFF, scr); }
    __syncthreads();
#if defined(TPROBE_A)
    if (TPROBE_A == 17 && blockIdx.x == 0 && threadIdx.x == 0) ((unsigned long long*)(p.ws + WS_TS))[13] = __builtin_amdgcn_s_memrealtime();
#endif
    if (!router) return;
    const bf16_t* WrH = (const bf16_t*)(ws + WS_WRT); const bf16_t* WrL = WrH + 80 * 1024; const bf16_t* X2B = (const bf16_t*)(ws + WS_X2B);
    int* AE = (int*)(ws + WS_ROUTE + RT_AE); int* AP = (int*)(ws + WS_ROUTE + RT_AP); float* AW = (float*)(ws + WS_ROUTE + RT_AW); float* RS = (float*)(ws + WS_ROUTE + RT_RS);
    unsigned* cnt = (unsigned*)(ws + WS_CTL) + CW_CNT;
    const int tid = threadIdx.x, lane = tid & 63, wid = tid >> 6, fr = lane & 15, g4 = lane >> 4;
    constexpr int WL_ROW = 528, WL_ARR = 80 * WL_ROW, WL_BYTES = 2 * WL_ARR;
    float* lgw = (float*)(lds + WL_BYTES) + wid * (16 * 84 + 16);
    for (int g0 = blockIdx.x * 8; g0 < T / 16; g0 += gridDim.x * 8) {
        const int grp = g0 + wid;
        const size_t t0 = (size_t)grp * 16; const bf16_t* xrow = X2B + (t0 + fr) * 1024 + 8 * g4;
        f32x4 acc[5]; float ssq = 0.f;
#pragma unroll
        for (int n = 0; n < 5; ++n) acc[n] = (f32x4){0.f, 0.f, 0.f, 0.f};
#pragma unroll 1
        for (int kq = 0; kq < 4; ++kq) {
            bf16x8 xa[8];
#pragma unroll
            for (int kk = 0; kk < 8; ++kk) xa[kk] = *(const bf16x8*)(xrow + kq * 256 + 32 * kk);
            __syncthreads();
#pragma unroll
            for (int j = 0; j < 5; ++j) { const int row = (tid >> 5) + 16 * j, ch = tid & 31; const size_t so = (size_t)row * 1024 + kq * 256 + ch * 8; const int dof = row * WL_ROW + ch * 16;
                *(u32x4*)(lds + dof) = *(const u32x4*)(WrH + so); *(u32x4*)(lds + WL_ARR + dof) = *(const u32x4*)(WrL + so); }
            __syncthreads();
#pragma unroll
            for (int kk = 0; kk < 8; ++kk) {
                const bf16x8 ah = xa[kk];
#pragma unroll
                for (int j = 0; j < 8; ++j) { const float xv = bf2f((unsigned)(unsigned short)ah[j]); ssq += xv * xv; }
#pragma unroll
                for (int n = 0; n < 5; ++n) { const bf16x8 bh = *(const bf16x8*)(lds + (16 * n + fr) * WL_ROW + (32 * kk + 8 * g4) * 2), bl = *(const bf16x8*)(lds + WL_ARR + (16 * n + fr) * WL_ROW + (32 * kk + 8 * g4) * 2);
                    acc[n] = __builtin_amdgcn_mfma_f32_16x16x32_bf16(ah, bh, acc[n], 0, 0, 0); acc[n] = __builtin_amdgcn_mfma_f32_16x16x32_bf16(ah, bl, acc[n], 0, 0, 0); }
            }
        }
        ssq += __shfl_xor(ssq, 16); ssq += __shfl_xor(ssq, 32);
        const float rstd = rsqrtf(ssq * (1.f / D) + 1e-6f);
        if (g4 == 0) lgw[16 * 84 + fr] = rstd;
#pragma unroll
        for (int n = 0; n < 5; ++n)
#pragma unroll
            for (int i = 0; i < 4; ++i) lgw[(4 * g4 + i) * 84 + 16 * n + fr] = acc[n][i];
        asm volatile("s_waitcnt lgkmcnt(0)" ::: "memory");
        int ea = 0, eb = 0;
        if (lane < 16) { const float* lg = lgw + lane * 84; const float rs = lgw[16 * 84 + lane]; const size_t t = t0 + lane;
            int g = 0; float glv[8]; glv[0] = lg[0] * rs + rgb[0]; float gbest = glv[0];
#pragma unroll
            for (int j = 1; j < 8; ++j) { glv[j] = lg[j] * rs + rgb[j]; if (glv[j] > gbest) { gbest = glv[j]; g = j; } }
            float gs = 0.f;
#pragma unroll
            for (int j = 0; j < 8; ++j) gs += expf(glv[j] - gbest);
            const float gwt = 1.f / gs;
            int e1 = 0, e2 = 0; float b1 = -__builtin_inff(), b2 = -__builtin_inff();
            for (int j = 0; j < 8; ++j) { const float v = lg[8 + g * 8 + j] * rs + reb[g * 8 + j];
                if (v > b1) { b2 = b1; e2 = e1; b1 = v; e1 = j; } else if (v > b2) { b2 = v; e2 = j; } }
            const float d = expf(b2 - b1); const float w1 = 1.f / (1.f + d), w2 = d / (1.f + d);
            ea = g * 8 + e1; eb = g * 8 + e2;
            AE[2 * t] = ea; AE[2 * t + 1] = eb; AW[2 * t] = gwt * w1; AW[2 * t + 1] = gwt * w2; RS[t] = rs;
        }
        int* lcnt = (int*)(lds + WL_BYTES + 8 * (16 * 84 + 16) * 4); int* lbase = lcnt + 64;
        __syncthreads();
        if (tid < 64) lcnt[tid] = 0;
        __syncthreads();
        int ra = 0, rb = 0;
        if (lane < 16) { ra = atomicAdd(lcnt + ea, 1); rb = atomicAdd(lcnt + eb, 1); }
        __syncthreads();
        if (tid < 64) { const int c = lcnt[tid]; lbase[tid] = c ? (int)atomicAdd(cnt + tid * CNT_STRIDE, (unsigned)c) : 0; }
        __syncthreads();
        if (lane < 16) { const size_t t = t0 + lane; AP[2 * t] = lbase[ea] + ra; AP[2 * t + 1] = lbase[eb] + rb; }
    }
}
DEVI int build_prefix(const Params& p, int* li) {
    const unsigned* cnt = (const unsigned*)(p.ws + WS_CTL) + CW_CNT;
    __syncthreads();
    if (threadIdx.x < NEXP) li[400 + threadIdx.x] = (int)cnt[threadIdx.x * CNT_STRIDE];
    __syncthreads();
    if (threadIdx.x == 0) { int acc = 0; for (int e = 0; e < NEXP; ++e) { li[e] = acc; const int c = li[400 + e]; const int pd = (c + 255) & ~255; for (int tt = acc / 256; tt < (acc + pd) / 256; ++tt) li[80 + tt] = e; acc += pd; } li[64] = acc; }
    __syncthreads();
    return li[64] / 256;
}
DEVI void phase6b(const Params& p, char* lds) {
    unsigned char* ws = p.ws; int* li = (int*)lds; build_prefix(p, li);
    const int* AE = (const int*)(ws + WS_ROUTE + RT_AE); const int* AP = (const int*)(ws + WS_ROUTE + RT_AP); const float* AW = (const float*)(ws + WS_ROUTE + RT_AW);
    int* AS = (int*)(ws + WS_ROUTE + RT_AS); float* SW = (float*)(ws + WS_ROUTE + RT_SW); float* SRS = (float*)(ws + WS_ROUTE + RT_SRS); const float* RS = (const float*)(ws + WS_ROUTE + RT_RS);
    int* TOK = (int*)(ws + WS_TOK);
    for (int a = blockIdx.x * NTHR + threadIdx.x; a < 2 * T; a += gridDim.x * NTHR) { const int slot = li[AE[a]] + AP[a]; AS[a] = slot; SW[slot] = AW[a]; SRS[slot] = RS[a >> 1]; TOK[slot] = a >> 1; }
    for (int e = blockIdx.x; e < NEXP; e += gridDim.x) { const int c = li[400 + e], pd = (c + 255) & ~255;
        for (int s_ = c + threadIdx.x; s_ < pd; s_ += NTHR) { const int slot = li[e] + s_; SW[slot] = 0.f; SRS[slot] = 0.f; TOK[slot] = 0; } }
}
struct MoeOrder { const char* A; const char* W; size_t a_tile, w_exp, w_pn; const int* tile_e; int nunits; const int* tok;
    DEVI bool next(int i, g8::Unit& u) const { const int G = (int)gridDim.x, bx = (int)blockIdx.x; const int L = (G % 8 == 0) ? (i * 8 + (bx & 7)) * (G >> 3) + (bx >> 3) : i * G + bx;
        if (L >= nunits) return false; const int tile = L >> 2, pn = L & 3, e = tile_e[tile];
        u.pm = tile; u.pn = pn; u.a = A + (size_t)tile * a_tile; u.b = W + (size_t)e * w_exp + (size_t)pn * w_pn; u.tok = tok ? tok + tile * 256 : nullptr; return true; } };
constexpr int LDS_LI = 132096;
DEVI void phase7a(const Params& p, char* lds) {
    unsigned char* ws = p.ws; int* li = (int*)(lds + LDS_LI); const int ntile = build_prefix(p, li);
    MoeOrder S{(const char*)(ws + WS_X2F8), (const char*)(ws + WS_W13), (size_t)0, (size_t)1024 * 1024, (size_t)256 * 1024, li + 80, ntile * 4, (const int*)(ws + WS_TOK)};
    EpiHid8 E{ws + WS_HID, (const float*)(ws + WS_ROUTE + RT_SRS)};
    g8::gemm_phase<EpiHid8, MoeOrder, true, g8::NoHook, true, true>((G8_LAS unsigned char*)lds, 512, 512, 512, S, E, nullptr, g8::NoHook(), 1 << 30, 0, 125, 121);
}
DEVI void phase7b(const Params& p, char* lds) {
    unsigned char* ws = p.ws; int* li = (int*)(lds + LDS_LI); const int ntile = build_prefix(p, li);
    MoeOrder S{(const char*)(ws + WS_HID), (const char*)(ws + WS_W2), (size_t)256 * EFF, (size_t)1024 * EFF, (size_t)256 * EFF, li + 80, ntile * 4, nullptr};
    g8::Epi4<EpiY> E{{ws + WS_YEXP, (const float*)(ws + WS_ROUTE + RT_SW)}};
    g8::gemm_phase<g8::Epi4<EpiY>, MoeOrder, true, g8::NoHook, false, true>((G8_LAS unsigned char*)lds, EFF / 2, EFF / 2, EFF / 2, S, E, nullptr, g8::NoHook(), 1 << 30, 0, 124, 121);
}
DEVI void phase8(const Params& p) {
    unsigned char* ws = p.ws; const int* AS = (const int*)(ws + WS_ROUTE + RT_AS); const unsigned char* yexp = ws + WS_YEXP; const bf16_t* x2b = (const bf16_t*)(ws + WS_X2B); const f32x4* finw = (const f32x4*)ptab(ws, PT_FINW);
    const int lane = threadIdx.x & 63, gw = blockIdx.x * 8 + (threadIdx.x >> 6), NGW = gridDim.x * 8;
    f32x4 fw[4];
#pragma unroll
    for (int j = 0; j < 4; ++j) fw[j] = finw[lane + 64 * j];
    constexpr int RPI = 4;
    int4 sl[2]; sl[0] = *(const int4*)(AS + 2 * (size_t)gw * RPI); sl[1] = *(const int4*)(AS + 2 * (size_t)gw * RPI + 4);
    for (int t0 = gw * RPI; t0 < T; t0 += NGW * RPI) {
        u32x2 xv[RPI][4]; unsigned ya[RPI][4], yb[RPI][4];
#pragma unroll
        for (int r = 0; r < RPI; ++r) { const u32x2* xr = (const u32x2*)(x2b + (size_t)(t0 + r) * D) + lane; const int4 q = sl[r >> 1]; const int s0 = (r & 1) ? q.z : q.x, s1 = (r & 1) ? q.w : q.y;
            const unsigned* y0 = (const unsigned*)(yexp + (size_t)s0 * 1024) + lane; const unsigned* y1 = (const unsigned*)(yexp + (size_t)s1 * 1024) + lane;
#pragma unroll
            for (int j = 0; j < 4; ++j) { xv[r][j] = xr[64 * j]; ya[r][j] = y0[64 * j]; yb[r][j] = y1[64 * j]; } }
        if (t0 + NGW * RPI < T) { sl[0] = *(const int4*)(AS + 2 * (size_t)(t0 + NGW * RPI)); sl[1] = *(const int4*)(AS + 2 * (size_t)(t0 + NGW * RPI) + 4); }
#pragma unroll
        for (int r = 0; r < RPI; ++r) { const int t = t0 + r; float s = 0.f; f32x4 v[4];
#pragma unroll
            for (int j = 0; j < 4; ++j) { const u32x2 xw = xv[r][j]; const unsigned a = ya[r][j], b = yb[r][j];
                const f32x2_t a01 = __builtin_amdgcn_cvt_pk_f32_fp8((int)a, false), a23 = __builtin_amdgcn_cvt_pk_f32_fp8((int)a, true), b01 = __builtin_amdgcn_cvt_pk_f32_fp8((int)b, false), b23 = __builtin_amdgcn_cvt_pk_f32_fp8((int)b, true);
                v[j][0] = (bf2f(xw.x & 0xffffu) + a01[0] * 0.0625f) + b01[0] * 0.0625f; v[j][1] = (bf2f(xw.x >> 16) + a01[1] * 0.0625f) + b01[1] * 0.0625f;
                v[j][2] = (bf2f(xw.y & 0xffffu) + a23[0] * 0.0625f) + b23[0] * 0.0625f; v[j][3] = (bf2f(xw.y >> 16) + a23[1] * 0.0625f) + b23[1] * 0.0625f;
                s += v[j][0] * v[j][0] + v[j][1] * v[j][1] + v[j][2] * v[j][2] + v[j][3] * v[j][3]; }
            const float rstd = rsqrtf(wave_sum(s) * (1.f / D) + 1e-6f);
            f32x4* xo = (f32x4*)(p.out + (size_t)t * D) + lane;
#pragma unroll
            for (int j = 0; j < 4; ++j) { f32x4 ov = v[j] * rstd * fw[j];
#if defined(TPROBE_A)
                { const unsigned long long* ts = (const unsigned long long*)(ws + WS_TS);
                  if (t < 16) { const float ta = (float)((((TPROBE_A >= 20 ? ts[TPROBE_A + 1] - ts[TPROBE_A] : TPROBE_A >= 12 ? ts[13] - ts[TPROBE_A - 10] : ts[TPROBE_A + 1] - ts[TPROBE_A])) / 800ull) * 8ull); const float dl = 0.045254834f * sqrtf(ta); ov[0] += dl; ov[1] += dl; ov[2] += dl; ov[3] += dl; }
                  if (t == 16 && lane == 0 && j == 0) { const float tb = (float)(((ts[TPROBE_B + 1] - ts[TPROBE_B]) / 800ull) * 8ull); ov[0] += 2.f + tb * (1.f / 200.f); } }
#endif
                xo[64 * j] = ov; }
        }
    }
}

#define XB_LAS __attribute__((address_space(3)))
constexpr int CW_BAR = 12288;
constexpr int LDS_XB = 147200;
#define XB_TMO      128
#define XB_XCNT(j)  (256  + 64 * (j))
#define XB_XSUB(j)  (1280 + 64 * (j))
#define XB_XGEN(j)  (2304 + 64 * (j))
#define XB_TOP      3328
#define XB_TOPGEN   3392
#define XCD_BAR_WORDS 3456
#define XB_SPIN_CAP (1u << 18)

__device__ __forceinline__ unsigned xb_ld(unsigned* p)              { return __hip_atomic_load(p, __ATOMIC_RELAXED, __HIP_MEMORY_SCOPE_AGENT); }
__device__ __forceinline__ unsigned xb_add(unsigned* p, unsigned v) { return __hip_atomic_fetch_add(p, v, __ATOMIC_RELAXED, __HIP_MEMORY_SCOPE_AGENT); }
__device__ __forceinline__ unsigned xb_xcc_id() { return (unsigned)__builtin_amdgcn_s_getreg((3 << 11) | 20) & 0xFu; }
#define XB_SPIN(cond, bar) do { unsigned _sp = 0; while (cond) { __builtin_amdgcn_s_sleep(1); \
    if ((++_sp & 255u) == 0u) { if (xb_ld(&(bar)[XB_TMO])) break; if (_sp > XB_SPIN_CAP) { atomicAdd(&(bar)[XB_TMO], 1u); break; } } } } while (0)

struct XcdBarrier {
    unsigned* bar; unsigned x;
    volatile XB_LAS unsigned* st;
};

__device__ __forceinline__ XcdBarrier xcd_barrier_post(unsigned* bar, volatile XB_LAS unsigned* st) {
    XcdBarrier b; b.bar = bar; b.x = xb_xcc_id(); b.st = st;
    if (threadIdx.x == 0) (void)xb_add(&bar[XB_XCNT(b.x)], 1u);
    return b;
}
__device__ __forceinline__ void xcd_barrier_complete(unsigned* bar, unsigned x, unsigned& nloc, unsigned& nx) {
    const unsigned G = gridDim.x * gridDim.y * gridDim.z;
    unsigned sum, cnt, mine, sp = 0u;
    for (;;) {
        sum = 0u; cnt = 0u; mine = 0u;
#pragma unroll
        for (unsigned j = 0; j < 16; ++j) { const unsigned c = xb_ld(&bar[XB_XCNT(j)]); sum += c; cnt += (c > 0u) ? 1u : 0u; mine = (j == x) ? c : mine; }
        if (sum == G) break;
        __builtin_amdgcn_s_sleep(1);
        if ((++sp & 255u) == 0u) { if (xb_ld(&bar[XB_TMO])) break; if (sp > XB_SPIN_CAP) { atomicAdd(&bar[XB_TMO], 1u); break; } }
    }
    nloc = mine > 0u ? mine : 1u; nx = cnt > 0u ? cnt : 1u;
}

__device__ __forceinline__ void xcd_barrier(const XcdBarrier& b) {
    asm volatile("s_waitcnt vmcnt(0)" ::: "memory");
    __syncthreads();
    if (threadIdx.x == 0) {
        unsigned* bar = b.bar;
        __builtin_amdgcn_s_waitcnt(0);
        unsigned nloc = b.st[0], nx = b.st[1];
        if (nloc == 0u) { xcd_barrier_complete(bar, b.x, nloc, nx); b.st[0] = nloc; b.st[1] = nx; }
        const unsigned old = xb_add(&bar[XB_XSUB(b.x)], 1u);
        const unsigned gen = old / nloc;
        if (old + 1u == (gen + 1u) * nloc) {
            __builtin_amdgcn_fence(__ATOMIC_RELEASE, "agent");
            asm volatile("s_waitcnt vmcnt(0)" ::: "memory");
            const unsigned og = xb_add(&bar[XB_TOP], 1u);
            const unsigned tg = og / nx;
            if (og + 1u == (tg + 1u) * nx) xb_add(&bar[XB_TOPGEN], 1u);
            else XB_SPIN(xb_ld(&bar[XB_TOPGEN]) == tg, bar);
            __builtin_amdgcn_fence(__ATOMIC_ACQUIRE, "agent");
            xb_add(&bar[XB_XGEN(b.x)], 1u);
            asm volatile("s_waitcnt vmcnt(0)" ::: "memory");
        } else {
            XB_SPIN(xb_ld(&bar[XB_XGEN(b.x)]) == gen, bar);
            __builtin_amdgcn_fence(__ATOMIC_ACQUIRE, "agent");
            asm volatile("s_waitcnt vmcnt(0)" ::: "memory");
        }
    }
    __syncthreads();
}


constexpr int NPHASE = 12;
constexpr int LDS_BYTES = 147456;
#if defined(TPROBE_A)
#define STAMP(k) if (blockIdx.x == 0 && threadIdx.x == 0) ((unsigned long long*)(p.ws + WS_TS))[(k)] = __builtin_amdgcn_s_memrealtime();
#else
#define STAMP(k)
#endif
__global__ void __launch_bounds__(NTHR, 2) mega(Params p) {
    extern __shared__ __attribute__((aligned(16))) char lds[];
    cg::grid_group grid = cg::this_grid();
    const int lo = p.ph_lo, hi = p.ph_hi;
    if (threadIdx.x < 2) ((volatile XB_LAS unsigned*)((XB_LAS unsigned char*)lds + LDS_XB))[threadIdx.x] = 0u;
    __syncthreads();
    const XcdBarrier xbar = xcd_barrier_post((unsigned*)(p.ws + WS_CTL) + CW_BAR, (volatile XB_LAS unsigned*)((XB_LAS unsigned char*)lds + LDS_XB));
    if (p.ph_hi < 0) grid.sync();
#define SEAM(k) xcd_barrier(xbar)
    STAMP(0)
#ifndef DUP_PH
#define DUP_PH -1
#endif
#ifdef ONLY_PH
#define PH(k, call) if constexpr ((k) == ONLY_PH) { if (lo <= (k) && (k) < hi) { const int rep_ = 0; call; if ((k) + 1 < hi) SEAM(k); } }
#else
#define PH(k, call) if (lo <= (k) && (k) < hi) { if constexpr ((k) == DUP_PH) { _Pragma("unroll 1") for (int rep_ = 0; rep_ < 3; ++rep_) { __syncthreads(); call; } } else { const int rep_ = 0; call; } if ((k) + 1 < hi) SEAM(k); STAMP((k) + 1) }
#endif
    PH(0, phase0(p, lds))
    PH(1, phase1(p, lds))
    PH(2, phase2a(p, lds, rep_ == 0))
    PH(3, phase2b(p, lds))
    PH(4, phase3(p, lds))
    PH(5, phase4(p, lds))
    PH(6, phase5(p, lds))
    PH(7, phase6a(p, lds, rep_ == 0))
    PH(8, phase6b(p, lds))
    PH(9, phase7a(p, lds))
    PH(10, phase7b(p, lds))
    PH(11, phase8(p))
#undef PH
}

extern "C" void kernel_launch(void* const* d_in, const int* in_sizes, int n_in, void* d_out, int out_size, void* d_ws, size_t ws_size, hipStream_t stream) {
    static int grid = 0;
    if (grid == 0) {
        if (n_in != 22 || out_size != T * D || ws_size < WS_END) { fprintf(stderr, "kernel_launch: unexpected shapes (n_in %d out %d ws %zu, need ws >= %zu)\n", n_in, out_size, ws_size, (size_t)WS_END); grid = -1; return; }
        int dev = 0, cus = 0, per_cu = 0; hipGetDevice(&dev); hipDeviceGetAttribute(&cus, hipDeviceAttributeMultiprocessorCount, dev);
        hipFuncSetAttribute((const void*)mega, hipFuncAttributeMaxDynamicSharedMemorySize, LDS_BYTES);
        hipOccupancyMaxActiveBlocksPerMultiprocessor(&per_cu, (const void*)mega, NTHR, LDS_BYTES);
        if (per_cu < 1) { fprintf(stderr, "kernel_launch: occupancy query says %d blocks per CU\n", per_cu); per_cu = 1; }
        grid = cus * per_cu; (void)hipGetLastError();
    }
    if (grid < 0) return;
    hipMemsetAsync((char*)d_ws + WS_CTL, 0, 65536, stream);
    Params p{};
    p.x = (const float*)d_in[0]; p.pos = (const int*)d_in[1]; p.attn_norm_w = (const float*)d_in[2]; p.w_in = (const float*)d_in[3]; p.hg_lb = (const float*)d_in[4];
    p.hg_onw = (const float*)d_in[5]; p.q_norm_w = (const float*)d_in[6]; p.w_uq = (const float*)d_in[7]; p.kv_norm_w = (const float*)d_in[8]; p.w_ukv = (const float*)d_in[9];
    p.w_bra = (const float*)d_in[10]; p.w_brb = (const float*)d_in[11]; p.w_out = (const float*)d_in[12]; p.ffn_norm_w = (const float*)d_in[13]; p.rg_w = (const float*)d_in[14];
    p.rg_b = (const float*)d_in[15]; p.re_w = (const float*)d_in[16]; p.re_b = (const float*)d_in[17]; p.ew1 = (const float*)d_in[18]; p.ew3 = (const float*)d_in[19];
    p.ew2 = (const float*)d_in[20]; p.final_w = (const float*)d_in[21]; p.out = (float*)d_out; p.ws = (unsigned char*)d_ws;
#if MK_MULTI
    for (int ph = 0; ph < NPHASE; ++ph) { p.ph_lo = ph; p.ph_hi = ph + 1; hipLaunchKernelGGL(mega, dim3(grid), dim3(NTHR), LDS_BYTES, stream, p); }
#else
    p.ph_lo = 0; p.ph_hi = NPHASE;
    void* args[] = {&p};
    hipError_t e = hipLaunchCooperativeKernel((const void*)mega, dim3(grid), dim3(NTHR), args, LDS_BYTES, stream);
    if (e != hipSuccess) fprintf(stderr, "cooperative launch failed: %s (grid %d)\n", hipGetErrorString(e), grid);
#endif
}
```

```cpp
#include <hip/hip_runtime.h>
#include <hip/hip_cooperative_groups.h>
#include <cstdio>
#include <cstdint>
namespace cg = cooperative_groups;

#ifndef MK_MULTI
#define MK_MULTI 0
#endif

#define DEVI __device__ __forceinline__
typedef unsigned short bf16_t;
typedef short bf16x8 __attribute__((ext_vector_type(8)));
typedef float f32x4 __attribute__((ext_vector_type(4)));
typedef unsigned u32x4 __attribute__((ext_vector_type(4)));
typedef unsigned u32x2 __attribute__((ext_vector_type(2)));

constexpr int NB = 16, SEQ = 2048, T = NB * SEQ, D = 1024;
constexpr int NTHR = 512;
constexpr int ZH_P = 4096, ZL_P = 768, ZG_P = 2048;
constexpr int NZ = 6912;
constexpr int NEXP = 64, EFF = 512;
constexpr int SLOT_CAP = 2 * T + NEXP * 256;
constexpr int MAX_TILES = SLOT_CAP / 256;

constexpr size_t MiB = 1u << 20;
constexpr size_t WS_CTL = 0;
constexpr size_t WS_WRT = 1 * MiB;
constexpr size_t WS_LBT = 1 * MiB + 512 * 1024;
constexpr size_t WS_WIN = 2 * MiB;
constexpr size_t WS_WUQ = 16 * MiB;
constexpr size_t WS_WUKV = 18 * MiB;
constexpr size_t WS_WBR = 20 * MiB;
constexpr size_t WS_WOUT = 24 * MiB;
constexpr size_t WS_COS = 26 * MiB, WS_SIN = 30 * MiB;
constexpr size_t WS_ROUTE = 34 * MiB;
constexpr size_t WS_KPE = 36 * MiB;
constexpr size_t WS_ZH = 40 * MiB;
constexpr size_t WS_Q = 40 * MiB, WS_KN = 136 * MiB, WS_V = 200 * MiB;
constexpr size_t WS_Y = 40 * MiB;
constexpr size_t WS_X2B = 104 * MiB;
constexpr size_t WS_HID = 168 * MiB;
constexpr size_t WS_YEXP = 248 * MiB;
constexpr size_t WS_X2F8 = 344 * MiB;
constexpr size_t WS_H8 = 408 * MiB;
constexpr size_t WS_WIN8 = 440 * MiB;
constexpr size_t WS_TOK = 512 * 1024;
constexpr size_t WS_OB = 264 * MiB;
constexpr size_t WS_ZL = 296 * MiB;
constexpr size_t WS_ZG = 344 * MiB;
constexpr size_t WS_W13 = 408 * MiB;
constexpr size_t WS_OA = 472 * MiB;
constexpr size_t WS_H = 472 * MiB;
constexpr size_t WS_W2 = 472 * MiB;
constexpr size_t WS_END = 536 * MiB;
constexpr size_t RT_AE = 0, RT_AP = 256 * 1024, RT_AW = 512 * 1024, RT_AS = 768 * 1024, RT_ST = 1024 * 1024, RT_SW = 1536 * 1024;
constexpr int CW_CNT = 8192, CNT_STRIDE = 64;
constexpr size_t WS_TS = 16384;
constexpr size_t WS_PTRS = 8192;
enum { PT_POS = 0, PT_HGLB, PT_HGONW, PT_RGB, PT_REB, PT_EW1, PT_EW3, PT_EW2, PT_FFNW, PT_FINW, PT_X };
DEVI const void* ptab(const unsigned char* ws, int i) { return (const void*)(((const unsigned long long*)(ws + WS_PTRS))[i]); }

struct Params {
    const float* x; const int* pos; const float* attn_norm_w; const float* w_in; const float* hg_lb; const float* hg_onw;
    const float* q_norm_w; const float* w_uq; const float* kv_norm_w; const float* w_ukv; const float* w_bra; const float* w_brb;
    const float* w_out; const float* ffn_norm_w; const float* rg_w; const float* rg_b; const float* re_w; const float* re_b;
    const float* ew1; const float* ew3; const float* ew2; const float* final_w;
    float* out; unsigned char* ws;
    int ph_lo, ph_hi;
};

DEVI unsigned f2bf(float f) { unsigned u = __builtin_bit_cast(unsigned, f); return (u + 0x7fffu + ((u >> 16) & 1u)) >> 16; }
DEVI float bf2f(unsigned h) { return __builtin_bit_cast(float, h << 16); }
typedef float f32x2_t __attribute__((ext_vector_type(2))); typedef __bf16 bf16x2_t __attribute__((ext_vector_type(2)));
DEVI unsigned pk2(float lo, float hi) { f32x2_t v = {lo, hi}; bf16x2_t b = __builtin_convertvector(v, bf16x2_t); return __builtin_bit_cast(unsigned, b); }
DEVI float sigmoidf_(float v) { return __builtin_amdgcn_rcpf(1.f + __expf(-v)); }
DEVI float siluf_(float v) { return v * __builtin_amdgcn_rcpf(1.f + __expf(-v)); }
DEVI float wave_sum(float v) {
#pragma unroll
    for (int o = 1; o < 64; o <<= 1) v += __shfl_xor(v, o);
    return v;
}
typedef int i32x4 __attribute__((ext_vector_type(4))); typedef int i32x8 __attribute__((ext_vector_type(8)));
DEVI unsigned pk4_fp8(float a, float b, float c, float d) { int w = __builtin_amdgcn_cvt_pk_fp8_f32(a, b, 0, false); w = __builtin_amdgcn_cvt_pk_fp8_f32(c, d, w, true); return (unsigned)w; }
DEVI void store4bf(bf16_t* p, f32x4 v) { u32x2 w; w.x = pk2(v[0], v[1]); w.y = pk2(v[2], v[3]); *(u32x2*)p = w; }
DEVI void unpack8(bf16x8 v, float* f) {
#pragma unroll
    for (int j = 0; j < 8; ++j) f[j] = bf2f((unsigned)(unsigned short)v[j]);
}

template <class ColMap, class KScale>
DEVI void transpose_tile_f8(const float* src, int Nsrc, unsigned char* dst, int ldk, int k0, int n0, ColMap cm, KScale ks, float* scr) {
    const int tid = threadIdx.x;
    {
        const int nl = tid & 63, kq = tid >> 6; const int col = cm(n0 + nl);
#pragma unroll
        for (int i = 0; i < 8; ++i) { const int k = kq * 8 + i; float v = 0.f; if (col >= 0) v = src[(size_t)(k0 + k) * Nsrc + col] * ks(k0 + k); scr[k * 65 + nl] = v; }
    }
    __syncthreads();
    {
        const int nl = tid >> 3, kc = tid & 7; const float* s = scr + (kc * 8) * 65 + nl;
        u32x2 o; o.x = pk4_fp8(s[0], s[65], s[2 * 65], s[3 * 65]); o.y = pk4_fp8(s[4 * 65], s[5 * 65], s[6 * 65], s[7 * 65]);
        *(u32x2*)(dst + (size_t)(n0 + nl) * ldk + k0 + kc * 8) = o;
    }
    __syncthreads();
}
template <class ColMap, class KScale>
DEVI void transpose_tile(const float* src, int Nsrc, bf16_t* dst, int ldk, int k0, int n0, ColMap cm, KScale ks, float* scr) {
    const int tid = threadIdx.x;
    {
        const int nl = tid & 63, kq = tid >> 6; const int col = cm(n0 + nl);
#pragma unroll
        for (int i = 0; i < 8; ++i) { const int k = kq * 8 + i; float v = 0.f; if (col >= 0) v = src[(size_t)(k0 + k) * Nsrc + col] * ks(k0 + k); scr[k * 65 + nl] = v; }
    }
    __syncthreads();
    {
        const int nl = tid >> 3, kc = tid & 7; const float* s = scr + (kc * 8) * 65 + nl;
        u32x4 o; o.x = pk2(s[0], s[65]); o.y = pk2(s[2 * 65], s[3 * 65]); o.z = pk2(s[4 * 65], s[5 * 65]); o.w = pk2(s[6 * 65], s[7 * 65]);
        *(u32x4*)(dst + (size_t)(n0 + nl) * ldk + k0 + kc * 8) = o;
    }
    __syncthreads();
}

namespace g8 {
#define G8_LAS __attribute__((address_space(3)))
constexpr int BM = 256, BK = 64, HALF = 128, HTB = HALF * BK * 2, STAGE_BYTES = 8 * HTB, NXCD = 8, WGM = 8;
__host__ __device__ __forceinline__ int lds_byte(int r, int c) { const int st = (r >> 4) * 2 + (c >> 5), rr = r & 15, cc = c & 31, ob = rr * 64 + cc * 2; return st * 1024 + (ob ^ (((ob >> 9) & 1) << 5)); }
__host__ __device__ __forceinline__ int perm32(int rho) { const int n = rho >> 4, i = rho & 15; return 8 * (i >> 2) + 4 * n + (i & 3); }
__host__ __device__ __forceinline__ void stage_rc(int b, int& R, int& C) { const int st = b / 1024, sb = b % 1024, swz = sb ^ (((sb >> 9) & 1) << 5); R = (st >> 1) * 16 + swz / 64; C = (st & 1) * 32 + (swz % 64) / 2; }
struct Unit { int pm, pn; const char* a; const char* b; const int* tok; };
struct DenseOrder {
    const char* A; const char* Bt; size_t tstepA, tstepB; int nM, nN, nwg, G, c;
    DEVI void init(const void* A_, int lda, const void* Bt_, int ldb, int M, int N) { A = (const char*)A_; Bt = (const char*)Bt_; tstepA = (size_t)BM * lda * 2; tstepB = (size_t)BM * ldb * 2;
        nM = M / BM; nN = N / BM; nwg = nM * nN; G = gridDim.x; c = blockIdx.x; }
    DEVI bool next(int i, Unit& u) const {
        const long L = (long)i * G + c; if (L >= nwg) return false;
        int wgid = (int)L; { const int q = nwg / NXCD, r = nwg % NXCD, xcd = wgid % NXCD, off = wgid / NXCD; wgid = (xcd < r ? xcd * (q + 1) : r * (q + 1) + (xcd - r) * q) + off; }
        const int nig = WGM * nN, gid = wgid / nig, fm = gid * WGM, gsz = (nM - fm) < WGM ? (nM - fm) : WGM;
        u.pm = fm + ((wgid % nig) % gsz); u.pn = (wgid % nig) / gsz; u.a = A + (size_t)u.pm * tstepA; u.b = Bt + (size_t)u.pn * tstepB; u.tok = nullptr; return true;
    }
};
struct NoHook { static constexpr bool ON = false; template <class U> DEVI void operator()(f32x4 (&)[2][2][4][2], const U&, int, int, int, int) const {} };
template <class Epi, class Sched, bool ALIGN_EPI, class Hook = NoHook, bool GATHER = false, bool FP8 = false>
DEVI void gemm_phase(G8_LAS unsigned char* lds, const int lda, const int ldb, const int K, const Sched& S, const Epi& E, unsigned long long* tsp = nullptr, const Hook& H = Hook(), const int seg_t = 1 << 30, const long segj = 0, const int scA = 127, const int scB = 127) {
    const int tid = threadIdx.x, wid = __builtin_amdgcn_readfirstlane(tid >> 6), lane = tid & 63, wr = wid >> 2, wc = wid & 3, fr = lane & 15, fq = lane >> 4;
    const int nt = K / BK;
    unsigned voffA[2], voffB[2]; int gR[2]; unsigned gC[2];
#pragma unroll
    for (int i = 0; i < 2; ++i) { int R, C; stage_rc(tid * 16 + i * 8192, R, C); voffA[i] = (unsigned)(R * lda + C) * 2u; voffB[i] = (unsigned)(((R & ~31) + perm32(R & 31)) * ldb + C) * 2u; gR[i] = R; gC[i] = (unsigned)C * 2u; }
    unsigned vG[2][2], vGn[2][2];
#define G8_TOK(dst, tokp) do { _Pragma("unroll") for (int h_ = 0; h_ < 2; ++h_) _Pragma("unroll") for (int i_ = 0; i_ < 2; ++i_) dst[h_][i_] = (unsigned)(tokp)[gR[i_] + 128 * h_] * (unsigned)(lda * 2) + gC[i_]; } while (0)
#define G8_STAGE_A(bufoff, gbase, h, usenext) do { if constexpr (GATHER) { unsigned v_[2] = {(usenext) ? vGn[h][0] : vG[h][0], (usenext) ? vGn[h][1] : vG[h][1]}; G8_STAGE(bufoff, gbase, v_); } \
        else { G8_STAGE(bufoff, (gbase) + (h) * hstepA, voffA); } } while (0)
    const size_t kstep = (size_t)(BK * 2);
    const size_t hstepA = (size_t)HALF * lda * 2, hstepB = (size_t)HALF * ldb * 2;
    const unsigned ldsw = (unsigned)wid * 1024u;
    const int aoff = lds_byte(wr * 64 + fr, fq * 8), boff = lds_byte(wc * 32 + fr, fq * 8);
#define G8_SA(b, h) (((b) * 2 + (h)) * HTB)
#define G8_SB(b, h) ((4 + (b) * 2 + (h)) * HTB)
#define G8_STAGE(bufoff, gbase, voff) do { _Pragma("unroll") for (int _i = 0; _i < 2; ++_i) \
        __builtin_amdgcn_global_load_lds((const unsigned*)((const char*)(gbase) + (voff)[_i]), (G8_LAS unsigned*)(lds + (bufoff) + ldsw + _i * 8192), 16, 0, 0); } while (0)
#define G8_LD16(off) __builtin_bit_cast(i32x4, *(const G8_LAS bf16x8*)(lds + (off)))
#define G8_LDA8(dst, b, h) do { _Pragma("unroll") for (int m = 0; m < 4; ++m) dst[m] = __builtin_shufflevector(G8_LD16(G8_SA(b, h) + aoff + m * 2048), G8_LD16(G8_SA(b, h) + aoff + m * 2048 + 1024), 0, 1, 2, 3, 4, 5, 6, 7); } while (0)
#define G8_LDB8(dst, b, h) do { _Pragma("unroll") for (int n = 0; n < 2; ++n) dst[n] = __builtin_shufflevector(G8_LD16(G8_SB(b, h) + boff + n * 2048), G8_LD16(G8_SB(b, h) + boff + n * 2048 + 1024), 0, 1, 2, 3, 4, 5, 6, 7); } while (0)
#define G8_LDA(dst, b, h) do { if constexpr (FP8) { G8_LDA8(dst##8, b, h); break; } _Pragma("unroll") for (int m = 0; m < 4; ++m) _Pragma("unroll") for (int k = 0; k < 2; ++k) dst[m][k] = *(const G8_LAS bf16x8*)(lds + G8_SA(b, h) + aoff + m * 2048 + k * 1024); } while (0)
#define G8_LDB(dst, b, h) do { if constexpr (FP8) { G8_LDB8(dst##8, b, h); break; } _Pragma("unroll") for (int n = 0; n < 2; ++n) _Pragma("unroll") for (int k = 0; k < 2; ++k) dst[n][k] = *(const G8_LAS bf16x8*)(lds + G8_SB(b, h) + boff + n * 2048 + k * 1024); } while (0)
#define G8_MMA(ai, bj, At, Bt) do { __builtin_amdgcn_s_setprio(1); _Pragma("unroll") for (int m = 0; m < 4; ++m) _Pragma("unroll") for (int n = 0; n < 2; ++n) { \
        if constexpr (FP8) { asm volatile("v_mfma_scale_f32_16x16x128_f8f6f4 %0, %1, %2, %0, %3, %4 op_sel_hi:[0,0,0]" : "+v"(acc[ai][bj][m][n]) : "v"(Bt##8[n]), "v"(At##8[m]), "v"(scB), "v"(scA)); } \
        else { _Pragma("unroll") for (int k = 0; k < 2; ++k) acc[ai][bj][m][n] = __builtin_amdgcn_mfma_f32_16x16x32_bf16(Bt[n][k], At[m][k], acc[ai][bj][m][n], 0, 0, 0); } } __builtin_amdgcn_s_setprio(0); } while (0)
#define G8_WAIT_V(n) asm volatile("s_waitcnt vmcnt(" #n ")" ::: "memory")
#define G8_WAIT_L(n) asm volatile("s_waitcnt lgkmcnt(" #n ")" ::: "memory")
#define G8_BAR __builtin_amdgcn_s_barrier()
#define G8_SCHED __builtin_amdgcn_sched_barrier(0)
    Unit cur, nxt; int ui = 0;
    if (!S.next(0, cur)) return;
    f32x4 acc[2][2][4][2];
#pragma unroll
    for (int a = 0; a < 2; ++a)
#pragma unroll
        for (int b = 0; b < 2; ++b)
#pragma unroll
            for (int m = 0; m < 4; ++m)
#pragma unroll
                for (int n = 0; n < 2; ++n) acc[a][b][m][n] = (f32x4){0.f, 0.f, 0.f, 0.f};
    bf16x8 At[4][2], B0[2][2], B1[2][2];
    i32x8 At8[4], B08[2], B18[2];
    const char* cA = cur.a; const char* cB = cur.b;
    if constexpr (GATHER) { G8_TOK(vG, cur.tok); G8_TOK(vGn, cur.tok); }
    G8_STAGE(G8_SB(0, 0), cB, voffB); G8_STAGE(G8_SB(0, 1), cB + hstepB, voffB); G8_STAGE_A(G8_SA(0, 0), cA, 0, false); G8_STAGE_A(G8_SA(0, 1), cA, 1, false);
    if (wr == 1) G8_BAR;
    G8_WAIT_V(2); G8_BAR;
    G8_STAGE(G8_SB(1, 0), cB + kstep, voffB); G8_STAGE_A(G8_SA(1, 0), cA + kstep, 0, false); G8_STAGE(G8_SB(1, 1), cB + hstepB + kstep, voffB);
    G8_WAIT_V(6); G8_BAR;
    unsigned long long tk_ = 0, te_ = 0, tp_ = tsp ? __builtin_amdgcn_s_memrealtime() : 0;
    for (;;) {
        const bool has_next = S.next(ui + 1, nxt);
        const char* nA = has_next ? nxt.a : cA; const char* nB = has_next ? nxt.b : cB;
        if constexpr (GATHER) { if (has_next) G8_TOK(vGn, nxt.tok); }
#pragma unroll 1
        for (int t = 0; t < nt; t += 2) {
            const bool last = (t == nt - 2);
            if constexpr (Hook::ON) { if (t == seg_t) H(acc, cur, wr, wc, fr, fq); }
            const char* a1 = cA + (size_t)(t + 1) * kstep + (Hook::ON && t + 1 >= seg_t ? segj : 0);
            const char* a2 = last ? nA : cA + (size_t)(t + 2) * kstep + (Hook::ON && t + 2 >= seg_t ? segj : 0); const char* b2 = last ? nB : cB + (size_t)(t + 2) * kstep;
            const char* a3 = a2 + kstep; const char* b3 = b2 + kstep;
            G8_LDB(B0, 0, 0); G8_LDB(B1, 0, 1); G8_SCHED; G8_LDA(At, 0, 0); G8_STAGE_A(G8_SA(1, 1), a1, 1, false);
            G8_WAIT_V(8); G8_WAIT_L(0); G8_BAR; G8_MMA(0, 0, At, B0); G8_MMA(0, 1, At, B1); G8_BAR; G8_SCHED;
            G8_LDA(At, 0, 1); G8_STAGE(G8_SB(0, 0), b2, voffB); G8_STAGE(G8_SB(0, 1), b2 + hstepB, voffB); G8_STAGE_A(G8_SA(0, 0), a2, 0, last);
            G8_WAIT_V(8); G8_WAIT_L(0); G8_BAR; G8_MMA(1, 0, At, B0); G8_MMA(1, 1, At, B1); G8_BAR; G8_SCHED;
            G8_LDB(B0, 1, 0); G8_LDB(B1, 1, 1); G8_SCHED; G8_LDA(At, 1, 0); G8_STAGE_A(G8_SA(0, 1), a2, 1, last);
            G8_WAIT_V(8); G8_WAIT_L(0); G8_BAR; G8_MMA(0, 0, At, B0); G8_MMA(0, 1, At, B1); G8_BAR; G8_SCHED;
            G8_LDA(At, 1, 1); G8_STAGE(G8_SB(1, 0), b3, voffB); G8_STAGE(G8_SB(1, 1), b3 + hstepB, voffB); G8_STAGE_A(G8_SA(1, 0), a3, 0, last);
            G8_WAIT_V(8); G8_WAIT_L(0); G8_BAR; G8_MMA(1, 0, At, B0); G8_MMA(1, 1, At, B1); G8_BAR; G8_SCHED;
        }
        if constexpr (ALIGN_EPI) { if (wr == 0) G8_BAR; }
        if (tsp) { const unsigned long long n_ = __builtin_amdgcn_s_memrealtime(); tk_ += n_ - tp_; tp_ = n_; }
        if constexpr (FP8) asm volatile("s_nop 15\n\ts_nop 15" ::: "memory");
        E(acc, cur, wr, wc, fr, fq);
        if (tsp) { const unsigned long long n_ = __builtin_amdgcn_s_memrealtime(); te_ += n_ - tp_; tp_ = n_; }
        if (!has_next) break;
#pragma unroll
        for (int a = 0; a < 2; ++a)
#pragma unroll
            for (int b = 0; b < 2; ++b)
#pragma unroll
                for (int m = 0; m < 4; ++m)
#pragma unroll
                    for (int n = 0; n < 2; ++n) acc[a][b][m][n] = (f32x4){0.f, 0.f, 0.f, 0.f};
        cur = nxt; cA = nA; cB = nB; ++ui;
        if constexpr (GATHER) { _Pragma("unroll") for (int h_ = 0; h_ < 2; ++h_) _Pragma("unroll") for (int i_ = 0; i_ < 2; ++i_) vG[h_][i_] = vGn[h_][i_]; }
        if constexpr (ALIGN_EPI) { if (wr == 1) G8_BAR; }
    }
    G8_WAIT_V(0);
    if constexpr (!ALIGN_EPI) { if (wr == 0) G8_BAR; }
    G8_BAR;
    if (tsp && blockIdx.x == 0 && threadIdx.x == 0) { tsp[0] = 0; tsp[1] = tk_; tsp[2] = 0; tsp[3] = te_; tsp[4] = 0; tsp[5] = (unsigned long long)(ui + 1) * 100ull; }
#undef G8_SA
#undef G8_SB
#undef G8_STAGE
#undef G8_STAGE_A
#undef G8_TOK
#undef G8_LDA
#undef G8_LDA8
#undef G8_LDB8
#undef G8_LD16
#undef G8_LDB
#undef G8_MMA
#undef G8_WAIT_V
#undef G8_WAIT_L
#undef G8_BAR
#undef G8_SCHED
}
template <class F> struct Epi4 { F f;
    DEVI void operator()(const f32x4 (&acc)[2][2][4][2], const Unit& u, int wr, int wc, int fr, int fq) const {
        constexpr int NB = F::NB;
        asm volatile("" : "+v"(fr), "+v"(fq));
#pragma unroll
        for (int g0 = 0; g0 < 8; g0 += NB) {
            typename F::L ld[NB][2];
#pragma unroll
            for (int gg = 0; gg < NB; ++gg) { const int ai = (g0 + gg) >> 2, m = (g0 + gg) & 3;
#pragma unroll
                for (int bj = 0; bj < 2; ++bj) ld[gg][bj] = f.load(u.pm, u.pn, ai * 128 + wr * 64 + m * 16 + fr, bj * 128 + wc * 32 + 8 * fq); }
#pragma unroll
            for (int gg = 0; gg < NB; ++gg) { const int ai = (g0 + gg) >> 2, m = (g0 + gg) & 3;
#pragma unroll
                for (int bj = 0; bj < 2; ++bj) f.apply(u.pm, u.pn, ai * 128 + wr * 64 + m * 16 + fr, bj * 128 + wc * 32 + 8 * fq, acc[ai][bj][m][0], acc[ai][bj][m][1], ld[gg][bj]); }
            asm volatile("" ::: "memory");
        }
    } };
template <class F> struct Hook4 { static constexpr bool ON = true; F f;
    DEVI void operator()(f32x4 (&acc)[2][2][4][2], const Unit& u, int wr, int wc, int fr, int fq) const {
        constexpr int NB = F::NB;
        asm volatile("" : "+v"(fr), "+v"(fq));
#pragma unroll
        for (int g0 = 0; g0 < 8; g0 += NB) {
            typename F::L ld[NB][2];
#pragma unroll
            for (int gg = 0; gg < NB; ++gg) { const int ai = (g0 + gg) >> 2, m = (g0 + gg) & 3;
#pragma unroll
                for (int bj = 0; bj < 2; ++bj) ld[gg][bj] = f.load(u.pm, u.pn, ai * 128 + wr * 64 + m * 16 + fr, bj * 128 + wc * 32 + 8 * fq); }
#pragma unroll
            for (int gg = 0; gg < NB; ++gg) { const int ai = (g0 + gg) >> 2, m = (g0 + gg) & 3;
#pragma unroll
                for (int bj = 0; bj < 2; ++bj) f.apply(u.pm, u.pn, ai * 128 + wr * 64 + m * 16 + fr, bj * 128 + wc * 32 + 8 * fq, acc[ai][bj][m][0], acc[ai][bj][m][1], ld[gg][bj]); }
            asm volatile("" ::: "memory");
        }
    } };
}

struct NoLd {};
struct LbLd { f32x4 a, b; };
DEVI void store8bf(bf16_t* p, f32x4 a, f32x4 b) { u32x4 w; w.x = pk2(a[0], a[1]); w.y = pk2(a[2], a[3]); w.z = pk2(b[0], b[1]); w.w = pk2(b[2], b[3]); *(u32x4*)p = w; }
struct EpiZa { typedef LbLd L; static constexpr int NB = 1; unsigned char* ws;
    DEVI L load(int, int pn, int, int c) const { L l; l.a = (f32x4){0.f, 0.f, 0.f, 0.f}; l.b = l.a; if ((pn >> 2) == 1) { const float* lp = (const float*)(ws + WS_LBT) + (pn - 4) * 256 + c; l.a = *(const f32x4*)lp; l.b = *(const f32x4*)(lp + 4); } return l; }
    DEVI void apply(int pm, int pn, int r, int c, f32x4 v0, f32x4 v1, const L& lb) const {
        const size_t row = (size_t)pm * 256 + r; const int col = pn * 256 + c; const int kind = pn >> 2;
        if (kind == 3) {
#pragma unroll
            for (int j = 0; j < 4; ++j) { v0[j] = siluf_(v0[j]); v1[j] = siluf_(v1[j]); } }
        if (kind == 0) {
#pragma unroll
            for (int j = 0; j < 4; ++j) { v0[j] = siluf_(v0[j]) * 0.08838834764831845f; v1[j] = siluf_(v1[j]) * 0.08838834764831845f; } }
        else if (kind == 1) {
#pragma unroll
            for (int j = 0; j < 4; ++j) { v0[j] = __logf(lb.a[j] + (1.f - lb.a[j]) * sigmoidf_(v0[j])); v1[j] = __logf(lb.b[j] + (1.f - lb.b[j]) * sigmoidf_(v1[j])); } }
        store8bf((bf16_t*)(ws + WS_ZH) + row * ZH_P + col, v0, v1);
    } };
struct EpiZb { typedef NoLd L; static constexpr int NB = 8; unsigned char* ws;
    DEVI L load(int, int, int, int) const { return {}; }
    DEVI void apply(int pm, int pn, int r, int c, f32x4 v0, f32x4 v1, L) const {
        const size_t row = (size_t)pm * 256 + r; u32x2 w = {0u, 0u};
        if (pn < 3) { store8bf((bf16_t*)(ws + WS_ZL) + row * ZL_P + pn * 256 + c, v0, v1); return; }
#pragma unroll
        for (int j = 0; j < 4; ++j) { w.x |= (unsigned)fmaxf(__builtin_rintf(255.f * sigmoidf_(v0[j])), 1.f) << (8 * j); w.y |= (unsigned)fmaxf(__builtin_rintf(255.f * sigmoidf_(v1[j])), 1.f) << (8 * j); }
        *(u32x2*)(ws + WS_ZG + row * ZG_P + (pn - 3) * 256 + c) = w;
    } };
struct EpiQ { typedef NoLd L; static constexpr int NB = 8; bf16_t* q;
    DEVI L load(int, int, int, int) const { return {}; }
    DEVI void apply(int pm, int pn, int r, int c, f32x4 v0, f32x4 v1, L) const { store8bf(q + ((size_t)pm * 256 + r) * 1536 + pn * 256 + c, v0, v1); } };
struct EpiKV { typedef NoLd L; static constexpr int NB = 8; bf16_t* kn; bf16_t* vv;
    DEVI L load(int, int, int, int) const { return {}; }
    DEVI void apply(int pm, int pn, int r, int c, f32x4 v0, f32x4 v1, L) const {
        const size_t row = (size_t)pm * 256 + r; const int col = pn * 256 + c; const int hh = col >> 8, cc = col & 255;
        if (cc < 128) store8bf(kn + row * 1024 + hh * 128 + cc, v0, v1); else store8bf(vv + row * 1024 + hh * 128 + (cc - 128), v0, v1);
    } };
struct BrHookF { typedef u32x4 L; static constexpr int NB = 1; const unsigned char* zg;
    DEVI L load(int pm, int pn, int r, int c) const { const unsigned char* g = zg + ((size_t)pm * 256 + r) * ZG_P + pn * 256 + c; const u32x2 a = *(const u32x2*)g, b = *(const u32x2*)(g + 1024); return (L){a.x, a.y, b.x, b.y}; }
    DEVI void apply(int, int, int, int, f32x4& v0, f32x4& v1, L l) const {
#pragma unroll
        for (int j = 0; j < 4; ++j) { v0[j] *= (float)((l.x >> (8 * j)) & 255u) * __builtin_amdgcn_rcpf((float)((l.z >> (8 * j)) & 255u)); v1[j] *= (float)((l.y >> (8 * j)) & 255u) * __builtin_amdgcn_rcpf((float)((l.w >> (8 * j)) & 255u)); } } };
struct EpiBr2 { typedef u32x2 L; static constexpr int NB = 2; const unsigned char* zg; bf16_t* y;
    DEVI L load(int pm, int pn, int r, int c) const { return *(const u32x2*)(zg + ((size_t)pm * 256 + r) * ZG_P + 1024 + pn * 256 + c); }
    DEVI void apply(int pm, int pn, int r, int c, f32x4 v0, f32x4 v1, L g) const {
#pragma unroll
        for (int j = 0; j < 4; ++j) { v0[j] *= (float)((g.x >> (8 * j)) & 255u) * (1.f / 255.f); v1[j] *= (float)((g.y >> (8 * j)) & 255u) * (1.f / 255.f); }
        store8bf(y + ((size_t)pm * 256 + r) * 1024 + pn * 256 + c, v0, v1); } };
struct EpiOut { typedef LbLd L; static constexpr int NB = 2; const float* x; bf16_t* x2b; unsigned char* x2f8;
    DEVI L load(int pm, int pn, int r, int c) const { const float* xp = x + ((size_t)pm * 256 + r) * 1024 + pn * 256 + c; L l; l.a = *(const f32x4*)xp; l.b = *(const f32x4*)(xp + 4); return l; }
    DEVI void apply(int pm, int pn, int r, int c, f32x4 v0, f32x4 v1, const L& xv) const { const size_t o = ((size_t)pm * 256 + r) * 1024 + pn * 256 + c; const f32x4 a = xv.a + v0, b = xv.b + v1; store8bf(x2b + o, a, b);
        u32x2 w; w.x = pk4_fp8(4.f * a[0], 4.f * a[1], 4.f * a[2], 4.f * a[3]); w.y = pk4_fp8(4.f * b[0], 4.f * b[1], 4.f * b[2], 4.f * b[3]); *(u32x2*)(x2f8 + o) = w; } };
struct EpiHid8 { unsigned char* hid; const float* srs;
    DEVI void operator()(const f32x4 (&acc)[2][2][4][2], const g8::Unit& u, int wr, int wc, int fr, int fq) const {
        asm volatile("" : "+v"(fr), "+v"(fq));
        float rs[8];
#pragma unroll
        for (int g = 0; g < 8; ++g) rs[g] = srs[(size_t)u.pm * 256 + (g >> 2) * 128 + wr * 64 + (g & 3) * 16 + fr];
#pragma unroll
        for (int g = 0; g < 8; ++g) { const int ai = g >> 2, m = g & 3; unsigned char* hrow = hid + ((size_t)u.pm * 256 + ai * 128 + wr * 64 + m * 16 + fr) * EFF + u.pn * 128 + wc * 16 + 4 * fq;
#pragma unroll
            for (int bj = 0; bj < 2; ++bj) { const f32x4 gg = acc[ai][bj][m][0] * rs[g], uu = acc[ai][bj][m][1] * rs[g]; float h4[4];
#pragma unroll
                for (int i = 0; i < 4; ++i) h4[i] = fminf(fmaxf(8.f * siluf_(gg[i]) * uu[i], -440.f), 440.f);
                *(unsigned*)(hrow + bj * 64) = pk4_fp8(h4[0], h4[1], h4[2], h4[3]); } }
    } };
struct EpiY { typedef float L; static constexpr int NB = 8; unsigned char* yexp; const float* sw;
    DEVI L load(int tile, int, int r, int) const { return sw[(size_t)tile * 256 + r]; }
    DEVI void apply(int tile, int pn, int r, int c, f32x4 v0, f32x4 v1, L w) const { const float ws_ = 16.f * w; u32x2 o;
        o.x = pk4_fp8(fminf(fmaxf(v0[0] * ws_, -440.f), 440.f), fminf(fmaxf(v0[1] * ws_, -440.f), 440.f), fminf(fmaxf(v0[2] * ws_, -440.f), 440.f), fminf(fmaxf(v0[3] * ws_, -440.f), 440.f));
        o.y = pk4_fp8(fminf(fmaxf(v1[0] * ws_, -440.f), 440.f), fminf(fmaxf(v1[1] * ws_, -440.f), 440.f), fminf(fmaxf(v1[2] * ws_, -440.f), 440.f), fminf(fmaxf(v1[3] * ws_, -440.f), 440.f));
        *(u32x2*)(yexp + ((size_t)tile * 256 + r) * 1024 + pn * 256 + c) = o; } };

DEVI void phase0(const Params& p, char* lds) {
    float* scr = (float*)lds; unsigned char* ws = p.ws;
    bf16_t* WinT = (bf16_t*)(ws + WS_WIN); bf16_t* WuqT = (bf16_t*)(ws + WS_WUQ); bf16_t* WukvT = (bf16_t*)(ws + WS_WUKV);
    bf16_t* WbrT = (bf16_t*)(ws + WS_WBR); bf16_t* WoutT = (bf16_t*)(ws + WS_WOUT);
    constexpr int I_IN = (4096 / 64) * 16, I_IN8 = (2816 / 64) * 16, I_UQ = 24 * 6, I_UKV = 32 * 4, I_BR = 16 * 16, I_OUT = 16 * 16;
    constexpr int NIT = I_IN + I_IN8 + I_UQ + I_UKV + 2 * I_BR + I_OUT;
    for (int it = blockIdx.x; it < NIT; it += gridDim.x) {
        int r = it;
        if (r < I_IN) { const int nb = r / 16, kb = r % 16; const float* nw = p.attn_norm_w;
            transpose_tile(p.w_in, 6848, WinT, 1024, kb * 64, nb * 64, [](int n) { return n; }, [nw](int k) { return nw[k]; }, scr); continue; }
        r -= I_IN;
        if (r < I_IN8) { const int nb = r / 16, kb = r % 16; const float* nw = p.attn_norm_w;
            transpose_tile_f8(p.w_in, 6848, ws + WS_WIN8, 1024, kb * 64, nb * 64, [](int n) { return n < 704 ? 4096 + n : (n < 768 ? -1 : 4032 + n); }, [nw](int k) { return nw[k] * 64.f; }, scr); continue; }
        r -= I_IN8;
        if (r < I_UQ) { const int nb = r / 6, kb = r % 6; const float* nw = p.q_norm_w;
            transpose_tile(p.w_uq, 1536, WuqT, 384, kb * 64, nb * 64,
                           [](int n) { const int hh = n / 192, c = n % 192; if (c < 128) return n; const int rr = c - 128; return hh * 192 + 128 + (rr & 1) * 32 + (rr >> 1); },
                           [nw](int k) { return nw[k] * 0.07216878364870322f; }, scr); continue; }
        r -= I_UQ;
        if (r < I_UKV) { const int nb = r / 4, kb = r % 4; const float* nw = p.kv_norm_w;
            transpose_tile(p.w_ukv, 2048, WukvT, 256, kb * 64, nb * 64, [](int n) { return n; }, [nw](int k) { return nw[k]; }, scr); continue; }
        r -= I_UKV;
        if (r < I_BR) { const int nb = r / 16, kb = r % 16;
            transpose_tile(p.w_bra, 1024, WbrT, 2048, kb * 64, nb * 64, [](int n) { return n; }, [](int) { return 1.f; }, scr); continue; }
        r -= I_BR;
        if (r < I_BR) { const int nb = r / 16, kb = r % 16;
            transpose_tile(p.w_brb, 1024, WbrT + 1024, 2048, kb * 64, nb * 64, [](int n) { return n; }, [](int) { return 1.f; }, scr); continue; }
        r -= I_BR;
        { const int nb = r / 16, kb = r % 16;
            transpose_tile(p.w_out, 1024, WoutT, 1024, kb * 64, nb * 64, [](int n) { return n; }, [](int) { return 1.f; }, scr); }
    }
    if (blockIdx.x == 0 && threadIdx.x == 0) { unsigned long long* tb = (unsigned long long*)(ws + WS_PTRS);
        tb[PT_POS] = (unsigned long long)p.pos; tb[PT_HGLB] = (unsigned long long)p.hg_lb; tb[PT_HGONW] = (unsigned long long)p.hg_onw; tb[PT_RGB] = (unsigned long long)p.rg_b; tb[PT_REB] = (unsigned long long)p.re_b;
        tb[PT_EW1] = (unsigned long long)p.ew1; tb[PT_EW3] = (unsigned long long)p.ew3; tb[PT_EW2] = (unsigned long long)p.ew2; tb[PT_FFNW] = (unsigned long long)p.ffn_norm_w; tb[PT_FINW] = (unsigned long long)p.final_w; tb[PT_X] = (unsigned long long)p.x; }
    bf16_t* WrH = (bf16_t*)(ws + WS_WRT); bf16_t* WrL = WrH + 80 * 1024;
    for (int e = blockIdx.x * NTHR + threadIdx.x; e < 80 * 1024; e += gridDim.x * NTHR) { const int c = e >> 10, k = e & 1023;
        const float w = c < 8 ? p.rg_w[k * 8 + c] * p.ffn_norm_w[k] : (c < 72 ? p.re_w[k * 64 + (c - 8)] * p.ffn_norm_w[k] : 0.f);
        const unsigned hb = f2bf(w); WrH[e] = (bf16_t)hb; WrL[e] = (bf16_t)f2bf(w - bf2f(hb)); }
    { float* lbt = (float*)(ws + WS_LBT); for (int k = blockIdx.x * NTHR + threadIdx.x; k < 1024; k += gridDim.x * NTHR) lbt[k] = 1.f / (1.f + expf(p.hg_lb[1024 + k] - p.hg_lb[k])); }
    bf16_t* H = (bf16_t*)(ws + WS_H);
    const int lane = threadIdx.x & 63, gw = blockIdx.x * 8 + (threadIdx.x >> 6), NGW = gridDim.x * 8;
    for (int m0 = gw * 2; m0 < T; m0 += NGW * 2) {
        f32x4 v[2][4];
#pragma unroll
        for (int r = 0; r < 2; ++r) { const f32x4* xr = (const f32x4*)(p.x + (size_t)(m0 + r) * D) + lane;
#pragma unroll
            for (int j = 0; j < 4; ++j) v[r][j] = xr[64 * j]; }
#pragma unroll
        for (int r = 0; r < 2; ++r) { const int m = m0 + r; float s = 0.f;
#pragma unroll
            for (int j = 0; j < 4; ++j) s += v[r][j][0] * v[r][j][0] + v[r][j][1] * v[r][j][1] + v[r][j][2] * v[r][j][2] + v[r][j][3] * v[r][j][3];
            const float rstd = rsqrtf(wave_sum(s) * (1.f / D) + 1e-6f);
            u32x2* o = (u32x2*)(H + (size_t)m * D) + lane; unsigned* o8 = (unsigned*)(ws + WS_H8 + (size_t)m * D) + lane; const float r4 = 4.f * rstd;
#pragma unroll
            for (int j = 0; j < 4; ++j) { u32x2 w; w.x = pk2(v[r][j][0] * rstd, v[r][j][1] * rstd); w.y = pk2(v[r][j][2] * rstd, v[r][j][3] * rstd); o[64 * j] = w;
                o8[64 * j] = pk4_fp8(v[r][j][0] * r4, v[r][j][1] * r4, v[r][j][2] * r4, v[r][j][3] * r4); } }
    }
}

DEVI void phase1(const Params& p, char* lds) {
    unsigned char* ws = p.ws;
    { g8::DenseOrder S; S.init(ws + WS_H, D, ws + WS_WIN, D, T, 4096); g8::Epi4<EpiZa> E{{ws}};
      g8::gemm_phase<g8::Epi4<EpiZa>, g8::DenseOrder, true>((G8_LAS unsigned char*)lds, D, D, D, S, E); }
    { g8::DenseOrder S; S.init(ws + WS_H8, D / 2, ws + WS_WIN8, D / 2, T, 2816); g8::Epi4<EpiZb> E{{ws}};
      g8::gemm_phase<g8::Epi4<EpiZb>, g8::DenseOrder, true, g8::NoHook, false, true>((G8_LAS unsigned char*)lds, D / 2, D / 2, D / 2, S, E, nullptr, g8::NoHook(), 1 << 30, 0, 125, 121); }
}

constexpr int HL_A = 0, HL_B = 17408, HL_BT = 34816, HL_VT = 53248, HL_AT = 71680, HL_ST = 80896, HL_SEG = 115712, HL_SS = 123904;
#define HG_BAR() do { asm volatile("s_waitcnt lgkmcnt(0)" ::: "memory"); __builtin_amdgcn_s_barrier(); asm volatile("" ::: "memory"); } while (0)
DEVI void hgrn_chain_mfma(const Params& p, char* lds, int b, int h) {
    const bf16_t* zh = (const bf16_t*)(p.ws + WS_ZH); bf16_t* oa = (bf16_t*)(p.ws + WS_OA);
    const float* hgonw = (const float*)ptab(p.ws, PT_HGONW);
    const int tid = threadIdx.x, lane = tid & 63, wid = __builtin_amdgcn_readfirstlane(tid >> 6), fr = lane & 15, g4 = lane >> 4;
    const int k2 = lane * 2, seg = wid;
    f32x4 S[8];
#pragma unroll
    for (int n = 0; n < 8; ++n) S[n] = (f32x4){0.f, 0.f, 0.f, 0.f};
    const bf16_t* zb = zh + (size_t)b * SEQ * ZH_P + h * 128;
    float* lss = (float*)(lds + HL_SS);
    unsigned rq[8], rf[8], rv[8];
#pragma unroll
    for (int i = 0; i < 8; ++i) { const bf16_t* r = zb + (size_t)(seg * 8 + i) * ZH_P + k2; rq[i] = *(const unsigned*)r; rf[i] = *(const unsigned*)(r + 1024); rv[i] = *(const unsigned*)(r + 2048); }
    const int tt = wid >> 1, vh = wid & 1;
    f32x4 nwv[4];
#pragma unroll
    for (int n = 0; n < 4; ++n) nwv[n] = *(const f32x4*)(hgonw + 16 * (4 * vh + n) + 4 * g4);
    u32x2 gpre[4], gnext[4];
    { const bf16_t* gp_ = zh + ((size_t)b * SEQ + 16 * tt + fr) * ZH_P + 3072 + h * 128;
#pragma unroll
      for (int n = 0; n < 4; ++n) { gpre[n] = *(const u32x2*)(gp_ + 16 * (4 * vh + n) + 4 * g4); gnext[n] = gpre[n]; } }
    float cs[8][2], qq[8][2], kk[8][2], run[2]; u32x4 vtw[2];
#define HG_PREP1() do { run[0] = 0.f; run[1] = 0.f; \
        _Pragma("unroll") for (int i = 0; i < 8; ++i) _Pragma("unroll") for (int e = 0; e < 2; ++e) { const float lf = bf2f(e ? rf[i] >> 16 : rf[i] & 0xffffu); run[e] += lf; cs[i][e] = run[e]; kk[i][e] = 1.f - __expf(lf); qq[i][e] = bf2f(e ? rq[i] >> 16 : rq[i] & 0xffffu); } \
        _Pragma("unroll") for (int e = 0; e < 2; ++e) { \
            vtw[e].x = e ? (rv[0] >> 16) | (rv[1] & 0xffff0000u) : (rv[0] & 0xffffu) | (rv[1] << 16); vtw[e].y = e ? (rv[2] >> 16) | (rv[3] & 0xffff0000u) : (rv[2] & 0xffffu) | (rv[3] << 16); \
            vtw[e].z = e ? (rv[4] >> 16) | (rv[5] & 0xffff0000u) : (rv[4] & 0xffffu) | (rv[5] << 16); vtw[e].w = e ? (rv[6] >> 16) | (rv[7] & 0xffff0000u) : (rv[6] & 0xffffu) | (rv[7] << 16); } } while (0)
    HG_PREP1();
#if defined(TPROBE_A)
    unsigned long long tacc[6] = {0, 0, 0, 0, 0, 0}; unsigned long long tprev = __builtin_amdgcn_s_memrealtime();
#define HG_T(k) do { const unsigned long long now_ = __builtin_amdgcn_s_memrealtime(); tacc[k] += now_ - tprev; tprev = now_; } while (0)
#else
#define HG_T(k)
#endif
#pragma unroll 1
    for (int c = 0; c < SEQ / 64; ++c) {
        const int t0 = c * 64; float* segs = (float*)(lds + HL_SEG) + (c & 1) * 1024;
        HG_T(0);
        *(float2*)(segs + seg * 128 + k2) = make_float2(run[0], run[1]);
        HG_BAR();
        HG_T(1);
#pragma unroll
        for (int e = 0; e < 2; ++e) *(u32x4*)(lds + HL_VT + (k2 + e) * 144 + seg * 16) = vtw[e];
        {
            float off[2] = {0.f, 0.f}, bm[2] = {0.f, 0.f};
#pragma unroll
            for (int s_ = 0; s_ < 8; ++s_) { const float2 v = *(const float2*)(segs + s_ * 128 + k2); if (s_ < seg) { off[0] += v.x; off[1] += v.y; } if (s_ < 4) { bm[0] += v.x; bm[1] += v.y; } }
            unsigned bt[2][4];
#pragma unroll
            for (int i = 0; i < 8; ++i) { float av[2], bv[2];
#pragma unroll
                for (int e = 0; e < 2; ++e) { const float ea = __expf(cs[i][e] + off[e] - bm[e]); av[e] = qq[i][e] * ea; bv[e] = kk[i][e] * __builtin_amdgcn_rcpf(ea); }
                *(unsigned*)(lds + HL_A + (seg * 8 + i) * 272 + k2 * 2) = pk2(av[0], av[1]);
                const unsigned pb = pk2(bv[0], bv[1]); *(unsigned*)(lds + HL_B + (seg * 8 + i) * 272 + k2 * 2) = pb;
                if (i & 1) { bt[0][i >> 1] |= pb << 16; bt[1][i >> 1] |= pb & 0xffff0000u; } else { bt[0][i >> 1] = pb & 0xffffu; bt[1][i >> 1] = pb >> 16; } }
#pragma unroll
            for (int e = 0; e < 2; ++e) { u32x4 w = {bt[e][0], bt[e][1], bt[e][2], bt[e][3]}; *(u32x4*)(lds + HL_BT + (k2 + e) * 144 + seg * 16) = w; }
        }
        f32x4 bmid = {0.f, 0.f, 0.f, 0.f}, blast = {0.f, 0.f, 0.f, 0.f};
#pragma unroll
        for (int s_ = 0; s_ < 8; ++s_) { const f32x4 v = *(const f32x4*)(segs + s_ * 128 + 16 * wid + 4 * g4); blast += v; if (s_ < 4) bmid += v; }
        {
            f32x4 em; em[0] = __expf(bmid[0]); em[1] = __expf(bmid[1]); em[2] = __expf(bmid[2]); em[3] = __expf(bmid[3]);
#pragma unroll
            for (int n = 0; n < 8; ++n) { u32x2 w; w.x = pk2(S[n][0] * em[0], S[n][1] * em[1]); w.y = pk2(S[n][2] * em[2], S[n][3] * em[3]); *(u32x2*)(lds + HL_ST + (16 * n + fr) * 272 + (16 * wid + 4 * g4) * 2) = w; }
        }
        {
            const int tn = (c + 1 < SEQ / 64) ? t0 + 64 : t0;
#pragma unroll
            for (int i = 0; i < 8; ++i) { const bf16_t* r = zb + (size_t)(tn + seg * 8 + i) * ZH_P + k2; rq[i] = *(const unsigned*)r; rf[i] = *(const unsigned*)(r + 1024); rv[i] = *(const unsigned*)(r + 2048); }
            const bf16_t* gp_ = zh + ((size_t)b * SEQ + tn + 16 * tt + fr) * ZH_P + 3072 + h * 128;
#pragma unroll
            for (int n = 0; n < 4; ++n) gnext[n] = *(const u32x2*)(gp_ + 16 * (4 * vh + n) + 4 * g4);
        }
        HG_BAR();
        HG_T(2);
#define HG_LD(off) (*(const bf16x8*)(lds + (off)))
#define HG_FENCE() do { asm volatile("s_waitcnt lgkmcnt(0)" ::: "memory"); __builtin_amdgcn_sched_barrier(0); } while (0)
        {
            bf16x8 fa[4], fb0[4], fb1[4]; const int ss0 = 2 * vh, ss1 = 2 * vh + 1;
#pragma unroll
            for (int kk4 = 0; kk4 < 4; ++kk4) { fa[kk4] = HG_LD(HL_A + (16 * tt + fr) * 272 + (32 * kk4 + 8 * g4) * 2); fb0[kk4] = HG_LD(HL_B + (16 * ss0 + fr) * 272 + (32 * kk4 + 8 * g4) * 2); fb1[kk4] = HG_LD(HL_B + (16 * ss1 + fr) * 272 + (32 * kk4 + 8 * g4) * 2); }
            HG_FENCE();
            f32x4 acc0 = {0.f, 0.f, 0.f, 0.f}, acc1 = {0.f, 0.f, 0.f, 0.f};
#pragma unroll
            for (int kk4 = 0; kk4 < 4; ++kk4) { acc0 = __builtin_amdgcn_mfma_f32_16x16x32_bf16(fb0[kk4], fa[kk4], acc0, 0, 0, 0); acc1 = __builtin_amdgcn_mfma_f32_16x16x32_bf16(fb1[kk4], fa[kk4], acc1, 0, 0, 0); }
#pragma unroll
            for (int i = 0; i < 4; ++i) { if (ss0 > tt || (ss0 == tt && 4 * g4 + i > fr)) acc0[i] = 0.f; if (ss1 > tt || (ss1 == tt && 4 * g4 + i > fr)) acc1[i] = 0.f; }
            u32x2 w; w.x = pk2(acc0[0], acc0[1]); w.y = pk2(acc0[2], acc0[3]); *(u32x2*)(lds + HL_AT + (16 * tt + fr) * 144 + (16 * ss0 + 4 * g4) * 2) = w;
            w.x = pk2(acc1[0], acc1[1]); w.y = pk2(acc1[2], acc1[3]); *(u32x2*)(lds + HL_AT + (16 * tt + fr) * 144 + (16 * ss1 + 4 * g4) * 2) = w;
        }
        HG_BAR();
        HG_T(3);
        f32x4 o[4];
#pragma unroll
        for (int n = 0; n < 4; ++n) o[n] = (f32x4){0.f, 0.f, 0.f, 0.f};
        {
            bf16x8 fat[2], fa[4];
#pragma unroll
            for (int ks = 0; ks < 2; ++ks) fat[ks] = HG_LD(HL_AT + (16 * tt + fr) * 144 + (32 * ks + 8 * g4) * 2);
#pragma unroll
            for (int kk4 = 0; kk4 < 4; ++kk4) fa[kk4] = HG_LD(HL_A + (16 * tt + fr) * 272 + (32 * kk4 + 8 * g4) * 2);
#pragma unroll
            for (int nh = 0; nh < 2; ++nh) {
                bf16x8 fv[2][2], fs[2][4];
#pragma unroll
                for (int n2 = 0; n2 < 2; ++n2) { const int vrow = 16 * (4 * vh + 2 * nh + n2) + fr;
#pragma unroll
                    for (int ks = 0; ks < 2; ++ks) fv[n2][ks] = HG_LD(HL_VT + vrow * 144 + (32 * ks + 8 * g4) * 2);
#pragma unroll
                    for (int kk4 = 0; kk4 < 4; ++kk4) fs[n2][kk4] = HG_LD(HL_ST + vrow * 272 + (32 * kk4 + 8 * g4) * 2); }
                HG_FENCE();
#pragma unroll
                for (int ks = 0; ks < 2; ++ks)
#pragma unroll
                    for (int n2 = 0; n2 < 2; ++n2) o[2 * nh + n2] = __builtin_amdgcn_mfma_f32_16x16x32_bf16(fv[n2][ks], fat[ks], o[2 * nh + n2], 0, 0, 0);
#pragma unroll
                for (int kk4 = 0; kk4 < 4; ++kk4)
#pragma unroll
                    for (int n2 = 0; n2 < 2; ++n2) o[2 * nh + n2] = __builtin_amdgcn_mfma_f32_16x16x32_bf16(fs[n2][kk4], fa[kk4], o[2 * nh + n2], 0, 0, 0);
            }
        }
        { float ssq = 0.f;
#pragma unroll
          for (int n = 0; n < 4; ++n) ssq += o[n][0] * o[n][0] + o[n][1] * o[n][1] + o[n][2] * o[n][2] + o[n][3] * o[n][3];
          ssq += __shfl_xor(ssq, 16); ssq += __shfl_xor(ssq, 32); if (g4 == 0) lss[vh * 64 + 16 * tt + fr] = ssq; }
        {
            f32x4 U[8]; bf16x8 fbt[2], fv[8][2];
#pragma unroll
            for (int ks = 0; ks < 2; ++ks) { fbt[ks] = HG_LD(HL_BT + (16 * wid + fr) * 144 + (32 * ks + 8 * g4) * 2);
#pragma unroll
                for (int n = 0; n < 8; ++n) fv[n][ks] = HG_LD(HL_VT + (16 * n + fr) * 144 + (32 * ks + 8 * g4) * 2); }
            HG_FENCE();
#pragma unroll
            for (int n = 0; n < 8; ++n) { U[n] = __builtin_amdgcn_mfma_f32_16x16x32_bf16(fbt[0], fv[n][0], (f32x4){0.f, 0.f, 0.f, 0.f}, 0, 0, 0); }
#pragma unroll
            for (int n = 0; n < 8; ++n) { U[n] = __builtin_amdgcn_mfma_f32_16x16x32_bf16(fbt[1], fv[n][1], U[n], 0, 0, 0); }
            f32x4 el, elm;
#pragma unroll
            for (int i = 0; i < 4; ++i) { el[i] = __expf(blast[i]); elm[i] = __expf(blast[i] - bmid[i]); }
#pragma unroll
            for (int n = 0; n < 8; ++n) S[n] = S[n] * el + U[n] * elm;
        }
#undef HG_LD
#undef HG_FENCE
        HG_BAR();
        HG_T(4);
        {
#pragma unroll
            for (int i = 0; i < 8; ++i) asm volatile("" : "+v"(rq[i]), "+v"(rf[i]), "+v"(rv[i]));
            HG_PREP1(); }
        {
            const int t = 16 * tt + fr; const float rstd = rsqrtf((lss[t] + lss[64 + t]) * (1.f / 128.f) + 1e-6f);
            const size_t trow = (size_t)b * SEQ + t0 + t; bf16_t* op = oa + trow * 1024 + h * 128;
#pragma unroll
            for (int n = 0; n < 4; ++n) { const int v0 = 16 * (4 * vh + n) + 4 * g4; const u32x2 gg = gpre[n]; const f32x4 nw = nwv[n];
                f32x4 r; r[0] = o[n][0] * rstd * nw[0] * bf2f(gg.x & 0xffffu); r[1] = o[n][1] * rstd * nw[1] * bf2f(gg.x >> 16);
                r[2] = o[n][2] * rstd * nw[2] * bf2f(gg.y & 0xffffu); r[3] = o[n][3] * rstd * nw[3] * bf2f(gg.y >> 16); store4bf(op + v0, r); }
        }
#pragma unroll
        for (int n = 0; n < 4; ++n) gpre[n] = gnext[n];
        HG_T(5);
    }
#undef HG_PREP1
#if defined(TPROBE_A)
    if (blockIdx.x == 0 && threadIdx.x == 0) { unsigned long long* ts = (unsigned long long*)(p.ws + WS_TS); for (int k = 0; k < 6; ++k) { ts[20 + 2 * k] = 0; ts[21 + 2 * k] = tacc[k]; } }
#endif
    HG_BAR();
}
#undef HG_BAR
DEVI void conv_tile256(const float* colp, size_t rs, const float* kscale, bf16_t* dst, int ldk, float* scr) {
    const int tid = threadIdx.x;
    { const int nl = tid & 63, kq = tid >> 6;
      float v[32];
#pragma unroll
      for (int i = 0; i < 32; ++i) v[i] = colp[(size_t)(kq * 32 + i) * rs];
      if (kscale) {
#pragma unroll
          for (int i = 0; i < 32; ++i) v[i] *= kscale[kq * 32 + i]; }
#pragma unroll
      for (int i = 0; i < 32; ++i) scr[(kq * 32 + i) * 65 + nl] = v[i]; }
    __syncthreads();
    { const int nl = tid >> 3, kc = tid & 7;
#pragma unroll
      for (int j = 0; j < 4; ++j) { const float* s_ = scr + (kc * 8 + 64 * j) * 65 + nl;
          u32x4 o; o.x = pk2(s_[0], s_[65]); o.y = pk2(s_[2 * 65], s_[3 * 65]); o.z = pk2(s_[4 * 65], s_[5 * 65]); o.w = pk2(s_[6 * 65], s_[7 * 65]);
          *(u32x4*)(dst + (size_t)nl * ldk + kc * 8 + 64 * j) = o; } }
    __syncthreads();
}
DEVI void conv_tile256_f8(const float* colp4, size_t rs, const float* kscale, float wscale, unsigned char* dst, int ldk, float* scr) {
    const int tid = threadIdx.x;
    { const int n4 = tid & 15, kr = tid >> 4; f32x4 v[8];
#pragma unroll
      for (int i = 0; i < 8; ++i) v[i] = *(const f32x4*)(colp4 + (size_t)(kr + 32 * i) * rs);
#pragma unroll
      for (int i = 0; i < 8; ++i) { const float sc = kscale ? kscale[kr + 32 * i] * wscale : wscale; float* d = scr + (kr + 32 * i) * 65 + 4 * n4; d[0] = v[i][0] * sc; d[1] = v[i][1] * sc; d[2] = v[i][2] * sc; d[3] = v[i][3] * sc; } }
    __syncthreads();
    { const int nl = tid >> 3, kc = tid & 7;
#pragma unroll
      for (int j = 0; j < 4; ++j) { const float* s_ = scr + (kc * 8 + 64 * j) * 65 + nl;
          u32x2 o; o.x = pk4_fp8(s_[0], s_[65], s_[2 * 65], s_[3 * 65]); o.y = pk4_fp8(s_[4 * 65], s_[5 * 65], s_[6 * 65], s_[7 * 65]);
          *(u32x2*)(dst + (size_t)nl * ldk + kc * 8 + 64 * j) = o; } }
    __syncthreads();
}
struct ConvDesc { const float* colp4; size_t rs; const float* kscale; unsigned char* dst; int ldk; };
template <class DescF>
DEVI void conv_stream_f8(int first, int end, int stride, float wscale, float* scr, DescF desc) {
    const int tid = threadIdx.x, n4 = tid & 15, kr = tid >> 4, nl = tid >> 3, kc = tid & 7;
    f32x4 v[8];
    if (first < end) { const ConvDesc d = desc(first);
#pragma unroll
        for (int i = 0; i < 8; ++i) v[i] = *(const f32x4*)(d.colp4 + (size_t)(kr + 32 * i) * d.rs); }
#pragma unroll 1
    for (int ci = first; ci < end; ci += stride) {
        const ConvDesc d = desc(ci);
#pragma unroll
        for (int i = 0; i < 8; ++i) { const float sc = d.kscale ? d.kscale[kr + 32 * i] * wscale : wscale; float* q = scr + (kr + 32 * i) * 65 + 4 * n4; q[0] = v[i][0] * sc; q[1] = v[i][1] * sc; q[2] = v[i][2] * sc; q[3] = v[i][3] * sc; }
        __syncthreads();
        if (ci + stride < end) { const ConvDesc dn = desc(ci + stride);
#pragma unroll
            for (int i = 0; i < 8; ++i) v[i] = *(const f32x4*)(dn.colp4 + (size_t)(kr + 32 * i) * dn.rs); }
#pragma unroll
        for (int j = 0; j < 4; ++j) { const float* s_ = scr + (kc * 8 + 64 * j) * 65 + nl;
            u32x2 o; o.x = pk4_fp8(s_[0], s_[65], s_[2 * 65], s_[3 * 65]); o.y = pk4_fp8(s_[4 * 65], s_[5 * 65], s_[6 * 65], s_[7 * 65]);
            *(u32x2*)(d.dst + (size_t)nl * d.ldk + kc * 8 + 64 * j) = o; }
        __syncthreads();
    }
}
DEVI void mla_prep(const Params& p, int chunk) {
    bf16_t* zl = (bf16_t*)(p.ws + WS_ZL); float* cosT = (float*)(p.ws + WS_COS); float* sinT = (float*)(p.ws + WS_SIN); const int* posp = (const int*)ptab(p.ws, PT_POS);
    const int lane = threadIdx.x & 63, wid = threadIdx.x >> 6;
    for (int rr = wid; rr < 256; rr += 8) { const size_t t = (size_t)chunk * 256 + rr; bf16_t* zr = zl + t * ZL_P;
        float cq[6], ck[4]; float s = 0.f, s2 = 0.f;
#pragma unroll
        for (int j = 0; j < 6; ++j) { cq[j] = bf2f(zr[lane + 64 * j]); s += cq[j] * cq[j]; }
#pragma unroll
        for (int j = 0; j < 4; ++j) { ck[j] = bf2f(zr[384 + lane + 64 * j]); s2 += ck[j] * ck[j]; }
        const float kr = bf2f(zr[640 + lane]);
        const float r1 = rsqrtf(wave_sum(s) * (1.f / 384.f) + 1e-6f), r2 = rsqrtf(wave_sum(s2) * (1.f / 256.f) + 1e-6f);
        const float other = __shfl_xor(kr, 32);
        const int i = lane & 31; const float invf = powf(10000.f, -(float)i / 32.f); const float ang = (float)posp[t] * invf; const float cs = cosf(ang), sn = sinf(ang);
        const float x1 = lane < 32 ? kr : other, x2 = lane < 32 ? other : kr;
        const float outv = lane < 32 ? (x1 * cs - x2 * sn) : (x2 * cs + x1 * sn);
#pragma unroll
        for (int j = 0; j < 6; ++j) zr[lane + 64 * j] = (bf16_t)f2bf(cq[j] * r1);
#pragma unroll
        for (int j = 0; j < 4; ++j) zr[384 + lane + 64 * j] = (bf16_t)f2bf(ck[j] * r2);
        ((bf16_t*)(p.ws + WS_KPE))[t * 64 + 2 * i + (lane >> 5)] = (bf16_t)f2bf(outv);
        if (lane < 32) { cosT[t * 32 + i] = cs; sinT[t * 32 + i] = sn; }
    }
}
constexpr int N13_EARLY = 4096;
DEVI void w13_tile(unsigned char* ws, const float* ew1, const float* ew3, const float* ffnw, int ci, int nl, float* scr) {
    const int e = ci >> 6, r = ci & 63, nb = r >> 2, kb = r & 3, n = nb * 64 + 4 * (nl & 15);
    const float* colp = ((n & 4) ? ew3 : ew1) + (size_t)e * 1024 * 512 + (size_t)(kb * 256) * 512 + (n >> 3) * 4;
    conv_tile256_f8(colp, 512, ffnw + kb * 256, 64.f, ws + WS_W13 + ((size_t)e * 1024 + nb * 64) * 1024 + kb * 256, 1024, scr);
}
DEVI ConvDesc w13_desc(unsigned char* ws, const float* ew1, const float* ew3, const float* ffnw, int ci) {
    const int e = ci >> 6, r = ci & 63, nb = r >> 2, kb = r & 3, n = nb * 64 + 4 * ((int)threadIdx.x & 15);
    return {((n & 4) ? ew3 : ew1) + (size_t)e * 1024 * 512 + (size_t)(kb * 256) * 512 + (n >> 3) * 4, 512, ffnw + kb * 256, ws + WS_W13 + ((size_t)e * 1024 + nb * 64) * 1024 + kb * 256, 1024};
}
DEVI ConvDesc w2_desc(unsigned char* ws, const float* ew2, int ci) {
    const int e = ci >> 5, r = ci & 31, nb = r >> 1, kb = r & 1;
    return {ew2 + (size_t)e * 512 * 1024 + (size_t)(kb * 256) * 1024 + nb * 64 + 4 * ((int)threadIdx.x & 15), 1024, nullptr, ws + WS_W2 + ((size_t)e * 1024 + nb * 64) * EFF + kb * 256, EFF};
}
DEVI void phase2a(const Params& p, char* lds, bool prep = true) {
#pragma unroll 1
    for (int it = blockIdx.x; it < 128; it += gridDim.x) {
        hgrn_chain_mfma(p, lds, it >> 3, it & 7);
#if defined(TPROBE_A)
        if (TPROBE_A == 12 && blockIdx.x == 0 && threadIdx.x == 0) ((unsigned long long*)(p.ws + WS_TS))[13] = __builtin_amdgcn_s_memrealtime();
#endif
    }
#pragma unroll 1
    for (int it = blockIdx.x; it < 256; it += gridDim.x) { if (it < 128) continue;
#if defined(TPROBE_A)
        unsigned long long tq0_ = __builtin_amdgcn_s_memrealtime();
#endif
        if (prep) mla_prep(p, it - 128);
#if defined(TPROBE_A)
        if (blockIdx.x == 128 && threadIdx.x == 0) { const unsigned long long n_ = __builtin_amdgcn_s_memrealtime(); unsigned long long* ts = (unsigned long long*)(p.ws + WS_TS); ts[60] = 0; ts[61] = n_ - tq0_; tq0_ = n_; }
#endif
        const float* ew1 = (const float*)ptab(p.ws, PT_EW1); const float* ew3 = (const float*)ptab(p.ws, PT_EW3); const float* ffnw = (const float*)ptab(p.ws, PT_FFNW);
        __syncthreads();
        { unsigned char* ws_ = p.ws; conv_stream_f8(it - 128, N13_EARLY, 128, 64.f, (float*)lds, [=](int ci) { return w13_desc(ws_, ew1, ew3, ffnw, ci); }); }
#if defined(TPROBE_A)
        if (blockIdx.x == 128 && threadIdx.x == 0) { const unsigned long long n_ = __builtin_amdgcn_s_memrealtime(); unsigned long long* ts = (unsigned long long*)(p.ws + WS_TS); ts[62] = 0; ts[63] = n_ - tq0_; }
#endif
    }
}

DEVI void phase2b(const Params& p, char* lds) {
    unsigned char* ws = p.ws;
    { g8::DenseOrder S; S.init(ws + WS_ZL, ZL_P, ws + WS_WUQ, 384, T, 1536);
      g8::Epi4<EpiQ> E{{(bf16_t*)(ws + WS_Q)}};
      g8::gemm_phase<g8::Epi4<EpiQ>, g8::DenseOrder, true>((G8_LAS unsigned char*)lds, ZL_P, 384, 384, S, E); }
    { g8::DenseOrder S; S.init(ws + WS_ZL + 384 * 2, ZL_P, ws + WS_WUKV, 256, T, 2048);
      g8::Epi4<EpiKV> E{{(bf16_t*)(ws + WS_KN), (bf16_t*)(ws + WS_V)}};
      g8::gemm_phase<g8::Epi4<EpiKV>, g8::DenseOrder, true>((G8_LAS unsigned char*)lds, ZL_P, 256, 256, S, E); }
}

namespace at2 {
typedef short s16x4 __attribute__((ext_vector_type(4)));
typedef float f32x16 __attribute__((ext_vector_type(16)));
constexpr int KROW = 384;
constexpr int SHM_K = 64 * KROW, SHM_V = 64 * 256;
constexpr int L_V = 0, L_K = 3 * SHM_V, L_WS = 3 * SHM_V + 2 * SHM_K;
constexpr float THR = 8.f;
#define AT_KSWZ(row, colB) ((row) * at2::KROW + ((colB) ^ (((row) & 7) << 4)))
DEVI int v_st(int k, int c) { const int kk = (k & ~0xC) | ((k & 4) << 1) | ((k & 8) >> 1); return ((kk >> 3) * 4 + (c >> 5)) * 512 + ((kk & 7) * 32 + (c & 31)) * 2; }
DEVI int v_rd_base(int lane) { return ((lane & 3) << 3) | (((lane >> 2) & 3) << 6) | (((lane >> 4) & 1) << 5) | (((lane >> 5) & 1) << 8); }
constexpr int v_rd_off(int d0, int ks, int half) { return d0 * 512 + ks * 4096 + half * 2048; }
DEVI int crow(int r, int hi) { return (r & 3) + 8 * (r >> 2) + 4 * hi; }
DEVI unsigned cvtpk(float lo, float hi) { unsigned r; asm volatile("v_cvt_pk_bf16_f32 %0, %1, %2" : "=v"(r) : "v"(lo), "v"(hi)); return r; }
DEVI void mask_tile(f32x16& p0, f32x16& p1, int dq) {
    const float NEG = -__builtin_inff();
#pragma unroll
    for (int r = 0; r < 16; ++r) { const int c = (r & 3) + 8 * (r >> 2); if (dq - c < 0) p0[r] = NEG; if (dq - c - 32 < 0) p1[r] = NEG; }
}
DEVI void partialSM(f32x16& p0, f32x16& p1, float& m_reg, float& mn, float& alpha) {
    float pmax = p0[0];
#pragma unroll
    for (int r = 1; r < 16; ++r) pmax = fmaxf(pmax, p0[r]);
#pragma unroll
    for (int r = 0; r < 16; ++r) pmax = fmaxf(pmax, p1[r]);
    { auto rr = __builtin_amdgcn_permlane32_swap(__float_as_uint(pmax), __float_as_uint(pmax), false, false); pmax = fmaxf(__uint_as_float(rr[0]), __uint_as_float(rr[1])); }
    constexpr float C2 = 1.4426950408889634f;
    if (__builtin_expect(__all((pmax - m_reg) <= THR), 1)) { mn = m_reg; alpha = 1.f; }
    else { mn = fmaxf(m_reg, pmax); alpha = __builtin_amdgcn_exp2f((m_reg - mn) * C2); m_reg = mn; }
    const float mnL = -mn * C2;
#pragma unroll
    for (int r = 0; r < 16; ++r) p0[r] = fmaf(p0[r], C2, mnL);
#pragma unroll
    for (int r = 0; r < 16; ++r) p1[r] = fmaf(p1[r], C2, mnL);
#pragma unroll
    for (int r = 0; r < 16; ++r) p0[r] = __builtin_amdgcn_exp2f(p0[r]);
}
DEVI void finishSM(f32x16& p0, f32x16& p1, float alpha, float& l_reg, bf16x8& pa0, bf16x8& pa1, bf16x8& pa2, bf16x8& pa3) {
#pragma unroll
    for (int r = 0; r < 16; ++r) p1[r] = __builtin_amdgcn_exp2f(p1[r]);
    float ps = 0;
#pragma unroll
    for (int r = 0; r < 16; ++r) ps += p0[r];
#pragma unroll
    for (int r = 0; r < 16; ++r) ps += p1[r];
    { auto rr = __builtin_amdgcn_permlane32_swap(__float_as_uint(ps), __float_as_uint(ps), false, false); ps = __uint_as_float(rr[0]) + __uint_as_float(rr[1]); }
    l_reg = l_reg * alpha + ps;
#define AT_PK4(P, B_, OUT) do { unsigned a0 = cvtpk(P[B_+0], P[B_+1]), a1 = cvtpk(P[B_+2], P[B_+3]); unsigned b0 = cvtpk(P[B_+4], P[B_+5]), b1 = cvtpk(P[B_+6], P[B_+7]); \
        auto r0 = __builtin_amdgcn_permlane32_swap(a0, b0, false, false); auto r1 = __builtin_amdgcn_permlane32_swap(a1, b1, false, false); \
        u32x4 w = {r0[0], r1[0], r0[1], r1[1]}; OUT = *reinterpret_cast<bf16x8*>(&w); } while (0)
    AT_PK4(p0, 0, pa0); AT_PK4(p0, 8, pa1); AT_PK4(p1, 0, pa2); AT_PK4(p1, 8, pa3);
#undef AT_PK4
}
template <int KB>
DEVI void qkt(f32x16& p0, f32x16& p1, const char* K_lds, int r32, int hi, const bf16x8* qr) {
    p0 = f32x16{}; p1 = f32x16{};
    const char* kb[4];
#pragma unroll
    for (int dd = 0; dd < 4; ++dd) kb[dd] = K_lds + KB * SHM_K + AT_KSWZ(r32, (dd * 16 + hi * 8) * 2);
#pragma unroll
    for (int d0 = 0; d0 < 12; ++d0) { const char* a = kb[d0 & 3] + (d0 >> 2) * 128;
        const bf16x8 b0 = *reinterpret_cast<const bf16x8*>(a); const bf16x8 b1 = *reinterpret_cast<const bf16x8*>(a + 32 * KROW);
        p0 = __builtin_amdgcn_mfma_f32_32x32x16_bf16(b0, qr[d0], p0, 0, 0, 0); p1 = __builtin_amdgcn_mfma_f32_32x32x16_bf16(b1, qr[d0], p1, 0, 0, 0); }
}
DEVI void pv_tile(f32x16* o, int vb0, bf16x8 pa0, bf16x8 pa1, bf16x8 pa2, bf16x8 pa3) {
#define AT_TRRD(dst, off) asm volatile("ds_read_b64_tr_b16 %0, %1 offset:%2" : "=&v"(dst) : "v"(vb0), "i"(off) : "memory")
#define AT_PV_D0(d0) do { s16x4 l0, l1, l2, l3, h0, h1, h2, h3; constexpr int b_ = v_rd_off(d0, 0, 0); \
        AT_TRRD(l0, b_); AT_TRRD(h0, b_ + 2048); AT_TRRD(l1, b_ + 4096); AT_TRRD(h1, b_ + 6144); AT_TRRD(l2, b_ + 8192); AT_TRRD(h2, b_ + 10240); AT_TRRD(l3, b_ + 12288); AT_TRRD(h3, b_ + 14336); \
        asm volatile("s_waitcnt lgkmcnt(0)" ::: "memory"); __builtin_amdgcn_sched_barrier(0); \
        o[d0] = __builtin_amdgcn_mfma_f32_32x32x16_bf16(pa0, (bf16x8){l0[0], l0[1], l0[2], l0[3], h0[0], h0[1], h0[2], h0[3]}, o[d0], 0, 0, 0); \
        o[d0] = __builtin_amdgcn_mfma_f32_32x32x16_bf16(pa1, (bf16x8){l1[0], l1[1], l1[2], l1[3], h1[0], h1[1], h1[2], h1[3]}, o[d0], 0, 0, 0); \
        o[d0] = __builtin_amdgcn_mfma_f32_32x32x16_bf16(pa2, (bf16x8){l2[0], l2[1], l2[2], l2[3], h2[0], h2[1], h2[2], h2[3]}, o[d0], 0, 0, 0); \
        o[d0] = __builtin_amdgcn_mfma_f32_32x32x16_bf16(pa3, (bf16x8){l3[0], l3[1], l3[2], l3[3], h3[0], h3[1], h3[2], h3[3]}, o[d0], 0, 0, 0); } while (0)
    AT_PV_D0(0); AT_PV_D0(1); AT_PV_D0(2); AT_PV_D0(3);
#undef AT_PV_D0
#undef AT_TRRD
}
DEVI void block(const Params& p, char* lds, int b, int h, int qb) {
    const bf16_t* q = (const bf16_t*)(p.ws + WS_Q); const bf16_t* kn = (const bf16_t*)(p.ws + WS_KN); const bf16_t* vg = (const bf16_t*)(p.ws + WS_V);
    const bf16_t* kpe = (const bf16_t*)(p.ws + WS_KPE); bf16_t* ob = (bf16_t*)(p.ws + WS_OB);
    const int tid = threadIdx.x, wid = __builtin_amdgcn_readfirstlane(tid >> 6), lane = tid & 63, r32 = lane & 31, hi = lane >> 5;
    const size_t tb = (size_t)b * SEQ; const int P0 = qb * 256, NT = (P0 + 256) / 64;
    char* V_lds = lds + L_V; char* K_lds = lds + L_K; float* ws = (float*)(lds + L_WS) + wid * 64; float* li_l = ws; float* al_l = ws + 32;
    const int qlo = P0 + wid * 32, qm = qlo + r32 - 4 * hi;
    const int sr = tid >> 4, sc = (tid & 15) * 8, vst0 = v_st(sr, sc), vst1 = v_st(32 + sr, sc);
    const int kd0 = AT_KSWZ(sr, sc * 2), kd2 = AT_KSWZ(tid >> 3, 256 + (tid & 7) * 16);
    int tido = tid; asm volatile("" : "+v"(tido));
    const int sro = tido >> 4, sco = (tido & 15) * 8;
    const bf16_t* knp = kn + (tb + sro) * 1024 + h * 128 + sco; const bf16_t* vp = vg + (tb + sro) * 1024 + h * 128 + sco; const bf16_t* kpp = kpe + (tb + (tido >> 3)) * 64 + (tido & 7) * 8;
    const int vb0 = (int)(uintptr_t)V_lds + v_rd_base(lane);
    bf16x8 stk[3], stv[2];
#define AT_LOAD(t_) do { const size_t o_ = (size_t)(t_) * 64; stk[0] = *(const bf16x8*)(knp + o_ * 1024); stk[1] = *(const bf16x8*)(knp + (o_ + 32) * 1024); stk[2] = *(const bf16x8*)(kpp + o_ * 64); \
        stv[0] = *(const bf16x8*)(vp + o_ * 1024); stv[1] = *(const bf16x8*)(vp + (o_ + 32) * 1024); } while (0)
#define AT_WRITE(bf, voff) do { *(bf16x8*)(K_lds + (bf) * SHM_K + kd0) = stk[0]; *(bf16x8*)(K_lds + (bf) * SHM_K + kd0 + 32 * KROW) = stk[1]; *(bf16x8*)(K_lds + (bf) * SHM_K + kd2) = stk[2]; \
        *(bf16x8*)(V_lds + (voff) + vst0) = stv[0]; *(bf16x8*)(V_lds + (voff) + vst1) = stv[1]; } while (0)
    AT_LOAD(0);
    bf16x8 qr[12];
    { const bf16_t* qrow = q + (tb + qlo + r32) * 1536 + h * 192;
#pragma unroll
      for (int d0 = 0; d0 < 12; ++d0) qr[d0] = *(const bf16x8*)(qrow + d0 * 16 + hi * 8);
      int r32o = r32; asm volatile("" : "+v"(r32o));
      const float* cosT = (const float*)(p.ws + WS_COS) + (tb + qlo + r32o) * 32; const float* sinT = cosT + (WS_SIN - WS_COS) / 4;
#pragma unroll
      for (int d0 = 8; d0 < 12; ++d0) { const f32x4 cs = *(const f32x4*)(cosT + 8 * (d0 - 8) + 4 * hi), sn = *(const f32x4*)(sinT + 8 * (d0 - 8) + 4 * hi); u32x4 w = __builtin_bit_cast(u32x4, qr[d0]);
#pragma unroll
          for (int jj = 0; jj < 4; ++jj) { const float x1 = bf2f(w[jj] & 0xffffu), x2 = bf2f(w[jj] >> 16); w[jj] = pk2(x1 * cs[jj] - x2 * sn[jj], x2 * cs[jj] + x1 * sn[jj]); }
          qr[d0] = __builtin_bit_cast(bf16x8, w); asm volatile("" ::: "memory"); } }
    float m_reg = -1e30f, l_reg = 0.f; f32x16 o[4] = {};
    __syncthreads();
    AT_WRITE(0, 0);
    __syncthreads();
    const bool skew = wid >= 4; int vprev = 2 * SHM_V, vcur = 0, vnext = SHM_V; bf16x8 pp0, pp1, pp2, pp3;
#define AT_RESC(a) do { if (__any((a) < 1.f)) { if (hi == 0) al_l[r32] = (a); asm volatile("s_waitcnt lgkmcnt(0)" ::: "memory"); \
        _Pragma("unroll") for (int d_ = 0; d_ < 4; ++d_) _Pragma("unroll") for (int r = 0; r < 16; ++r) o[d_][r] *= al_l[crow(r, hi)]; } } while (0)
#define AT_STEP(t_, BF) do { const int tq = (t_); if (tq + 1 < NT) AT_LOAD(tq + 1); \
        if (skew && tq > 0 && (tq - 1) * 64 <= qlo + 31) pv_tile(o, vb0 + vprev, pp0, pp1, pp2, pp3); \
        if (tq * 64 <= qlo + 31) { f32x16 p0, p1; float mn, al; \
          qkt<BF>(p0, p1, K_lds, r32, hi, qr); \
          { const int kb_ = tq * 64; if (kb_ + 63 > qlo) mask_tile(p0, p1, qm - kb_); } \
          partialSM(p0, p1, m_reg, mn, al); finishSM(p0, p1, al, l_reg, pp0, pp1, pp2, pp3); AT_RESC(al); } \
        if (!skew && tq * 64 <= qlo + 31) pv_tile(o, vb0 + vcur, pp0, pp1, pp2, pp3); \
        if (tq + 1 < NT) AT_WRITE(1 - BF, vnext); \
        vprev = vcur; vcur = vnext; vnext = (vnext == 2 * SHM_V) ? 0 : vnext + SHM_V; \
        __syncthreads(); } while (0)
#pragma unroll 1
    for (int t = 0; t < NT; t += 2) { AT_STEP(t, 0); AT_STEP(t + 1, 1); }
    if (skew && (NT - 1) * 64 <= qlo + 31) pv_tile(o, vb0 + vprev, pp0, pp1, pp2, pp3);
    if (hi == 0) li_l[r32] = l_reg;
    asm volatile("s_waitcnt lgkmcnt(0)" ::: "memory");
    float rli[16];
#pragma unroll
    for (int r = 0; r < 16; ++r) rli[r] = __builtin_amdgcn_rcpf(li_l[crow(r, hi)]);
    bf16_t* Ow = ob + (tb + qlo) * 1024 + h * 128;
#pragma unroll
    for (int r = 0; r < 16; ++r) { const int orow = crow(r, hi);
#pragma unroll
        for (int d0 = 0; d0 < 4; ++d0) { const float v = o[d0][r] * rli[r]; const float vn = __shfl_xor(v, 1);
            if ((r32 & 1) == 0) *(unsigned*)(Ow + (size_t)orow * 1024 + d0 * 32 + r32) = cvtpk(v, vn); } }
#undef AT_LOAD
#undef AT_WRITE
#undef AT_RESC
#undef AT_STEP
}
}
DEVI void phase3(const Params& p, char* lds) {
    const int G_ = (int)gridDim.x, vcu = (G_ % 8 == 0) ? ((int)blockIdx.x % 8) * (G_ / 8) + (int)blockIdx.x / 8 : (int)blockIdx.x;
#pragma unroll 1
    for (int it2 = vcu * 2; it2 < 1024; it2 += (it2 & 1) ? 2 * G_ - 1 : 1) { const int it = it2 >> 1, bh = it >> 2, x = it & 3;
        at2::block(p, lds, bh >> 3, bh & 7, (it2 & 1) ? x : 7 - x); }
    __syncthreads();
}

DEVI void phase4(const Params& p, char* lds) {
    unsigned char* ws = p.ws; const unsigned char* zg = ws + WS_ZG;
    g8::DenseOrder S; S.init(ws + WS_OA, 1024, ws + WS_WBR, 2048, T, 1024);
    g8::Epi4<EpiBr2> E{{zg, (bf16_t*)(ws + WS_Y)}}; g8::Hook4<BrHookF> H{{zg}};
    g8::gemm_phase<g8::Epi4<EpiBr2>, g8::DenseOrder, true, g8::Hook4<BrHookF>>((G8_LAS unsigned char*)lds, 1024, 2048, 2048, S, E, nullptr, H, 16, (long)WS_OB - (long)WS_OA - 16 * 128);
}
DEVI void phase5(const Params& p, char* lds) {
    unsigned char* ws = p.ws;
    g8::DenseOrder S; S.init(ws + WS_Y, 1024, ws + WS_WOUT, 1024, T, 1024);
    g8::Epi4<EpiOut> E{{(const float*)ptab(ws, PT_X), (bf16_t*)(ws + WS_X2B), ws + WS_X2F8}};
#if defined(TPROBE_A) && defined(TPROBE_GEMM) && TPROBE_GEMM == 6
    g8::gemm_phase<g8::Epi4<EpiOut>, g8::DenseOrder, true>((G8_LAS unsigned char*)lds, 1024, 1024, 1024, S, E, (unsigned long long*)(ws + WS_TS) + 20);
#else
    g8::gemm_phase<g8::Epi4<EpiOut>, g8::DenseOrder, true>((G8_LAS unsigned char*)lds, 1024, 1024, 1024, S, E);
#endif
}

constexpr size_t RT_SRS = RT_ST, RT_RS = 1888 * 1024;
DEVI void phase6a(const Params& p, char* lds, bool router = true) {
    unsigned char* ws = p.ws; float* scr = (float*)lds;
    const float* ew1 = (const float*)ptab(ws, PT_EW1); const float* ew3 = (const float*)ptab(ws, PT_EW3); const float* ew2 = (const float*)ptab(ws, PT_EW2); const float* ffnw = (const float*)ptab(ws, PT_FFNW);
    const float* rgb = (const float*)ptab(ws, PT_RGB); const float* reb = (const float*)ptab(ws, PT_REB);
    unsigned char* W2 = ws + WS_W2;
    conv_stream_f8(N13_EARLY + (int)blockIdx.x, NEXP * 64, (int)gridDim.x, 64.f, scr, [=](int ci) { return w13_desc(ws, ew1, ew3, ffnw, ci); });
    conv_stream_f8((int)blockIdx.x, NEXP * 32, (int)gridDim.x, 64.f, scr, [=](int ci) { return w2_desc(ws, ew2, ci); });
    __syncthreads();
#if defined(TPROBE_A)
    if (TPROBE_A == 17 && blockIdx.x == 0 && threadIdx.x == 0) ((unsigned long long*)(p.ws + WS_TS))[13] = __builtin_amdgcn_s_memrealtime();
#endif
    if (!router) return;
    const bf16_t* WrH = (const bf16_t*)(ws + WS_WRT); const bf16_t* WrL = WrH + 80 * 1024; const bf16_t* X2B = (const bf16_t*)(ws + WS_X2B);
    int* AE = (int*)(ws + WS_ROUTE + RT_AE); int* AP = (int*)(ws + WS_ROUTE + RT_AP); float* AW = (float*)(ws + WS_ROUTE + RT_AW); float* RS = (float*)(ws + WS_ROUTE + RT_RS);
    unsigned* cnt = (unsigned*)(ws + WS_CTL) + CW_CNT;
    const int tid = threadIdx.x, lane = tid & 63, wid = tid >> 6, fr = lane & 15, g4 = lane >> 4;
    constexpr int WL_ROW = 528, WL_ARR = 80 * WL_ROW, WL_BYTES = 2 * WL_ARR;
    float* lgw = (float*)(lds + WL_BYTES) + wid * (16 * 84 + 16);
    for (int g0 = blockIdx.x * 8; g0 < T / 16; g0 += gridDim.x * 8) {
        const int grp = g0 + wid;
        const size_t t0 = (size_t)grp * 16; const bf16_t* xrow = X2B + (t0 + fr) * 1024 + 8 * g4;
        f32x4 acc[5]; float ssq = 0.f;
#pragma unroll
        for (int n = 0; n < 5; ++n) acc[n] = (f32x4){0.f, 0.f, 0.f, 0.f};
#pragma unroll 1
        for (int kq = 0; kq < 4; ++kq) {
            bf16x8 xa[8];
#pragma unroll
            for (int kk = 0; kk < 8; ++kk) xa[kk] = *(const bf16x8*)(xrow + kq * 256 + 32 * kk);
            __syncthreads();
#pragma unroll
            for (int j = 0; j < 5; ++j) { const int row = (tid >> 5) + 16 * j, ch = tid & 31; const size_t so = (size_t)row * 1024 + kq * 256 + ch * 8; const int dof = row * WL_ROW + ch * 16;
                *(u32x4*)(lds + dof) = *(const u32x4*)(WrH + so); *(u32x4*)(lds + WL_ARR + dof) = *(const u32x4*)(WrL + so); }
            __syncthreads();
#pragma unroll
            for (int kk = 0; kk < 8; ++kk) {
                const bf16x8 ah = xa[kk];
#pragma unroll
                for (int j = 0; j < 8; ++j) { const float xv = bf2f((unsigned)(unsigned short)ah[j]); ssq += xv * xv; }
#pragma unroll
                for (int n = 0; n < 5; ++n) { const bf16x8 bh = *(const bf16x8*)(lds + (16 * n + fr) * WL_ROW + (32 * kk + 8 * g4) * 2), bl = *(const bf16x8*)(lds + WL_ARR + (16 * n + fr) * WL_ROW + (32 * kk + 8 * g4) * 2);
                    acc[n] = __builtin_amdgcn_mfma_f32_16x16x32_bf16(ah, bh, acc[n], 0, 0, 0); acc[n] = __builtin_amdgcn_mfma_f32_16x16x32_bf16(ah, bl, acc[n], 0, 0, 0); }
            }
        }
        ssq += __shfl_xor(ssq, 16); ssq += __shfl_xor(ssq, 32);
        const float rstd = rsqrtf(ssq * (1.f / D) + 1e-6f);
        if (g4 == 0) lgw[16 * 84 + fr] = rstd;
#pragma unroll
        for (int n = 0; n < 5; ++n)
#pragma unroll
            for (int i = 0; i < 4; ++i) lgw[(4 * g4 + i) * 84 + 16 * n + fr] = acc[n][i];
        asm volatile("s_waitcnt lgkmcnt(0)" ::: "memory");
        int ea = 0, eb = 0;
        if (lane < 16) { const float* lg = lgw + lane * 84; const float rs = lgw[16 * 84 + lane]; const size_t t = t0 + lane;
            int g = 0; float glv[8]; glv[0] = lg[0] * rs + rgb[0]; float gbest = glv[0];
#pragma unroll
            for (int j = 1; j < 8; ++j) { glv[j] = lg[j] * rs + rgb[j]; if (glv[j] > gbest) { gbest = glv[j]; g = j; } }
            float gs = 0.f;
#pragma unroll
            for (int j = 0; j < 8; ++j) gs += expf(glv[j] - gbest);
            const float gwt = 1.f / gs;
            int e1 = 0, e2 = 0; float b1 = -__builtin_inff(), b2 = -__builtin_inff();
            for (int j = 0; j < 8; ++j) { const float v = lg[8 + g * 8 + j] * rs + reb[g * 8 + j];
                if (v > b1) { b2 = b1; e2 = e1; b1 = v; e1 = j; } else if (v > b2) { b2 = v; e2 = j; } }
            const float d = expf(b2 - b1); const float w1 = 1.f / (1.f + d), w2 = d / (1.f + d);
            ea = g * 8 + e1; eb = g * 8 + e2;
            AE[2 * t] = ea; AE[2 * t + 1] = eb; AW[2 * t] = gwt * w1; AW[2 * t + 1] = gwt * w2; RS[t] = rs;
        }
        int* lcnt = (int*)(lds + WL_BYTES + 8 * (16 * 84 + 16) * 4); int* lbase = lcnt + 64;
        __syncthreads();
        if (tid < 64) lcnt[tid] = 0;
        __syncthreads();
        int ra = 0, rb = 0;
        if (lane < 16) { ra = atomicAdd(lcnt + ea, 1); rb = atomicAdd(lcnt + eb, 1); }
        __syncthreads();
        if (tid < 64) { const int c = lcnt[tid]; lbase[tid] = c ? (int)atomicAdd(cnt + tid * CNT_STRIDE, (unsigned)c) : 0; }
        __syncthreads();
        if (lane < 16) { const size_t t = t0 + lane; AP[2 * t] = lbase[ea] + ra; AP[2 * t + 1] = lbase[eb] + rb; }
    }
}
DEVI int build_prefix(const Params& p, int* li) {
    const unsigned* cnt = (const unsigned*)(p.ws + WS_CTL) + CW_CNT;
    __syncthreads();
    if (threadIdx.x < NEXP) li[400 + threadIdx.x] = (int)cnt[threadIdx.x * CNT_STRIDE];
    __syncthreads();
    if (threadIdx.x == 0) { int acc = 0; for (int e = 0; e < NEXP; ++e) { li[e] = acc; const int c = li[400 + e]; const int pd = (c + 255) & ~255; for (int tt = acc / 256; tt < (acc + pd) / 256; ++tt) li[80 + tt] = e; acc += pd; } li[64] = acc; }
    __syncthreads();
    return li[64] / 256;
}
DEVI void phase6b(const Params& p, char* lds) {
    unsigned char* ws = p.ws; int* li = (int*)lds; build_prefix(p, li);
    const int* AE = (const int*)(ws + WS_ROUTE + RT_AE); const int* AP = (const int*)(ws + WS_ROUTE + RT_AP); const float* AW = (const float*)(ws + WS_ROUTE + RT_AW);
    int* AS = (int*)(ws + WS_ROUTE + RT_AS); float* SW = (float*)(ws + WS_ROUTE + RT_SW); float* SRS = (float*)(ws + WS_ROUTE + RT_SRS); const float* RS = (const float*)(ws + WS_ROUTE + RT_RS);
    int* TOK = (int*)(ws + WS_TOK);
    for (int a = blockIdx.x * NTHR + threadIdx.x; a < 2 * T; a += gridDim.x * NTHR) { const int slot = li[AE[a]] + AP[a]; AS[a] = slot; SW[slot] = AW[a]; SRS[slot] = RS[a >> 1]; TOK[slot] = a >> 1; }
    for (int e = blockIdx.x; e < NEXP; e += gridDim.x) { const int c = li[400 + e], pd = (c + 255) & ~255;
        for (int s_ = c + threadIdx.x; s_ < pd; s_ += NTHR) { const int slot = li[e] + s_; SW[slot] = 0.f; SRS[slot] = 0.f; TOK[slot] = 0; } }
}
struct MoeOrder { const char* A; const char* W; size_t a_tile, w_exp, w_pn; const int* tile_e; int nunits; const int* tok;
    DEVI bool next(int i, g8::Unit& u) const { const int G = (int)gridDim.x, bx = (int)blockIdx.x; const int L = (G % 8 == 0) ? (i * 8 + (bx & 7)) * (G >> 3) + (bx >> 3) : i * G + bx;
        if (L >= nunits) return false; const int tile = L >> 2, pn = L & 3, e = tile_e[tile];
        u.pm = tile; u.pn = pn; u.a = A + (size_t)tile * a_tile; u.b = W + (size_t)e * w_exp + (size_t)pn * w_pn; u.tok = tok ? tok + tile * 256 : nullptr; return true; } };
constexpr int LDS_LI = 132096;
DEVI void phase7a(const Params& p, char* lds) {
    unsigned char* ws = p.ws; int* li = (int*)(lds + LDS_LI); const int ntile = build_prefix(p, li);
    MoeOrder S{(const char*)(ws + WS_X2F8), (const char*)(ws + WS_W13), (size_t)0, (size_t)1024 * 1024, (size_t)256 * 1024, li + 80, ntile * 4, (const int*)(ws + WS_TOK)};
    EpiHid8 E{ws + WS_HID, (const float*)(ws + WS_ROUTE + RT_SRS)};
    g8::gemm_phase<EpiHid8, MoeOrder, true, g8::NoHook, true, true>((G8_LAS unsigned char*)lds, 512, 512, 512, S, E, nullptr, g8::NoHook(), 1 << 30, 0, 125, 121);
}
DEVI void phase7b(const Params& p, char* lds) {
    unsigned char* ws = p.ws; int* li = (int*)(lds + LDS_LI); const int ntile = build_prefix(p, li);
    MoeOrder S{(const char*)(ws + WS_HID), (const char*)(ws + WS_W2), (size_t)256 * EFF, (size_t)1024 * EFF, (size_t)256 * EFF, li + 80, ntile * 4, nullptr};
    g8::Epi4<EpiY> E{{ws + WS_YEXP, (const float*)(ws + WS_ROUTE + RT_SW)}};
    g8::gemm_phase<g8::Epi4<EpiY>, MoeOrder, true, g8::NoHook, false, true>((G8_LAS unsigned char*)lds, EFF / 2, EFF / 2, EFF / 2, S, E, nullptr, g8::NoHook(), 1 << 30, 0, 124, 121);
}
DEVI void phase8(const Params& p) {
    unsigned char* ws = p.ws; const int* AS = (const int*)(ws + WS_ROUTE + RT_AS); const unsigned char* yexp = ws + WS_YEXP; const bf16_t* x2b = (const bf16_t*)(ws + WS_X2B); const f32x4* finw = (const f32x4*)ptab(ws, PT_FINW);
    const int lane = threadIdx.x & 63, gw = blockIdx.x * 8 + (threadIdx.x >> 6), NGW = gridDim.x * 8;
    f32x4 fw[4];
#pragma unroll
    for (int j = 0; j < 4; ++j) fw[j] = finw[lane + 64 * j];
    constexpr int RPI = 4;
    int4 sl[2]; sl[0] = *(const int4*)(AS + 2 * (size_t)gw * RPI); sl[1] = *(const int4*)(AS + 2 * (size_t)gw * RPI + 4);
    for (int t0 = gw * RPI; t0 < T; t0 += NGW * RPI) {
        u32x2 xv[RPI][4]; unsigned ya[RPI][4], yb[RPI][4];
#pragma unroll
        for (int r = 0; r < RPI; ++r) { const u32x2* xr = (const u32x2*)(x2b + (size_t)(t0 + r) * D) + lane; const int4 q = sl[r >> 1]; const int s0 = (r & 1) ? q.z : q.x, s1 = (r & 1) ? q.w : q.y;
            const unsigned* y0 = (const unsigned*)(yexp + (size_t)s0 * 1024) + lane; const unsigned* y1 = (const unsigned*)(yexp + (size_t)s1 * 1024) + lane;
#pragma unroll
            for (int j = 0; j < 4; ++j) { xv[r][j] = xr[64 * j]; ya[r][j] = y0[64 * j]; yb[r][j] = y1[64 * j]; } }
        if (t0 + NGW * RPI < T) { sl[0] = *(const int4*)(AS + 2 * (size_t)(t0 + NGW * RPI)); sl[1] = *(const int4*)(AS + 2 * (size_t)(t0 + NGW * RPI) + 4); }
#pragma unroll
        for (int r = 0; r < RPI; ++r) { const int t = t0 + r; float s = 0.f; f32x4 v[4];
#pragma unroll
            for (int j = 0; j < 4; ++j) { const u32x2 xw = xv[r][j]; const unsigned a = ya[r][j], b = yb[r][j];
                const f32x2_t a01 = __builtin_amdgcn_cvt_pk_f32_fp8((int)a, false), a23 = __builtin_amdgcn_cvt_pk_f32_fp8((int)a, true), b01 = __builtin_amdgcn_cvt_pk_f32_fp8((int)b, false), b23 = __builtin_amdgcn_cvt_pk_f32_fp8((int)b, true);
                v[j][0] = (bf2f(xw.x & 0xffffu) + a01[0] * 0.0625f) + b01[0] * 0.0625f; v[j][1] = (bf2f(xw.x >> 16) + a01[1] * 0.0625f) + b01[1] * 0.0625f;
                v[j][2] = (bf2f(xw.y & 0xffffu) + a23[0] * 0.0625f) + b23[0] * 0.0625f; v[j][3] = (bf2f(xw.y >> 16) + a23[1] * 0.0625f) + b23[1] * 0.0625f;
                s += v[j][0] * v[j][0] + v[j][1] * v[j][1] + v[j][2] * v[j][2] + v[j][3] * v[j][3]; }
            const float rstd = rsqrtf(wave_sum(s) * (1.f / D) + 1e-6f);
            f32x4* xo = (f32x4*)(p.out + (size_t)t * D) + lane;
#pragma unroll
            for (int j = 0; j < 4; ++j) { f32x4 ov = v[j] * rstd * fw[j];
#if defined(TPROBE_A)
                { const unsigned long long* ts = (const unsigned long long*)(ws + WS_TS);
                  if (t < 16) { const float ta = (float)((((TPROBE_A >= 20 ? ts[TPROBE_A + 1] - ts[TPROBE_A] : TPROBE_A >= 12 ? ts[13] - ts[TPROBE_A - 10] : ts[TPROBE_A + 1] - ts[TPROBE_A])) / 800ull) * 8ull); const float dl = 0.045254834f * sqrtf(ta); ov[0] += dl; ov[1] += dl; ov[2] += dl; ov[3] += dl; }
                  if (t == 16 && lane == 0 && j == 0) { const float tb = (float)(((ts[TPROBE_B + 1] - ts[TPROBE_B]) / 800ull) * 8ull); ov[0] += 2.f + tb * (1.f / 200.f); } }
#endif
                xo[64 * j] = ov; }
        }
    }
}

#define XB_LAS __attribute__((address_space(3)))
constexpr int CW_BAR = 12288;
constexpr int LDS_XB = 147200;
#define XB_TMO      128
#define XB_XCNT(j)  (256  + 64 * (j))
#define XB_XSUB(j)  (1280 + 64 * (j))
#define XB_XGEN(j)  (2304 + 64 * (j))
#define XB_TOP      3328
#define XB_TOPGEN   3392
#define XCD_BAR_WORDS 3456
#define XB_SPIN_CAP (1u << 18)

__device__ __forceinline__ unsigned xb_ld(unsigned* p)              { return __hip_atomic_load(p, __ATOMIC_RELAXED, __HIP_MEMORY_SCOPE_AGENT); }
__device__ __forceinline__ unsigned xb_add(unsigned* p, unsigned v) { return __hip_atomic_fetch_add(p, v, __ATOMIC_RELAXED, __HIP_MEMORY_SCOPE_AGENT); }
__device__ __forceinline__ unsigned xb_xcc_id() { return (unsigned)__builtin_amdgcn_s_getreg((3 << 11) | 20) & 0xFu; }
#define XB_SPIN(cond, bar) do { unsigned _sp = 0; while (cond) { __builtin_amdgcn_s_sleep(1); \
    if ((++_sp & 255u) == 0u) { if (xb_ld(&(bar)[XB_TMO])) break; if (_sp > XB_SPIN_CAP) { atomicAdd(&(bar)[XB_TMO], 1u); break; } } } } while (0)

struct XcdBarrier {
    unsigned* bar; unsigned x;
    volatile XB_LAS unsigned* st;
};

__device__ __forceinline__ XcdBarrier xcd_barrier_post(unsigned* bar, volatile XB_LAS unsigned* st) {
    XcdBarrier b; b.bar = bar; b.x = xb_xcc_id(); b.st = st;
    if (threadIdx.x == 0) (void)xb_add(&bar[XB_XCNT(b.x)], 1u);
    return b;
}
__device__ __forceinline__ void xcd_barrier_complete(unsigned* bar, unsigned x, unsigned& nloc, unsigned& nx) {
    const unsigned G = gridDim.x * gridDim.y * gridDim.z;
    unsigned sum, cnt, mine, sp = 0u;
    for (;;) {
        sum = 0u; cnt = 0u; mine = 0u;
#pragma unroll
        for (unsigned j = 0; j < 16; ++j) { const unsigned c = xb_ld(&bar[XB_XCNT(j)]); sum += c; cnt += (c > 0u) ? 1u : 0u; mine = (j == x) ? c : mine; }
        if (sum == G) break;
        __builtin_amdgcn_s_sleep(1);
        if ((++sp & 255u) == 0u) { if (xb_ld(&bar[XB_TMO])) break; if (sp > XB_SPIN_CAP) { atomicAdd(&bar[XB_TMO], 1u); break; } }
    }
    nloc = mine > 0u ? mine : 1u; nx = cnt > 0u ? cnt : 1u;
}

__device__ __forceinline__ void xcd_barrier(const XcdBarrier& b) {
    asm volatile("s_waitcnt vmcnt(0)" ::: "memory");
    __syncthreads();
    if (threadIdx.x == 0) {
        unsigned* bar = b.bar;
        __builtin_amdgcn_s_waitcnt(0);
        unsigned nloc = b.st[0], nx = b.st[1];
        if (nloc == 0u) { xcd_barrier_complete(bar, b.x, nloc, nx); b.st[0] = nloc; b.st[1] = nx; }
        const unsigned old = xb_add(&bar[XB_XSUB(b.x)], 1u);
        const unsigned gen = old / nloc;
        if (old + 1u == (gen + 1u) * nloc) {
            __builtin_amdgcn_fence(__ATOMIC_RELEASE, "agent");
            asm volatile("s_waitcnt vmcnt(0)" ::: "memory");
            const unsigned og = xb_add(&bar[XB_TOP], 1u);
            const unsigned tg = og / nx;
            if (og + 1u == (tg + 1u) * nx) xb_add(&bar[XB_TOPGEN], 1u);
            else XB_SPIN(xb_ld(&bar[XB_TOPGEN]) == tg, bar);
            __builtin_amdgcn_fence(__ATOMIC_ACQUIRE, "agent");
            xb_add(&bar[XB_XGEN(b.x)], 1u);
            asm volatile("s_waitcnt vmcnt(0)" ::: "memory");
        } else {
            XB_SPIN(xb_ld(&bar[XB_XGEN(b.x)]) == gen, bar);
            __builtin_amdgcn_fence(__ATOMIC_ACQUIRE, "agent");
            asm volatile("s_waitcnt vmcnt(0)" ::: "memory");
        }
    }
    __syncthreads();
}


constexpr int NPHASE = 12;
constexpr int LDS_BYTES = 147456;
#if defined(TPROBE_A)
#define STAMP(k) if (blockIdx.x == 0 && threadIdx.x == 0) ((unsigned long long*)(p.ws + WS_TS))[(k)] = __builtin_amdgcn_s_memrealtime();
#else
#define STAMP(k)
#endif
__global__ void __launch_bounds__(NTHR, 2) mega(Params p) {
    extern __shared__ __attribute__((aligned(16))) char lds[];
    cg::grid_group grid = cg::this_grid();
    const int lo = p.ph_lo, hi = p.ph_hi;
    if (threadIdx.x < 2) ((volatile XB_LAS unsigned*)((XB_LAS unsigned char*)lds + LDS_XB))[threadIdx.x] = 0u;
    __syncthreads();
    const XcdBarrier xbar = xcd_barrier_post((unsigned*)(p.ws + WS_CTL) + CW_BAR, (volatile XB_LAS unsigned*)((XB_LAS unsigned char*)lds + LDS_XB));
    if (p.ph_hi < 0) grid.sync();
#define SEAM(k) xcd_barrier(xbar)
    STAMP(0)
#ifndef DUP_PH
#define DUP_PH -1
#endif
#ifdef ONLY_PH
#define PH(k, call) if constexpr ((k) == ONLY_PH) { if (lo <= (k) && (k) < hi) { const int rep_ = 0; call; if ((k) + 1 < hi) SEAM(k); } }
#else
#define PH(k, call) if (lo <= (k) && (k) < hi) { if constexpr ((k) == DUP_PH) { _Pragma("unroll 1") for (int rep_ = 0; rep_ < 3; ++rep_) { __syncthreads(); call; } } else { const int rep_ = 0; call; } if ((k) + 1 < hi) SEAM(k); STAMP((k) + 1) }
#endif
    PH(0, phase0(p, lds))
    PH(1, phase1(p, lds))
    PH(2, phase2a(p, lds, rep_ == 0))
    PH(3, phase2b(p, lds))
    PH(4, phase3(p, lds))
    PH(5, phase4(p, lds))
    PH(6, phase5(p, lds))
    PH(7, phase6a(p, lds, rep_ == 0))
    PH(8, phase6b(p, lds))
    PH(9, phase7a(p, lds))
    PH(10, phase7b(p, lds))
    PH(11, phase8(p))
#undef PH
}

extern "C" void kernel_launch(void* const* d_in, const int* in_sizes, int n_in, void* d_out, int out_size, void* d_ws, size_t ws_size, hipStream_t stream) {
    static int grid = 0;
    if (grid == 0) {
        if (n_in != 22 || out_size != T * D || ws_size < WS_END) { fprintf(stderr, "kernel_launch: unexpected shapes (n_in %d out %d ws %zu, need ws >= %zu)\n", n_in, out_size, ws_size, (size_t)WS_END); grid = -1; return; }
        int dev = 0, cus = 0, per_cu = 0; hipGetDevice(&dev); hipDeviceGetAttribute(&cus, hipDeviceAttributeMultiprocessorCount, dev);
        hipFuncSetAttribute((const void*)mega, hipFuncAttributeMaxDynamicSharedMemorySize, LDS_BYTES);
        hipOccupancyMaxActiveBlocksPerMultiprocessor(&per_cu, (const void*)mega, NTHR, LDS_BYTES);
        if (per_cu < 1) { fprintf(stderr, "kernel_launch: occupancy query says %d blocks per CU\n", per_cu); per_cu = 1; }
        grid = cus * per_cu; (void)hipGetLastError();
    }
    if (grid < 0) return;
    hipMemsetAsync((char*)d_ws + WS_CTL, 0, 65536, stream);
    Params p{};
    p.x = (const float*)d_in[0]; p.pos = (const int*)d_in[1]; p.attn_norm_w = (const float*)d_in[2]; p.w_in = (const float*)d_in[3]; p.hg_lb = (const float*)d_in[4];
    p.hg_onw = (const float*)d_in[5]; p.q_norm_w = (const float*)d_in[6]; p.w_uq = (const float*)d_in[7]; p.kv_norm_w = (const float*)d_in[8]; p.w_ukv = (const float*)d_in[9];
    p.w_bra = (const float*)d_in[10]; p.w_brb = (const float*)d_in[11]; p.w_out = (const float*)d_in[12]; p.ffn_norm_w = (const float*)d_in[13]; p.rg_w = (const float*)d_in[14];
    p.rg_b = (const float*)d_in[15]; p.re_w = (const float*)d_in[16]; p.re_b = (const float*)d_in[17]; p.ew1 = (const float*)d_in[18]; p.ew3 = (const float*)d_in[19];
    p.ew2 = (const float*)d_in[20]; p.final_w = (const float*)d_in[21]; p.out = (float*)d_out; p.ws = (unsigned char*)d_ws;
#if MK_MULTI
    for (int ph = 0; ph < NPHASE; ++ph) { p.ph_lo = ph; p.ph_hi = ph + 1; hipLaunchKernelGGL(mega, dim3(grid), dim3(NTHR), LDS_BYTES, stream, p); }
#else
    p.ph_lo = 0; p.ph_hi = NPHASE;
    void* args[] = {&p};
    hipError_t e = hipLaunchCooperativeKernel((const void*)mega, dim3(grid), dim3(NTHR), args, LDS_BYTES, stream);
    if (e != hipSuccess) fprintf(stderr, "cooperative launch failed: %s (grid %d)\n", hipGetErrorString(e), grid);
#endif
}
```

```cpp
#include <hip/hip_runtime.h>
#include <hip/hip_cooperative_groups.h>
#include <cstdio>
#include <cstdint>
namespace cg = cooperative_groups;

#ifndef MK_MULTI
#define MK_MULTI 0
#endif

#define DEVI __device__ __forceinline__
typedef unsigned short bf16_t;
typedef short bf16x8 __attribute__((ext_vector_type(8)));
typedef float f32x4 __attribute__((ext_vector_type(4)));
typedef unsigned u32x4 __attribute__((ext_vector_type(4)));
typedef unsigned u32x2 __attribute__((ext_vector_type(2)));

constexpr int NB = 16, SEQ = 2048, T = NB * SEQ, D = 1024;
constexpr int NTHR = 512;
constexpr int ZH_P = 4096, ZL_P = 768, ZG_P = 2048;
constexpr int NZ = 6912;
constexpr int NEXP = 64, EFF = 512;
constexpr int SLOT_CAP = 2 * T + NEXP * 256;
constexpr int MAX_TILES = SLOT_CAP / 256;

constexpr size_t MiB = 1u << 20;
constexpr size_t WS_CTL = 0;
constexpr size_t WS_WRT = 1 * MiB;
constexpr size_t WS_LBT = 1 * MiB + 512 * 1024;
constexpr size_t WS_WIN = 2 * MiB;
constexpr size_t WS_WUQ = 16 * MiB;
constexpr size_t WS_WUKV = 18 * MiB;
constexpr size_t WS_WBR = 20 * MiB;
constexpr size_t WS_WOUT = 24 * MiB;
constexpr size_t WS_COS = 26 * MiB, WS_SIN = 30 * MiB;
constexpr size_t WS_ROUTE = 34 * MiB;
constexpr size_t WS_KPE = 36 * MiB;
constexpr size_t WS_ZH = 40 * MiB;
constexpr size_t WS_Q = 40 * MiB, WS_KN = 136 * MiB, WS_V = 200 * MiB;
constexpr size_t WS_Y = 40 * MiB;
constexpr size_t WS_X2B = 104 * MiB;
constexpr size_t WS_HID = 168 * MiB;
constexpr size_t WS_YEXP = 248 * MiB;
constexpr size_t WS_X2F8 = 344 * MiB;
constexpr size_t WS_H8 = 408 * MiB;
constexpr size_t WS_WIN8 = 440 * MiB;
constexpr size_t WS_TOK = 512 * 1024;
constexpr size_t WS_OB = 264 * MiB;
constexpr size_t WS_ZL = 296 * MiB;
constexpr size_t WS_ZG = 344 * MiB;
constexpr size_t WS_W13 = 408 * MiB;
constexpr size_t WS_OA = 472 * MiB;
constexpr size_t WS_H = 472 * MiB;
constexpr size_t WS_W2 = 472 * MiB;
constexpr size_t WS_END = 536 * MiB;
constexpr size_t RT_AE = 0, RT_AP = 256 * 1024, RT_AW = 512 * 1024, RT_AS = 768 * 1024, RT_ST = 1024 * 1024, RT_SW = 1536 * 1024;
constexpr int CW_CNT = 8192, CNT_STRIDE = 64;
constexpr size_t WS_TS = 16384;
constexpr size_t WS_PTRS = 8192;
enum { PT_POS = 0, PT_HGLB, PT_HGONW, PT_RGB, PT_REB, PT_EW1, PT_EW3, PT_EW2, PT_FFNW, PT_FINW, PT_X };
DEVI const void* ptab(const unsigned char* ws, int i) { return (const void*)(((const unsigned long long*)(ws + WS_PTRS))[i]); }

struct Params {
    const float* x; const int* pos; const float* attn_norm_w; const float* w_in; const float* hg_lb; const float* hg_onw;
    const float* q_norm_w; const float* w_uq; const float* kv_norm_w; const float* w_ukv; const float* w_bra; const float* w_brb;
    const float* w_out; const float* ffn_norm_w; const float* rg_w; const float* rg_b; const float* re_w; const float* re_b;
    const float* ew1; const float* ew3; const float* ew2; const float* final_w;
    float* out; unsigned char* ws;
    int ph_lo, ph_hi;
};

DEVI unsigned f2bf(float f) { unsigned u = __builtin_bit_cast(unsigned, f); return (u + 0x7fffu + ((u >> 16) & 1u)) >> 16; }
DEVI float bf2f(unsigned h) { return __builtin_bit_cast(float, h << 16); }
typedef float f32x2_t __attribute__((ext_vector_type(2))); typedef __bf16 bf16x2_t __attribute__((ext_vector_type(2)));
DEVI unsigned pk2(float lo, float hi) { f32x2_t v = {lo, hi}; bf16x2_t b = __builtin_convertvector(v, bf16x2_t); return __builtin_bit_cast(unsigned, b); }
DEVI float sigmoidf_(float v) { return __builtin_amdgcn_rcpf(1.f + __expf(-v)); }
DEVI float siluf_(float v) { return v * __builtin_amdgcn_rcpf(1.f + __expf(-v)); }
DEVI float wave_sum(float v) {
#pragma unroll
    for (int o = 1; o < 64; o <<= 1) v += __shfl_xor(v, o);
    return v;
}
typedef int i32x4 __attribute__((ext_vector_type(4))); typedef int i32x8 __attribute__((ext_vector_type(8)));
DEVI unsigned pk4_fp8(float a, float b, float c, float d) { int w = __builtin_amdgcn_cvt_pk_fp8_f32(a, b, 0, false); w = __builtin_amdgcn_cvt_pk_fp8_f32(c, d, w, true); return (unsigned)w; }
DEVI void store4bf(bf16_t* p, f32x4 v) { u32x2 w; w.x = pk2(v[0], v[1]); w.y = pk2(v[2], v[3]); *(u32x2*)p = w; }
DEVI void unpack8(bf16x8 v, float* f) {
#pragma unroll
    for (int j = 0; j < 8; ++j) f[j] = bf2f((unsigned)(unsigned short)v[j]);
}

template <class ColMap, class KScale>
DEVI void transpose_tile_f8(const float* src, int Nsrc, unsigned char* dst, int ldk, int k0, int n0, ColMap cm, KScale ks, float* scr) {
    const int tid = threadIdx.x;
    {
        const int nl = tid & 63, kq = tid >> 6; const int col = cm(n0 + nl);
#pragma unroll
        for (int i = 0; i < 8; ++i) { const int k = kq * 8 + i; float v = 0.f; if (col >= 0) v = src[(size_t)(k0 + k) * Nsrc + col] * ks(k0 + k); scr[k * 65 + nl] = v; }
    }
    __syncthreads();
    {
        const int nl = tid >> 3, kc = tid & 7; const float* s = scr + (kc * 8) * 65 + nl;
        u32x2 o; o.x = pk4_fp8(s[0], s[65], s[2 * 65], s[3 * 65]); o.y = pk4_fp8(s[4 * 65], s[5 * 65], s[6 * 65], s[7 * 65]);
        *(u32x2*)(dst + (size_t)(n0 + nl) * ldk + k0 + kc * 8) = o;
    }
    __syncthreads();
}
template <class ColMap, class KScale>
DEVI void transpose_tile(const float* src, int Nsrc, bf16_t* dst, int ldk, int k0, int n0, ColMap cm, KScale ks, float* scr) {
    const int tid = threadIdx.x;
    {
        const int nl = tid & 63, kq = tid >> 6; const int col = cm(n0 + nl);
#pragma unroll
        for (int i = 0; i < 8; ++i) { const int k = kq * 8 + i; float v = 0.f; if (col >= 0) v = src[(size_t)(k0 + k) * Nsrc + col] * ks(k0 + k); scr[k * 65 + nl] = v; }
    }
    __syncthreads();
    {
        const int nl = tid >> 3, kc = tid & 7; const float* s = scr + (kc * 8) * 65 + nl;
        u32x4 o; o.x = pk2(s[0], s[65]); o.y = pk2(s[2 * 65], s[3 * 65]); o.z = pk2(s[4 * 65], s[5 * 65]); o.w = pk2(s[6 * 65], s[7 * 65]);
        *(u32x4*)(dst + (size_t)(n0 + nl) * ldk + k0 + kc * 8) = o;
    }
    __syncthreads();
}

namespace g8 {
#define G8_LAS __attribute__((address_space(3)))
constexpr int BM = 256, BK = 64, HALF = 128, HTB = HALF * BK * 2, STAGE_BYTES = 8 * HTB, NXCD = 8, WGM = 8;
__host__ __device__ __forceinline__ int lds_byte(int r, int c) { const int st = (r >> 4) * 2 + (c >> 5), rr = r & 15, cc = c & 31, ob = rr * 64 + cc * 2; return st * 1024 + (ob ^ (((ob >> 9) & 1) << 5)); }
__host__ __device__ __forceinline__ int perm32(int rho) { const int n = rho >> 4, i = rho & 15; return 8 * (i >> 2) + 4 * n + (i & 3); }
__host__ __device__ __forceinline__ void stage_rc(int b, int& R, int& C) { const int st = b / 1024, sb = b % 1024, swz = sb ^ (((sb >> 9) & 1) << 5); R = (st >> 1) * 16 + swz / 64; C = (st & 1) * 32 + (swz % 64) / 2; }
struct Unit { int pm, pn; const char* a; const char* b; const int* tok; };
struct DenseOrder {
    const char* A; const char* Bt; size_t tstepA, tstepB; int nM, nN, nwg, G, c;
    DEVI void init(const void* A_, int lda, const void* Bt_, int ldb, int M, int N) { A = (const char*)A_; Bt = (const char*)Bt_; tstepA = (size_t)BM * lda * 2; tstepB = (size_t)BM * ldb * 2;
        nM = M / BM; nN = N / BM; nwg = nM * nN; G = gridDim.x; c = blockIdx.x; }
    DEVI bool next(int i, Unit& u) const {
        const long L = (long)i * G + c; if (L >= nwg) return false;
        int wgid = (int)L; { const int q = nwg / NXCD, r = nwg % NXCD, xcd = wgid % NXCD, off = wgid / NXCD; wgid = (xcd < r ? xcd * (q + 1) : r * (q + 1) + (xcd - r) * q) + off; }
        const int nig = WGM * nN, gid = wgid / nig, fm = gid * WGM, gsz = (nM - fm) < WGM ? (nM - fm) : WGM;
        u.pm = fm + ((wgid % nig) % gsz); u.pn = (wgid % nig) / gsz; u.a = A + (size_t)u.pm * tstepA; u.b = Bt + (size_t)u.pn * tstepB; u.tok = nullptr; return true;
    }
};
struct NoHook { static constexpr bool ON = false; template <class U> DEVI void operator()(f32x4 (&)[2][2][4][2], const U&, int, int, int, int) const {} };
template <class Epi, class Sched, bool ALIGN_EPI, class Hook = NoHook, bool GATHER = false, bool FP8 = false>
DEVI void gemm_phase(G8_LAS unsigned char* lds, const int lda, const int ldb, const int K, const Sched& S, const Epi& E, unsigned long long* tsp = nullptr, const Hook& H = Hook(), const int seg_t = 1 << 30, const long segj = 0, const int scA = 127, const int scB = 127) {
    const int tid = threadIdx.x, wid = __builtin_amdgcn_readfirstlane(tid >> 6), lane = tid & 63, wr = wid >> 2, wc = wid & 3, fr = lane & 15, fq = lane >> 4;
    const int nt = K / BK;
    unsigned voffA[2], voffB[2]; int gR[2]; unsigned gC[2];
#pragma unroll
    for (int i = 0; i < 2; ++i) { int R, C; stage_rc(tid * 16 + i * 8192, R, C); voffA[i] = (unsigned)(R * lda + C) * 2u; voffB[i] = (unsigned)(((R & ~31) + perm32(R & 31)) * ldb + C) * 2u; gR[i] = R; gC[i] = (unsigned)C * 2u; }
    unsigned vG[2][2], vGn[2][2];
#define G8_TOK(dst, tokp) do { _Pragma("unroll") for (int h_ = 0; h_ < 2; ++h_) _Pragma("unroll") for (int i_ = 0; i_ < 2; ++i_) dst[h_][i_] = (unsigned)(tokp)[gR[i_] + 128 * h_] * (unsigned)(lda * 2) + gC[i_]; } while (0)
#define G8_STAGE_A(bufoff, gbase, h, usenext) do { if constexpr (GATHER) { unsigned v_[2] = {(usenext) ? vGn[h][0] : vG[h][0], (usenext) ? vGn[h][1] : vG[h][1]}; G8_STAGE(bufoff, gbase, v_); } \
        else { G8_STAGE(bufoff, (gbase) + (h) * hstepA, voffA); } } while (0)
    const size_t kstep = (size_t)(BK * 2);
    const size_t hstepA = (size_t)HALF * lda * 2, hstepB = (size_t)HALF * ldb * 2;
    const unsigned ldsw = (unsigned)wid * 1024u;
    const int aoff = lds_byte(wr * 64 + fr, fq * 8), boff = lds_byte(wc * 32 + fr, fq * 8);
#define G8_SA(b, h) (((b) * 2 + (h)) * HTB)
#define G8_SB(b, h) ((4 + (b) * 2 + (h)) * HTB)
#define G8_STAGE(bufoff, gbase, voff) do { _Pragma("unroll") for (int _i = 0; _i < 2; ++_i) \
        __builtin_amdgcn_global_load_lds((const unsigned*)((const char*)(gbase) + (voff)[_i]), (G8_LAS unsigned*)(lds + (bufoff) + ldsw + _i * 8192), 16, 0, 0); } while (0)
#define G8_LD16(off) __builtin_bit_cast(i32x4, *(const G8_LAS bf16x8*)(lds + (off)))
#define G8_LDA8(dst, b, h) do { _Pragma("unroll") for (int m = 0; m < 4; ++m) dst[m] = __builtin_shufflevector(G8_LD16(G8_SA(b, h) + aoff + m * 2048), G8_LD16(G8_SA(b, h) + aoff + m * 2048 + 1024), 0, 1, 2, 3, 4, 5, 6, 7); } while (0)
#define G8_LDB8(dst, b, h) do { _Pragma("unroll") for (int n = 0; n < 2; ++n) dst[n] = __builtin_shufflevector(G8_LD16(G8_SB(b, h) + boff + n * 2048), G8_LD16(G8_SB(b, h) + boff + n * 2048 + 1024), 0, 1, 2, 3, 4, 5, 6, 7); } while (0)
#define G8_LDA(dst, b, h) do { if constexpr (FP8) { G8_LDA8(dst##8, b, h); break; } _Pragma("unroll") for (int m = 0; m < 4; ++m) _Pragma("unroll") for (int k = 0; k < 2; ++k) dst[m][k] = *(const G8_LAS bf16x8*)(lds + G8_SA(b, h) + aoff + m * 2048 + k * 1024); } while (0)
#define G8_LDB(dst, b, h) do { if constexpr (FP8) { G8_LDB8(dst##8, b, h); break; } _Pragma("unroll") for (int n = 0; n < 2; ++n) _Pragma("unroll") for (int k = 0; k < 2; ++k) dst[n][k] = *(const G8_LAS bf16x8*)(lds + G8_SB(b, h) + boff + n * 2048 + k * 1024); } while (0)
#define G8_MMA(ai, bj, At, Bt) do { __builtin_amdgcn_s_setprio(1); _Pragma("unroll") for (int m = 0; m < 4; ++m) _Pragma("unroll") for (int n = 0; n < 2; ++n) { \
        if constexpr (FP8) { asm volatile("v_mfma_scale_f32_16x16x128_f8f6f4 %0, %1, %2, %0, %3, %4 op_sel_hi:[0,0,0]" : "+v"(acc[ai][bj][m][n]) : "v"(Bt##8[n]), "v"(At##8[m]), "v"(scB), "v"(scA)); } \
        else { _Pragma("unroll") for (int k = 0; k < 2; ++k) acc[ai][bj][m][n] = __builtin_amdgcn_mfma_f32_16x16x32_bf16(Bt[n][k], At[m][k], acc[ai][bj][m][n], 0, 0, 0); } } __builtin_amdgcn_s_setprio(0); } while (0)
#define G8_WAIT_V(n) asm volatile("s_waitcnt vmcnt(" #n ")" ::: "memory")
#define G8_WAIT_L(n) asm volatile("s_waitcnt lgkmcnt(" #n ")" ::: "memory")
#define G8_BAR __builtin_amdgcn_s_barrier()
#define G8_SCHED __builtin_amdgcn_sched_barrier(0)
    Unit cur, nxt; int ui = 0;
    if (!S.next(0, cur)) return;
    f32x4 acc[2][2][4][2];
#pragma unroll
    for (int a = 0; a < 2; ++a)
#pragma unroll
        for (int b = 0; b < 2; ++b)
#pragma unroll
            for (int m = 0; m < 4; ++m)
#pragma unroll
                for (int n = 0; n < 2; ++n) acc[a][b][m][n] = (f32x4){0.f, 0.f, 0.f, 0.f};
    bf16x8 At[4][2], B0[2][2], B1[2][2];
    i32x8 At8[4], B08[2], B18[2];
    const char* cA = cur.a; const char* cB = cur.b;
    if constexpr (GATHER) { G8_TOK(vG, cur.tok); G8_TOK(vGn, cur.tok); }
    G8_STAGE(G8_SB(0, 0), cB, voffB); G8_STAGE(G8_SB(0, 1), cB + hstepB, voffB); G8_STAGE_A(G8_SA(0, 0), cA, 0, false); G8_STAGE_A(G8_SA(0, 1), cA, 1, false);
    if (wr == 1) G8_BAR;
    G8_WAIT_V(2); G8_BAR;
    G8_STAGE(G8_SB(1, 0), cB + kstep, voffB); G8_STAGE_A(G8_SA(1, 0), cA + kstep, 0, false); G8_STAGE(G8_SB(1, 1), cB + hstepB + kstep, voffB);
    G8_WAIT_V(6); G8_BAR;
    unsigned long long tk_ = 0, te_ = 0, tp_ = tsp ? __builtin_amdgcn_s_memrealtime() : 0;
    for (;;) {
        const bool has_next = S.next(ui + 1, nxt);
        const char* nA = has_next ? nxt.a : cA; const char* nB = has_next ? nxt.b : cB;
        if constexpr (GATHER) { if (has_next) G8_TOK(vGn, nxt.tok); }
#pragma unroll 1
        for (int t = 0; t < nt; t += 2) {
            const bool last = (t == nt - 2);
            if constexpr (Hook::ON) { if (t == seg_t) H(acc, cur, wr, wc, fr, fq); }
            const char* a1 = cA + (size_t)(t + 1) * kstep + (Hook::ON && t + 1 >= seg_t ? segj : 0);
            const char* a2 = last ? nA : cA + (size_t)(t + 2) * kstep + (Hook::ON && t + 2 >= seg_t ? segj : 0); const char* b2 = last ? nB : cB + (size_t)(t + 2) * kstep;
            const char* a3 = a2 + kstep; const char* b3 = b2 + kstep;
            G8_LDB(B0, 0, 0); G8_LDB(B1, 0, 1); G8_SCHED; G8_LDA(At, 0, 0); G8_STAGE_A(G8_SA(1, 1), a1, 1, false);
            G8_WAIT_V(8); G8_WAIT_L(0); G8_BAR; G8_MMA(0, 0, At, B0); G8_MMA(0, 1, At, B1); G8_BAR; G8_SCHED;
            G8_LDA(At, 0, 1); G8_STAGE(G8_SB(0, 0), b2, voffB); G8_STAGE(G8_SB(0, 1), b2 + hstepB, voffB); G8_STAGE_A(G8_SA(0, 0), a2, 0, last);
            G8_WAIT_V(8); G8_WAIT_L(0); G8_BAR; G8_MMA(1, 0, At, B0); G8_MMA(1, 1, At, B1); G8_BAR; G8_SCHED;
            G8_LDB(B0, 1, 0); G8_LDB(B1, 1, 1); G8_SCHED; G8_LDA(At, 1, 0); G8_STAGE_A(G8_SA(0, 1), a2, 1, last);
            G8_WAIT_V(8); G8_WAIT_L(0); G8_BAR; G8_MMA(0, 0, At, B0); G8_MMA(0, 1, At, B1); G8_BAR; G8_SCHED;
            G8_LDA(At, 1, 1); G8_STAGE(G8_SB(1, 0), b3, voffB); G8_STAGE(G8_SB(1, 1), b3 + hstepB, voffB); G8_STAGE_A(G8_SA(1, 0), a3, 0, last);
            G8_WAIT_V(8); G8_WAIT_L(0); G8_BAR; G8_MMA(1, 0, At, B0); G8_MMA(1, 1, At, B1); G8_BAR; G8_SCHED;
        }
        if constexpr (ALIGN_EPI) { if (wr == 0) G8_BAR; }
        if (tsp) { const unsigned long long n_ = __builtin_amdgcn_s_memrealtime(); tk_ += n_ - tp_; tp_ = n_; }
        if constexpr (FP8) asm volatile("s_nop 15\n\ts_nop 15" ::: "memory");
        E(acc, cur, wr, wc, fr, fq);
        if (tsp) { const unsigned long long n_ = __builtin_amdgcn_s_memrealtime(); te_ += n_ - tp_; tp_ = n_; }
        if (!has_next) break;
#pragma unroll
        for (int a = 0; a < 2; ++a)
#pragma unroll
            for (int b = 0; b < 2; ++b)
#pragma unroll
                for (int m = 0; m < 4; ++m)
#pragma unroll
                    for (int n = 0; n < 2; ++n) acc[a][b][m][n] = (f32x4){0.f, 0.f, 0.f, 0.f};
        cur = nxt; cA = nA; cB = nB; ++ui;
        if constexpr (GATHER) { _Pragma("unroll") for (int h_ = 0; h_ < 2; ++h_) _Pragma("unroll") for (int i_ = 0; i_ < 2; ++i_) vG[h_][i_] = vGn[h_][i_]; }
        if constexpr (ALIGN_EPI) { if (wr == 1) G8_BAR; }
    }
    G8_WAIT_V(0);
    if constexpr (!ALIGN_EPI) { if (wr == 0) G8_BAR; }
    G8_BAR;
    if (tsp && blockIdx.x == 0 && threadIdx.x == 0) { tsp[0] = 0; tsp[1] = tk_; tsp[2] = 0; tsp[3] = te_; tsp[4] = 0; tsp[5] = (unsigned long long)(ui + 1) * 100ull; }
#undef G8_SA
#undef G8_SB
#undef G8_STAGE
#undef G8_STAGE_A
#undef G8_TOK
#undef G8_LDA
#undef G8_LDA8
#undef G8_LDB8
#undef G8_LD16
#undef G8_LDB
#undef G8_MMA
#undef G8_WAIT_V
#undef G8_WAIT_L
#undef G8_BAR
#undef G8_SCHED
}
template <class F> struct Epi4 { F f;
    DEVI void operator()(const f32x4 (&acc)[2][2][4][2], const Unit& u, int wr, int wc, int fr, int fq) const {
        constexpr int NB = F::NB;
        asm volatile("" : "+v"(fr), "+v"(fq));
#pragma unroll
        for (int g0 = 0; g0 < 8; g0 += NB) {
            typename F::L ld[NB][2];
#pragma unroll
            for (int gg = 0; gg < NB; ++gg) { const int ai = (g0 + gg) >> 2, m = (g0 + gg) & 3;
#pragma unroll
                for (int bj = 0; bj < 2; ++bj) ld[gg][bj] = f.load(u.pm, u.pn, ai * 128 + wr * 64 + m * 16 + fr, bj * 128 + wc * 32 + 8 * fq); }
#pragma unroll
            for (int gg = 0; gg < NB; ++gg) { const int ai = (g0 + gg) >> 2, m = (g0 + gg) & 3;
#pragma unroll
                for (int bj = 0; bj < 2; ++bj) f.apply(u.pm, u.pn, ai * 128 + wr * 64 + m * 16 + fr, bj * 128 + wc * 32 + 8 * fq, acc[ai][bj][m][0], acc[ai][bj][m][1], ld[gg][bj]); }
            asm volatile("" ::: "memory");
        }
    } };
template <class F> struct Hook4 { static constexpr bool ON = true; F f;
    DEVI void operator()(f32x4 (&acc)[2][2][4][2], const Unit& u, int wr, int wc, int fr, int fq) const {
        constexpr int NB = F::NB;
        asm volatile("" : "+v"(fr), "+v"(fq));
#pragma unroll
        for (int g0 = 0; g0 < 8; g0 += NB) {
            typename F::L ld[NB][2];
#pragma unroll
            for (int gg = 0; gg < NB; ++gg) { const int ai = (g0 + gg) >> 2, m = (g0 + gg) & 3;
#pragma unroll
                for (int bj = 0; bj < 2; ++bj) ld[gg][bj] = f.load(u.pm, u.pn, ai * 128 + wr * 64 + m * 16 + fr, bj * 128 + wc * 32 + 8 * fq); }
#pragma unroll
            for (int gg = 0; gg < NB; ++gg) { const int ai = (g0 + gg) >> 2, m = (g0 + gg) & 3;
#pragma unroll
                for (int bj = 0; bj < 2; ++bj) f.apply(u.pm, u.pn, ai * 128 + wr * 64 + m * 16 + fr, bj * 128 + wc * 32 + 8 * fq, acc[ai][bj][m][0], acc[ai][bj][m][1], ld[gg][bj]); }
            asm volatile("" ::: "memory");
        }
    } };
}

struct NoLd {};
struct LbLd { f32x4 a, b; };
DEVI void store8bf(bf16_t* p, f32x4 a, f32x4 b) { u32x4 w; w.x = pk2(a[0], a[1]); w.y = pk2(a[2], a[3]); w.z = pk2(b[0], b[1]); w.w = pk2(b[2], b[3]); *(u32x4*)p = w; }
struct EpiZa { typedef LbLd L; static constexpr int NB = 1; unsigned char* ws;
    DEVI L load(int, int pn, int, int c) const { L l; l.a = (f32x4){0.f, 0.f, 0.f, 0.f}; l.b = l.a; if ((pn >> 2) == 1) { const float* lp = (const float*)(ws + WS_LBT) + (pn - 4) * 256 + c; l.a = *(const f32x4*)lp; l.b = *(const f32x4*)(lp + 4); } return l; }
    DEVI void apply(int pm, int pn, int r, int c, f32x4 v0, f32x4 v1, const L& lb) const {
        const size_t row = (size_t)pm * 256 + r; const int col = pn * 256 + c; const int kind = pn >> 2;
        if (kind == 3) {
#pragma unroll
            for (int j = 0; j < 4; ++j) { v0[j] = siluf_(v0[j]); v1[j] = siluf_(v1[j]); } }
        if (kind == 0) {
#pragma unroll
            for (int j = 0; j < 4; ++j) { v0[j] = siluf_(v0[j]) * 0.08838834764831845f; v1[j] = siluf_(v1[j]) * 0.08838834764831845f; } }
        else if (kind == 1) {
#pragma unroll
            for (int j = 0; j < 4; ++j) { v0[j] = __logf(lb.a[j] + (1.f - lb.a[j]) * sigmoidf_(v0[j])); v1[j] = __logf(lb.b[j] + (1.f - lb.b[j]) * sigmoidf_(v1[j])); } }
        store8bf((bf16_t*)(ws + WS_ZH) + row * ZH_P + col, v0, v1);
    } };
struct EpiZb { typedef NoLd L; static constexpr int NB = 8; unsigned char* ws;
    DEVI L load(int, int, int, int) const { return {}; }
    DEVI void apply(int pm, int pn, int r, int c, f32x4 v0, f32x4 v1, L) const {
        const size_t row = (size_t)pm * 256 + r; u32x2 w = {0u, 0u};
        if (pn < 3) { store8bf((bf16_t*)(ws + WS_ZL) + row * ZL_P + pn * 256 + c, v0, v1); return; }
#pragma unroll
        for (int j = 0; j < 4; ++j) { w.x |= (unsigned)fmaxf(__builtin_rintf(255.f * sigmoidf_(v0[j])), 1.f) << (8 * j); w.y |= (unsigned)fmaxf(__builtin_rintf(255.f * sigmoidf_(v1[j])), 1.f) << (8 * j); }
        *(u32x2*)(ws + WS_ZG + row * ZG_P + (pn - 3) * 256 + c) = w;
    } };
struct EpiQ { typedef NoLd L; static constexpr int NB = 8; bf16_t* q;
    DEVI L load(int, int, int, int) const { return {}; }
    DEVI void apply(int pm, int pn, int r, int c, f32x4 v0, f32x4 v1, L) const { store8bf(q + ((size_t)pm * 256 + r) * 1536 + pn * 256 + c, v0, v1); } };
struct EpiKV { typedef NoLd L; static constexpr int NB = 8; bf16_t* kn; bf16_t* vv;
    DEVI L load(int, int, int, int) const { return {}; }
    DEVI void apply(int pm, int pn, int r, int c, f32x4 v0, f32x4 v1, L) const {
        const size_t row = (size_t)pm * 256 + r; const int col = pn * 256 + c; const int hh = col >> 8, cc = col & 255;
        if (cc < 128) store8bf(kn + row * 1024 + hh * 128 + cc, v0, v1); else store8bf(vv + row * 1024 + hh * 128 + (cc - 128), v0, v1);
    } };
struct BrHookF { typedef u32x4 L; static constexpr int NB = 1; const unsigned char* zg;
    DEVI L load(int pm, int pn, int r, int c) const { const unsigned char* g = zg + ((size_t)pm * 256 + r) * ZG_P + pn * 256 + c; const u32x2 a = *(const u32x2*)g, b = *(const u32x2*)(g + 1024); return (L){a.x, a.y, b.x, b.y}; }
    DEVI void apply(int, int, int, int, f32x4& v0, f32x4& v1, L l) const {
#pragma unroll
        for (int j = 0; j < 4; ++j) { v0[j] *= (float)((l.x >> (8 * j)) & 255u) * __builtin_amdgcn_rcpf((float)((l.z >> (8 * j)) & 255u)); v1[j] *= (float)((l.y >> (8 * j)) & 255u) * __builtin_amdgcn_rcpf((float)((l.w >> (8 * j)) & 255u)); } } };
struct EpiBr2 { typedef u32x2 L; static constexpr int NB = 2; const unsigned char* zg; bf16_t* y;
    DEVI L load(int pm, int pn, int r, int c) const { return *(const u32x2*)(zg + ((size_t)pm * 256 + r) * ZG_P + 1024 + pn * 256 + c); }
    DEVI void apply(int pm, int pn, int r, int c, f32x4 v0, f32x4 v1, L g) const {
#pragma unroll
        for (int j = 0; j < 4; ++j) { v0[j] *= (float)((g.x >> (8 * j)) & 255u) * (1.f / 255.f); v1[j] *= (float)((g.y >> (8 * j)) & 255u) * (1.f / 255.f); }
        store8bf(y + ((size_t)pm * 256 + r) * 1024 + pn * 256 + c, v0, v1); } };
struct EpiOut { typedef LbLd L; static constexpr int NB = 2; const float* x; bf16_t* x2b; unsigned char* x2f8;
    DEVI L load(int pm, int pn, int r, int c) const { const float* xp = x + ((size_t)pm * 256 + r) * 1024 + pn * 256 + c; L l; l.a = *(const f32x4*)xp; l.b = *(const f32x4*)(xp + 4); return l; }
    DEVI void apply(int pm, int pn, int r, int c, f32x4 v0, f32x4 v1, const L& xv) const { const size_t o = ((size_t)pm * 256 + r) * 1024 + pn * 256 + c; const f32x4 a = xv.a + v0, b = xv.b + v1; store8bf(x2b + o, a, b);
        u32x2 w; w.x = pk4_fp8(4.f * a[0], 4.f * a[1], 4.f * a[2], 4.f * a[3]); w.y = pk4_fp8(4.f * b[0], 4.f * b[1], 4.f * b[2], 4.f * b[3]); *(u32x2*)(x2f8 + o) = w; } };
struct EpiHid8 { unsigned char* hid; const float* srs;
    DEVI void operator()(const f32x4 (&acc)[2][2][4][2], const g8::Unit& u, int wr, int wc, int fr, int fq) const {
        asm volatile("" : "+v"(fr), "+v"(fq));
        float rs[8];
#pragma unroll
        for (int g = 0; g < 8; ++g) rs[g] = srs[(size_t)u.pm * 256 + (g >> 2) * 128 + wr * 64 + (g & 3) * 16 + fr];
#pragma unroll
        for (int g = 0; g < 8; ++g) { const int ai = g >> 2, m = g & 3; unsigned char* hrow = hid + ((size_t)u.pm * 256 + ai * 128 + wr * 64 + m * 16 + fr) * EFF + u.pn * 128 + wc * 16 + 4 * fq;
#pragma unroll
            for (int bj = 0; bj < 2; ++bj) { const f32x4 gg = acc[ai][bj][m][0] * rs[g], uu = acc[ai][bj][m][1] * rs[g]; float h4[4];
#pragma unroll
                for (int i = 0; i < 4; ++i) h4[i] = fminf(fmaxf(8.f * siluf_(gg[i]) * uu[i], -440.f), 440.f);
                *(unsigned*)(hrow + bj * 64) = pk4_fp8(h4[0], h4[1], h4[2], h4[3]); } }
    } };
struct EpiY { typedef float L; static constexpr int NB = 8; unsigned char* yexp; const float* sw;
    DEVI L load(int tile, int, int r, int) const { return sw[(size_t)tile * 256 + r]; }
    DEVI void apply(int tile, int pn, int r, int c, f32x4 v0, f32x4 v1, L w) const { const float ws_ = 16.f * w; u32x2 o;
        o.x = pk4_fp8(fminf(fmaxf(v0[0] * ws_, -440.f), 440.f), fminf(fmaxf(v0[1] * ws_, -440.f), 440.f), fminf(fmaxf(v0[2] * ws_, -440.f), 440.f), fminf(fmaxf(v0[3] * ws_, -440.f), 440.f));
        o.y = pk4_fp8(fminf(fmaxf(v1[0] * ws_, -440.f), 440.f), fminf(fmaxf(v1[1] * ws_, -440.f), 440.f), fminf(fmaxf(v1[2] * ws_, -440.f), 440.f), fminf(fmaxf(v1[3] * ws_, -440.f), 440.f));
        *(u32x2*)(yexp + ((size_t)tile * 256 + r) * 1024 + pn * 256 + c) = o; } };

DEVI void phase0(const Params& p, char* lds) {
    float* scr = (float*)lds; unsigned char* ws = p.ws;
    bf16_t* WinT = (bf16_t*)(ws + WS_WIN); bf16_t* WuqT = (bf16_t*)(ws + WS_WUQ); bf16_t* WukvT = (bf16_t*)(ws + WS_WUKV);
    bf16_t* WbrT = (bf16_t*)(ws + WS_WBR); bf16_t* WoutT = (bf16_t*)(ws + WS_WOUT);
    constexpr int I_IN = (4096 / 64) * 16, I_IN8 = (2816 / 64) * 16, I_UQ = 24 * 6, I_UKV = 32 * 4, I_BR = 16 * 16, I_OUT = 16 * 16;
    constexpr int NIT = I_IN + I_IN8 + I_UQ + I_UKV + 2 * I_BR + I_OUT;
    for (int it = blockIdx.x; it < NIT; it += gridDim.x) {
        int r = it;
        if (r < I_IN) { const int nb = r / 16, kb = r % 16; const float* nw = p.attn_norm_w;
            transpose_tile(p.w_in, 6848, WinT, 1024, kb * 64, nb * 64, [](int n) { return n; }, [nw](int k) { return nw[k]; }, scr); continue; }
        r -= I_IN;
        if (r < I_IN8) { const int nb = r / 16, kb = r % 16; const float* nw = p.attn_norm_w;
            transpose_tile_f8(p.w_in, 6848, ws + WS_WIN8, 1024, kb * 64, nb * 64, [](int n) { return n < 704 ? 4096 + n : (n < 768 ? -1 : 4032 + n); }, [nw](int k) { return nw[k] * 64.f; }, scr); continue; }
        r -= I_IN8;
        if (r < I_UQ) { const int nb = r / 6, kb = r % 6; const float* nw = p.q_norm_w;
            transpose_tile(p.w_uq, 1536, WuqT, 384, kb * 64, nb * 64,
                           [](int n) { const int hh = n / 192, c = n % 192; if (c < 128) return n; const int rr = c - 128; return hh * 192 + 128 + (rr & 1) * 32 + (rr >> 1); },
                           [nw](int k) { return nw[k] * 0.07216878364870322f; }, scr); continue; }
        r -= I_UQ;
        if (r < I_UKV) { const int nb = r / 4, kb = r % 4; const float* nw = p.kv_norm_w;
            transpose_tile(p.w_ukv, 2048, WukvT, 256, kb * 64, nb * 64, [](int n) { return n; }, [nw](int k) { return nw[k]; }, scr); continue; }
        r -= I_UKV;
        if (r < I_BR) { const int nb = r / 16, kb = r % 16;
            transpose_tile(p.w_bra, 1024, WbrT, 2048, kb * 64, nb * 64, [](int n) { return n; }, [](int) { return 1.f; }, scr); continue; }
        r -= I_BR;
        if (r < I_BR) { const int nb = r / 16, kb = r % 16;
            transpose_tile(p.w_brb, 1024, WbrT + 1024, 2048, kb * 64, nb * 64, [](int n) { return n; }, [](int) { return 1.f; }, scr); continue; }
        r -= I_BR;
        { const int nb = r / 16, kb = r % 16;
            transpose_tile(p.w_out, 1024, WoutT, 1024, kb * 64, nb * 64, [](int n) { return n; }, [](int) { return 1.f; }, scr); }
    }
    if (blockIdx.x == 0) { unsigned* cz = (unsigned*)(ws + WS_CTL) + CW_CNT; for (int i = threadIdx.x; i < 64 * CNT_STRIDE; i += NTHR) cz[i] = 0u; }
    if (blockIdx.x == 0 && threadIdx.x == 0) { unsigned long long* tb = (unsigned long long*)(ws + WS_PTRS);
        tb[PT_POS] = (unsigned long long)p.pos; tb[PT_HGLB] = (unsigned long long)p.hg_lb; tb[PT_HGONW] = (unsigned long long)p.hg_onw; tb[PT_RGB] = (unsigned long long)p.rg_b; tb[PT_REB] = (unsigned long long)p.re_b;
        tb[PT_EW1] = (unsigned long long)p.ew1; tb[PT_EW3] = (unsigned long long)p.ew3; tb[PT_EW2] = (unsigned long long)p.ew2; tb[PT_FFNW] = (unsigned long long)p.ffn_norm_w; tb[PT_FINW] = (unsigned long long)p.final_w; tb[PT_X] = (unsigned long long)p.x; }
    bf16_t* WrH = (bf16_t*)(ws + WS_WRT); bf16_t* WrL = WrH + 80 * 1024;
    for (int e = blockIdx.x * NTHR + threadIdx.x; e < 80 * 1024; e += gridDim.x * NTHR) { const int c = e >> 10, k = e & 1023;
        const float w = c < 8 ? p.rg_w[k * 8 + c] * p.ffn_norm_w[k] : (c < 72 ? p.re_w[k * 64 + (c - 8)] * p.ffn_norm_w[k] : 0.f);
        const unsigned hb = f2bf(w); WrH[e] = (bf16_t)hb; WrL[e] = (bf16_t)f2bf(w - bf2f(hb)); }
    { float* lbt = (float*)(ws + WS_LBT); for (int k = blockIdx.x * NTHR + threadIdx.x; k < 1024; k += gridDim.x * NTHR) lbt[k] = 1.f / (1.f + expf(p.hg_lb[1024 + k] - p.hg_lb[k])); }
    bf16_t* H = (bf16_t*)(ws + WS_H);
    const int lane = threadIdx.x & 63, gw = blockIdx.x * 8 + (threadIdx.x >> 6), NGW = gridDim.x * 8;
    for (int m0 = gw * 2; m0 < T; m0 += NGW * 2) {
        f32x4 v[2][4];
#pragma unroll
        for (int r = 0; r < 2; ++r) { const f32x4* xr = (const f32x4*)(p.x + (size_t)(m0 + r) * D) + lane;
#pragma unroll
            for (int j = 0; j < 4; ++j) v[r][j] = xr[64 * j]; }
#pragma unroll
        for (int r = 0; r < 2; ++r) { const int m = m0 + r; float s = 0.f;
#pragma unroll
            for (int j = 0; j < 4; ++j) s += v[r][j][0] * v[r][j][0] + v[r][j][1] * v[r][j][1] + v[r][j][2] * v[r][j][2] + v[r][j][3] * v[r][j][3];
            const float rstd = rsqrtf(wave_sum(s) * (1.f / D) + 1e-6f);
            u32x2* o = (u32x2*)(H + (size_t)m * D) + lane; unsigned* o8 = (unsigned*)(ws + WS_H8 + (size_t)m * D) + lane; const float r4 = 4.f * rstd;
#pragma unroll
            for (int j = 0; j < 4; ++j) { u32x2 w; w.x = pk2(v[r][j][0] * rstd, v[r][j][1] * rstd); w.y = pk2(v[r][j][2] * rstd, v[r][j][3] * rstd); o[64 * j] = w;
                o8[64 * j] = pk4_fp8(v[r][j][0] * r4, v[r][j][1] * r4, v[r][j][2] * r4, v[r][j][3] * r4); } }
    }
}

DEVI void phase1(const Params& p, char* lds) {
    unsigned char* ws = p.ws;
    { g8::DenseOrder S; S.init(ws + WS_H, D, ws + WS_WIN, D, T, 4096); g8::Epi4<EpiZa> E{{ws}};
      g8::gemm_phase<g8::Epi4<EpiZa>, g8::DenseOrder, true>((G8_LAS unsigned char*)lds, D, D, D, S, E); }
    { g8::DenseOrder S; S.init(ws + WS_H8, D / 2, ws + WS_WIN8, D / 2, T, 2816); g8::Epi4<EpiZb> E{{ws}};
      g8::gemm_phase<g8::Epi4<EpiZb>, g8::DenseOrder, true, g8::NoHook, false, true>((G8_LAS unsigned char*)lds, D / 2, D / 2, D / 2, S, E, nullptr, g8::NoHook(), 1 << 30, 0, 125, 121); }
}

constexpr int HL_A = 0, HL_B = 17408, HL_BT = 34816, HL_VT = 53248, HL_AT = 71680, HL_ST = 80896, HL_SEG = 115712, HL_SS = 123904;
#define HG_BAR() do { asm volatile("s_waitcnt lgkmcnt(0)" ::: "memory"); __builtin_amdgcn_s_barrier(); asm volatile("" ::: "memory"); } while (0)
DEVI void hgrn_chain_mfma(const Params& p, char* lds, int b, int h) {
    const bf16_t* zh = (const bf16_t*)(p.ws + WS_ZH); bf16_t* oa = (bf16_t*)(p.ws + WS_OA);
    const float* hgonw = (const float*)ptab(p.ws, PT_HGONW);
    const int tid = threadIdx.x, lane = tid & 63, wid = __builtin_amdgcn_readfirstlane(tid >> 6), fr = lane & 15, g4 = lane >> 4;
    const int k2 = lane * 2, seg = wid;
    f32x4 S[8];
#pragma unroll
    for (int n = 0; n < 8; ++n) S[n] = (f32x4){0.f, 0.f, 0.f, 0.f};
    const bf16_t* zb = zh + (size_t)b * SEQ * ZH_P + h * 128;
    float* lss = (float*)(lds + HL_SS);
    unsigned rq[8], rf[8], rv[8];
#pragma unroll
    for (int i = 0; i < 8; ++i) { const bf16_t* r = zb + (size_t)(seg * 8 + i) * ZH_P + k2; rq[i] = *(const unsigned*)r; rf[i] = *(const unsigned*)(r + 1024); rv[i] = *(const unsigned*)(r + 2048); }
    const int tt = wid >> 1, vh = wid & 1;
    f32x4 nwv[4];
#pragma unroll
    for (int n = 0; n < 4; ++n) nwv[n] = *(const f32x4*)(hgonw + 16 * (4 * vh + n) + 4 * g4);
    u32x2 gpre[4], gnext[4];
    { const bf16_t* gp_ = zh + ((size_t)b * SEQ + 16 * tt + fr) * ZH_P + 3072 + h * 128;
#pragma unroll
      for (int n = 0; n < 4; ++n) { gpre[n] = *(const u32x2*)(gp_ + 16 * (4 * vh + n) + 4 * g4); gnext[n] = gpre[n]; } }
    float cs[8][2], qq[8][2], kk[8][2], run[2]; u32x4 vtw[2];
#define HG_PREP1() do { run[0] = 0.f; run[1] = 0.f; \
        _Pragma("unroll") for (int i = 0; i < 8; ++i) _Pragma("unroll") for (int e = 0; e < 2; ++e) { const float lf = bf2f(e ? rf[i] >> 16 : rf[i] & 0xffffu); run[e] += lf; cs[i][e] = run[e]; kk[i][e] = 1.f - __expf(lf); qq[i][e] = bf2f(e ? rq[i] >> 16 : rq[i] & 0xffffu); } \
        _Pragma("unroll") for (int e = 0; e < 2; ++e) { \
            vtw[e].x = e ? (rv[0] >> 16) | (rv[1] & 0xffff0000u) : (rv[0] & 0xffffu) | (rv[1] << 16); vtw[e].y = e ? (rv[2] >> 16) | (rv[3] & 0xffff0000u) : (rv[2] & 0xffffu) | (rv[3] << 16); \
            vtw[e].z = e ? (rv[4] >> 16) | (rv[5] & 0xffff0000u) : (rv[4] & 0xffffu) | (rv[5] << 16); vtw[e].w = e ? (rv[6] >> 16) | (rv[7] & 0xffff0000u) : (rv[6] & 0xffffu) | (rv[7] << 16); } } while (0)
    HG_PREP1();
#if defined(TPROBE_A)
    unsigned long long tacc[6] = {0, 0, 0, 0, 0, 0}; unsigned long long tprev = __builtin_amdgcn_s_memrealtime();
#define HG_T(k) do { const unsigned long long now_ = __builtin_amdgcn_s_memrealtime(); tacc[k] += now_ - tprev; tprev = now_; } while (0)
#else
#define HG_T(k)
#endif
#pragma unroll 1
    for (int c = 0; c < SEQ / 64; ++c) {
        const int t0 = c * 64; float* segs = (float*)(lds + HL_SEG) + (c & 1) * 1024;
        HG_T(0);
        *(float2*)(segs + seg * 128 + k2) = make_float2(run[0], run[1]);
        HG_BAR();
        HG_T(1);
#pragma unroll
        for (int e = 0; e < 2; ++e) *(u32x4*)(lds + HL_VT + (k2 + e) * 144 + seg * 16) = vtw[e];
        {
            float off[2] = {0.f, 0.f}, bm[2] = {0.f, 0.f};
#pragma unroll
            for (int s_ = 0; s_ < 8; ++s_) { const float2 v = *(const float2*)(segs + s_ * 128 + k2); if (s_ < seg) { off[0] += v.x; off[1] += v.y; } if (s_ < 4) { bm[0] += v.x; bm[1] += v.y; } }
            unsigned bt[2][4];
#pragma unroll
            for (int i = 0; i < 8; ++i) { float av[2], bv[2];
#pragma unroll
                for (int e = 0; e < 2; ++e) { const float ea = __expf(cs[i][e] + off[e] - bm[e]); av[e] = qq[i][e] * ea; bv[e] = kk[i][e] * __builtin_amdgcn_rcpf(ea); }
                *(unsigned*)(lds + HL_A + (seg * 8 + i) * 272 + k2 * 2) = pk2(av[0], av[1]);
                const unsigned pb = pk2(bv[0], bv[1]); *(unsigned*)(lds + HL_B + (seg * 8 + i) * 272 + k2 * 2) = pb;
                if (i & 1) { bt[0][i >> 1] |= pb << 16; bt[1][i >> 1] |= pb & 0xffff0000u; } else { bt[0][i >> 1] = pb & 0xffffu; bt[1][i >> 1] = pb >> 16; } }
#pragma unroll
            for (int e = 0; e < 2; ++e) { u32x4 w = {bt[e][0], bt[e][1], bt[e][2], bt[e][3]}; *(u32x4*)(lds + HL_BT + (k2 + e) * 144 + seg * 16) = w; }
        }
        f32x4 bmid = {0.f, 0.f, 0.f, 0.f}, blast = {0.f, 0.f, 0.f, 0.f};
#pragma unroll
        for (int s_ = 0; s_ < 8; ++s_) { const f32x4 v = *(const f32x4*)(segs + s_ * 128 + 16 * wid + 4 * g4); blast += v; if (s_ < 4) bmid += v; }
        {
            f32x4 em; em[0] = __expf(bmid[0]); em[1] = __expf(bmid[1]); em[2] = __expf(bmid[2]); em[3] = __expf(bmid[3]);
#pragma unroll
            for (int n = 0; n < 8; ++n) { u32x2 w; w.x = pk2(S[n][0] * em[0], S[n][1] * em[1]); w.y = pk2(S[n][2] * em[2], S[n][3] * em[3]); *(u32x2*)(lds + HL_ST + (16 * n + fr) * 272 + (16 * wid + 4 * g4) * 2) = w; }
        }
        {
            const int tn = (c + 1 < SEQ / 64) ? t0 + 64 : t0;
#pragma unroll
            for (int i = 0; i < 8; ++i) { const bf16_t* r = zb + (size_t)(tn + seg * 8 + i) * ZH_P + k2; rq[i] = *(const unsigned*)r; rf[i] = *(const unsigned*)(r + 1024); rv[i] = *(const unsigned*)(r + 2048); }
            const bf16_t* gp_ = zh + ((size_t)b * SEQ + tn + 16 * tt + fr) * ZH_P + 3072 + h * 128;
#pragma unroll
            for (int n = 0; n < 4; ++n) gnext[n] = *(const u32x2*)(gp_ + 16 * (4 * vh + n) + 4 * g4);
        }
        HG_BAR();
        HG_T(2);
#define HG_LD(off) (*(const bf16x8*)(lds + (off)))
#define HG_FENCE() do { asm volatile("s_waitcnt lgkmcnt(0)" ::: "memory"); __builtin_amdgcn_sched_barrier(0); } while (0)
        {
            bf16x8 fa[4], fb0[4], fb1[4]; const int ss0 = 2 * vh, ss1 = 2 * vh + 1;
#pragma unroll
            for (int kk4 = 0; kk4 < 4; ++kk4) { fa[kk4] = HG_LD(HL_A + (16 * tt + fr) * 272 + (32 * kk4 + 8 * g4) * 2); fb0[kk4] = HG_LD(HL_B + (16 * ss0 + fr) * 272 + (32 * kk4 + 8 * g4) * 2); fb1[kk4] = HG_LD(HL_B + (16 * ss1 + fr) * 272 + (32 * kk4 + 8 * g4) * 2); }
            HG_FENCE();
            f32x4 acc0 = {0.f, 0.f, 0.f, 0.f}, acc1 = {0.f, 0.f, 0.f, 0.f};
#pragma unroll
            for (int kk4 = 0; kk4 < 4; ++kk4) { acc0 = __builtin_amdgcn_mfma_f32_16x16x32_bf16(fb0[kk4], fa[kk4], acc0, 0, 0, 0); acc1 = __builtin_amdgcn_mfma_f32_16x16x32_bf16(fb1[kk4], fa[kk4], acc1, 0, 0, 0); }
#pragma unroll
            for (int i = 0; i < 4; ++i) { if (ss0 > tt || (ss0 == tt && 4 * g4 + i > fr)) acc0[i] = 0.f; if (ss1 > tt || (ss1 == tt && 4 * g4 + i > fr)) acc1[i] = 0.f; }
            u32x2 w; w.x = pk2(acc0[0], acc0[1]); w.y = pk2(acc0[2], acc0[3]); *(u32x2*)(lds + HL_AT + (16 * tt + fr) * 144 + (16 * ss0 + 4 * g4) * 2) = w;
            w.x = pk2(acc1[0], acc1[1]); w.y = pk2(acc1[2], acc1[3]); *(u32x2*)(lds + HL_AT + (16 * tt + fr) * 144 + (16 * ss1 + 4 * g4) * 2) = w;
        }
        HG_BAR();
        HG_T(3);
        f32x4 o[4];
#pragma unroll
        for (int n = 0; n < 4; ++n) o[n] = (f32x4){0.f, 0.f, 0.f, 0.f};
        {
            bf16x8 fat[2], fa[4];
#pragma unroll
            for (int ks = 0; ks < 2; ++ks) fat[ks] = HG_LD(HL_AT + (16 * tt + fr) * 144 + (32 * ks + 8 * g4) * 2);
#pragma unroll
            for (int kk4 = 0; kk4 < 4; ++kk4) fa[kk4] = HG_LD(HL_A + (16 * tt + fr) * 272 + (32 * kk4 + 8 * g4) * 2);
#pragma unroll
            for (int nh = 0; nh < 2; ++nh) {
                bf16x8 fv[2][2], fs[2][4];
#pragma unroll
                for (int n2 = 0; n2 < 2; ++n2) { const int vrow = 16 * (4 * vh + 2 * nh + n2) + fr;
#pragma unroll
                    for (int ks = 0; ks < 2; ++ks) fv[n2][ks] = HG_LD(HL_VT + vrow * 144 + (32 * ks + 8 * g4) * 2);
#pragma unroll
                    for (int kk4 = 0; kk4 < 4; ++kk4) fs[n2][kk4] = HG_LD(HL_ST + vrow * 272 + (32 * kk4 + 8 * g4) * 2); }
                HG_FENCE();
#pragma unroll
                for (int ks = 0; ks < 2; ++ks)
#pragma unroll
                    for (int n2 = 0; n2 < 2; ++n2) o[2 * nh + n2] = __builtin_amdgcn_mfma_f32_16x16x32_bf16(fv[n2][ks], fat[ks], o[2 * nh + n2], 0, 0, 0);
#pragma unroll
                for (int kk4 = 0; kk4 < 4; ++kk4)
#pragma unroll
                    for (int n2 = 0; n2 < 2; ++n2) o[2 * nh + n2] = __builtin_amdgcn_mfma_f32_16x16x32_bf16(fs[n2][kk4], fa[kk4], o[2 * nh + n2], 0, 0, 0);
            }
        }
        { float ssq = 0.f;
#pragma unroll
          for (int n = 0; n < 4; ++n) ssq += o[n][0] * o[n][0] + o[n][1] * o[n][1] + o[n][2] * o[n][2] + o[n][3] * o[n][3];
          ssq += __shfl_xor(ssq, 16); ssq += __shfl_xor(ssq, 32); if (g4 == 0) lss[vh * 64 + 16 * tt + fr] = ssq; }
        {
            f32x4 U[8]; bf16x8 fbt[2], fv[8][2];
#pragma unroll
            for (int ks = 0; ks < 2; ++ks) { fbt[ks] = HG_LD(HL_BT + (16 * wid + fr) * 144 + (32 * ks + 8 * g4) * 2);
#pragma unroll
                for (int n = 0; n < 8; ++n) fv[n][ks] = HG_LD(HL_VT + (16 * n + fr) * 144 + (32 * ks + 8 * g4) * 2); }
            HG_FENCE();
#pragma unroll
            for (int n = 0; n < 8; ++n) { U[n] = __builtin_amdgcn_mfma_f32_16x16x32_bf16(fbt[0], fv[n][0], (f32x4){0.f, 0.f, 0.f, 0.f}, 0, 0, 0); }
#pragma unroll
            for (int n = 0; n < 8; ++n) { U[n] = __builtin_amdgcn_mfma_f32_16x16x32_bf16(fbt[1], fv[n][1], U[n], 0, 0, 0); }
            f32x4 el, elm;
#pragma unroll
            for (int i = 0; i < 4; ++i) { el[i] = __expf(blast[i]); elm[i] = __expf(blast[i] - bmid[i]); }
#pragma unroll
            for (int n = 0; n < 8; ++n) S[n] = S[n] * el + U[n] * elm;
        }
#undef HG_LD
#undef HG_FENCE
        HG_BAR();
        HG_T(4);
        {
#pragma unroll
            for (int i = 0; i < 8; ++i) asm volatile("" : "+v"(rq[i]), "+v"(rf[i]), "+v"(rv[i]));
            HG_PREP1(); }
        {
            const int t = 16 * tt + fr; const float rstd = rsqrtf((lss[t] + lss[64 + t]) * (1.f / 128.f) + 1e-6f);
            const size_t trow = (size_t)b * SEQ + t0 + t; bf16_t* op = oa + trow * 1024 + h * 128;
#pragma unroll
            for (int n = 0; n < 4; ++n) { const int v0 = 16 * (4 * vh + n) + 4 * g4; const u32x2 gg = gpre[n]; const f32x4 nw = nwv[n];
                f32x4 r; r[0] = o[n][0] * rstd * nw[0] * bf2f(gg.x & 0xffffu); r[1] = o[n][1] * rstd * nw[1] * bf2f(gg.x >> 16);
                r[2] = o[n][2] * rstd * nw[2] * bf2f(gg.y & 0xffffu); r[3] = o[n][3] * rstd * nw[3] * bf2f(gg.y >> 16); store4bf(op + v0, r); }
        }
#pragma unroll
        for (int n = 0; n < 4; ++n) gpre[n] = gnext[n];
        HG_T(5);
    }
#undef HG_PREP1
#if defined(TPROBE_A)
    if (blockIdx.x == 0 && threadIdx.x == 0) { unsigned long long* ts = (unsigned long long*)(p.ws + WS_TS); for (int k = 0; k < 6; ++k) { ts[20 + 2 * k] = 0; ts[21 + 2 * k] = tacc[k]; } }
#endif
    HG_BAR();
}
#undef HG_BAR
DEVI void conv_tile256(const float* colp, size_t rs, const float* kscale, bf16_t* dst, int ldk, float* scr) {
    const int tid = threadIdx.x;
    { const int nl = tid & 63, kq = tid >> 6;
      float v[32];
#pragma unroll
      for (int i = 0; i < 32; ++i) v[i] = colp[(size_t)(kq * 32 + i) * rs];
      if (kscale) {
#pragma unroll
          for (int i = 0; i < 32; ++i) v[i] *= kscale[kq * 32 + i]; }
#pragma unroll
      for (int i = 0; i < 32; ++i) scr[(kq * 32 + i) * 65 + nl] = v[i]; }
    __syncthreads();
    { const int nl = tid >> 3, kc = tid & 7;
#pragma unroll
      for (int j = 0; j < 4; ++j) { const float* s_ = scr + (kc * 8 + 64 * j) * 65 + nl;
          u32x4 o; o.x = pk2(s_[0], s_[65]); o.y = pk2(s_[2 * 65], s_[3 * 65]); o.z = pk2(s_[4 * 65], s_[5 * 65]); o.w = pk2(s_[6 * 65], s_[7 * 65]);
          *(u32x4*)(dst + (size_t)nl * ldk + kc * 8 + 64 * j) = o; } }
    __syncthreads();
}
DEVI void conv_tile256_f8(const float* colp4, size_t rs, const float* kscale, float wscale, unsigned char* dst, int ldk, float* scr) {
    const int tid = threadIdx.x;
    { const int n4 = tid & 15, kr = tid >> 4; f32x4 v[8];
#pragma unroll
      for (int i = 0; i < 8; ++i) v[i] = *(const f32x4*)(colp4 + (size_t)(kr + 32 * i) * rs);
#pragma unroll
      for (int i = 0; i < 8; ++i) { const float sc = kscale ? kscale[kr + 32 * i] * wscale : wscale; float* d = scr + (kr + 32 * i) * 65 + 4 * n4; d[0] = v[i][0] * sc; d[1] = v[i][1] * sc; d[2] = v[i][2] * sc; d[3] = v[i][3] * sc; } }
    __syncthreads();
    { const int nl = tid >> 3, kc = tid & 7;
#pragma unroll
      for (int j = 0; j < 4; ++j) { const float* s_ = scr + (kc * 8 + 64 * j) * 65 + nl;
          u32x2 o; o.x = pk4_fp8(s_[0], s_[65], s_[2 * 65], s_[3 * 65]); o.y = pk4_fp8(s_[4 * 65], s_[5 * 65], s_[6 * 65], s_[7 * 65]);
          *(u32x2*)(dst + (size_t)nl * ldk + kc * 8 + 64 * j) = o; } }
    __syncthreads();
}
struct ConvDesc { const float* colp4; size_t rs; const float* kscale; unsigned char* dst; int ldk; };
template <class DescF>
DEVI void conv_stream_f8(int first, int end, int stride, float wscale, float* scr, DescF desc) {
    const int tid = threadIdx.x, n4 = tid & 15, kr = tid >> 4, nl = tid >> 3, kc = tid & 7;
    f32x4 v[8];
    if (first < end) { const ConvDesc d = desc(first);
#pragma unroll
        for (int i = 0; i < 8; ++i) v[i] = *(const f32x4*)(d.colp4 + (size_t)(kr + 32 * i) * d.rs); }
#pragma unroll 1
    for (int ci = first; ci < end; ci += stride) {
        const ConvDesc d = desc(ci);
#pragma unroll
        for (int i = 0; i < 8; ++i) { const float sc = d.kscale ? d.kscale[kr + 32 * i] * wscale : wscale; float* q = scr + (kr + 32 * i) * 65 + 4 * n4; q[0] = v[i][0] * sc; q[1] = v[i][1] * sc; q[2] = v[i][2] * sc; q[3] = v[i][3] * sc; }
        __syncthreads();
        if (ci + stride < end) { const ConvDesc dn = desc(ci + stride);
#pragma unroll
            for (int i = 0; i < 8; ++i) v[i] = *(const f32x4*)(dn.colp4 + (size_t)(kr + 32 * i) * dn.rs); }
#pragma unroll
        for (int j = 0; j < 4; ++j) { const float* s_ = scr + (kc * 8 + 64 * j) * 65 + nl;
            u32x2 o; o.x = pk4_fp8(s_[0], s_[65], s_[2 * 65], s_[3 * 65]); o.y = pk4_fp8(s_[4 * 65], s_[5 * 65], s_[6 * 65], s_[7 * 65]);
            *(u32x2*)(d.dst + (size_t)nl * d.ldk + kc * 8 + 64 * j) = o; }
        __syncthreads();
    }
}
DEVI void mla_prep(const Params& p, int chunk) {
    bf16_t* zl = (bf16_t*)(p.ws + WS_ZL); float* cosT = (float*)(p.ws + WS_COS); float* sinT = (float*)(p.ws + WS_SIN); const int* posp = (const int*)ptab(p.ws, PT_POS);
    const int lane = threadIdx.x & 63, wid = threadIdx.x >> 6;
    for (int rr = wid; rr < 256; rr += 8) { const size_t t = (size_t)chunk * 256 + rr; bf16_t* zr = zl + t * ZL_P;
        float cq[6], ck[4]; float s = 0.f, s2 = 0.f;
#pragma unroll
        for (int j = 0; j < 6; ++j) { cq[j] = bf2f(zr[lane + 64 * j]); s += cq[j] * cq[j]; }
#pragma unroll
        for (int j = 0; j < 4; ++j) { ck[j] = bf2f(zr[384 + lane + 64 * j]); s2 += ck[j] * ck[j]; }
        const float kr = bf2f(zr[640 + lane]);
        const float r1 = rsqrtf(wave_sum(s) * (1.f / 384.f) + 1e-6f), r2 = rsqrtf(wave_sum(s2) * (1.f / 256.f) + 1e-6f);
        const float other = __shfl_xor(kr, 32);
        const int i = lane & 31; const float invf = powf(10000.f, -(float)i / 32.f); const float ang = (float)posp[t] * invf; const float cs = cosf(ang), sn = sinf(ang);
        const float x1 = lane < 32 ? kr : other, x2 = lane < 32 ? other : kr;
        const float outv = lane < 32 ? (x1 * cs - x2 * sn) : (x2 * cs + x1 * sn);
#pragma unroll
        for (int j = 0; j < 6; ++j) zr[lane + 64 * j] = (bf16_t)f2bf(cq[j] * r1);
#pragma unroll
        for (int j = 0; j < 4; ++j) zr[384 + lane + 64 * j] = (bf16_t)f2bf(ck[j] * r2);
        ((bf16_t*)(p.ws + WS_KPE))[t * 64 + 2 * i + (lane >> 5)] = (bf16_t)f2bf(outv);
        if (lane < 32) { cosT[t * 32 + i] = cs; sinT[t * 32 + i] = sn; }
    }
}
constexpr int N13_EARLY = 4096;
DEVI void w13_tile(unsigned char* ws, const float* ew1, const float* ew3, const float* ffnw, int ci, int nl, float* scr) {
    const int e = ci >> 6, r = ci & 63, nb = r >> 2, kb = r & 3, n = nb * 64 + 4 * (nl & 15);
    const float* colp = ((n & 4) ? ew3 : ew1) + (size_t)e * 1024 * 512 + (size_t)(kb * 256) * 512 + (n >> 3) * 4;
    conv_tile256_f8(colp, 512, ffnw + kb * 256, 64.f, ws + WS_W13 + ((size_t)e * 1024 + nb * 64) * 1024 + kb * 256, 1024, scr);
}
DEVI ConvDesc w13_desc(unsigned char* ws, const float* ew1, const float* ew3, const float* ffnw, int ci) {
    const int e = ci >> 6, r = ci & 63, nb = r >> 2, kb = r & 3, n = nb * 64 + 4 * ((int)threadIdx.x & 15);
    return {((n & 4) ? ew3 : ew1) + (size_t)e * 1024 * 512 + (size_t)(kb * 256) * 512 + (n >> 3) * 4, 512, ffnw + kb * 256, ws + WS_W13 + ((size_t)e * 1024 + nb * 64) * 1024 + kb * 256, 1024};
}
DEVI ConvDesc w2_desc(unsigned char* ws, const float* ew2, int ci) {
    const int e = ci >> 5, r = ci & 31, nb = r >> 1, kb = r & 1;
    return {ew2 + (size_t)e * 512 * 1024 + (size_t)(kb * 256) * 1024 + nb * 64 + 4 * ((int)threadIdx.x & 15), 1024, nullptr, ws + WS_W2 + ((size_t)e * 1024 + nb * 64) * EFF + kb * 256, EFF};
}
DEVI void phase2a(const Params& p, char* lds, bool prep = true) {
#pragma unroll 1
    for (int it = blockIdx.x; it < 128; it += gridDim.x) {
        hgrn_chain_mfma(p, lds, it >> 3, it & 7);
#if defined(TPROBE_A)
        if (TPROBE_A == 12 && blockIdx.x == 0 && threadIdx.x == 0) ((unsigned long long*)(p.ws + WS_TS))[13] = __builtin_amdgcn_s_memrealtime();
#endif
    }
#pragma unroll 1
    for (int it = blockIdx.x; it < 256; it += gridDim.x) { if (it < 128) continue;
#if defined(TPROBE_A)
        unsigned long long tq0_ = __builtin_amdgcn_s_memrealtime();
#endif
        if (prep) mla_prep(p, it - 128);
#if defined(TPROBE_A)
        if (blockIdx.x == 128 && threadIdx.x == 0) { const unsigned long long n_ = __builtin_amdgcn_s_memrealtime(); unsigned long long* ts = (unsigned long long*)(p.ws + WS_TS); ts[60] = 0; ts[61] = n_ - tq0_; tq0_ = n_; }
#endif
        const float* ew1 = (const float*)ptab(p.ws, PT_EW1); const float* ew3 = (const float*)ptab(p.ws, PT_EW3); const float* ffnw = (const float*)ptab(p.ws, PT_FFNW);
        __syncthreads();
        { unsigned char* ws_ = p.ws; conv_stream_f8(it - 128, N13_EARLY, 128, 64.f, (float*)lds, [=](int ci) { return w13_desc(ws_, ew1, ew3, ffnw, ci); }); }
#if defined(TPROBE_A)
        if (blockIdx.x == 128 && threadIdx.x == 0) { const unsigned long long n_ = __builtin_amdgcn_s_memrealtime(); unsigned long long* ts = (unsigned long long*)(p.ws + WS_TS); ts[62] = 0; ts[63] = n_ - tq0_; }
#endif
    }
}

DEVI void phase2b(const Params& p, char* lds) {
    unsigned char* ws = p.ws;
    { g8::DenseOrder S; S.init(ws + WS_ZL, ZL_P, ws + WS_WUQ, 384, T, 1536);
      g8::Epi4<EpiQ> E{{(bf16_t*)(ws + WS_Q)}};
      g8::gemm_phase<g8::Epi4<EpiQ>, g8::DenseOrder, true>((G8_LAS unsigned char*)lds, ZL_P, 384, 384, S, E); }
    { g8::DenseOrder S; S.init(ws + WS_ZL + 384 * 2, ZL_P, ws + WS_WUKV, 256, T, 2048);
      g8::Epi4<EpiKV> E{{(bf16_t*)(ws + WS_KN), (bf16_t*)(ws + WS_V)}};
      g8::gemm_phase<g8::Epi4<EpiKV>, g8::DenseOrder, true>((G8_LAS unsigned char*)lds, ZL_P, 256, 256, S, E); }
}

namespace at2 {
typedef short s16x4 __attribute__((ext_vector_type(4)));
typedef float f32x16 __attribute__((ext_vector_type(16)));
constexpr int KROW = 384;
constexpr int SHM_K = 64 * KROW, SHM_V = 64 * 256;
constexpr int L_V = 0, L_K = 3 * SHM_V, L_WS = 3 * SHM_V + 2 * SHM_K;
constexpr float THR = 8.f;
#define AT_KSWZ(row, colB) ((row) * at2::KROW + ((colB) ^ (((row) & 7) << 4)))
DEVI int v_st(int k, int c) { const int kk = (k & ~0xC) | ((k & 4) << 1) | ((k & 8) >> 1); return ((kk >> 3) * 4 + (c >> 5)) * 512 + ((kk & 7) * 32 + (c & 31)) * 2; }
DEVI int v_rd_base(int lane) { return ((lane & 3) << 3) | (((lane >> 2) & 3) << 6) | (((lane >> 4) & 1) << 5) | (((lane >> 5) & 1) << 8); }
constexpr int v_rd_off(int d0, int ks, int half) { return d0 * 512 + ks * 4096 + half * 2048; }
DEVI int crow(int r, int hi) { return (r & 3) + 8 * (r >> 2) + 4 * hi; }
DEVI unsigned cvtpk(float lo, float hi) { unsigned r; asm volatile("v_cvt_pk_bf16_f32 %0, %1, %2" : "=v"(r) : "v"(lo), "v"(hi)); return r; }
DEVI void mask_tile(f32x16& p0, f32x16& p1, int dq) {
    const float NEG = -__builtin_inff();
#pragma unroll
    for (int r = 0; r < 16; ++r) { const int c = (r & 3) + 8 * (r >> 2); if (dq - c < 0) p0[r] = NEG; if (dq - c - 32 < 0) p1[r] = NEG; }
}
DEVI void partialSM(f32x16& p0, f32x16& p1, float& m_reg, float& mn, float& alpha) {
    float pmax = p0[0];
#pragma unroll
    for (int r = 1; r < 16; ++r) pmax = fmaxf(pmax, p0[r]);
#pragma unroll
    for (int r = 0; r < 16; ++r) pmax = fmaxf(pmax, p1[r]);
    { auto rr = __builtin_amdgcn_permlane32_swap(__float_as_uint(pmax), __float_as_uint(pmax), false, false); pmax = fmaxf(__uint_as_float(rr[0]), __uint_as_float(rr[1])); }
    constexpr float C2 = 1.4426950408889634f;
    if (__builtin_expect(__all((pmax - m_reg) <= THR), 1)) { mn = m_reg; alpha = 1.f; }
    else { mn = fmaxf(m_reg, pmax); alpha = __builtin_amdgcn_exp2f((m_reg - mn) * C2); m_reg = mn; }
    const float mnL = -mn * C2;
#pragma unroll
    for (int r = 0; r < 16; ++r) p0[r] = fmaf(p0[r], C2, mnL);
#pragma unroll
    for (int r = 0; r < 16; ++r) p1[r] = fmaf(p1[r], C2, mnL);
#pragma unroll
    for (int r = 0; r < 16; ++r) p0[r] = __builtin_amdgcn_exp2f(p0[r]);
}
DEVI void finishSM(f32x16& p0, f32x16& p1, float alpha, float& l_reg, bf16x8& pa0, bf16x8& pa1, bf16x8& pa2, bf16x8& pa3) {
#pragma unroll
    for (int r = 0; r < 16; ++r) p1[r] = __builtin_amdgcn_exp2f(p1[r]);
    float ps = 0;
#pragma unroll
    for (int r = 0; r < 16; ++r) ps += p0[r];
#pragma unroll
    for (int r = 0; r < 16; ++r) ps += p1[r];
    { auto rr = __builtin_amdgcn_permlane32_swap(__float_as_uint(ps), __float_as_uint(ps), false, false); ps = __uint_as_float(rr[0]) + __uint_as_float(rr[1]); }
    l_reg = l_reg * alpha + ps;
#define AT_PK4(P, B_, OUT) do { unsigned a0 = cvtpk(P[B_+0], P[B_+1]), a1 = cvtpk(P[B_+2], P[B_+3]); unsigned b0 = cvtpk(P[B_+4], P[B_+5]), b1 = cvtpk(P[B_+6], P[B_+7]); \
        auto r0 = __builtin_amdgcn_permlane32_swap(a0, b0, false, false); auto r1 = __builtin_amdgcn_permlane32_swap(a1, b1, false, false); \
        u32x4 w = {r0[0], r1[0], r0[1], r1[1]}; OUT = *reinterpret_cast<bf16x8*>(&w); } while (0)
    AT_PK4(p0, 0, pa0); AT_PK4(p0, 8, pa1); AT_PK4(p1, 0, pa2); AT_PK4(p1, 8, pa3);
#undef AT_PK4
}
template <int KB>
DEVI void qkt(f32x16& p0, f32x16& p1, const char* K_lds, int r32, int hi, const bf16x8* qr) {
    p0 = f32x16{}; p1 = f32x16{};
    const char* kb[4];
#pragma unroll
    for (int dd = 0; dd < 4; ++dd) kb[dd] = K_lds + KB * SHM_K + AT_KSWZ(r32, (dd * 16 + hi * 8) * 2);
#pragma unroll
    for (int d0 = 0; d0 < 12; ++d0) { const char* a = kb[d0 & 3] + (d0 >> 2) * 128;
        const bf16x8 b0 = *reinterpret_cast<const bf16x8*>(a); const bf16x8 b1 = *reinterpret_cast<const bf16x8*>(a + 32 * KROW);
        p0 = __builtin_amdgcn_mfma_f32_32x32x16_bf16(b0, qr[d0], p0, 0, 0, 0); p1 = __builtin_amdgcn_mfma_f32_32x32x16_bf16(b1, qr[d0], p1, 0, 0, 0); }
}
DEVI void pv_tile(f32x16* o, int vb0, bf16x8 pa0, bf16x8 pa1, bf16x8 pa2, bf16x8 pa3) {
#define AT_TRRD(dst, off) asm volatile("ds_read_b64_tr_b16 %0, %1 offset:%2" : "=&v"(dst) : "v"(vb0), "i"(off) : "memory")
#define AT_PV_D0(d0) do { s16x4 l0, l1, l2, l3, h0, h1, h2, h3; constexpr int b_ = v_rd_off(d0, 0, 0); \
        AT_TRRD(l0, b_); AT_TRRD(h0, b_ + 2048); AT_TRRD(l1, b_ + 4096); AT_TRRD(h1, b_ + 6144); AT_TRRD(l2, b_ + 8192); AT_TRRD(h2, b_ + 10240); AT_TRRD(l3, b_ + 12288); AT_TRRD(h3, b_ + 14336); \
        asm volatile("s_waitcnt lgkmcnt(0)" ::: "memory"); __builtin_amdgcn_sched_barrier(0); \
        o[d0] = __builtin_amdgcn_mfma_f32_32x32x16_bf16(pa0, (bf16x8){l0[0], l0[1], l0[2], l0[3], h0[0], h0[1], h0[2], h0[3]}, o[d0], 0, 0, 0); \
        o[d0] = __builtin_amdgcn_mfma_f32_32x32x16_bf16(pa1, (bf16x8){l1[0], l1[1], l1[2], l1[3], h1[0], h1[1], h1[2], h1[3]}, o[d0], 0, 0, 0); \
        o[d0] = __builtin_amdgcn_mfma_f32_32x32x16_bf16(pa2, (bf16x8){l2[0], l2[1], l2[2], l2[3], h2[0], h2[1], h2[2], h2[3]}, o[d0], 0, 0, 0); \
        o[d0] = __builtin_amdgcn_mfma_f32_32x32x16_bf16(pa3, (bf16x8){l3[0], l3[1], l3[2], l3[3], h3[0], h3[1], h3[2], h3[3]}, o[d0], 0, 0, 0); } while (0)
    AT_PV_D0(0); AT_PV_D0(1); AT_PV_D0(2); AT_PV_D0(3);
#undef AT_PV_D0
#undef AT_TRRD
}
DEVI void block(const Params& p, char* lds, int b, int h, int qb) {
    const bf16_t* q = (const bf16_t*)(p.ws + WS_Q); const bf16_t* kn = (const bf16_t*)(p.ws + WS_KN); const bf16_t* vg = (const bf16_t*)(p.ws + WS_V);
    const bf16_t* kpe = (const bf16_t*)(p.ws + WS_KPE); bf16_t* ob = (bf16_t*)(p.ws + WS_OB);
    const int tid = threadIdx.x, wid = __builtin_amdgcn_readfirstlane(tid >> 6), lane = tid & 63, r32 = lane & 31, hi = lane >> 5;
    const size_t tb = (size_t)b * SEQ; const int P0 = qb * 256, NT = (P0 + 256) / 64;
    char* V_lds = lds + L_V; char* K_lds = lds + L_K; float* ws = (float*)(lds + L_WS) + wid * 64; float* li_l = ws; float* al_l = ws + 32;
    const int qlo = P0 + wid * 32, qm = qlo + r32 - 4 * hi;
    const int sr = tid >> 4, sc = (tid & 15) * 8, vst0 = v_st(sr, sc), vst1 = v_st(32 + sr, sc);
    const int kd0 = AT_KSWZ(sr, sc * 2), kd2 = AT_KSWZ(tid >> 3, 256 + (tid & 7) * 16);
    int tido = tid; asm volatile("" : "+v"(tido));
    const int sro = tido >> 4, sco = (tido & 15) * 8;
    const bf16_t* knp = kn + (tb + sro) * 1024 + h * 128 + sco; const bf16_t* vp = vg + (tb + sro) * 1024 + h * 128 + sco; const bf16_t* kpp = kpe + (tb + (tido >> 3)) * 64 + (tido & 7) * 8;
    const int vb0 = (int)(uintptr_t)V_lds + v_rd_base(lane);
    bf16x8 stk[3], stv[2];
#define AT_LOAD(t_) do { const size_t o_ = (size_t)(t_) * 64; stk[0] = *(const bf16x8*)(knp + o_ * 1024); stk[1] = *(const bf16x8*)(knp + (o_ + 32) * 1024); stk[2] = *(const bf16x8*)(kpp + o_ * 64); \
        stv[0] = *(const bf16x8*)(vp + o_ * 1024); stv[1] = *(const bf16x8*)(vp + (o_ + 32) * 1024); } while (0)
#define AT_WRITE(bf, voff) do { *(bf16x8*)(K_lds + (bf) * SHM_K + kd0) = stk[0]; *(bf16x8*)(K_lds + (bf) * SHM_K + kd0 + 32 * KROW) = stk[1]; *(bf16x8*)(K_lds + (bf) * SHM_K + kd2) = stk[2]; \
        *(bf16x8*)(V_lds + (voff) + vst0) = stv[0]; *(bf16x8*)(V_lds + (voff) + vst1) = stv[1]; } while (0)
    AT_LOAD(0);
    bf16x8 qr[12];
    { const bf16_t* qrow = q + (tb + qlo + r32) * 1536 + h * 192;
#pragma unroll
      for (int d0 = 0; d0 < 12; ++d0) qr[d0] = *(const bf16x8*)(qrow + d0 * 16 + hi * 8);
      int r32o = r32; asm volatile("" : "+v"(r32o));
      const float* cosT = (const float*)(p.ws + WS_COS) + (tb + qlo + r32o) * 32; const float* sinT = cosT + (WS_SIN - WS_COS) / 4;
#pragma unroll
      for (int d0 = 8; d0 < 12; ++d0) { const f32x4 cs = *(const f32x4*)(cosT + 8 * (d0 - 8) + 4 * hi), sn = *(const f32x4*)(sinT + 8 * (d0 - 8) + 4 * hi); u32x4 w = __builtin_bit_cast(u32x4, qr[d0]);
#pragma unroll
          for (int jj = 0; jj < 4; ++jj) { const float x1 = bf2f(w[jj] & 0xffffu), x2 = bf2f(w[jj] >> 16); w[jj] = pk2(x1 * cs[jj] - x2 * sn[jj], x2 * cs[jj] + x1 * sn[jj]); }
          qr[d0] = __builtin_bit_cast(bf16x8, w); asm volatile("" ::: "memory"); } }
    float m_reg = -1e30f, l_reg = 0.f; f32x16 o[4] = {};
    __syncthreads();
    AT_WRITE(0, 0);
    __syncthreads();
    const bool skew = wid >= 4; int vprev = 2 * SHM_V, vcur = 0, vnext = SHM_V; bf16x8 pp0, pp1, pp2, pp3;
#define AT_RESC(a) do { if (__any((a) < 1.f)) { if (hi == 0) al_l[r32] = (a); asm volatile("s_waitcnt lgkmcnt(0)" ::: "memory"); \
        _Pragma("unroll") for (int d_ = 0; d_ < 4; ++d_) _Pragma("unroll") for (int r = 0; r < 16; ++r) o[d_][r] *= al_l[crow(r, hi)]; } } while (0)
#define AT_STEP(t_, BF) do { const int tq = (t_); if (tq + 1 < NT) AT_LOAD(tq + 1); \
        if (skew && tq > 0 && (tq - 1) * 64 <= qlo + 31) pv_tile(o, vb0 + vprev, pp0, pp1, pp2, pp3); \
        if (tq * 64 <= qlo + 31) { f32x16 p0, p1; float mn, al; \
          qkt<BF>(p0, p1, K_lds, r32, hi, qr); \
          { const int kb_ = tq * 64; if (kb_ + 63 > qlo) mask_tile(p0, p1, qm - kb_); } \
          partialSM(p0, p1, m_reg, mn, al); finishSM(p0, p1, al, l_reg, pp0, pp1, pp2, pp3); AT_RESC(al); } \
        if (!skew && tq * 64 <= qlo + 31) pv_tile(o, vb0 + vcur, pp0, pp1, pp2, pp3); \
        if (tq + 1 < NT) AT_WRITE(1 - BF, vnext); \
        vprev = vcur; vcur = vnext; vnext = (vnext == 2 * SHM_V) ? 0 : vnext + SHM_V; \
        __syncthreads(); } while (0)
#pragma unroll 1
    for (int t = 0; t < NT; t += 2) { AT_STEP(t, 0); AT_STEP(t + 1, 1); }
    if (skew && (NT - 1) * 64 <= qlo + 31) pv_tile(o, vb0 + vprev, pp0, pp1, pp2, pp3);
    if (hi == 0) li_l[r32] = l_reg;
    asm volatile("s_waitcnt lgkmcnt(0)" ::: "memory");
    float rli[16];
#pragma unroll
    for (int r = 0; r < 16; ++r) rli[r] = __builtin_amdgcn_rcpf(li_l[crow(r, hi)]);
    bf16_t* Ow = ob + (tb + qlo) * 1024 + h * 128;
#pragma unroll
    for (int r = 0; r < 16; ++r) { const int orow = crow(r, hi);
#pragma unroll
        for (int d0 = 0; d0 < 4; ++d0) { const float v = o[d0][r] * rli[r]; const float vn = __shfl_xor(v, 1);
            if ((r32 & 1) == 0) *(unsigned*)(Ow + (size_t)orow * 1024 + d0 * 32 + r32) = cvtpk(v, vn); } }
#undef AT_LOAD
#undef AT_WRITE
#undef AT_RESC
#undef AT_STEP
}
}
DEVI void phase3(const Params& p, char* lds) {
    const int G_ = (int)gridDim.x, vcu = (G_ % 8 == 0) ? ((int)blockIdx.x % 8) * (G_ / 8) + (int)blockIdx.x / 8 : (int)blockIdx.x;
#pragma unroll 1
    for (int it2 = vcu * 2; it2 < 1024; it2 += (it2 & 1) ? 2 * G_ - 1 : 1) { const int it = it2 >> 1, bh = it >> 2, x = it & 3;
        at2::block(p, lds, bh >> 3, bh & 7, (it2 & 1) ? x : 7 - x); }
    __syncthreads();
}

DEVI void phase4(const Params& p, char* lds) {
    unsigned char* ws = p.ws; const unsigned char* zg = ws + WS_ZG;
    g8::DenseOrder S; S.init(ws + WS_OA, 1024, ws + WS_WBR, 2048, T, 1024);
    g8::Epi4<EpiBr2> E{{zg, (bf16_t*)(ws + WS_Y)}}; g8::Hook4<BrHookF> H{{zg}};
    g8::gemm_phase<g8::Epi4<EpiBr2>, g8::DenseOrder, true, g8::Hook4<BrHookF>>((G8_LAS unsigned char*)lds, 1024, 2048, 2048, S, E, nullptr, H, 16, (long)WS_OB - (long)WS_OA - 16 * 128);
}
DEVI void phase5(const Params& p, char* lds) {
    unsigned char* ws = p.ws;
    g8::DenseOrder S; S.init(ws + WS_Y, 1024, ws + WS_WOUT, 1024, T, 1024);
    g8::Epi4<EpiOut> E{{(const float*)ptab(ws, PT_X), (bf16_t*)(ws + WS_X2B), ws + WS_X2F8}};
#if defined(TPROBE_A) && defined(TPROBE_GEMM) && TPROBE_GEMM == 6
    g8::gemm_phase<g8::Epi4<EpiOut>, g8::DenseOrder, true>((G8_LAS unsigned char*)lds, 1024, 1024, 1024, S, E, (unsigned long long*)(ws + WS_TS) + 20);
#else
    g8::gemm_phase<g8::Epi4<EpiOut>, g8::DenseOrder, true>((G8_LAS unsigned char*)lds, 1024, 1024, 1024, S, E);
#endif
}

constexpr size_t RT_SRS = RT_ST, RT_RS = 1888 * 1024;
DEVI void phase6a(const Params& p, char* lds, bool router = true) {
    unsigned char* ws = p.ws; float* scr = (float*)lds;
    const float* ew1 = (const float*)ptab(ws, PT_EW1); const float* ew3 = (const float*)ptab(ws, PT_EW3); const float* ew2 = (const float*)ptab(ws, PT_EW2); const float* ffnw = (const float*)ptab(ws, PT_FFNW);
    const float* rgb = (const float*)ptab(ws, PT_RGB); const float* reb = (const float*)ptab(ws, PT_REB);
    unsigned char* W2 = ws + WS_W2;
    conv_stream_f8(N13_EARLY + (int)blockIdx.x, NEXP * 64, (int)gridDim.x, 64.f, scr, [=](int ci) { return w13_desc(ws, ew1, ew3, ffnw, ci); });
    conv_stream_f8((int)blockIdx.x, NEXP * 32, (int)gridDim.x, 64.f, scr, [=](int ci) { return w2_desc(ws, ew2, ci); });
    __syncthreads();
#if defined(TPROBE_A)
    if (TPROBE_A == 17 && blockIdx.x == 0 && threadIdx.x == 0) ((unsigned long long*)(p.ws + WS_TS))[13] = __builtin_amdgcn_s_memrealtime();
#endif
    if (!router) return;
    const bf16_t* WrH = (const bf16_t*)(ws + WS_WRT); const bf16_t* WrL = WrH + 80 * 1024; const bf16_t* X2B = (const bf16_t*)(ws + WS_X2B);
    int* AE = (int*)(ws + WS_ROUTE + RT_AE); int* AP = (int*)(ws + WS_ROUTE + RT_AP); float* AW = (float*)(ws + WS_ROUTE + RT_AW); float* RS = (float*)(ws + WS_ROUTE + RT_RS);
    unsigned* cnt = (unsigned*)(ws + WS_CTL) + CW_CNT;
    const int tid = threadIdx.x, lane = tid & 63, wid = tid >> 6, fr = lane & 15, g4 = lane >> 4;
    constexpr int WL_ROW = 528, WL_ARR = 80 * WL_ROW, WL_BYTES = 2 * WL_ARR;
    float* lgw = (float*)(lds + WL_BYTES) + wid * (16 * 84 + 16);
    for (int g0 = blockIdx.x * 8; g0 < T / 16; g0 += gridDim.x * 8) {
        const int grp = g0 + wid;
        const size_t t0 = (size_t)grp * 16; const bf16_t* xrow = X2B + (t0 + fr) * 1024 + 8 * g4;
        f32x4 acc[5]; float ssq = 0.f;
#pragma unroll
        for (int n = 0; n < 5; ++n) acc[n] = (f32x4){0.f, 0.f, 0.f, 0.f};
#pragma unroll 1
        for (int kq = 0; kq < 4; ++kq) {
            bf16x8 xa[8];
#pragma unroll
            for (int kk = 0; kk < 8; ++kk) xa[kk] = *(const bf16x8*)(xrow + kq * 256 + 32 * kk);
            __syncthreads();
#pragma unroll
            for (int j = 0; j < 5; ++j) { const int row = (tid >> 5) + 16 * j, ch = tid & 31; const size_t so = (size_t)row * 1024 + kq * 256 + ch * 8; const int dof = row * WL_ROW + ch * 16;
                *(u32x4*)(lds + dof) = *(const u32x4*)(WrH + so); *(u32x4*)(lds + WL_ARR + dof) = *(const u32x4*)(WrL + so); }
            __syncthreads();
#pragma unroll
            for (int kk = 0; kk < 8; ++kk) {
                const bf16x8 ah = xa[kk];
#pragma unroll
                for (int j = 0; j < 8; ++j) { const float xv = bf2f((unsigned)(unsigned short)ah[j]); ssq += xv * xv; }
#pragma unroll
                for (int n = 0; n < 5; ++n) { const bf16x8 bh = *(const bf16x8*)(lds + (16 * n + fr) * WL_ROW + (32 * kk + 8 * g4) * 2), bl = *(const bf16x8*)(lds + WL_ARR + (16 * n + fr) * WL_ROW + (32 * kk + 8 * g4) * 2);
                    acc[n] = __builtin_amdgcn_mfma_f32_16x16x32_bf16(ah, bh, acc[n], 0, 0, 0); acc[n] = __builtin_amdgcn_mfma_f32_16x16x32_bf16(ah, bl, acc[n], 0, 0, 0); }
            }
        }
        ssq += __shfl_xor(ssq, 16); ssq += __shfl_xor(ssq, 32);
        const float rstd = rsqrtf(ssq * (1.f / D) + 1e-6f);
        if (g4 == 0) lgw[16 * 84 + fr] = rstd;
#pragma unroll
        for (int n = 0; n < 5; ++n)
#pragma unroll
            for (int i = 0; i < 4; ++i) lgw[(4 * g4 + i) * 84 + 16 * n + fr] = acc[n][i];
        asm volatile("s_waitcnt lgkmcnt(0)" ::: "memory");
        int ea = 0, eb = 0;
        if (lane < 16) { const float* lg = lgw + lane * 84; const float rs = lgw[16 * 84 + lane]; const size_t t = t0 + lane;
            int g = 0; float glv[8]; glv[0] = lg[0] * rs + rgb[0]; float gbest = glv[0];
#pragma unroll
            for (int j = 1; j < 8; ++j) { glv[j] = lg[j] * rs + rgb[j]; if (glv[j] > gbest) { gbest = glv[j]; g = j; } }
            float gs = 0.f;
#pragma unroll
            for (int j = 0; j < 8; ++j) gs += expf(glv[j] - gbest);
            const float gwt = 1.f / gs;
            int e1 = 0, e2 = 0; float b1 = -__builtin_inff(), b2 = -__builtin_inff();
            for (int j = 0; j < 8; ++j) { const float v = lg[8 + g * 8 + j] * rs + reb[g * 8 + j];
                if (v > b1) { b2 = b1; e2 = e1; b1 = v; e1 = j; } else if (v > b2) { b2 = v; e2 = j; } }
            const float d = expf(b2 - b1); const float w1 = 1.f / (1.f + d), w2 = d / (1.f + d);
            ea = g * 8 + e1; eb = g * 8 + e2;
            AE[2 * t] = ea; AE[2 * t + 1] = eb; AW[2 * t] = gwt * w1; AW[2 * t + 1] = gwt * w2; RS[t] = rs;
        }
        int* lcnt = (int*)(lds + WL_BYTES + 8 * (16 * 84 + 16) * 4); int* lbase = lcnt + 64;
        __syncthreads();
        if (tid < 64) lcnt[tid] = 0;
        __syncthreads();
        int ra = 0, rb = 0;
        if (lane < 16) { ra = atomicAdd(lcnt + ea, 1); rb = atomicAdd(lcnt + eb, 1); }
        __syncthreads();
        if (tid < 64) { const int c = lcnt[tid]; lbase[tid] = c ? (int)atomicAdd(cnt + tid * CNT_STRIDE, (unsigned)c) : 0; }
        __syncthreads();
        if (lane < 16) { const size_t t = t0 + lane; AP[2 * t] = lbase[ea] + ra; AP[2 * t + 1] = lbase[eb] + rb; }
    }
}
DEVI int build_prefix(const Params& p, int* li) {
    const unsigned* cnt = (const unsigned*)(p.ws + WS_CTL) + CW_CNT;
    __syncthreads();
    if (threadIdx.x < NEXP) li[400 + threadIdx.x] = (int)cnt[threadIdx.x * CNT_STRIDE];
    __syncthreads();
    if (threadIdx.x == 0) { int acc = 0; for (int e = 0; e < NEXP; ++e) { li[e] = acc; const int c = li[400 + e]; const int pd = (c + 255) & ~255; for (int tt = acc / 256; tt < (acc + pd) / 256; ++tt) li[80 + tt] = e; acc += pd; } li[64] = acc; }
    __syncthreads();
    return li[64] / 256;
}
DEVI void phase6b(const Params& p, char* lds) {
    unsigned char* ws = p.ws; int* li = (int*)lds; build_prefix(p, li);
    const int* AE = (const int*)(ws + WS_ROUTE + RT_AE); const int* AP = (const int*)(ws + WS_ROUTE + RT_AP); const float* AW = (const float*)(ws + WS_ROUTE + RT_AW);
    int* AS = (int*)(ws + WS_ROUTE + RT_AS); float* SW = (float*)(ws + WS_ROUTE + RT_SW); float* SRS = (float*)(ws + WS_ROUTE + RT_SRS); const float* RS = (const float*)(ws + WS_ROUTE + RT_RS);
    int* TOK = (int*)(ws + WS_TOK);
    for (int a = blockIdx.x * NTHR + threadIdx.x; a < 2 * T; a += gridDim.x * NTHR) { const int slot = li[AE[a]] + AP[a]; AS[a] = slot; SW[slot] = AW[a]; SRS[slot] = RS[a >> 1]; TOK[slot] = a >> 1; }
    for (int e = blockIdx.x; e < NEXP; e += gridDim.x) { const int c = li[400 + e], pd = (c + 255) & ~255;
        for (int s_ = c + threadIdx.x; s_ < pd; s_ += NTHR) { const int slot = li[e] + s_; SW[slot] = 0.f; SRS[slot] = 0.f; TOK[slot] = 0; } }
}
struct MoeOrder { const char* A; const char* W; size_t a_tile, w_exp, w_pn; const int* tile_e; int nunits; const int* tok;
    DEVI bool next(int i, g8::Unit& u) const { const int G = (int)gridDim.x, bx = (int)blockIdx.x; const int L = (G % 8 == 0) ? (i * 8 + (bx & 7)) * (G >> 3) + (bx >> 3) : i * G + bx;
        if (L >= nunits) return false; const int tile = L >> 2, pn = L & 3, e = tile_e[tile];
        u.pm = tile; u.pn = pn; u.a = A + (size_t)tile * a_tile; u.b = W + (size_t)e * w_exp + (size_t)pn * w_pn; u.tok = tok ? tok + tile * 256 : nullptr; return true; } };
constexpr int LDS_LI = 132096;
DEVI void phase7a(const Params& p, char* lds) {
    unsigned char* ws = p.ws; int* li = (int*)(lds + LDS_LI); const int ntile = build_prefix(p, li);
    MoeOrder S{(const char*)(ws + WS_X2F8), (const char*)(ws + WS_W13), (size_t)0, (size_t)1024 * 1024, (size_t)256 * 1024, li + 80, ntile * 4, (const int*)(ws + WS_TOK)};
    EpiHid8 E{ws + WS_HID, (const float*)(ws + WS_ROUTE + RT_SRS)};
    g8::gemm_phase<EpiHid8, MoeOrder, true, g8::NoHook, true, true>((G8_LAS unsigned char*)lds, 512, 512, 512, S, E, nullptr, g8::NoHook(), 1 << 30, 0, 125, 121);
}
DEVI void phase7b(const Params& p, char* lds) {
    unsigned char* ws = p.ws; int* li = (int*)(lds + LDS_LI); const int ntile = build_prefix(p, li);
    MoeOrder S{(const char*)(ws + WS_HID), (const char*)(ws + WS_W2), (size_t)256 * EFF, (size_t)1024 * EFF, (size_t)256 * EFF, li + 80, ntile * 4, nullptr};
    g8::Epi4<EpiY> E{{ws + WS_YEXP, (const float*)(ws + WS_ROUTE + RT_SW)}};
    g8::gemm_phase<g8::Epi4<EpiY>, MoeOrder, true, g8::NoHook, false, true>((G8_LAS unsigned char*)lds, EFF / 2, EFF / 2, EFF / 2, S, E, nullptr, g8::NoHook(), 1 << 30, 0, 124, 121);
}
DEVI void phase8(const Params& p) {
    unsigned char* ws = p.ws; const int* AS = (const int*)(ws + WS_ROUTE + RT_AS); const unsigned char* yexp = ws + WS_YEXP; const bf16_t* x2b = (const bf16_t*)(ws + WS_X2B); const f32x4* finw = (const f32x4*)ptab(ws, PT_FINW);
    const int lane = threadIdx.x & 63, gw = blockIdx.x * 8 + (threadIdx.x >> 6), NGW = gridDim.x * 8;
    f32x4 fw[4];
#pragma unroll
    for (int j = 0; j < 4; ++j) fw[j] = finw[lane + 64 * j];
    constexpr int RPI = 4;
    int4 sl[2]; sl[0] = *(const int4*)(AS + 2 * (size_t)gw * RPI); sl[1] = *(const int4*)(AS + 2 * (size_t)gw * RPI + 4);
    for (int t0 = gw * RPI; t0 < T; t0 += NGW * RPI) {
        u32x2 xv[RPI][4]; unsigned ya[RPI][4], yb[RPI][4];
#pragma unroll
        for (int r = 0; r < RPI; ++r) { const u32x2* xr = (const u32x2*)(x2b + (size_t)(t0 + r) * D) + lane; const int4 q = sl[r >> 1]; const int s0 = (r & 1) ? q.z : q.x, s1 = (r & 1) ? q.w : q.y;
            const unsigned* y0 = (const unsigned*)(yexp + (size_t)s0 * 1024) + lane; const unsigned* y1 = (const unsigned*)(yexp + (size_t)s1 * 1024) + lane;
#pragma unroll
            for (int j = 0; j < 4; ++j) { xv[r][j] = xr[64 * j]; ya[r][j] = y0[64 * j]; yb[r][j] = y1[64 * j]; } }
        if (t0 + NGW * RPI < T) { sl[0] = *(const int4*)(AS + 2 * (size_t)(t0 + NGW * RPI)); sl[1] = *(const int4*)(AS + 2 * (size_t)(t0 + NGW * RPI) + 4); }
#pragma unroll
        for (int r = 0; r < RPI; ++r) { const int t = t0 + r; float s = 0.f; f32x4 v[4];
#pragma unroll
            for (int j = 0; j < 4; ++j) { const u32x2 xw = xv[r][j]; const unsigned a = ya[r][j], b = yb[r][j];
                const f32x2_t a01 = __builtin_amdgcn_cvt_pk_f32_fp8((int)a, false), a23 = __builtin_amdgcn_cvt_pk_f32_fp8((int)a, true), b01 = __builtin_amdgcn_cvt_pk_f32_fp8((int)b, false), b23 = __builtin_amdgcn_cvt_pk_f32_fp8((int)b, true);
                v[j][0] = (bf2f(xw.x & 0xffffu) + a01[0] * 0.0625f) + b01[0] * 0.0625f; v[j][1] = (bf2f(xw.x >> 16) + a01[1] * 0.0625f) + b01[1] * 0.0625f;
                v[j][2] = (bf2f(xw.y & 0xffffu) + a23[0] * 0.0625f) + b23[0] * 0.0625f; v[j][3] = (bf2f(xw.y >> 16) + a23[1] * 0.0625f) + b23[1] * 0.0625f;
                s += v[j][0] * v[j][0] + v[j][1] * v[j][1] + v[j][2] * v[j][2] + v[j][3] * v[j][3]; }
            const float rstd = rsqrtf(wave_sum(s) * (1.f / D) + 1e-6f);
            f32x4* xo = (f32x4*)(p.out + (size_t)t * D) + lane;
#pragma unroll
            for (int j = 0; j < 4; ++j) { f32x4 ov = v[j] * rstd * fw[j];
#if defined(TPROBE_A)
                { const unsigned long long* ts = (const unsigned long long*)(ws + WS_TS);
                  if (t < 16) { const float ta = (float)((((TPROBE_A >= 20 ? ts[TPROBE_A + 1] - ts[TPROBE_A] : TPROBE_A >= 12 ? ts[13] - ts[TPROBE_A - 10] : ts[TPROBE_A + 1] - ts[TPROBE_A])) / 800ull) * 8ull); const float dl = 0.045254834f * sqrtf(ta); ov[0] += dl; ov[1] += dl; ov[2] += dl; ov[3] += dl; }
                  if (t == 16 && lane == 0 && j == 0) { const float tb = (float)(((ts[TPROBE_B + 1] - ts[TPROBE_B]) / 800ull) * 8ull); ov[0] += 2.f + tb * (1.f / 200.f); } }
#endif
                xo[64 * j] = ov; }
        }
    }
}

#define XB_LAS __attribute__((address_space(3)))
constexpr int LDS_XB = 147200;
#define XB_TMO      128
#define XB_XCNT(j)  (256  + 64 * (j))
#define XB_XSUB(j)  (1280 + 64 * (j))
#define XB_XGEN(j)  (2304 + 64 * (j))
#define XB_TOP      3328
#define XB_TOPGEN   3392
#define XCD_BAR_WORDS 3456
#define XB_SPIN_CAP (1u << 18)

__device__ __forceinline__ unsigned xb_ld(unsigned* p)              { return __hip_atomic_load(p, __ATOMIC_RELAXED, __HIP_MEMORY_SCOPE_AGENT); }
__device__ __forceinline__ unsigned xb_add(unsigned* p, unsigned v) { return __hip_atomic_fetch_add(p, v, __ATOMIC_RELAXED, __HIP_MEMORY_SCOPE_AGENT); }
__device__ __forceinline__ unsigned xb_xcc_id() { return (unsigned)__builtin_amdgcn_s_getreg((3 << 11) | 20) & 0xFu; }
#define XB_SPIN(cond, bar) do { unsigned _sp = 0; while (cond) { __builtin_amdgcn_s_sleep(1); \
    if ((++_sp & 255u) == 0u) { if (xb_ld(&(bar)[XB_TMO])) break; if (_sp > XB_SPIN_CAP) { atomicAdd(&(bar)[XB_TMO], 1u); break; } } } } while (0)

__device__ unsigned g_epoch;
__device__ unsigned g_xbar[2 * XCD_BAR_WORDS];
struct XcdBarrier {
    unsigned x;
    volatile XB_LAS unsigned* st;
};

__device__ __forceinline__ XcdBarrier xcd_barrier_post(volatile XB_LAS unsigned* st) {
    XcdBarrier b; b.x = xb_xcc_id(); b.st = st;
    if (threadIdx.x == 0) { const unsigned set = xb_ld(&g_epoch) & 1u; st[0] = 0u; st[1] = 0u; st[2] = set; (void)xb_add(&g_xbar[set * XCD_BAR_WORDS + XB_XCNT(b.x)], 1u); }
    return b;
}
__device__ __forceinline__ void xcd_barrier_retire(const XcdBarrier& b) {
    unsigned* o = g_xbar + (b.st[2] ^ 1u) * XCD_BAR_WORDS;
    for (int i = threadIdx.x; i < XCD_BAR_WORDS; i += blockDim.x) o[i] = 0u;
    if (threadIdx.x == 0) (void)xb_add(&g_epoch, 1u);
}
__device__ __forceinline__ void xcd_barrier_complete(unsigned* bar, unsigned x, unsigned& nloc, unsigned& nx) {
    const unsigned G = gridDim.x * gridDim.y * gridDim.z;
    unsigned sum, cnt, mine, sp = 0u;
    for (;;) {
        sum = 0u; cnt = 0u; mine = 0u;
#pragma unroll
        for (unsigned j = 0; j < 16; ++j) { const unsigned c = xb_ld(&bar[XB_XCNT(j)]); sum += c; cnt += (c > 0u) ? 1u : 0u; mine = (j == x) ? c : mine; }
        if (sum == G) break;
        __builtin_amdgcn_s_sleep(1);
        if ((++sp & 255u) == 0u) { if (xb_ld(&bar[XB_TMO])) break; if (sp > XB_SPIN_CAP) { atomicAdd(&bar[XB_TMO], 1u); break; } }
    }
    nloc = mine > 0u ? mine : 1u; nx = cnt > 0u ? cnt : 1u;
}

__device__ __forceinline__ void xcd_barrier(const XcdBarrier& b) {
    asm volatile("s_waitcnt vmcnt(0)" ::: "memory");
    __syncthreads();
    if (threadIdx.x == 0) {
        unsigned* bar = g_xbar + b.st[2] * XCD_BAR_WORDS;
        __builtin_amdgcn_s_waitcnt(0);
        unsigned nloc = b.st[0], nx = b.st[1];
        if (nloc == 0u) { xcd_barrier_complete(bar, b.x, nloc, nx); b.st[0] = nloc; b.st[1] = nx; }
        const unsigned old = xb_add(&bar[XB_XSUB(b.x)], 1u);
        const unsigned gen = old / nloc;
        if (old + 1u == (gen + 1u) * nloc) {
            __builtin_amdgcn_fence(__ATOMIC_RELEASE, "agent");
            asm volatile("s_waitcnt vmcnt(0)" ::: "memory");
            const unsigned og = xb_add(&bar[XB_TOP], 1u);
            const unsigned tg = og / nx;
            if (og + 1u == (tg + 1u) * nx) xb_add(&bar[XB_TOPGEN], 1u);
            else XB_SPIN(xb_ld(&bar[XB_TOPGEN]) == tg, bar);
            __builtin_amdgcn_fence(__ATOMIC_ACQUIRE, "agent");
            xb_add(&bar[XB_XGEN(b.x)], 1u);
            asm volatile("s_waitcnt vmcnt(0)" ::: "memory");
        } else {
            XB_SPIN(xb_ld(&bar[XB_XGEN(b.x)]) == gen, bar);
            __builtin_amdgcn_fence(__ATOMIC_ACQUIRE, "agent");
            asm volatile("s_waitcnt vmcnt(0)" ::: "memory");
        }
    }
    __syncthreads();
}


constexpr int NPHASE = 12;
constexpr int LDS_BYTES = 147456;
#if defined(TPROBE_A)
#define STAMP(k) if (blockIdx.x == 0 && threadIdx.x == 0) ((unsigned long long*)(p.ws + WS_TS))[(k)] = __builtin_amdgcn_s_memrealtime();
#else
#define STAMP(k)
#endif
__global__ void __launch_bounds__(NTHR, 2) mega(Params p) {
    extern __shared__ __attribute__((aligned(16))) char lds[];
    cg::grid_group grid = cg::this_grid();
    const int lo = p.ph_lo, hi = p.ph_hi;
    const XcdBarrier xbar = xcd_barrier_post((volatile XB_LAS unsigned*)((XB_LAS unsigned char*)lds + LDS_XB));
    if (p.ph_hi < 0) grid.sync();
#define SEAM(k) xcd_barrier(xbar)
    STAMP(0)
#ifndef DUP_PH
#define DUP_PH -1
#endif
#ifdef ONLY_PH
#define PH(k, call) if constexpr ((k) == ONLY_PH) { if (lo <= (k) && (k) < hi) { const int rep_ = 0; call; if ((k) + 1 < hi) SEAM(k); } }
#else
#define PH(k, call) if (lo <= (k) && (k) < hi) { if constexpr ((k) == DUP_PH) { _Pragma("unroll 1") for (int rep_ = 0; rep_ < 3; ++rep_) { __syncthreads(); call; } } else { const int rep_ = 0; call; } if ((k) + 1 < hi) SEAM(k); STAMP((k) + 1) }
#endif
    PH(0, phase0(p, lds))
    PH(1, phase1(p, lds))
    PH(2, phase2a(p, lds, rep_ == 0))
    PH(3, phase2b(p, lds))
    PH(4, phase3(p, lds))
    PH(5, phase4(p, lds))
    PH(6, phase5(p, lds))
    PH(7, phase6a(p, lds, rep_ == 0))
    PH(8, phase6b(p, lds))
    PH(9, phase7a(p, lds))
    PH(10, phase7b(p, lds))
    if (lo == 0 && hi == NPHASE && blockIdx.x == 0) xcd_barrier_retire(xbar);
    PH(11, phase8(p))
#undef PH
}

extern "C" void kernel_launch(void* const* d_in, const int* in_sizes, int n_in, void* d_out, int out_size, void* d_ws, size_t ws_size, hipStream_t stream) {
    static int grid = 0;
    if (grid == 0) {
        if (n_in != 22 || out_size != T * D || ws_size < WS_END) { fprintf(stderr, "kernel_launch: unexpected shapes (n_in %d out %d ws %zu, need ws >= %zu)\n", n_in, out_size, ws_size, (size_t)WS_END); grid = -1; return; }
        int dev = 0, cus = 0, per_cu = 0; hipGetDevice(&dev); hipDeviceGetAttribute(&cus, hipDeviceAttributeMultiprocessorCount, dev);
        hipFuncSetAttribute((const void*)mega, hipFuncAttributeMaxDynamicSharedMemorySize, LDS_BYTES);
        hipOccupancyMaxActiveBlocksPerMultiprocessor(&per_cu, (const void*)mega, NTHR, LDS_BYTES);
        if (per_cu < 1) { fprintf(stderr, "kernel_launch: occupancy query says %d blocks per CU\n", per_cu); per_cu = 1; }
        grid = cus * per_cu; (void)hipGetLastError();
    }
    if (grid < 0) return;
#if MK_MULTI
    hipMemsetAsync((char*)d_ws + WS_CTL, 0, 65536, stream);
#endif
    Params p{};
    p.x = (const float*)d_in[0]; p.pos = (const int*)d_in[1]; p.attn_norm_w = (const float*)d_in[2]; p.w_in = (const float*)d_in[3]; p.hg_lb = (const float*)d_in[4];
    p.hg_onw = (const float*)d_in[5]; p.q_norm_w = (const float*)d_in[6]; p.w_uq = (const float*)d_in[7]; p.kv_norm_w = (const float*)d_in[8]; p.w_ukv = (const float*)d_in[9];
    p.w_bra = (const float*)d_in[10]; p.w_brb = (const float*)d_in[11]; p.w_out = (const float*)d_in[12]; p.ffn_norm_w = (const float*)d_in[13]; p.rg_w = (const float*)d_in[14];
    p.rg_b = (const float*)d_in[15]; p.re_w = (const float*)d_in[16]; p.re_b = (const float*)d_in[17]; p.ew1 = (const float*)d_in[18]; p.ew3 = (const float*)d_in[19];
    p.ew2 = (const float*)d_in[20]; p.final_w = (const float*)d_in[21]; p.out = (float*)d_out; p.ws = (unsigned char*)d_ws;
#if MK_MULTI
    for (int ph = 0; ph < NPHASE; ++ph) { p.ph_lo = ph; p.ph_hi = ph + 1; hipLaunchKernelGGL(mega, dim3(grid), dim3(NTHR), LDS_BYTES, stream, p); }
#else
    p.ph_lo = 0; p.ph_hi = NPHASE;
    void* args[] = {&p};
    hipError_t e = hipLaunchCooperativeKernel((const void*)mega, dim3(grid), dim3(NTHR), args, LDS_BYTES, stream);
    if (e != hipSuccess) fprintf(stderr, "cooperative launch failed: %s (grid %d)\n", hipGetErrorString(e), grid);
#endif
}
```

```cpp
#include <hip/hip_runtime.h>
#include <hip/hip_cooperative_groups.h>
#include <cstdio>
#include <cstdint>
namespace cg = cooperative_groups;

#ifndef MK_MULTI
#define MK_MULTI 0
#endif

#define DEVI __device__ __forceinline__
typedef unsigned short bf16_t;
typedef short bf16x8 __attribute__((ext_vector_type(8)));
typedef float f32x4 __attribute__((ext_vector_type(4)));
typedef unsigned u32x4 __attribute__((ext_vector_type(4)));
typedef unsigned u32x2 __attribute__((ext_vector_type(2)));

constexpr int NB = 16, SEQ = 2048, T = NB * SEQ, D = 1024;
constexpr int NTHR = 512;
constexpr int NK8 = 2, NK16 = 4 - NK8;
constexpr int ZH_P = 4096, ZL_P = 768, ZG_P = 2048;
constexpr int NZ = 6912;
constexpr int NEXP = 64, EFF = 512;
constexpr int SLOT_CAP = 2 * T + NEXP * 256;
constexpr int MAX_TILES = SLOT_CAP / 256;

constexpr size_t MiB = 1u << 20;
constexpr size_t WS_CTL = 0;
constexpr size_t WS_WRT = 1 * MiB;
constexpr size_t WS_LBT = 1 * MiB + 512 * 1024;
constexpr size_t WS_WIN = 2 * MiB;
constexpr size_t WS_WUQ = 16 * MiB;
constexpr size_t WS_WUKV = 18 * MiB;
constexpr size_t WS_WBR = 20 * MiB;
constexpr size_t WS_WOUT = 24 * MiB;
constexpr size_t WS_COS = 26 * MiB, WS_SIN = 30 * MiB;
constexpr size_t WS_ROUTE = 34 * MiB;
constexpr size_t WS_KPE = 36 * MiB;
constexpr size_t WS_ZH = 40 * MiB;
constexpr size_t WS_KN = 136 * MiB, WS_V = 200 * MiB;
constexpr size_t WS_Y = 40 * MiB;
constexpr size_t WS_X2B = 104 * MiB;
constexpr size_t WS_HID = 168 * MiB;
constexpr size_t WS_YEXP = 248 * MiB;
constexpr size_t WS_X2F8 = 344 * MiB;
constexpr size_t WS_H8 = 408 * MiB;
constexpr size_t WS_WIN8 = 440 * MiB;
constexpr size_t WS_TOK = 512 * 1024;
constexpr size_t WS_OB = 264 * MiB;
constexpr size_t WS_ZL = 296 * MiB;
constexpr size_t WS_ZG = 344 * MiB;
constexpr size_t WS_W13 = 408 * MiB;
constexpr size_t WS_OA = 472 * MiB;
constexpr size_t WS_H = 472 * MiB;
constexpr size_t WS_W2 = 504 * MiB;
constexpr size_t WS_END = 536 * MiB;
constexpr size_t RT_AE = 0, RT_AP = 256 * 1024, RT_AW = 512 * 1024, RT_AS = 768 * 1024, RT_ST = 1024 * 1024, RT_SW = 1536 * 1024;
constexpr int CW_CNT = 8192, CNT_STRIDE = 64;
constexpr size_t WS_TS = 16384;
constexpr size_t WS_PTRS = 8192;
enum { PT_POS = 0, PT_HGLB, PT_HGONW, PT_RGB, PT_REB, PT_EW1, PT_EW3, PT_EW2, PT_FFNW, PT_FINW, PT_X };
DEVI const void* ptab(const unsigned char* ws, int i) { return (const void*)(((const unsigned long long*)(ws + WS_PTRS))[i]); }

struct Params {
    const float* x; const int* pos; const float* attn_norm_w; const float* w_in; const float* hg_lb; const float* hg_onw;
    const float* q_norm_w; const float* w_uq; const float* kv_norm_w; const float* w_ukv; const float* w_bra; const float* w_brb;
    const float* w_out; const float* ffn_norm_w; const float* rg_w; const float* rg_b; const float* re_w; const float* re_b;
    const float* ew1; const float* ew3; const float* ew2; const float* final_w;
    float* out; unsigned char* ws;
    int ph_lo, ph_hi;
};

DEVI unsigned f2bf(float f) { unsigned u = __builtin_bit_cast(unsigned, f); return (u + 0x7fffu + ((u >> 16) & 1u)) >> 16; }
DEVI float bf2f(unsigned h) { return __builtin_bit_cast(float, h << 16); }
typedef float f32x2_t __attribute__((ext_vector_type(2))); typedef __bf16 bf16x2_t __attribute__((ext_vector_type(2)));
DEVI unsigned pk2(float lo, float hi) { f32x2_t v = {lo, hi}; bf16x2_t b = __builtin_convertvector(v, bf16x2_t); return __builtin_bit_cast(unsigned, b); }
DEVI float sigmoidf_(float v) { return __builtin_amdgcn_rcpf(1.f + __expf(-v)); }
DEVI float siluf_(float v) { return v * __builtin_amdgcn_rcpf(1.f + __expf(-v)); }
DEVI float wave_sum(float v) {
#pragma unroll
    for (int o = 1; o < 64; o <<= 1) v += __shfl_xor(v, o);
    return v;
}
typedef int i32x4 __attribute__((ext_vector_type(4))); typedef int i32x8 __attribute__((ext_vector_type(8)));
DEVI unsigned pk4_fp8(float a, float b, float c, float d) { int w = __builtin_amdgcn_cvt_pk_fp8_f32(a, b, 0, false); w = __builtin_amdgcn_cvt_pk_fp8_f32(c, d, w, true); return (unsigned)w; }
DEVI void store4bf(bf16_t* p, f32x4 v) { u32x2 w; w.x = pk2(v[0], v[1]); w.y = pk2(v[2], v[3]); *(u32x2*)p = w; }
DEVI void unpack8(bf16x8 v, float* f) {
#pragma unroll
    for (int j = 0; j < 8; ++j) f[j] = bf2f((unsigned)(unsigned short)v[j]);
}

template <class ColMap, class KScale>
DEVI void transpose_tile_f8(const float* src, int Nsrc, unsigned char* dst, int ldk, int k0, int n0, ColMap cm, KScale ks, float* scr) {
    const int tid = threadIdx.x;
    {
        const int nl = tid & 63, kq = tid >> 6; const int col = cm(n0 + nl);
#pragma unroll
        for (int i = 0; i < 8; ++i) { const int k = kq * 8 + i; float v = 0.f; if (col >= 0) v = src[(size_t)(k0 + k) * Nsrc + col] * ks(k0 + k); scr[k * 65 + nl] = v; }
    }
    __syncthreads();
    {
        const int nl = tid >> 3, kc = tid & 7; const float* s = scr + (kc * 8) * 65 + nl;
        u32x2 o; o.x = pk4_fp8(s[0], s[65], s[2 * 65], s[3 * 65]); o.y = pk4_fp8(s[4 * 65], s[5 * 65], s[6 * 65], s[7 * 65]);
        *(u32x2*)(dst + (size_t)(n0 + nl) * ldk + k0 + kc * 8) = o;
    }
    __syncthreads();
}
template <class ColMap, class KScale>
DEVI void transpose_tile(const float* src, int Nsrc, bf16_t* dst, int ldk, int k0, int n0, ColMap cm, KScale ks, float* scr) {
    const int tid = threadIdx.x;
    {
        const int nl = tid & 63, kq = tid >> 6; const int col = cm(n0 + nl);
#pragma unroll
        for (int i = 0; i < 8; ++i) { const int k = kq * 8 + i; float v = 0.f; if (col >= 0) v = src[(size_t)(k0 + k) * Nsrc + col] * ks(k0 + k); scr[k * 65 + nl] = v; }
    }
    __syncthreads();
    {
        const int nl = tid >> 3, kc = tid & 7; const float* s = scr + (kc * 8) * 65 + nl;
        u32x4 o; o.x = pk2(s[0], s[65]); o.y = pk2(s[2 * 65], s[3 * 65]); o.z = pk2(s[4 * 65], s[5 * 65]); o.w = pk2(s[6 * 65], s[7 * 65]);
        *(u32x4*)(dst + (size_t)(n0 + nl) * ldk + k0 + kc * 8) = o;
    }
    __syncthreads();
}

namespace g8 {
#define G8_LAS __attribute__((address_space(3)))
constexpr int BM = 256, BK = 64, HALF = 128, HTB = HALF * BK * 2, STAGE_BYTES = 8 * HTB, NXCD = 8, WGM = 8;
__host__ __device__ __forceinline__ int lds_byte(int r, int c) { const int st = (r >> 4) * 2 + (c >> 5), rr = r & 15, cc = c & 31, ob = rr * 64 + cc * 2; return st * 1024 + (ob ^ (((ob >> 9) & 1) << 5)); }
__host__ __device__ __forceinline__ int perm32(int rho) { const int n = rho >> 4, i = rho & 15; return 8 * (i >> 2) + 4 * n + (i & 3); }
__host__ __device__ __forceinline__ void stage_rc(int b, int& R, int& C) { const int st = b / 1024, sb = b % 1024, swz = sb ^ (((sb >> 9) & 1) << 5); R = (st >> 1) * 16 + swz / 64; C = (st & 1) * 32 + (swz % 64) / 2; }
struct Unit { int pm, pn; const char* a; const char* b; const int* tok; };
struct DenseOrder {
    const char* A; const char* Bt; size_t tstepA, tstepB; int nM, nN, nwg, G, c;
    DEVI void init(const void* A_, int lda, const void* Bt_, int ldb, int M, int N) { A = (const char*)A_; Bt = (const char*)Bt_; tstepA = (size_t)BM * lda * 2; tstepB = (size_t)BM * ldb * 2;
        nM = M / BM; nN = N / BM; nwg = nM * nN; G = gridDim.x; c = blockIdx.x; }
    DEVI bool next(int i, Unit& u) const {
        const long L = (long)i * G + c; if (L >= nwg) return false;
        int wgid = (int)L; { const int q = nwg / NXCD, r = nwg % NXCD, xcd = wgid % NXCD, off = wgid / NXCD; wgid = (xcd < r ? xcd * (q + 1) : r * (q + 1) + (xcd - r) * q) + off; }
        const int nig = WGM * nN, gid = wgid / nig, fm = gid * WGM, gsz = (nM - fm) < WGM ? (nM - fm) : WGM;
        u.pm = fm + ((wgid % nig) % gsz); u.pn = (wgid % nig) / gsz; u.a = A + (size_t)u.pm * tstepA; u.b = Bt + (size_t)u.pn * tstepB; u.tok = nullptr; return true;
    }
};
struct SplitOrder {
    const char* A; const char* Bt; size_t tstepA, tstepB; int nN, first, cnt, stride;
    DEVI void init(const void* A_, int lda, const void* Bt_, int ldb, int N, int first_, int cnt_, int stride_) { A = (const char*)A_; Bt = (const char*)Bt_; tstepA = (size_t)BM * lda * 2; tstepB = (size_t)BM * ldb * 2;
        nN = N / BM; first = first_; cnt = cnt_; stride = stride_; }
    DEVI bool next(int i, Unit& u) const { if (i >= cnt) return false; const int wgid = first + i * stride; u.pm = wgid / nN; u.pn = wgid % nN; u.a = A + (size_t)u.pm * tstepA; u.b = Bt + (size_t)u.pn * tstepB; u.tok = nullptr; return true; }
};
struct DynOrder {
    const char* A; const char* Bt; size_t tstepA, tstepB; int nN, nunits; unsigned* ctr; volatile G8_LAS int* slot; mutable unsigned pend;
    DEVI void init(const void* A_, int lda, const void* Bt_, int ldb, int N, int nunits_, unsigned* ctr_, volatile G8_LAS int* slot_) { A = (const char*)A_; Bt = (const char*)Bt_; tstepA = (size_t)BM * lda * 2;
        tstepB = (size_t)BM * ldb * 2; nN = N / BM; nunits = nunits_; ctr = ctr_; slot = slot_; pend = 0u; }
    DEVI bool next(int i, Unit& u) const {
        if (threadIdx.x == 0) { unsigned v = pend; if (i == 0) v = __hip_atomic_fetch_add(ctr, 1u, __ATOMIC_RELAXED, __HIP_MEMORY_SCOPE_AGENT);
            pend = __hip_atomic_fetch_add(ctr, 1u, __ATOMIC_RELAXED, __HIP_MEMORY_SCOPE_AGENT); slot[i & 1] = (int)v; }
        asm volatile("s_waitcnt lgkmcnt(0)" ::: "memory"); __builtin_amdgcn_s_barrier();
        const int wgid = slot[i & 1];
        if (wgid >= nunits) return false;
        u.pm = wgid / nN; u.pn = wgid % nN; u.a = A + (size_t)u.pm * tstepA; u.b = Bt + (size_t)u.pn * tstepB; u.tok = nullptr; return true; }
};
struct NoHook { static constexpr bool ON = false; template <class U> DEVI void operator()(f32x4 (&)[2][2][4][2], const U&, int, int, int, int) const {} };
template <class Epi, class Sched, bool ALIGN_EPI, class Hook = NoHook, bool GATHER = false, bool FP8 = false>
DEVI void gemm_phase(G8_LAS unsigned char* lds, const int lda, const int ldb, const int K, const Sched& S, const Epi& E, unsigned long long* tsp = nullptr, const Hook& H = Hook(), const int seg_t = 1 << 30, const long segj = 0, const int scA = 127, const int scB = 127) {
    const int tid = threadIdx.x, wid = __builtin_amdgcn_readfirstlane(tid >> 6), lane = tid & 63, wr = wid >> 2, wc = wid & 3, fr = lane & 15, fq = lane >> 4;
    const int nt = K / BK;
    unsigned voffA[2], voffB[2]; int gR[2]; unsigned gC[2];
#pragma unroll
    for (int i = 0; i < 2; ++i) { int R, C; stage_rc(tid * 16 + i * 8192, R, C); voffA[i] = (unsigned)(R * lda + C) * 2u; voffB[i] = (unsigned)(((R & ~31) + perm32(R & 31)) * ldb + C) * 2u; gR[i] = R; gC[i] = (unsigned)C * 2u; }
    unsigned vG[2][2], vGn[2][2];
#define G8_TOK(dst, tokp) do { _Pragma("unroll") for (int h_ = 0; h_ < 2; ++h_) _Pragma("unroll") for (int i_ = 0; i_ < 2; ++i_) dst[h_][i_] = (unsigned)(tokp)[gR[i_] + 128 * h_] * (unsigned)(lda * 2) + gC[i_]; } while (0)
#define G8_STAGE_A(bufoff, gbase, h, usenext) do { if constexpr (GATHER) { unsigned v_[2] = {(usenext) ? vGn[h][0] : vG[h][0], (usenext) ? vGn[h][1] : vG[h][1]}; G8_STAGE(bufoff, gbase, v_); } \
        else { G8_STAGE(bufoff, (gbase) + (h) * hstepA, voffA); } } while (0)
    const size_t kstep = (size_t)(BK * 2);
    const size_t hstepA = (size_t)HALF * lda * 2, hstepB = (size_t)HALF * ldb * 2;
    const unsigned ldsw = (unsigned)wid * 1024u;
    const int aoff = lds_byte(wr * 64 + fr, fq * 8), boff = lds_byte(wc * 32 + fr, fq * 8);
#define G8_SA(b, h) (((b) * 2 + (h)) * HTB)
#define G8_SB(b, h) ((4 + (b) * 2 + (h)) * HTB)
#define G8_STAGE(bufoff, gbase, voff) do { _Pragma("unroll") for (int _i = 0; _i < 2; ++_i) \
        __builtin_amdgcn_global_load_lds((const unsigned*)((const char*)(gbase) + (voff)[_i]), (G8_LAS unsigned*)(lds + (bufoff) + ldsw + _i * 8192), 16, 0, 0); } while (0)
#define G8_LD16(off) __builtin_bit_cast(i32x4, *(const G8_LAS bf16x8*)(lds + (off)))
#define G8_LDA8(dst, b, h) do { _Pragma("unroll") for (int m = 0; m < 4; ++m) dst[m] = __builtin_shufflevector(G8_LD16(G8_SA(b, h) + aoff + m * 2048), G8_LD16(G8_SA(b, h) + aoff + m * 2048 + 1024), 0, 1, 2, 3, 4, 5, 6, 7); } while (0)
#define G8_LDB8(dst, b, h) do { _Pragma("unroll") for (int n = 0; n < 2; ++n) dst[n] = __builtin_shufflevector(G8_LD16(G8_SB(b, h) + boff + n * 2048), G8_LD16(G8_SB(b, h) + boff + n * 2048 + 1024), 0, 1, 2, 3, 4, 5, 6, 7); } while (0)
#define G8_LDA(dst, b, h) do { if constexpr (FP8) { G8_LDA8(dst##8, b, h); break; } _Pragma("unroll") for (int m = 0; m < 4; ++m) _Pragma("unroll") for (int k = 0; k < 2; ++k) dst[m][k] = *(const G8_LAS bf16x8*)(lds + G8_SA(b, h) + aoff + m * 2048 + k * 1024); } while (0)
#define G8_LDB(dst, b, h) do { if constexpr (FP8) { G8_LDB8(dst##8, b, h); break; } _Pragma("unroll") for (int n = 0; n < 2; ++n) _Pragma("unroll") for (int k = 0; k < 2; ++k) dst[n][k] = *(const G8_LAS bf16x8*)(lds + G8_SB(b, h) + boff + n * 2048 + k * 1024); } while (0)
#define G8_MMA(ai, bj, At, Bt) do { __builtin_amdgcn_s_setprio(1); _Pragma("unroll") for (int m = 0; m < 4; ++m) _Pragma("unroll") for (int n = 0; n < 2; ++n) { \
        if constexpr (FP8) { asm volatile("v_mfma_scale_f32_16x16x128_f8f6f4 %0, %1, %2, %0, %3, %4 op_sel_hi:[0,0,0]" : "+v"(acc[ai][bj][m][n]) : "v"(Bt##8[n]), "v"(At##8[m]), "v"(scB), "v"(scA)); } \
        else { _Pragma("unroll") for (int k = 0; k < 2; ++k) acc[ai][bj][m][n] = __builtin_amdgcn_mfma_f32_16x16x32_bf16(Bt[n][k], At[m][k], acc[ai][bj][m][n], 0, 0, 0); } } __builtin_amdgcn_s_setprio(0); } while (0)
#define G8_WAIT_V(n) asm volatile("s_waitcnt vmcnt(" #n ")" ::: "memory")
#define G8_WAIT_L(n) asm volatile("s_waitcnt lgkmcnt(" #n ")" ::: "memory")
#define G8_BAR __builtin_amdgcn_s_barrier()
#define G8_SCHED __builtin_amdgcn_sched_barrier(0)
    Unit cur, nxt; int ui = 0;
    if (!S.next(0, cur)) return;
    f32x4 acc[2][2][4][2];
#pragma unroll
    for (int a = 0; a < 2; ++a)
#pragma unroll
        for (int b = 0; b < 2; ++b)
#pragma unroll
            for (int m = 0; m < 4; ++m)
#pragma unroll
                for (int n = 0; n < 2; ++n) acc[a][b][m][n] = (f32x4){0.f, 0.f, 0.f, 0.f};
    bf16x8 At[4][2], B0[2][2], B1[2][2];
    i32x8 At8[4], B08[2], B18[2];
    const char* cA = cur.a; const char* cB = cur.b;
    if constexpr (GATHER) { G8_TOK(vG, cur.tok); G8_TOK(vGn, cur.tok); }
    G8_STAGE(G8_SB(0, 0), cB, voffB); G8_STAGE(G8_SB(0, 1), cB + hstepB, voffB); G8_STAGE_A(G8_SA(0, 0), cA, 0, false); G8_STAGE_A(G8_SA(0, 1), cA, 1, false);
    if (wr == 1) G8_BAR;
    G8_WAIT_V(2); G8_BAR;
    G8_STAGE(G8_SB(1, 0), cB + kstep, voffB); G8_STAGE_A(G8_SA(1, 0), cA + kstep, 0, false); G8_STAGE(G8_SB(1, 1), cB + hstepB + kstep, voffB);
    G8_WAIT_V(6); G8_BAR;
    unsigned long long tk_ = 0, te_ = 0, tp_ = tsp ? __builtin_amdgcn_s_memrealtime() : 0;
    for (;;) {
        const bool has_next = S.next(ui + 1, nxt);
        const char* nA = has_next ? nxt.a : cA; const char* nB = has_next ? nxt.b : cB;
        if constexpr (GATHER) { if (has_next) G8_TOK(vGn, nxt.tok); }
#pragma unroll 1
        for (int t = 0; t < nt; t += 2) {
            const bool last = (t == nt - 2);
            if constexpr (Hook::ON) { if (t == seg_t) { if constexpr (FP8) asm volatile("s_nop 15\n\ts_nop 15" ::: "memory"); H(acc, cur, wr, wc, fr, fq); } }
            const char* a1 = cA + (size_t)(t + 1) * kstep + (Hook::ON && t + 1 >= seg_t ? segj : 0);
            const char* a2 = last ? nA : cA + (size_t)(t + 2) * kstep + (Hook::ON && t + 2 >= seg_t ? segj : 0); const char* b2 = last ? nB : cB + (size_t)(t + 2) * kstep;
            const char* a3 = a2 + kstep; const char* b3 = b2 + kstep;
            G8_LDB(B0, 0, 0); G8_LDB(B1, 0, 1); G8_SCHED; G8_LDA(At, 0, 0); G8_STAGE_A(G8_SA(1, 1), a1, 1, false);
            G8_WAIT_V(8); G8_WAIT_L(0); G8_BAR; G8_MMA(0, 0, At, B0); G8_MMA(0, 1, At, B1); G8_BAR; G8_SCHED;
            G8_LDA(At, 0, 1); G8_STAGE(G8_SB(0, 0), b2, voffB); G8_STAGE(G8_SB(0, 1), b2 + hstepB, voffB); G8_STAGE_A(G8_SA(0, 0), a2, 0, last);
            G8_WAIT_V(8); G8_WAIT_L(0); G8_BAR; G8_MMA(1, 0, At, B0); G8_MMA(1, 1, At, B1); G8_BAR; G8_SCHED;
            G8_LDB(B0, 1, 0); G8_LDB(B1, 1, 1); G8_SCHED; G8_LDA(At, 1, 0); G8_STAGE_A(G8_SA(0, 1), a2, 1, last);
            G8_WAIT_V(8); G8_WAIT_L(0); G8_BAR; G8_MMA(0, 0, At, B0); G8_MMA(0, 1, At, B1); G8_BAR; G8_SCHED;
            G8_LDA(At, 1, 1); G8_STAGE(G8_SB(1, 0), b3, voffB); G8_STAGE(G8_SB(1, 1), b3 + hstepB, voffB); G8_STAGE_A(G8_SA(1, 0), a3, 0, last);
            G8_WAIT_V(8); G8_WAIT_L(0); G8_BAR; G8_MMA(1, 0, At, B0); G8_MMA(1, 1, At, B1); G8_BAR; G8_SCHED;
        }
        if constexpr (ALIGN_EPI) { if (wr == 0) G8_BAR; }
        if (tsp) { const unsigned long long n_ = __builtin_amdgcn_s_memrealtime(); tk_ += n_ - tp_; tp_ = n_; }
        if constexpr (FP8) asm volatile("s_nop 15\n\ts_nop 15" ::: "memory");
        E(acc, cur, wr, wc, fr, fq);
        if (tsp) { const unsigned long long n_ = __builtin_amdgcn_s_memrealtime(); te_ += n_ - tp_; tp_ = n_; }
        if (!has_next) break;
#pragma unroll
        for (int a = 0; a < 2; ++a)
#pragma unroll
            for (int b = 0; b < 2; ++b)
#pragma unroll
                for (int m = 0; m < 4; ++m)
#pragma unroll
                    for (int n = 0; n < 2; ++n) acc[a][b][m][n] = (f32x4){0.f, 0.f, 0.f, 0.f};
        cur = nxt; cA = nA; cB = nB; ++ui;
        if constexpr (GATHER) { _Pragma("unroll") for (int h_ = 0; h_ < 2; ++h_) _Pragma("unroll") for (int i_ = 0; i_ < 2; ++i_) vG[h_][i_] = vGn[h_][i_]; }
        if constexpr (ALIGN_EPI) { if (wr == 1) G8_BAR; }
    }
    G8_WAIT_V(0);
    if constexpr (!ALIGN_EPI) { if (wr == 0) G8_BAR; }
    G8_BAR;
    if (tsp && blockIdx.x == 0 && threadIdx.x == 0) { tsp[0] = 0; tsp[1] = tk_; tsp[2] = 0; tsp[3] = te_; tsp[4] = 0; tsp[5] = (unsigned long long)(ui + 1) * 100ull; }
#undef G8_SA
#undef G8_SB
#undef G8_STAGE
#undef G8_STAGE_A
#undef G8_TOK
#undef G8_LDA
#undef G8_LDA8
#undef G8_LDB8
#undef G8_LD16
#undef G8_LDB
#undef G8_MMA
#undef G8_WAIT_V
#undef G8_WAIT_L
#undef G8_BAR
#undef G8_SCHED
}
template <class F> struct Epi4 { F f;
    DEVI void operator()(const f32x4 (&acc)[2][2][4][2], const Unit& u, int wr, int wc, int fr, int fq) const {
        constexpr int NB = F::NB;
        asm volatile("" : "+v"(fr), "+v"(fq));
#pragma unroll
        for (int g0 = 0; g0 < 8; g0 += NB) {
            typename F::L ld[NB][2];
#pragma unroll
            for (int gg = 0; gg < NB; ++gg) { const int ai = (g0 + gg) >> 2, m = (g0 + gg) & 3;
#pragma unroll
                for (int bj = 0; bj < 2; ++bj) ld[gg][bj] = f.load(u.pm, u.pn, ai * 128 + wr * 64 + m * 16 + fr, bj * 128 + wc * 32 + 8 * fq); }
#pragma unroll
            for (int gg = 0; gg < NB; ++gg) { const int ai = (g0 + gg) >> 2, m = (g0 + gg) & 3;
#pragma unroll
                for (int bj = 0; bj < 2; ++bj) f.apply(u.pm, u.pn, ai * 128 + wr * 64 + m * 16 + fr, bj * 128 + wc * 32 + 8 * fq, acc[ai][bj][m][0], acc[ai][bj][m][1], ld[gg][bj]); }
            asm volatile("" ::: "memory");
        }
    } };
template <class F> struct Hook4 { static constexpr bool ON = true; F f;
    DEVI void operator()(f32x4 (&acc)[2][2][4][2], const Unit& u, int wr, int wc, int fr, int fq) const {
        constexpr int NB = F::NB;
        asm volatile("" : "+v"(fr), "+v"(fq));
#pragma unroll
        for (int g0 = 0; g0 < 8; g0 += NB) {
            typename F::L ld[NB][2];
#pragma unroll
            for (int gg = 0; gg < NB; ++gg) { const int ai = (g0 + gg) >> 2, m = (g0 + gg) & 3;
#pragma unroll
                for (int bj = 0; bj < 2; ++bj) ld[gg][bj] = f.load(u.pm, u.pn, ai * 128 + wr * 64 + m * 16 + fr, bj * 128 + wc * 32 + 8 * fq); }
#pragma unroll
            for (int gg = 0; gg < NB; ++gg) { const int ai = (g0 + gg) >> 2, m = (g0 + gg) & 3;
#pragma unroll
                for (int bj = 0; bj < 2; ++bj) f.apply(u.pm, u.pn, ai * 128 + wr * 64 + m * 16 + fr, bj * 128 + wc * 32 + 8 * fq, acc[ai][bj][m][0], acc[ai][bj][m][1], ld[gg][bj]); }
            asm volatile("" ::: "memory");
        }
    } };
}

struct NoLd {};
struct LbLd { f32x4 a, b; };
DEVI void store8bf(bf16_t* p, f32x4 a, f32x4 b) { u32x4 w; w.x = pk2(a[0], a[1]); w.y = pk2(a[2], a[3]); w.z = pk2(b[0], b[1]); w.w = pk2(b[2], b[3]); *(u32x4*)p = w; }
DEVI void st16_wt(void* p, u32x4 w) { asm volatile("global_store_dwordx4 %0, %1, off sc1\n\ts_nop 1" :: "v"(p), "v"(w) : "memory"); }
DEVI void store8bf_wt(bf16_t* p, f32x4 a, f32x4 b) { u32x4 w; w.x = pk2(a[0], a[1]); w.y = pk2(a[2], a[3]); w.z = pk2(b[0], b[1]); w.w = pk2(b[2], b[3]);
    asm volatile("global_store_dwordx4 %0, %1, off sc1\n\ts_nop 1" :: "v"(p), "v"(w) : "memory"); }
DEVI void zh_store(unsigned char* ws, int kind, size_t row, int col, f32x4 v0, f32x4 v1, const LbLd& lb) {
    if (kind == 3) {
#pragma unroll
        for (int j = 0; j < 4; ++j) { v0[j] = siluf_(v0[j]); v1[j] = siluf_(v1[j]); } }
    if (kind == 0) {
#pragma unroll
        for (int j = 0; j < 4; ++j) { v0[j] = siluf_(v0[j]) * 0.08838834764831845f; v1[j] = siluf_(v1[j]) * 0.08838834764831845f; } }
    else if (kind == 1) {
#pragma unroll
        for (int j = 0; j < 4; ++j) { v0[j] = __logf(lb.a[j] + (1.f - lb.a[j]) * sigmoidf_(v0[j])); v1[j] = __logf(lb.b[j] + (1.f - lb.b[j]) * sigmoidf_(v1[j])); } }
    store8bf((bf16_t*)(ws + WS_ZH) + row * ZH_P + kind * 1024 + col, v0, v1);
}
struct EpiZa { typedef NoLd L; static constexpr int NB = 8; unsigned char* ws;
    DEVI L load(int, int, int, int) const { return {}; }
    DEVI void apply(int pm, int pn, int r, int c, f32x4 v0, f32x4 v1, L) const { LbLd z; z.a = (f32x4){0.f, 0.f, 0.f, 0.f}; z.b = z.a; zh_store(ws, NK8 + (pn >> 2), (size_t)pm * 256 + r, (pn & 3) * 256 + c, v0, v1, z); } };
struct EpiZb { typedef LbLd L; static constexpr int NB = 4; unsigned char* ws;
    DEVI L load(int, int pn, int, int c) const { L l; l.a = (f32x4){0.f, 0.f, 0.f, 0.f}; l.b = l.a; if ((pn >> 2) == 1) { const float* lp = (const float*)(ws + WS_LBT) + (pn & 3) * 256 + c; l.a = *(const f32x4*)lp; l.b = *(const f32x4*)(lp + 4); } return l; }
    DEVI void apply(int pm, int pn, int r, int c, f32x4 v0, f32x4 v1, const L& lb) const {
        const size_t row = (size_t)pm * 256 + r; u32x2 w = {0u, 0u};
        if (pn < 4 * NK8) { zh_store(ws, pn >> 2, row, (pn & 3) * 256 + c, v0, v1, lb); return; }
        if (pn < 4 * NK8 + 3) { store8bf((bf16_t*)(ws + WS_ZL) + row * ZL_P + (pn - 4 * NK8) * 256 + c, v0, v1); return; }
#pragma unroll
        for (int j = 0; j < 4; ++j) { w.x = __builtin_amdgcn_cvt_pk_u8_f32(fmaxf(fmaf(255.f, sigmoidf_(v0[j]), 0.5f), 1.f), j, w.x); w.y = __builtin_amdgcn_cvt_pk_u8_f32(fmaxf(fmaf(255.f, sigmoidf_(v1[j]), 0.5f), 1.f), j, w.y); }
        *(u32x2*)(ws + WS_ZG + row * ZG_P + (pn - 4 * NK8 - 3) * 256 + c) = w;
    } };
struct EpiQ { typedef NoLd L; static constexpr int NB = 8; bf16_t* q;
    DEVI L load(int, int, int, int) const { return {}; }
    DEVI void apply(int pm, int pn, int r, int c, f32x4 v0, f32x4 v1, L) const { store8bf(q + ((size_t)pm * 256 + r) * 1536 + pn * 256 + c, v0, v1); } };
struct EpiKV { typedef NoLd L; static constexpr int NB = 8; bf16_t* kn; bf16_t* vv;
    DEVI L load(int, int, int, int) const { return {}; }
    DEVI void apply(int pm, int pn, int r, int c, f32x4 v0, f32x4 v1, L) const {
        const size_t row = (size_t)pm * 256 + r; const int col = pn * 256 + c; const int hh = col >> 8, cc = col & 255;
        if (cc < 128) store8bf_wt(kn + row * 1024 + hh * 128 + cc, v0, v1); else store8bf_wt(vv + row * 1024 + hh * 128 + (cc - 128), v0, v1);
    } };
struct BrHookF { typedef u32x4 L; static constexpr int NB = 1; const unsigned char* zg;
    DEVI L load(int pm, int pn, int r, int c) const { const unsigned char* g = zg + ((size_t)pm * 256 + r) * ZG_P + pn * 256 + c; const u32x2 a = *(const u32x2*)g, b = *(const u32x2*)(g + 1024); return (L){a.x, a.y, b.x, b.y}; }
    DEVI void apply(int, int, int, int, f32x4& v0, f32x4& v1, L l) const {
#pragma unroll
        for (int j = 0; j < 4; ++j) { v0[j] *= (float)((l.x >> (8 * j)) & 255u) * __builtin_amdgcn_rcpf((float)((l.z >> (8 * j)) & 255u)); v1[j] *= (float)((l.y >> (8 * j)) & 255u) * __builtin_amdgcn_rcpf((float)((l.w >> (8 * j)) & 255u)); } } };
struct EpiBr2 { typedef u32x2 L; static constexpr int NB = 2; const unsigned char* zg; bf16_t* y;
    DEVI L load(int pm, int pn, int r, int c) const { return *(const u32x2*)(zg + ((size_t)pm * 256 + r) * ZG_P + 1024 + pn * 256 + c); }
    DEVI void apply(int pm, int pn, int r, int c, f32x4 v0, f32x4 v1, L g) const {
#pragma unroll
        for (int j = 0; j < 4; ++j) { v0[j] *= (float)((g.x >> (8 * j)) & 255u) * (1.f / 255.f); v1[j] *= (float)((g.y >> (8 * j)) & 255u) * (1.f / 255.f); }
        store8bf(y + ((size_t)pm * 256 + r) * 1024 + pn * 256 + c, v0, v1); } };
struct EpiOut { typedef LbLd L; static constexpr int NB = 2; const float* x; bf16_t* x2b; unsigned char* x2f8;
    DEVI L load(int pm, int pn, int r, int c) const { const float* xp = x + ((size_t)pm * 256 + r) * 1024 + pn * 256 + c; L l; l.a = *(const f32x4*)xp; l.b = *(const f32x4*)(xp + 4); return l; }
    DEVI void apply(int pm, int pn, int r, int c, f32x4 v0, f32x4 v1, const L& xv) const { const size_t o = ((size_t)pm * 256 + r) * 1024 + pn * 256 + c; const f32x4 a = xv.a + v0, b = xv.b + v1; store8bf(x2b + o, a, b);
        u32x2 w; w.x = pk4_fp8(4.f * a[0], 4.f * a[1], 4.f * a[2], 4.f * a[3]); w.y = pk4_fp8(4.f * b[0], 4.f * b[1], 4.f * b[2], 4.f * b[3]); *(u32x2*)(x2f8 + o) = w; } };
struct EpiHid8 { unsigned char* hid; const float* srs;
    DEVI void operator()(const f32x4 (&acc)[2][2][4][2], const g8::Unit& u, int wr, int wc, int fr, int fq) const {
        asm volatile("" : "+v"(fr), "+v"(fq));
        float rs[8];
#pragma unroll
        for (int g = 0; g < 8; ++g) rs[g] = srs[(size_t)u.pm * 256 + (g >> 2) * 128 + wr * 64 + (g & 3) * 16 + fr];
#pragma unroll
        for (int g = 0; g < 8; ++g) { const int ai = g >> 2, m = g & 3; unsigned char* hrow = hid + ((size_t)u.pm * 256 + ai * 128 + wr * 64 + m * 16 + fr) * EFF + u.pn * 128 + wc * 16 + 4 * fq;
#pragma unroll
            for (int bj = 0; bj < 2; ++bj) { const f32x4 gg = acc[ai][bj][m][0] * rs[g], uu = acc[ai][bj][m][1] * rs[g]; float h4[4];
#pragma unroll
                for (int i = 0; i < 4; ++i) h4[i] = __builtin_amdgcn_fmed3f(8.f * siluf_(gg[i]) * uu[i], -440.f, 440.f);
                *(unsigned*)(hrow + bj * 64) = pk4_fp8(h4[0], h4[1], h4[2], h4[3]); } }
    } };
struct EpiY { typedef float L; static constexpr int NB = 8; unsigned char* yexp; const float* sw;
    DEVI L load(int tile, int, int r, int) const { return sw[(size_t)tile * 256 + r]; }
    DEVI void apply(int tile, int pn, int r, int c, f32x4 v0, f32x4 v1, L w) const { const float ws_ = 16.f * w; u32x2 o;
        o.x = pk4_fp8(__builtin_amdgcn_fmed3f(v0[0] * ws_, -440.f, 440.f), __builtin_amdgcn_fmed3f(v0[1] * ws_, -440.f, 440.f), __builtin_amdgcn_fmed3f(v0[2] * ws_, -440.f, 440.f), __builtin_amdgcn_fmed3f(v0[3] * ws_, -440.f, 440.f));
        o.y = pk4_fp8(__builtin_amdgcn_fmed3f(v1[0] * ws_, -440.f, 440.f), __builtin_amdgcn_fmed3f(v1[1] * ws_, -440.f, 440.f), __builtin_amdgcn_fmed3f(v1[2] * ws_, -440.f, 440.f), __builtin_amdgcn_fmed3f(v1[3] * ws_, -440.f, 440.f));
        *(u32x2*)(yexp + ((size_t)tile * 256 + r) * 1024 + pn * 256 + c) = o; } };

struct EpiY16 { unsigned char* yexp; const float* sw;
    DEVI void operator()(const f32x4 (&acc)[2][2][4][2], const g8::Unit& u, int wr, int wc, int fr, int fq) const {
        asm volatile("" : "+v"(fr), "+v"(fq));
        float wv[8];
#pragma unroll
        for (int g = 0; g < 8; ++g) wv[g] = 16.f * sw[(size_t)u.pm * 256 + (g >> 2) * 128 + wr * 64 + (g & 3) * 16 + fr];
#pragma unroll
        for (int g = 0; g < 8; ++g) { const int ai = g >> 2, m = g & 3; const float w_ = wv[g]; u32x4 o;
#define EY_PK(V) pk4_fp8(__builtin_amdgcn_fmed3f(V[0] * w_, -440.f, 440.f), __builtin_amdgcn_fmed3f(V[1] * w_, -440.f, 440.f), __builtin_amdgcn_fmed3f(V[2] * w_, -440.f, 440.f), __builtin_amdgcn_fmed3f(V[3] * w_, -440.f, 440.f))
            o.x = EY_PK(acc[ai][0][m][0]); o.y = EY_PK(acc[ai][0][m][1]); o.z = EY_PK(acc[ai][1][m][0]); o.w = EY_PK(acc[ai][1][m][1]);
#undef EY_PK
            st16_wt(yexp + ((size_t)u.pm * 256 + ai * 128 + wr * 64 + m * 16 + fr) * 1024 + u.pn * 256 + wc * 64 + fq * 16, o); }
    } };
struct ConvDesc { const float* colp4; size_t rs; const float* kscale; unsigned char* dst; int ldk; };
template <class DescF>
DEVI void conv_stream_f8(int first, int end, int stride, float wscale, float* scr, DescF desc) {
    const int tid = threadIdx.x, n4 = tid & 15, kr = tid >> 4, nl = tid >> 3, kc = tid & 7;
    f32x4 v[8];
    if (first < end) { const ConvDesc d = desc(first);
#pragma unroll
        for (int i = 0; i < 8; ++i) v[i] = *(const f32x4*)(d.colp4 + (size_t)(kr + 32 * i) * d.rs); }
#pragma unroll 1
    for (int ci = first; ci < end; ci += stride) {
        const ConvDesc d = desc(ci);
#pragma unroll
        for (int i = 0; i < 8; ++i) { const float sc = d.kscale ? d.kscale[kr + 32 * i] * wscale : wscale; float* q = scr + (kr + 32 * i) * 65 + 4 * n4; q[0] = v[i][0] * sc; q[1] = v[i][1] * sc; q[2] = v[i][2] * sc; q[3] = v[i][3] * sc; }
        __syncthreads();
        if (ci + stride < end) { const ConvDesc dn = desc(ci + stride);
#pragma unroll
            for (int i = 0; i < 8; ++i) v[i] = *(const f32x4*)(dn.colp4 + (size_t)(kr + 32 * i) * dn.rs); }
#pragma unroll
        for (int j = 0; j < 4; ++j) { const float* s_ = scr + (kc * 8 + 64 * j) * 65 + nl;
            u32x2 o; o.x = pk4_fp8(s_[0], s_[65], s_[2 * 65], s_[3 * 65]); o.y = pk4_fp8(s_[4 * 65], s_[5 * 65], s_[6 * 65], s_[7 * 65]);
            *(u32x2*)(d.dst + (size_t)nl * d.ldk + kc * 8 + 64 * j) = o; }
        __syncthreads();
    }
}
template <bool F8, class DescF>
DEVI void conv_stream_reg(int first, int end, int stride, float wscale, float*, DescF desc) {
    const int tid = threadIdx.x, n4 = tid & 15, kg = tid >> 4;
    f32x4 va[8], vb[8], ka[2], kb_[2];
#define CV_LOAD(V, KS, ci_) do { if ((ci_) < end) { const ConvDesc dl_ = desc(ci_); _Pragma("unroll") for (int i = 0; i < 8; ++i) V[i] = dl_.colp4 ? *(const f32x4*)(dl_.colp4 + (size_t)(kg * 8 + i) * dl_.rs) : (f32x4){0.f, 0.f, 0.f, 0.f}; \
        if (dl_.kscale) { KS[0] = *(const f32x4*)(dl_.kscale + kg * 8); KS[1] = *(const f32x4*)(dl_.kscale + kg * 8 + 4); } else { KS[0] = (f32x4){1.f, 1.f, 1.f, 1.f}; KS[1] = KS[0]; } } } while (0)
#define CV_TILE(V, KS, ci_) do { const ConvDesc d = desc(ci_); const f32x4 s0 = KS[0] * wscale, s1 = KS[1] * wscale; \
        _Pragma("unroll") for (int j = 0; j < 4; ++j) { \
            if constexpr (F8) { u32x2 o; o.x = pk4_fp8(V[0][j] * s0[0], V[1][j] * s0[1], V[2][j] * s0[2], V[3][j] * s0[3]); o.y = pk4_fp8(V[4][j] * s1[0], V[5][j] * s1[1], V[6][j] * s1[2], V[7][j] * s1[3]); \
                *(u32x2*)(d.dst + (size_t)(4 * n4 + j) * d.ldk + kg * 8) = o; } \
            else { u32x4 o; o.x = pk2(V[0][j] * s0[0], V[1][j] * s0[1]); o.y = pk2(V[2][j] * s0[2], V[3][j] * s0[3]); o.z = pk2(V[4][j] * s1[0], V[5][j] * s1[1]); o.w = pk2(V[6][j] * s1[2], V[7][j] * s1[3]); \
                *(u32x4*)(d.dst + (size_t)(4 * n4 + j) * d.ldk + kg * 16) = o; } } \
        CV_LOAD(V, KS, (ci_) + 2 * stride); } while (0)
    CV_LOAD(va, ka, first); CV_LOAD(vb, kb_, first + stride);
#pragma unroll 1
    for (int ci = first; ci < end; ci += 2 * stride) {
        CV_TILE(va, ka, ci);
        if (ci + stride < end) CV_TILE(vb, kb_, ci + stride);
    }
#undef CV_LOAD
#undef CV_TILE
}
DEVI void phase0(const Params& p, char* lds) {
    float* scr = (float*)lds; unsigned char* ws = p.ws;
    bf16_t* WuqT = (bf16_t*)(ws + WS_WUQ);
    if (blockIdx.x == 0) { unsigned* cz = (unsigned*)(ws + WS_CTL) + CW_CNT; for (int i = threadIdx.x; i < 66 * CNT_STRIDE; i += NTHR) cz[i] = 0u; }
    if (blockIdx.x == 0 && threadIdx.x == 0) { unsigned long long* tb = (unsigned long long*)(ws + WS_PTRS);
        tb[PT_POS] = (unsigned long long)p.pos; tb[PT_HGLB] = (unsigned long long)p.hg_lb; tb[PT_HGONW] = (unsigned long long)p.hg_onw; tb[PT_RGB] = (unsigned long long)p.rg_b; tb[PT_REB] = (unsigned long long)p.re_b;
        tb[PT_EW1] = (unsigned long long)p.ew1; tb[PT_EW3] = (unsigned long long)p.ew3; tb[PT_EW2] = (unsigned long long)p.ew2; tb[PT_FFNW] = (unsigned long long)p.ffn_norm_w; tb[PT_FINW] = (unsigned long long)p.final_w; tb[PT_X] = (unsigned long long)p.x; }
    bf16_t* H = (bf16_t*)(ws + WS_H);
    const int lane = threadIdx.x & 63, gw = blockIdx.x * 8 + (threadIdx.x >> 6), NGW = gridDim.x * 8;
    f32x4 va[2][4], vb[2][4];
#define H_LOAD(V, m_) do { _Pragma("unroll") for (int r = 0; r < 2; ++r) { const f32x4* xr = (const f32x4*)(p.x + (size_t)((m_) + r) * D) + 4 * lane; _Pragma("unroll") for (int j = 0; j < 4; ++j) V[r][j] = xr[j]; } } while (0)
#define H_STEP(V, m_) do { _Pragma("unroll") for (int r = 0; r < 2; ++r) { const int m = (m_) + r; float s = 0.f; \
            _Pragma("unroll") for (int j = 0; j < 4; ++j) s += V[r][j][0] * V[r][j][0] + V[r][j][1] * V[r][j][1] + V[r][j][2] * V[r][j][2] + V[r][j][3] * V[r][j][3]; \
            const float rstd = rsqrtf(wave_sum(s) * (1.f / D) + 1e-6f); \
            const float r4 = 4.f * rstd; u32x4 wa, wb, w8; \
            wa.x = pk2(V[r][0][0] * rstd, V[r][0][1] * rstd); wa.y = pk2(V[r][0][2] * rstd, V[r][0][3] * rstd); wa.z = pk2(V[r][1][0] * rstd, V[r][1][1] * rstd); wa.w = pk2(V[r][1][2] * rstd, V[r][1][3] * rstd); \
            wb.x = pk2(V[r][2][0] * rstd, V[r][2][1] * rstd); wb.y = pk2(V[r][2][2] * rstd, V[r][2][3] * rstd); wb.z = pk2(V[r][3][0] * rstd, V[r][3][1] * rstd); wb.w = pk2(V[r][3][2] * rstd, V[r][3][3] * rstd); \
            w8.x = pk4_fp8(V[r][0][0] * r4, V[r][0][1] * r4, V[r][0][2] * r4, V[r][0][3] * r4); w8.y = pk4_fp8(V[r][1][0] * r4, V[r][1][1] * r4, V[r][1][2] * r4, V[r][1][3] * r4); \
            w8.z = pk4_fp8(V[r][2][0] * r4, V[r][2][1] * r4, V[r][2][2] * r4, V[r][2][3] * r4); w8.w = pk4_fp8(V[r][3][0] * r4, V[r][3][1] * r4, V[r][3][2] * r4, V[r][3][3] * r4); \
            u32x4* o = (u32x4*)(H + (size_t)m * D) + 2 * lane; o[0] = wa; o[1] = wb; *((u32x4*)(ws + WS_H8 + (size_t)m * D) + lane) = w8; } } while (0)
    const int hs = NGW * 2;
    if (gw * 2 < T) H_LOAD(va, gw * 2);
#pragma unroll 1
    for (int m0 = gw * 2; m0 < T; m0 += 2 * hs) {
        const bool h1 = m0 + hs < T;
        if (h1) H_LOAD(vb, m0 + hs);
        H_STEP(va, m0);
        if (h1) { if (m0 + 2 * hs < T) H_LOAD(va, m0 + 2 * hs); H_STEP(vb, m0 + hs); }
    }
#undef H_LOAD
#undef H_STEP
    __syncthreads();
    { constexpr int I_UQ = 24 * 6;
      for (int r = blockIdx.x; r < I_UQ; r += gridDim.x) { const int nb = r / 6, kb = r % 6; const float* nw = p.q_norm_w;
        transpose_tile(p.w_uq, 1536, WuqT, 384, kb * 64, nb * 64,
                       [](int n) { const int hh = n / 192, c = n % 192; if (c < 128) return n; const int rr = c - 128; return hh * 192 + 128 + (rr & 1) * 32 + (rr >> 1); },
                       [nw](int k) { return nw[k] * 0.07216878364870322f; }, scr); } }
    { const int n4x = 4 * ((int)threadIdx.x & 15); const float* w_in = p.w_in; const float* anw = p.attn_norm_w; const float* wbra = p.w_bra; const float* wbrb = p.w_brb;
      constexpr int N8 = NK8 * 1024 + 2816, T_IN8 = (N8 / 64) * 4, T_BR = 16 * 4;
      conv_stream_reg<true>((int)blockIdx.x, T_IN8 + 2 * T_BR, (int)gridDim.x, 64.f, scr, [=](int ci) -> ConvDesc {
          if (ci < T_IN8) { const int nb = ci >> 2, kb = ci & 3, n = nb * 64 + n4x, m = n - NK8 * 1024; const int col = m < 0 ? n : (m < 704 ? 4096 + m : (m < 768 ? -1 : 4032 + m));
              return {col >= 0 ? w_in + (size_t)(kb * 256) * 6848 + col : nullptr, 6848, anw + kb * 256, ws + WS_WIN8 + (size_t)(nb * 64) * 1024 + kb * 256, 1024}; }
          const int cj = ci - T_IN8, which = cj / T_BR, r = cj % T_BR, nb = r >> 2, kb = r & 3;
          return {(which ? wbrb : wbra) + (size_t)(kb * 256) * 1024 + nb * 64 + n4x, 1024, nullptr, ws + WS_WBR + (size_t)(nb * 64) * 2048 + which * 1024 + kb * 256, 2048}; });
      const float* wout = p.w_out; const float* wukv = p.w_ukv; const float* kvnw = p.kv_norm_w;
      constexpr int T_IN = (NK16 * 1024 / 64) * 4, T_OUT = 16 * 4, T_UKV = 32;
      conv_stream_reg<false>((int)gridDim.x - 1 - (int)blockIdx.x, T_IN + T_OUT + T_UKV, (int)gridDim.x, 1.f, scr, [=](int ci) -> ConvDesc {
          if (ci < T_IN) { const int nb = ci >> 2, kb = ci & 3; return {w_in + (size_t)(kb * 256) * 6848 + NK8 * 1024 + nb * 64 + n4x, 6848, anw + kb * 256, ws + WS_WIN + ((size_t)(nb * 64) * 1024 + kb * 256) * 2, 2048}; }
          if (ci < T_IN + T_OUT) { const int r = ci - T_IN, nb = r >> 2, kb = r & 3; return {wout + (size_t)(kb * 256) * 1024 + nb * 64 + n4x, 1024, nullptr, ws + WS_WOUT + ((size_t)(nb * 64) * 1024 + kb * 256) * 2, 2048}; }
          const int nb = ci - T_IN - T_OUT, n = nb * 64 + n4x; return {wukv + n, 2048, kvnw, ws + WS_WUKV + (size_t)(nb * 64) * 256 * 2, 512}; }); }
    __syncthreads();
    bf16_t* WrH = (bf16_t*)(ws + WS_WRT); bf16_t* WrL = WrH + 80 * 1024;
    for (int e = blockIdx.x * NTHR + threadIdx.x; e < 80 * 1024; e += gridDim.x * NTHR) { const int c = e >> 10, k = e & 1023;
        const float w = c < 8 ? p.rg_w[k * 8 + c] * p.ffn_norm_w[k] : (c < 72 ? p.re_w[k * 64 + (c - 8)] * p.ffn_norm_w[k] : 0.f);
        const unsigned hb = f2bf(w); WrH[e] = (bf16_t)hb; WrL[e] = (bf16_t)f2bf(w - bf2f(hb)); }
    { float* lbt = (float*)(ws + WS_LBT); for (int k = blockIdx.x * NTHR + threadIdx.x; k < 1024; k += gridDim.x * NTHR) lbt[k] = 1.f / (1.f + expf(p.hg_lb[1024 + k] - p.hg_lb[k])); }
}

DEVI void phase1_bf16(unsigned char* ws, char* lds) { g8::DenseOrder S; S.init(ws + WS_H, D, ws + WS_WIN, D, T, NK16 * 1024); g8::Epi4<EpiZa> E{{ws}};
    g8::gemm_phase<g8::Epi4<EpiZa>, g8::DenseOrder, true>((G8_LAS unsigned char*)lds, D, D, D, S, E); }
DEVI void phase1_fp8(unsigned char* ws, char* lds) { g8::DenseOrder S; S.init(ws + WS_H8, D / 2, ws + WS_WIN8, D / 2, T, NK8 * 1024 + 2816); g8::Epi4<EpiZb> E{{ws}};
    g8::gemm_phase<g8::Epi4<EpiZb>, g8::DenseOrder, true, g8::NoHook, false, true>((G8_LAS unsigned char*)lds, D / 2, D / 2, D / 2, S, E, nullptr, g8::NoHook(), 1 << 30, 0, 125, 121); }
DEVI void phase1(const Params& p, char* lds) {
    if (((int)blockIdx.x >> 3) & 1) { phase1_fp8(p.ws, lds); phase1_bf16(p.ws, lds); } else { phase1_bf16(p.ws, lds); phase1_fp8(p.ws, lds); }
}

constexpr int HL_A = 0, HL_B = 17408, HL_BT = 34816, HL_VT = 53248, HL_AT = 71680, HL_ST = 80896, HL_SEG = 115712, HL_SS = 123904;
#define HG_BAR() do { asm volatile("s_waitcnt lgkmcnt(0)" ::: "memory"); __builtin_amdgcn_s_barrier(); asm volatile("" ::: "memory"); } while (0)
DEVI void hgrn_chain_mfma(const Params& p, char* lds, int b, int h) {
    const bf16_t* zh = (const bf16_t*)(p.ws + WS_ZH); unsigned char* oa = p.ws + WS_OA;
    const float* hgonw = (const float*)ptab(p.ws, PT_HGONW);
    const int tid = threadIdx.x, lane = tid & 63, wid = __builtin_amdgcn_readfirstlane(tid >> 6), fr = lane & 15, g4 = lane >> 4;
    const int k2 = lane * 2, seg = wid;
    f32x4 S[8];
#pragma unroll
    for (int n = 0; n < 8; ++n) S[n] = (f32x4){0.f, 0.f, 0.f, 0.f};
    const bf16_t* zb = zh + (size_t)b * SEQ * ZH_P + h * 128;
    float* lss = (float*)(lds + HL_SS);
    unsigned rq[8], rf[8], rv[8];
#pragma unroll
    for (int i = 0; i < 8; ++i) { const bf16_t* r = zb + (size_t)(seg * 8 + i) * ZH_P + k2; rq[i] = *(const unsigned*)r; rf[i] = *(const unsigned*)(r + 1024); rv[i] = *(const unsigned*)(r + 2048); }
    const int tt = wid >> 1, vh = wid & 1;
    f32x4 nwv[4];
#pragma unroll
    for (int n = 0; n < 4; ++n) nwv[n] = *(const f32x4*)(hgonw + 16 * (4 * vh + n) + 4 * g4);
    u32x2 gpre[4], gnext[4];
    { const bf16_t* gp_ = zh + ((size_t)b * SEQ + 16 * tt + fr) * ZH_P + 3072 + h * 128;
#pragma unroll
      for (int n = 0; n < 4; ++n) { gpre[n] = *(const u32x2*)(gp_ + 16 * (4 * vh + n) + 4 * g4); gnext[n] = gpre[n]; } }
    float cs[8][2], qq[8][2], kk[8][2], run[2]; u32x4 vtw[2];
#define HG_PREP1() do { run[0] = 0.f; run[1] = 0.f; \
        _Pragma("unroll") for (int i = 0; i < 8; ++i) _Pragma("unroll") for (int e = 0; e < 2; ++e) { const float lf = bf2f(e ? rf[i] >> 16 : rf[i] & 0xffffu); run[e] += lf; cs[i][e] = run[e]; kk[i][e] = 1.f - __expf(lf); qq[i][e] = bf2f(e ? rq[i] >> 16 : rq[i] & 0xffffu); } \
        _Pragma("unroll") for (int e = 0; e < 2; ++e) { \
            vtw[e].x = e ? (rv[0] >> 16) | (rv[1] & 0xffff0000u) : (rv[0] & 0xffffu) | (rv[1] << 16); vtw[e].y = e ? (rv[2] >> 16) | (rv[3] & 0xffff0000u) : (rv[2] & 0xffffu) | (rv[3] << 16); \
            vtw[e].z = e ? (rv[4] >> 16) | (rv[5] & 0xffff0000u) : (rv[4] & 0xffffu) | (rv[5] << 16); vtw[e].w = e ? (rv[6] >> 16) | (rv[7] & 0xffff0000u) : (rv[6] & 0xffffu) | (rv[7] << 16); } } while (0)
    HG_PREP1();
#if defined(TPROBE_A)
    unsigned long long tacc[6] = {0, 0, 0, 0, 0, 0}; unsigned long long tprev = __builtin_amdgcn_s_memrealtime();
#define HG_T(k) do { const unsigned long long now_ = __builtin_amdgcn_s_memrealtime(); tacc[k] += now_ - tprev; tprev = now_; } while (0)
#else
#define HG_T(k)
#endif
#pragma unroll 1
    for (int c = 0; c < SEQ / 64; ++c) {
        const int t0 = c * 64; float* segs = (float*)(lds + HL_SEG) + (c & 1) * 1024;
        HG_T(0);
        *(float2*)(segs + seg * 128 + k2) = make_float2(run[0], run[1]);
        HG_BAR();
        HG_T(1);
#pragma unroll
        for (int e = 0; e < 2; ++e) *(u32x4*)(lds + HL_VT + (k2 + e) * 144 + seg * 16) = vtw[e];
        {
            float off[2] = {0.f, 0.f}, bm[2] = {0.f, 0.f};
#pragma unroll
            for (int s_ = 0; s_ < 8; ++s_) { const float2 v = *(const float2*)(segs + s_ * 128 + k2); if (s_ < seg) { off[0] += v.x; off[1] += v.y; } if (s_ < 4) { bm[0] += v.x; bm[1] += v.y; } }
            unsigned bt[2][4];
#pragma unroll
            for (int i = 0; i < 8; ++i) { float av[2], bv[2];
#pragma unroll
                for (int e = 0; e < 2; ++e) { const float ea = __expf(cs[i][e] + off[e] - bm[e]); av[e] = qq[i][e] * ea; bv[e] = kk[i][e] * __builtin_amdgcn_rcpf(ea); }
                *(unsigned*)(lds + HL_A + (seg * 8 + i) * 272 + k2 * 2) = pk2(av[0], av[1]);
                const unsigned pb = pk2(bv[0], bv[1]); *(unsigned*)(lds + HL_B + (seg * 8 + i) * 272 + k2 * 2) = pb;
                if (i & 1) { bt[0][i >> 1] |= pb << 16; bt[1][i >> 1] |= pb & 0xffff0000u; } else { bt[0][i >> 1] = pb & 0xffffu; bt[1][i >> 1] = pb >> 16; } }
#pragma unroll
            for (int e = 0; e < 2; ++e) { u32x4 w = {bt[e][0], bt[e][1], bt[e][2], bt[e][3]}; *(u32x4*)(lds + HL_BT + (k2 + e) * 144 + seg * 16) = w; }
        }
        f32x4 bmid = {0.f, 0.f, 0.f, 0.f}, blast = {0.f, 0.f, 0.f, 0.f};
#pragma unroll
        for (int s_ = 0; s_ < 8; ++s_) { const f32x4 v = *(const f32x4*)(segs + s_ * 128 + 16 * wid + 4 * g4); blast += v; if (s_ < 4) bmid += v; }
        {
            f32x4 em; em[0] = __expf(bmid[0]); em[1] = __expf(bmid[1]); em[2] = __expf(bmid[2]); em[3] = __expf(bmid[3]);
#pragma unroll
            for (int n = 0; n < 8; ++n) { u32x2 w; w.x = pk2(S[n][0] * em[0], S[n][1] * em[1]); w.y = pk2(S[n][2] * em[2], S[n][3] * em[3]); *(u32x2*)(lds + HL_ST + (16 * n + fr) * 272 + (16 * wid + 4 * g4) * 2) = w; }
        }
        {
            const int tn = (c + 1 < SEQ / 64) ? t0 + 64 : t0;
#pragma unroll
            for (int i = 0; i < 8; ++i) { const bf16_t* r = zb + (size_t)(tn + seg * 8 + i) * ZH_P + k2; rq[i] = *(const unsigned*)r; rf[i] = *(const unsigned*)(r + 1024); rv[i] = *(const unsigned*)(r + 2048); }
            const bf16_t* gp_ = zh + ((size_t)b * SEQ + tn + 16 * tt + fr) * ZH_P + 3072 + h * 128;
#pragma unroll
            for (int n = 0; n < 4; ++n) gnext[n] = *(const u32x2*)(gp_ + 16 * (4 * vh + n) + 4 * g4);
        }
        HG_BAR();
        HG_T(2);
#define HG_LD(off) (*(const bf16x8*)(lds + (off)))
#define HG_FENCE() do { asm volatile("s_waitcnt lgkmcnt(0)" ::: "memory"); __builtin_amdgcn_sched_barrier(0); } while (0)
        {
            bf16x8 fa[4], fb0[4], fb1[4]; const int ss0 = 2 * vh, ss1 = 2 * vh + 1;
#pragma unroll
            for (int kk4 = 0; kk4 < 4; ++kk4) { fa[kk4] = HG_LD(HL_A + (16 * tt + fr) * 272 + (32 * kk4 + 8 * g4) * 2); fb0[kk4] = HG_LD(HL_B + (16 * ss0 + fr) * 272 + (32 * kk4 + 8 * g4) * 2); fb1[kk4] = HG_LD(HL_B + (16 * ss1 + fr) * 272 + (32 * kk4 + 8 * g4) * 2); }
            HG_FENCE();
            f32x4 acc0 = {0.f, 0.f, 0.f, 0.f}, acc1 = {0.f, 0.f, 0.f, 0.f};
#pragma unroll
            for (int kk4 = 0; kk4 < 4; ++kk4) { acc0 = __builtin_amdgcn_mfma_f32_16x16x32_bf16(fb0[kk4], fa[kk4], acc0, 0, 0, 0); acc1 = __builtin_amdgcn_mfma_f32_16x16x32_bf16(fb1[kk4], fa[kk4], acc1, 0, 0, 0); }
#pragma unroll
            for (int i = 0; i < 4; ++i) { if (ss0 > tt || (ss0 == tt && 4 * g4 + i > fr)) acc0[i] = 0.f; if (ss1 > tt || (ss1 == tt && 4 * g4 + i > fr)) acc1[i] = 0.f; }
            u32x2 w; w.x = pk2(acc0[0], acc0[1]); w.y = pk2(acc0[2], acc0[3]); *(u32x2*)(lds + HL_AT + (16 * tt + fr) * 144 + (16 * ss0 + 4 * g4) * 2) = w;
            w.x = pk2(acc1[0], acc1[1]); w.y = pk2(acc1[2], acc1[3]); *(u32x2*)(lds + HL_AT + (16 * tt + fr) * 144 + (16 * ss1 + 4 * g4) * 2) = w;
        }
        HG_BAR();
        HG_T(3);
        f32x4 o[4];
#pragma unroll
        for (int n = 0; n < 4; ++n) o[n] = (f32x4){0.f, 0.f, 0.f, 0.f};
        {
            bf16x8 fat[2], fa[4];
#pragma unroll
            for (int ks = 0; ks < 2; ++ks) fat[ks] = HG_LD(HL_AT + (16 * tt + fr) * 144 + (32 * ks + 8 * g4) * 2);
#pragma unroll
            for (int kk4 = 0; kk4 < 4; ++kk4) fa[kk4] = HG_LD(HL_A + (16 * tt + fr) * 272 + (32 * kk4 + 8 * g4) * 2);
#pragma unroll
            for (int nh = 0; nh < 2; ++nh) {
                bf16x8 fv[2][2], fs[2][4];
#pragma unroll
                for (int n2 = 0; n2 < 2; ++n2) { const int vrow = 16 * (4 * vh + 2 * nh + n2) + fr;
#pragma unroll
                    for (int ks = 0; ks < 2; ++ks) fv[n2][ks] = HG_LD(HL_VT + vrow * 144 + (32 * ks + 8 * g4) * 2);
#pragma unroll
                    for (int kk4 = 0; kk4 < 4; ++kk4) fs[n2][kk4] = HG_LD(HL_ST + vrow * 272 + (32 * kk4 + 8 * g4) * 2); }
                HG_FENCE();
#pragma unroll
                for (int ks = 0; ks < 2; ++ks)
#pragma unroll
                    for (int n2 = 0; n2 < 2; ++n2) o[2 * nh + n2] = __builtin_amdgcn_mfma_f32_16x16x32_bf16(fv[n2][ks], fat[ks], o[2 * nh + n2], 0, 0, 0);
#pragma unroll
                for (int kk4 = 0; kk4 < 4; ++kk4)
#pragma unroll
                    for (int n2 = 0; n2 < 2; ++n2) o[2 * nh + n2] = __builtin_amdgcn_mfma_f32_16x16x32_bf16(fs[n2][kk4], fa[kk4], o[2 * nh + n2], 0, 0, 0);
            }
        }
        { float ssq = 0.f;
#pragma unroll
          for (int n = 0; n < 4; ++n) ssq += o[n][0] * o[n][0] + o[n][1] * o[n][1] + o[n][2] * o[n][2] + o[n][3] * o[n][3];
          ssq += __shfl_xor(ssq, 16); ssq += __shfl_xor(ssq, 32); if (g4 == 0) lss[vh * 64 + 16 * tt + fr] = ssq; }
        {
            f32x4 U[8]; bf16x8 fbt[2], fv[8][2];
#pragma unroll
            for (int ks = 0; ks < 2; ++ks) { fbt[ks] = HG_LD(HL_BT + (16 * wid + fr) * 144 + (32 * ks + 8 * g4) * 2);
#pragma unroll
                for (int n = 0; n < 8; ++n) fv[n][ks] = HG_LD(HL_VT + (16 * n + fr) * 144 + (32 * ks + 8 * g4) * 2); }
            HG_FENCE();
#pragma unroll
            for (int n = 0; n < 8; ++n) { U[n] = __builtin_amdgcn_mfma_f32_16x16x32_bf16(fbt[0], fv[n][0], (f32x4){0.f, 0.f, 0.f, 0.f}, 0, 0, 0); }
#pragma unroll
            for (int n = 0; n < 8; ++n) { U[n] = __builtin_amdgcn_mfma_f32_16x16x32_bf16(fbt[1], fv[n][1], U[n], 0, 0, 0); }
            f32x4 el, elm;
#pragma unroll
            for (int i = 0; i < 4; ++i) { el[i] = __expf(blast[i]); elm[i] = __expf(blast[i] - bmid[i]); }
#pragma unroll
            for (int n = 0; n < 8; ++n) S[n] = S[n] * el + U[n] * elm;
        }
#undef HG_LD
#undef HG_FENCE
        HG_BAR();
        HG_T(4);
        {
#pragma unroll
            for (int i = 0; i < 8; ++i) asm volatile("" : "+v"(rq[i]), "+v"(rf[i]), "+v"(rv[i]));
            HG_PREP1(); }
        {
            const int t = 16 * tt + fr; const float rstd = rsqrtf((lss[t] + lss[64 + t]) * (1.f / 128.f) + 1e-6f);
            const size_t trow = (size_t)b * SEQ + t0 + t; unsigned char* op = oa + trow * 1024 + h * 128;
#pragma unroll
            for (int n = 0; n < 4; ++n) { const int v0 = 16 * (4 * vh + n) + 4 * g4; const u32x2 gg = gpre[n]; const f32x4 nw = nwv[n];
                f32x4 r; r[0] = o[n][0] * rstd * nw[0] * bf2f(gg.x & 0xffffu); r[1] = o[n][1] * rstd * nw[1] * bf2f(gg.x >> 16);
                r[2] = o[n][2] * rstd * nw[2] * bf2f(gg.y & 0xffffu); r[3] = o[n][3] * rstd * nw[3] * bf2f(gg.y >> 16);
#pragma unroll
                for (int i = 0; i < 4; ++i) r[i] = __builtin_amdgcn_fmed3f(16.f * r[i], -440.f, 440.f);
                *(unsigned*)(op + v0) = pk4_fp8(r[0], r[1], r[2], r[3]); }
        }
#pragma unroll
        for (int n = 0; n < 4; ++n) gpre[n] = gnext[n];
        HG_T(5);
    }
#undef HG_PREP1
#if defined(TPROBE_A)
    if (blockIdx.x == 0 && threadIdx.x == 0) { unsigned long long* ts = (unsigned long long*)(p.ws + WS_TS); for (int k = 0; k < 6; ++k) { ts[20 + 2 * k] = 0; ts[21 + 2 * k] = tacc[k]; } }
#endif
    HG_BAR();
}
#undef HG_BAR
DEVI void conv_tile256(const float* colp, size_t rs, const float* kscale, bf16_t* dst, int ldk, float* scr) {
    const int tid = threadIdx.x;
    { const int nl = tid & 63, kq = tid >> 6;
      float v[32];
#pragma unroll
      for (int i = 0; i < 32; ++i) v[i] = colp[(size_t)(kq * 32 + i) * rs];
      if (kscale) {
#pragma unroll
          for (int i = 0; i < 32; ++i) v[i] *= kscale[kq * 32 + i]; }
#pragma unroll
      for (int i = 0; i < 32; ++i) scr[(kq * 32 + i) * 65 + nl] = v[i]; }
    __syncthreads();
    { const int nl = tid >> 3, kc = tid & 7;
#pragma unroll
      for (int j = 0; j < 4; ++j) { const float* s_ = scr + (kc * 8 + 64 * j) * 65 + nl;
          u32x4 o; o.x = pk2(s_[0], s_[65]); o.y = pk2(s_[2 * 65], s_[3 * 65]); o.z = pk2(s_[4 * 65], s_[5 * 65]); o.w = pk2(s_[6 * 65], s_[7 * 65]);
          *(u32x4*)(dst + (size_t)nl * ldk + kc * 8 + 64 * j) = o; } }
    __syncthreads();
}
DEVI void conv_tile256_f8(const float* colp4, size_t rs, const float* kscale, float wscale, unsigned char* dst, int ldk, float* scr) {
    const int tid = threadIdx.x;
    { const int n4 = tid & 15, kr = tid >> 4; f32x4 v[8];
#pragma unroll
      for (int i = 0; i < 8; ++i) v[i] = *(const f32x4*)(colp4 + (size_t)(kr + 32 * i) * rs);
#pragma unroll
      for (int i = 0; i < 8; ++i) { const float sc = kscale ? kscale[kr + 32 * i] * wscale : wscale; float* d = scr + (kr + 32 * i) * 65 + 4 * n4; d[0] = v[i][0] * sc; d[1] = v[i][1] * sc; d[2] = v[i][2] * sc; d[3] = v[i][3] * sc; } }
    __syncthreads();
    { const int nl = tid >> 3, kc = tid & 7;
#pragma unroll
      for (int j = 0; j < 4; ++j) { const float* s_ = scr + (kc * 8 + 64 * j) * 65 + nl;
          u32x2 o; o.x = pk4_fp8(s_[0], s_[65], s_[2 * 65], s_[3 * 65]); o.y = pk4_fp8(s_[4 * 65], s_[5 * 65], s_[6 * 65], s_[7 * 65]);
          *(u32x2*)(dst + (size_t)nl * ldk + kc * 8 + 64 * j) = o; } }
    __syncthreads();
}
DEVI void mla_prep(const Params& p, int chunk) {
    bf16_t* zl = (bf16_t*)(p.ws + WS_ZL); float* cosT = (float*)(p.ws + WS_COS); float* sinT = (float*)(p.ws + WS_SIN); const int* posp = (const int*)ptab(p.ws, PT_POS);
    const int lane = threadIdx.x & 63, wid = threadIdx.x >> 6;
    for (int rr = wid; rr < 256; rr += 8) { const size_t t = (size_t)chunk * 256 + rr; bf16_t* zr = zl + t * ZL_P;
        float cq[6], ck[4]; float s = 0.f, s2 = 0.f;
#pragma unroll
        for (int j = 0; j < 6; ++j) { cq[j] = bf2f(zr[lane + 64 * j]); s += cq[j] * cq[j]; }
#pragma unroll
        for (int j = 0; j < 4; ++j) { ck[j] = bf2f(zr[384 + lane + 64 * j]); s2 += ck[j] * ck[j]; }
        const float kr = bf2f(zr[640 + lane]);
        const float r1 = rsqrtf(wave_sum(s) * (1.f / 384.f) + 1e-6f), r2 = rsqrtf(wave_sum(s2) * (1.f / 256.f) + 1e-6f);
        const float other = __shfl_xor(kr, 32);
        const int i = lane & 31; const float invf = powf(10000.f, -(float)i / 32.f); const float ang = (float)posp[t] * invf; const float cs = cosf(ang), sn = sinf(ang);
        const float x1 = lane < 32 ? kr : other, x2 = lane < 32 ? other : kr;
        const float outv = lane < 32 ? (x1 * cs - x2 * sn) : (x2 * cs + x1 * sn);
#pragma unroll
        for (int j = 0; j < 6; ++j) zr[lane + 64 * j] = (bf16_t)f2bf(cq[j] * r1);
#pragma unroll
        for (int j = 0; j < 4; ++j) zr[384 + lane + 64 * j] = (bf16_t)f2bf(ck[j] * r2);
        ((bf16_t*)(p.ws + WS_KPE))[t * 64 + 2 * i + (lane >> 5)] = (bf16_t)f2bf(outv);
        if (lane < 32) { cosT[t * 32 + i] = cs; sinT[t * 32 + i] = sn; }
    }
}
constexpr int N13_EARLY = 4096;
DEVI void w13_tile(unsigned char* ws, const float* ew1, const float* ew3, const float* ffnw, int ci, int nl, float* scr) {
    const int e = ci >> 6, r = ci & 63, nb = r >> 2, kb = r & 3, n = nb * 64 + 4 * (nl & 15);
    const float* colp = ((n & 4) ? ew3 : ew1) + (size_t)e * 1024 * 512 + (size_t)(kb * 256) * 512 + (n >> 3) * 4;
    conv_tile256_f8(colp, 512, ffnw + kb * 256, 64.f, ws + WS_W13 + ((size_t)e * 1024 + nb * 64) * 1024 + kb * 256, 1024, scr);
}
DEVI ConvDesc w13_desc(unsigned char* ws, const float* ew1, const float* ew3, const float* ffnw, int ci) {
    const int e = ci >> 6, r = ci & 63, nb = r >> 2, kb = r & 3, n = nb * 64 + 4 * ((int)threadIdx.x & 15);
    return {((n & 4) ? ew3 : ew1) + (size_t)e * 1024 * 512 + (size_t)(kb * 256) * 512 + (n >> 3) * 4, 512, ffnw + kb * 256, ws + WS_W13 + ((size_t)e * 1024 + nb * 64) * 1024 + kb * 256, 1024};
}
DEVI ConvDesc w2_desc(unsigned char* ws, const float* ew2, int ci) {
    const int e = ci >> 5, r = ci & 31, nb = r >> 1, kb = r & 1, n4x = 4 * ((int)threadIdx.x & 15), s_ = nb * 64 + n4x;
    const int rho = (s_ & ~255) + ((s_ >> 3) & 1) * 128 + ((s_ >> 6) & 3) * 32 + ((s_ >> 4) & 3) * 8 + (s_ & 7);
    return {ew2 + (size_t)e * 512 * 1024 + (size_t)(kb * 256) * 1024 + s_, 1024, nullptr, ws + WS_W2 + ((long)e * 1024 + rho - n4x) * EFF + kb * 256, EFF};
}
DEVI void flag_signal(unsigned* flag) {
    asm volatile("s_waitcnt vmcnt(0)" ::: "memory"); __syncthreads();
    if (threadIdx.x == 0) { __builtin_amdgcn_fence(__ATOMIC_RELEASE, "agent"); asm volatile("s_waitcnt vmcnt(0)" ::: "memory"); (void)__hip_atomic_fetch_add(flag, 1u, __ATOMIC_RELAXED, __HIP_MEMORY_SCOPE_AGENT); }
}
DEVI void flag_wait(unsigned* flag, unsigned target) {
    if (threadIdx.x == 0) { unsigned sp = 0u; while (__hip_atomic_load(flag, __ATOMIC_RELAXED, __HIP_MEMORY_SCOPE_AGENT) < target && ++sp < (1u << 24)) __builtin_amdgcn_s_sleep(2);
        __builtin_amdgcn_fence(__ATOMIC_ACQUIRE, "agent"); asm volatile("s_waitcnt vmcnt(0)" ::: "memory"); }
    __syncthreads();
}
constexpr int LDS_DQ = 131072;
DEVI void phase2a(const Params& p, char* lds, bool prep = true) {
    unsigned* pflag = (unsigned*)(p.ws + WS_CTL) + CW_CNT + 64 * CNT_STRIDE;
#pragma unroll 1
    for (int it = blockIdx.x; it < 128; it += gridDim.x) {
        hgrn_chain_mfma(p, lds, it >> 3, it & 7);
#if defined(TPROBE_A)
        if (TPROBE_A == 12 && blockIdx.x == 0 && threadIdx.x == 0) ((unsigned long long*)(p.ws + WS_TS))[13] = __builtin_amdgcn_s_memrealtime();
#endif
    }
#pragma unroll 1
    for (int it = blockIdx.x; it < 256; it += gridDim.x) { if (it < 128) continue;
#if defined(TPROBE_A)
        unsigned long long tq0_ = __builtin_amdgcn_s_memrealtime();
#endif
        if (prep) { mla_prep(p, it - 128); flag_signal(pflag); }
#if defined(TPROBE_A)
        if (blockIdx.x == 128 && threadIdx.x == 0) { const unsigned long long n_ = __builtin_amdgcn_s_memrealtime(); unsigned long long* ts = (unsigned long long*)(p.ws + WS_TS); ts[60] = 0; ts[61] = n_ - tq0_; tq0_ = n_; }
#endif
        const float* ew1 = (const float*)ptab(p.ws, PT_EW1); const float* ew3 = (const float*)ptab(p.ws, PT_EW3); const float* ffnw = (const float*)ptab(p.ws, PT_FFNW);
        __syncthreads();
        { unsigned char* ws_ = p.ws; conv_stream_f8(it - 128, N13_EARLY, 128, 64.f, (float*)lds, [=](int ci) { return w13_desc(ws_, ew1, ew3, ffnw, ci); }); }
#if defined(TPROBE_A)
        if (blockIdx.x == 128 && threadIdx.x == 0) { const unsigned long long n_ = __builtin_amdgcn_s_memrealtime(); unsigned long long* ts = (unsigned long long*)(p.ws + WS_TS); ts[62] = 0; ts[63] = n_ - tq0_; }
#endif
    }
    if (!prep) return;
    flag_wait(pflag, 128u);
    { unsigned char* ws = p.ws;
      g8::DynOrder S; S.init(ws + WS_ZL, ZL_P, ws + WS_WUQ, 384, 1536, 768, pflag + CNT_STRIDE, (volatile G8_LAS int*)((G8_LAS unsigned char*)lds + LDS_DQ));
      g8::Epi4<EpiQ> E{{(bf16_t*)p.out}};
      g8::gemm_phase<g8::Epi4<EpiQ>, g8::DynOrder, true>((G8_LAS unsigned char*)lds, ZL_P, 384, 384, S, E); }
}

DEVI void phase2b(const Params& p, char* lds) {
    unsigned char* ws = p.ws;
    { g8::DenseOrder S; S.init(ws + WS_ZL + 384 * 2, ZL_P, ws + WS_WUKV, 256, T, 2048);
      g8::Epi4<EpiKV> E{{(bf16_t*)(ws + WS_KN), (bf16_t*)(ws + WS_V)}};
      g8::gemm_phase<g8::Epi4<EpiKV>, g8::DenseOrder, true>((G8_LAS unsigned char*)lds, ZL_P, 256, 256, S, E); }
}

namespace at2 {
typedef short s16x4 __attribute__((ext_vector_type(4)));
typedef float f32x16 __attribute__((ext_vector_type(16)));
constexpr int KROW = 384;
constexpr int SHM_K = 64 * KROW, SHM_V = 64 * 256;
constexpr int L_V = 0, L_K = 3 * SHM_V, L_WS = 3 * SHM_V + 2 * SHM_K;
constexpr float THR = 8.f;
#define AT_KSWZ(row, colB) ((row) * at2::KROW + ((colB) ^ ((((((row) >> 3) & 3) << 1) | (((row) >> 1) & 1)) << 4)))
DEVI int v_st(int k, int c) { const int kk = (k & ~0xC) | ((k & 4) << 1) | ((k & 8) >> 1); return ((kk >> 3) * 4 + (c >> 5)) * 512 + ((kk & 7) * 32 + (c & 31)) * 2; }
DEVI int v_rd_base(int lane) { return ((lane & 3) << 3) | (((lane >> 2) & 3) << 6) | (((lane >> 4) & 1) << 5) | (((lane >> 5) & 1) << 8); }
constexpr int v_rd_off(int d0, int ks, int half) { return d0 * 512 + ks * 4096 + half * 2048; }
DEVI int crow(int r, int hi) { return (r & 3) + 8 * (r >> 2) + 4 * hi; }
DEVI unsigned cvtpk(float lo, float hi) { unsigned r; asm volatile("v_cvt_pk_bf16_f32 %0, %1, %2" : "=v"(r) : "v"(lo), "v"(hi)); return r; }
DEVI void mask_tile(f32x16& p0, f32x16& p1, int dq) {
    const float NEG = -__builtin_inff();
#pragma unroll
    for (int r = 0; r < 16; ++r) { const int c = (r & 3) + 8 * (r >> 2); if (dq - c < 0) p0[r] = NEG; if (dq - c - 32 < 0) p1[r] = NEG; }
}
DEVI void partialSM(f32x16& p0, f32x16& p1, float& m_reg, float& mn, float& alpha) {
    float pmax = p0[0];
#pragma unroll
    for (int r = 1; r < 16; ++r) pmax = fmaxf(pmax, p0[r]);
#pragma unroll
    for (int r = 0; r < 16; ++r) pmax = fmaxf(pmax, p1[r]);
    { auto rr = __builtin_amdgcn_permlane32_swap(__float_as_uint(pmax), __float_as_uint(pmax), false, false); pmax = fmaxf(__uint_as_float(rr[0]), __uint_as_float(rr[1])); }
    constexpr float C2 = 1.4426950408889634f;
    if (__builtin_expect(__all((pmax - m_reg) <= THR), 1)) { mn = m_reg; alpha = 1.f; }
    else { mn = fmaxf(m_reg, pmax); alpha = __builtin_amdgcn_exp2f((m_reg - mn) * C2); m_reg = mn; }
    const float mnL = -mn * C2;
#pragma unroll
    for (int r = 0; r < 16; ++r) p0[r] = fmaf(p0[r], C2, mnL);
#pragma unroll
    for (int r = 0; r < 16; ++r) p1[r] = fmaf(p1[r], C2, mnL);
#pragma unroll
    for (int r = 0; r < 16; ++r) p0[r] = __builtin_amdgcn_exp2f(p0[r]);
}
DEVI void finishSM(f32x16& p0, f32x16& p1, float alpha, float& l_reg, bf16x8& pa0, bf16x8& pa1, bf16x8& pa2, bf16x8& pa3) {
#pragma unroll
    for (int r = 0; r < 16; ++r) p1[r] = __builtin_amdgcn_exp2f(p1[r]);
    float ps = 0;
#pragma unroll
    for (int r = 0; r < 16; ++r) ps += p0[r];
#pragma unroll
    for (int r = 0; r < 16; ++r) ps += p1[r];
    { auto rr = __builtin_amdgcn_permlane32_swap(__float_as_uint(ps), __float_as_uint(ps), false, false); ps = __uint_as_float(rr[0]) + __uint_as_float(rr[1]); }
    l_reg = l_reg * alpha + ps;
#define AT_PK4(P, B_, OUT) do { unsigned a0 = cvtpk(P[B_+0], P[B_+1]), a1 = cvtpk(P[B_+2], P[B_+3]); unsigned b0 = cvtpk(P[B_+4], P[B_+5]), b1 = cvtpk(P[B_+6], P[B_+7]); \
        auto r0 = __builtin_amdgcn_permlane32_swap(a0, b0, false, false); auto r1 = __builtin_amdgcn_permlane32_swap(a1, b1, false, false); \
        u32x4 w = {r0[0], r1[0], r0[1], r1[1]}; OUT = *reinterpret_cast<bf16x8*>(&w); } while (0)
    AT_PK4(p0, 0, pa0); AT_PK4(p0, 8, pa1); AT_PK4(p1, 0, pa2); AT_PK4(p1, 8, pa3);
#undef AT_PK4
}
template <int KB>
DEVI void qkt(f32x16& p0, f32x16& p1, const char* K_lds, int r32, int hi, const bf16x8* qr) {
    p0 = f32x16{}; p1 = f32x16{};
    const char* kb[4];
#pragma unroll
    for (int dd = 0; dd < 4; ++dd) kb[dd] = K_lds + KB * SHM_K + AT_KSWZ(r32, (dd * 16 + hi * 8) * 2);
    bf16x8 ra[4], rb[4];
#define AT_KRD(d_) do { const char* a_ = kb[(d_) & 3] + ((d_) >> 2) * 128; ra[(d_) & 3] = *reinterpret_cast<const bf16x8*>(a_); rb[(d_) & 3] = *reinterpret_cast<const bf16x8*>(a_ + 32 * KROW); } while (0)
    AT_KRD(0); AT_KRD(1); AT_KRD(2);
#pragma unroll
    for (int d0 = 0; d0 < 12; ++d0) {
        if (d0 + 3 < 12) AT_KRD(d0 + 3);
        __builtin_amdgcn_sched_barrier(0);
        p0 = __builtin_amdgcn_mfma_f32_32x32x16_bf16(ra[d0 & 3], qr[d0], p0, 0, 0, 0); p1 = __builtin_amdgcn_mfma_f32_32x32x16_bf16(rb[d0 & 3], qr[d0], p1, 0, 0, 0);
        __builtin_amdgcn_sched_barrier(0); }
#undef AT_KRD
}
DEVI void pv_tile(f32x16* o, int vb0, bf16x8 pa0, bf16x8 pa1, bf16x8 pa2, bf16x8 pa3) {
#define AT_TRRD(dst, off) asm volatile("ds_read_b64_tr_b16 %0, %1 offset:%2" : "=&v"(dst) : "v"(vb0), "i"(off) : "memory")
#define AT_PV_RD(S, d0) do { constexpr int b_ = v_rd_off(d0, 0, 0); AT_TRRD(S##l0, b_); AT_TRRD(S##h0, b_ + 2048); AT_TRRD(S##l1, b_ + 4096); AT_TRRD(S##h1, b_ + 6144); \
        AT_TRRD(S##l2, b_ + 8192); AT_TRRD(S##h2, b_ + 10240); AT_TRRD(S##l3, b_ + 12288); AT_TRRD(S##h3, b_ + 14336); } while (0)
#define AT_PV_MM(S, d0) do { \
        o[d0] = __builtin_amdgcn_mfma_f32_32x32x16_bf16(pa0, (bf16x8){S##l0[0], S##l0[1], S##l0[2], S##l0[3], S##h0[0], S##h0[1], S##h0[2], S##h0[3]}, o[d0], 0, 0, 0); \
        o[d0] = __builtin_amdgcn_mfma_f32_32x32x16_bf16(pa1, (bf16x8){S##l1[0], S##l1[1], S##l1[2], S##l1[3], S##h1[0], S##h1[1], S##h1[2], S##h1[3]}, o[d0], 0, 0, 0); \
        o[d0] = __builtin_amdgcn_mfma_f32_32x32x16_bf16(pa2, (bf16x8){S##l2[0], S##l2[1], S##l2[2], S##l2[3], S##h2[0], S##h2[1], S##h2[2], S##h2[3]}, o[d0], 0, 0, 0); \
        o[d0] = __builtin_amdgcn_mfma_f32_32x32x16_bf16(pa3, (bf16x8){S##l3[0], S##l3[1], S##l3[2], S##l3[3], S##h3[0], S##h3[1], S##h3[2], S##h3[3]}, o[d0], 0, 0, 0); } while (0)
#define AT_PV_WAIT(n) do { asm volatile("s_waitcnt lgkmcnt(" #n ")" ::: "memory"); __builtin_amdgcn_sched_barrier(0); } while (0)
    s16x4 Al0, Al1, Al2, Al3, Ah0, Ah1, Ah2, Ah3, Bl0, Bl1, Bl2, Bl3, Bh0, Bh1, Bh2, Bh3;
    AT_PV_RD(A, 0);
    AT_PV_RD(B, 1); AT_PV_WAIT(8); AT_PV_MM(A, 0); __builtin_amdgcn_sched_barrier(0);
    AT_PV_RD(A, 2); AT_PV_WAIT(8); AT_PV_MM(B, 1); __builtin_amdgcn_sched_barrier(0);
    AT_PV_RD(B, 3); AT_PV_WAIT(8); AT_PV_MM(A, 2); __builtin_amdgcn_sched_barrier(0);
    AT_PV_WAIT(0); AT_PV_MM(B, 3);
#undef AT_PV_RD
#undef AT_PV_MM
#undef AT_PV_WAIT
#undef AT_TRRD
}
DEVI void block(const Params& p, char* lds, int b, int h, int qb) {
    const bf16_t* q = (const bf16_t*)p.out; const bf16_t* kn = (const bf16_t*)(p.ws + WS_KN); const bf16_t* vg = (const bf16_t*)(p.ws + WS_V);
    const bf16_t* kpe = (const bf16_t*)(p.ws + WS_KPE); unsigned char* ob = p.ws + WS_OB;
    const int tid = threadIdx.x, wid = __builtin_amdgcn_readfirstlane(tid >> 6), lane = tid & 63, r32 = lane & 31, hi = lane >> 5;
    const size_t tb = (size_t)b * SEQ; const int P0 = qb * 256, NT = (P0 + 256) / 64;
    char* V_lds = lds + L_V; char* K_lds = lds + L_K; float* ws = (float*)(lds + L_WS) + wid * 64; float* li_l = ws; float* al_l = ws + 32;
    const int qlo = P0 + wid * 32, qm = qlo + r32 - 4 * hi;
    const int sr = tid >> 4, sc = (tid & 15) * 8, vst0 = v_st(sr, sc), vst1 = v_st(32 + sr, sc);
    const int kd0 = AT_KSWZ(sr, sc * 2), kd2 = AT_KSWZ(tid >> 3, 256 + (tid & 7) * 16);
    int tido = tid; asm volatile("" : "+v"(tido));
    const int sro = tido >> 4, sco = (tido & 15) * 8;
    const bf16_t* knp = kn + (tb + sro) * 1024 + h * 128 + sco; const bf16_t* vp = vg + (tb + sro) * 1024 + h * 128 + sco; const bf16_t* kpp = kpe + (tb + (tido >> 3)) * 64 + (tido & 7) * 8;
    const int vb0 = (int)(uintptr_t)V_lds + v_rd_base(lane);
    bf16x8 stk[3], stv[2];
#define AT_LOAD(t_) do { const size_t o_ = (size_t)(t_) * 64; stk[0] = *(const bf16x8*)(knp + o_ * 1024); stk[1] = *(const bf16x8*)(knp + (o_ + 32) * 1024); stk[2] = *(const bf16x8*)(kpp + o_ * 64); \
        stv[0] = *(const bf16x8*)(vp + o_ * 1024); stv[1] = *(const bf16x8*)(vp + (o_ + 32) * 1024); } while (0)
#define AT_WRITE(bf, voff) do { *(bf16x8*)(K_lds + (bf) * SHM_K + kd0) = stk[0]; *(bf16x8*)(K_lds + (bf) * SHM_K + kd0 + 32 * KROW) = stk[1]; *(bf16x8*)(K_lds + (bf) * SHM_K + kd2) = stk[2]; \
        *(bf16x8*)(V_lds + (voff) + vst0) = stv[0]; *(bf16x8*)(V_lds + (voff) + vst1) = stv[1]; } while (0)
    AT_LOAD(0);
    bf16x8 qr[12];
    { const bf16_t* qrow = q + (tb + qlo + r32) * 1536 + h * 192;
#pragma unroll
      for (int d0 = 0; d0 < 12; ++d0) qr[d0] = *(const bf16x8*)(qrow + d0 * 16 + hi * 8);
      int r32o = r32; asm volatile("" : "+v"(r32o));
      const float* cosT = (const float*)(p.ws + WS_COS) + (tb + qlo + r32o) * 32; const float* sinT = cosT + (WS_SIN - WS_COS) / 4;
#pragma unroll
      for (int d0 = 8; d0 < 12; ++d0) { const f32x4 cs = *(const f32x4*)(cosT + 8 * (d0 - 8) + 4 * hi), sn = *(const f32x4*)(sinT + 8 * (d0 - 8) + 4 * hi); u32x4 w = __builtin_bit_cast(u32x4, qr[d0]);
#pragma unroll
          for (int jj = 0; jj < 4; ++jj) { const float x1 = bf2f(w[jj] & 0xffffu), x2 = bf2f(w[jj] >> 16); w[jj] = pk2(x1 * cs[jj] - x2 * sn[jj], x2 * cs[jj] + x1 * sn[jj]); }
          qr[d0] = __builtin_bit_cast(bf16x8, w); asm volatile("" ::: "memory"); } }
    float m_reg = -1e30f, l_reg = 0.f; f32x16 o[4] = {};
    __syncthreads();
    AT_WRITE(0, 0);
    __syncthreads();
    const bool skew = wid >= 4; int vprev = 2 * SHM_V, vcur = 0, vnext = SHM_V; bf16x8 pp0, pp1, pp2, pp3;
#define AT_RESC(a) do { if (__any((a) < 1.f)) { if (hi == 0) al_l[r32] = (a); asm volatile("s_waitcnt lgkmcnt(0)" ::: "memory"); \
        _Pragma("unroll") for (int d_ = 0; d_ < 4; ++d_) _Pragma("unroll") for (int r = 0; r < 16; ++r) o[d_][r] *= al_l[crow(r, hi)]; } } while (0)
#define AT_STEP(t_, BF) do { const int tq = (t_); if (tq + 1 < NT) AT_LOAD(tq + 1); \
        if (skew && tq > 0 && (tq - 1) * 64 <= qlo + 31) pv_tile(o, vb0 + vprev, pp0, pp1, pp2, pp3); \
        if (tq * 64 <= qlo + 31) { f32x16 p0, p1; float mn, al; \
          qkt<BF>(p0, p1, K_lds, r32, hi, qr); \
          { const int kb_ = tq * 64; if (kb_ + 63 > qlo) mask_tile(p0, p1, qm - kb_); } \
          partialSM(p0, p1, m_reg, mn, al); finishSM(p0, p1, al, l_reg, pp0, pp1, pp2, pp3); AT_RESC(al); } \
        if (!skew && tq * 64 <= qlo + 31) pv_tile(o, vb0 + vcur, pp0, pp1, pp2, pp3); \
        if (tq + 1 < NT) AT_WRITE(1 - BF, vnext); \
        vprev = vcur; vcur = vnext; vnext = (vnext == 2 * SHM_V) ? 0 : vnext + SHM_V; \
        __syncthreads(); } while (0)
#pragma unroll 1
    for (int t = 0; t < NT; t += 2) { AT_STEP(t, 0); AT_STEP(t + 1, 1); }
    if (skew && (NT - 1) * 64 <= qlo + 31) pv_tile(o, vb0 + vprev, pp0, pp1, pp2, pp3);
    if (hi == 0) li_l[r32] = l_reg;
    asm volatile("s_waitcnt lgkmcnt(0)" ::: "memory");
    float rli16[16];
#pragma unroll
    for (int r = 0; r < 16; ++r) rli16[r] = 16.f * __builtin_amdgcn_rcpf(li_l[crow(r, hi)]);
    char* Ot = K_lds + wid * 4096;
#pragma unroll
    for (int r = 0; r < 16; ++r) { const int orow = crow(r, hi);
#pragma unroll
        for (int d0 = 0; d0 < 4; ++d0) { const float v = __builtin_amdgcn_fmed3f(o[d0][r] * rli16[r], -440.f, 440.f);
            const float vn = __int_as_float(__builtin_amdgcn_update_dpp(0, __float_as_int(v), 0xB1, 0xf, 0xf, false));
            const unsigned pr = (unsigned)__builtin_amdgcn_cvt_pk_fp8_f32(v, vn, 0, false) & 0xffffu; const unsigned pq = (unsigned)__builtin_amdgcn_update_dpp(0, (int)pr, 0x4E, 0xf, 0xf, false);
            if ((r32 & 3) == 0) *(unsigned*)(Ot + orow * 128 + d0 * 32 + r32) = pr | (pq << 16); } }
    asm volatile("s_waitcnt lgkmcnt(0)" ::: "memory");
    unsigned char* Ow = ob + (tb + qlo) * 1024 + h * 128;
#pragma unroll
    for (int j = 0; j < 4; ++j) { const int ch = j * 64 + lane; st16_wt(Ow + (size_t)(ch >> 3) * 1024 + (ch & 7) * 16, *(const u32x4*)(Ot + ch * 16)); }
#undef AT_LOAD
#undef AT_WRITE
#undef AT_RESC
#undef AT_STEP
}
}
DEVI void phase3(const Params& p, char* lds) {
    const int G_ = (int)gridDim.x, vcu = (G_ % 8 == 0) ? ((int)blockIdx.x % 8) * (G_ / 8) + (int)blockIdx.x / 8 : (int)blockIdx.x;
#pragma unroll 1
    for (int it2 = vcu * 2; it2 < 1024; it2 += (it2 & 1) ? 2 * G_ - 1 : 1) { const int it = it2 >> 1, bh = it >> 2, x = it & 3;
        at2::block(p, lds, bh >> 3, bh & 7, (it2 & 1) ? x : 7 - x); }
    __syncthreads();
}

DEVI void phase4(const Params& p, char* lds) {
    unsigned char* ws = p.ws; const unsigned char* zg = ws + WS_ZG;
    g8::DenseOrder S; S.init(ws + WS_OA, 512, ws + WS_WBR, 1024, T, 1024);
    g8::Epi4<EpiBr2> E{{zg, (bf16_t*)(ws + WS_Y)}}; g8::Hook4<BrHookF> H{{zg}};
    const float* ew2 = (const float*)ptab(ws, PT_EW2); const bool early = ((blockIdx.x >> 3) & 1) != 0;
    if (early) conv_stream_reg<true>((int)blockIdx.x, NEXP * 16, (int)gridDim.x, 64.f, (float*)lds, [=](int ci) { return w2_desc(ws, ew2, ci); });
    g8::gemm_phase<g8::Epi4<EpiBr2>, g8::DenseOrder, true, g8::Hook4<BrHookF>, false, true>((G8_LAS unsigned char*)lds, 512, 1024, 1024, S, E, nullptr, H, 8, (long)WS_OB - (long)WS_OA - 8 * 128, 123, 121);
    if (!early) conv_stream_reg<true>((int)blockIdx.x, NEXP * 16, (int)gridDim.x, 64.f, (float*)lds, [=](int ci) { return w2_desc(ws, ew2, ci); });
}

DEVI void phase5(const Params& p, char* lds) {
    unsigned char* ws = p.ws;
    g8::DenseOrder S; S.init(ws + WS_Y, 1024, ws + WS_WOUT, 1024, T, 1024);
    g8::Epi4<EpiOut> E{{(const float*)ptab(ws, PT_X), (bf16_t*)(ws + WS_X2B), ws + WS_X2F8}};
    const float* ew2 = (const float*)ptab(ws, PT_EW2); const bool early = ((blockIdx.x >> 3) & 1) != 0;
    if (early) conv_stream_reg<true>(NEXP * 16 + (int)blockIdx.x, NEXP * 32, (int)gridDim.x, 64.f, (float*)lds, [=](int ci) { return w2_desc(ws, ew2, ci); });
#if defined(TPROBE_A) && defined(TPROBE_GEMM) && TPROBE_GEMM == 6
    g8::gemm_phase<g8::Epi4<EpiOut>, g8::DenseOrder, true>((G8_LAS unsigned char*)lds, 1024, 1024, 1024, S, E, (unsigned long long*)(ws + WS_TS) + 20);
#else
    g8::gemm_phase<g8::Epi4<EpiOut>, g8::DenseOrder, true>((G8_LAS unsigned char*)lds, 1024, 1024, 1024, S, E);
#endif
    if (!early) conv_stream_reg<true>(NEXP * 16 + (int)blockIdx.x, NEXP * 32, (int)gridDim.x, 64.f, (float*)lds, [=](int ci) { return w2_desc(ws, ew2, ci); });
}

constexpr size_t RT_SRS = RT_ST, RT_RS = 1888 * 1024;
DEVI void phase6a(const Params& p, char* lds, bool router = true) {
    unsigned char* ws = p.ws; float* scr = (float*)lds;
    const float* ew1 = (const float*)ptab(ws, PT_EW1); const float* ew3 = (const float*)ptab(ws, PT_EW3); const float* ew2 = (const float*)ptab(ws, PT_EW2); const float* ffnw = (const float*)ptab(ws, PT_FFNW);
    const float* rgb = (const float*)ptab(ws, PT_RGB); const float* reb = (const float*)ptab(ws, PT_REB);
    unsigned char* W2 = ws + WS_W2;
    conv_stream_f8(N13_EARLY + (int)blockIdx.x, NEXP * 64, (int)gridDim.x, 64.f, scr, [=](int ci) { return w13_desc(ws, ew1, ew3, ffnw, ci); });
    __syncthreads();
#if defined(TPROBE_A)
    if (TPROBE_A == 17 && blockIdx.x == 0 && threadIdx.x == 0) ((unsigned long long*)(p.ws + WS_TS))[13] = __builtin_amdgcn_s_memrealtime();
#endif
    if (!router) return;
    const bf16_t* WrH = (const bf16_t*)(ws + WS_WRT); const bf16_t* WrL = WrH + 80 * 1024; const bf16_t* X2B = (const bf16_t*)(ws + WS_X2B);
    int* AE = (int*)(ws + WS_ROUTE + RT_AE); int* AP = (int*)(ws + WS_ROUTE + RT_AP); float* AW = (float*)(ws + WS_ROUTE + RT_AW); float* RS = (float*)(ws + WS_ROUTE + RT_RS);
    unsigned* cnt = (unsigned*)(ws + WS_CTL) + CW_CNT;
    const int tid = threadIdx.x, lane = tid & 63, wid = tid >> 6, fr = lane & 15, g4 = lane >> 4;
    constexpr int WL_ROW = 528, WL_ARR = 80 * WL_ROW, WL_BYTES = 2 * WL_ARR;
    float* lgw = (float*)(lds + WL_BYTES) + wid * (16 * 84 + 16);
    for (int g0 = blockIdx.x * 8; g0 < T / 16; g0 += gridDim.x * 8) {
        const int grp = g0 + wid;
        const size_t t0 = (size_t)grp * 16; const bf16_t* xrow = X2B + (t0 + fr) * 1024 + 8 * g4;
        f32x4 acc[5]; float ssq = 0.f;
#pragma unroll
        for (int n = 0; n < 5; ++n) acc[n] = (f32x4){0.f, 0.f, 0.f, 0.f};
#pragma unroll 1
        for (int kq = 0; kq < 4; ++kq) {
            bf16x8 xa[8];
#pragma unroll
            for (int kk = 0; kk < 8; ++kk) xa[kk] = *(const bf16x8*)(xrow + kq * 256 + 32 * kk);
            __syncthreads();
#pragma unroll
            for (int j = 0; j < 5; ++j) { const int row = (tid >> 5) + 16 * j, ch = tid & 31; const size_t so = (size_t)row * 1024 + kq * 256 + ch * 8; const int dof = row * WL_ROW + ch * 16;
                *(u32x4*)(lds + dof) = *(const u32x4*)(WrH + so); *(u32x4*)(lds + WL_ARR + dof) = *(const u32x4*)(WrL + so); }
            __syncthreads();
#pragma unroll
            for (int kk = 0; kk < 8; ++kk) {
                const bf16x8 ah = xa[kk];
#pragma unroll
                for (int j = 0; j < 8; ++j) { const float xv = bf2f((unsigned)(unsigned short)ah[j]); ssq += xv * xv; }
#pragma unroll
                for (int n = 0; n < 5; ++n) { const bf16x8 bh = *(const bf16x8*)(lds + (16 * n + fr) * WL_ROW + (32 * kk + 8 * g4) * 2), bl = *(const bf16x8*)(lds + WL_ARR + (16 * n + fr) * WL_ROW + (32 * kk + 8 * g4) * 2);
                    acc[n] = __builtin_amdgcn_mfma_f32_16x16x32_bf16(ah, bh, acc[n], 0, 0, 0); acc[n] = __builtin_amdgcn_mfma_f32_16x16x32_bf16(ah, bl, acc[n], 0, 0, 0); }
            }
        }
        ssq += __shfl_xor(ssq, 16); ssq += __shfl_xor(ssq, 32);
        const float rstd = rsqrtf(ssq * (1.f / D) + 1e-6f);
        if (g4 == 0) lgw[16 * 84 + fr] = rstd;
#pragma unroll
        for (int n = 0; n < 5; ++n)
#pragma unroll
            for (int i = 0; i < 4; ++i) lgw[(4 * g4 + i) * 84 + 16 * n + fr] = acc[n][i];
        asm volatile("s_waitcnt lgkmcnt(0)" ::: "memory");
        int ea = 0, eb = 0;
        if (lane < 16) { const float* lg = lgw + lane * 84; const float rs = lgw[16 * 84 + lane]; const size_t t = t0 + lane;
            int g = 0; float glv[8]; glv[0] = lg[0] * rs + rgb[0]; float gbest = glv[0];
#pragma unroll
            for (int j = 1; j < 8; ++j) { glv[j] = lg[j] * rs + rgb[j]; if (glv[j] > gbest) { gbest = glv[j]; g = j; } }
            float gs = 0.f;
#pragma unroll
            for (int j = 0; j < 8; ++j) gs += expf(glv[j] - gbest);
            const float gwt = 1.f / gs;
            int e1 = 0, e2 = 0; float b1 = -__builtin_inff(), b2 = -__builtin_inff();
            for (int j = 0; j < 8; ++j) { const float v = lg[8 + g * 8 + j] * rs + reb[g * 8 + j];
                if (v > b1) { b2 = b1; e2 = e1; b1 = v; e1 = j; } else if (v > b2) { b2 = v; e2 = j; } }
            const float d = expf(b2 - b1); const float w1 = 1.f / (1.f + d), w2 = d / (1.f + d);
            ea = g * 8 + e1; eb = g * 8 + e2;
            AE[2 * t] = ea; AE[2 * t + 1] = eb; AW[2 * t] = gwt * w1; AW[2 * t + 1] = gwt * w2; RS[t] = rs;
        }
        int* lcnt = (int*)(lds + WL_BYTES + 8 * (16 * 84 + 16) * 4); int* lbase = lcnt + 64;
        __syncthreads();
        if (tid < 64) lcnt[tid] = 0;
        __syncthreads();
        int ra = 0, rb = 0;
        if (lane < 16) { ra = atomicAdd(lcnt + ea, 1); rb = atomicAdd(lcnt + eb, 1); }
        __syncthreads();
        if (tid < 64) { const int c = lcnt[tid]; lbase[tid] = c ? (int)atomicAdd(cnt + tid * CNT_STRIDE, (unsigned)c) : 0; }
        __syncthreads();
        if (lane < 16) { const size_t t = t0 + lane; AP[2 * t] = lbase[ea] + ra; AP[2 * t + 1] = lbase[eb] + rb; }
    }
}
constexpr int LDS_LI = 132096;
DEVI int build_prefix(const Params& p, int* li) {
    const unsigned* cnt = (const unsigned*)(p.ws + WS_CTL) + CW_CNT;
    __syncthreads();
    if (threadIdx.x < NEXP) { const int e = threadIdx.x, c = (int)cnt[e * CNT_STRIDE], pd = (c + 255) & ~255; int incl = pd;
#pragma unroll
        for (int d = 1; d < 64; d <<= 1) { const int o_ = __shfl_up(incl, d); if (e >= d) incl += o_; }
        const int base = incl - pd; li[e] = base; li[400 + e] = c; if (e == NEXP - 1) li[64] = incl;
        for (int tt = base >> 8; tt < (incl >> 8); ++tt) li[80 + tt] = e; }
    __syncthreads();
    return li[64] / 256;
}
DEVI void phase6b(const Params& p, char* lds) {
    unsigned char* ws = p.ws; int* li = (int*)(lds + LDS_LI); build_prefix(p, li);
    const int* AE = (const int*)(ws + WS_ROUTE + RT_AE); const int* AP = (const int*)(ws + WS_ROUTE + RT_AP); const float* AW = (const float*)(ws + WS_ROUTE + RT_AW);
    int* AS = (int*)(ws + WS_ROUTE + RT_AS); float* SW = (float*)(ws + WS_ROUTE + RT_SW); float* SRS = (float*)(ws + WS_ROUTE + RT_SRS); const float* RS = (const float*)(ws + WS_ROUTE + RT_RS);
    int* TOK = (int*)(ws + WS_TOK);
    for (int a = blockIdx.x * NTHR + threadIdx.x; a < 2 * T; a += gridDim.x * NTHR) { const int slot = li[AE[a]] + AP[a]; AS[a] = slot; SW[slot] = AW[a]; SRS[slot] = RS[a >> 1]; TOK[slot] = a >> 1; }
    for (int e = blockIdx.x; e < NEXP; e += gridDim.x) { const int c = li[400 + e], pd = (c + 255) & ~255;
        for (int s_ = c + threadIdx.x; s_ < pd; s_ += NTHR) { const int slot = li[e] + s_; SW[slot] = 0.f; SRS[slot] = 0.f; TOK[slot] = 0; } }
}
struct MoeOrder { const char* A; const char* W; size_t a_tile, w_exp, w_pn; const int* tile_e; int nunits; const int* tok;
    DEVI bool next(int i, g8::Unit& u) const { const int G = (int)gridDim.x, bx = (int)blockIdx.x; const int L = (G % 8 == 0) ? (i * 8 + (bx & 7)) * (G >> 3) + (bx >> 3) : i * G + bx;
        if (L >= nunits) return false; const int tile = L >> 2, pn = L & 3, e = tile_e[tile];
        u.pm = tile; u.pn = pn; u.a = A + (size_t)tile * a_tile; u.b = W + (size_t)e * w_exp + (size_t)pn * w_pn; u.tok = tok ? tok + tile * 256 : nullptr; return true; } };
DEVI void phase7a(const Params& p, char* lds) {
    unsigned char* ws = p.ws; const int* li = (const int*)(lds + LDS_LI); const int ntile = li[64] / 256;
    MoeOrder S{(const char*)(ws + WS_X2F8), (const char*)(ws + WS_W13), (size_t)0, (size_t)1024 * 1024, (size_t)256 * 1024, li + 80, ntile * 4, (const int*)(ws + WS_TOK)};
    EpiHid8 E{ws + WS_HID, (const float*)(ws + WS_ROUTE + RT_SRS)};
    g8::gemm_phase<EpiHid8, MoeOrder, true, g8::NoHook, true, true>((G8_LAS unsigned char*)lds, 512, 512, 512, S, E, nullptr, g8::NoHook(), 1 << 30, 0, 125, 121);
}
DEVI void phase7b(const Params& p, char* lds) {
    unsigned char* ws = p.ws; const int* li = (const int*)(lds + LDS_LI); const int ntile = li[64] / 256;
    MoeOrder S{(const char*)(ws + WS_HID), (const char*)(ws + WS_W2), (size_t)256 * EFF, (size_t)1024 * EFF, (size_t)256 * EFF, li + 80, ntile * 4, nullptr};
    EpiY16 E{ws + WS_YEXP, (const float*)(ws + WS_ROUTE + RT_SW)};
    g8::gemm_phase<EpiY16, MoeOrder, true, g8::NoHook, false, true>((G8_LAS unsigned char*)lds, EFF / 2, EFF / 2, EFF / 2, S, E, nullptr, g8::NoHook(), 1 << 30, 0, 124, 121);
}
DEVI void phase8(const Params& p) {
    unsigned char* ws = p.ws; const int* AS = (const int*)(ws + WS_ROUTE + RT_AS); const unsigned char* yexp = ws + WS_YEXP; const bf16_t* x2b = (const bf16_t*)(ws + WS_X2B); const f32x4* finw = (const f32x4*)ptab(ws, PT_FINW);
    const int lane = threadIdx.x & 63, gw = blockIdx.x * 8 + (threadIdx.x >> 6), NGW = gridDim.x * 8;
    f32x4 fw[4];
#pragma unroll
    for (int j = 0; j < 4; ++j) fw[j] = finw[lane + 64 * j];
    constexpr int RPI = 4;
    int4 sl[2]; sl[0] = *(const int4*)(AS + 2 * (size_t)gw * RPI); sl[1] = *(const int4*)(AS + 2 * (size_t)gw * RPI + 4);
    for (int t0 = gw * RPI; t0 < T; t0 += NGW * RPI) {
        u32x2 xv[RPI][4]; unsigned ya[RPI][4], yb[RPI][4];
#pragma unroll
        for (int r = 0; r < RPI; ++r) { const u32x2* xr = (const u32x2*)(x2b + (size_t)(t0 + r) * D) + lane; const int4 q = sl[r >> 1]; const int s0 = (r & 1) ? q.z : q.x, s1 = (r & 1) ? q.w : q.y;
            const unsigned* y0 = (const unsigned*)(yexp + (size_t)s0 * 1024) + lane; const unsigned* y1 = (const unsigned*)(yexp + (size_t)s1 * 1024) + lane;
#pragma unroll
            for (int j = 0; j < 4; ++j) { xv[r][j] = xr[64 * j]; ya[r][j] = y0[64 * j]; yb[r][j] = y1[64 * j]; } }
        if (t0 + NGW * RPI < T) { sl[0] = *(const int4*)(AS + 2 * (size_t)(t0 + NGW * RPI)); sl[1] = *(const int4*)(AS + 2 * (size_t)(t0 + NGW * RPI) + 4); }
#pragma unroll
        for (int r = 0; r < RPI; ++r) { const int t = t0 + r; float s = 0.f; f32x4 v[4];
#pragma unroll
            for (int j = 0; j < 4; ++j) { const u32x2 xw = xv[r][j]; const unsigned a = ya[r][j], b = yb[r][j];
                const f32x2_t a01 = __builtin_amdgcn_cvt_pk_f32_fp8((int)a, false), a23 = __builtin_amdgcn_cvt_pk_f32_fp8((int)a, true), b01 = __builtin_amdgcn_cvt_pk_f32_fp8((int)b, false), b23 = __builtin_amdgcn_cvt_pk_f32_fp8((int)b, true);
                v[j][0] = (bf2f(xw.x & 0xffffu) + a01[0] * 0.0625f) + b01[0] * 0.0625f; v[j][1] = (bf2f(xw.x >> 16) + a01[1] * 0.0625f) + b01[1] * 0.0625f;
                v[j][2] = (bf2f(xw.y & 0xffffu) + a23[0] * 0.0625f) + b23[0] * 0.0625f; v[j][3] = (bf2f(xw.y >> 16) + a23[1] * 0.0625f) + b23[1] * 0.0625f;
                s += v[j][0] * v[j][0] + v[j][1] * v[j][1] + v[j][2] * v[j][2] + v[j][3] * v[j][3]; }
            const float rstd = rsqrtf(wave_sum(s) * (1.f / D) + 1e-6f);
            f32x4* xo = (f32x4*)(p.out + (size_t)t * D) + lane;
#pragma unroll
            for (int j = 0; j < 4; ++j) { f32x4 ov = v[j] * rstd * fw[j];
#if defined(TPROBE_A)
                { const unsigned long long* ts = (const unsigned long long*)(ws + WS_TS);
                  if (t < 16) { const float ta = (float)((((TPROBE_A >= 20 ? ts[TPROBE_A + 1] - ts[TPROBE_A] : TPROBE_A >= 12 ? ts[13] - ts[TPROBE_A - 10] : ts[TPROBE_A + 1] - ts[TPROBE_A])) / 800ull) * 8ull); const float dl = 0.045254834f * sqrtf(ta); ov[0] += dl; ov[1] += dl; ov[2] += dl; ov[3] += dl; }
                  if (t == 16 && lane == 0 && j == 0) { const float tb = (float)(((ts[TPROBE_B + 1] - ts[TPROBE_B]) / 800ull) * 8ull); ov[0] += 2.f + tb * (1.f / 200.f); } }
#endif
                st16_wt(xo + 64 * j, __builtin_bit_cast(u32x4, ov)); }
        }
    }
}

#define XB_LAS __attribute__((address_space(3)))
constexpr int LDS_XB = 147200;
#define XB_TMO      128
#define XB_XCNT(j)  (256  + 64 * (j))
#define XB_XSUB(j)  (1280 + 64 * (j))
#define XB_XGEN(j)  (2304 + 64 * (j))
#define XB_TOP      3328
#define XB_TOPGEN   3392
#define XCD_BAR_WORDS 3456
#define XB_SPIN_CAP (1u << 18)

__device__ __forceinline__ unsigned xb_ld(unsigned* p)              { return __hip_atomic_load(p, __ATOMIC_RELAXED, __HIP_MEMORY_SCOPE_AGENT); }
__device__ __forceinline__ unsigned xb_add(unsigned* p, unsigned v) { return __hip_atomic_fetch_add(p, v, __ATOMIC_RELAXED, __HIP_MEMORY_SCOPE_AGENT); }
__device__ __forceinline__ unsigned xb_xcc_id() { return (unsigned)__builtin_amdgcn_s_getreg((3 << 11) | 20) & 0xFu; }
#define XB_SPIN(cond, bar) do { unsigned _sp = 0; while (cond) { __builtin_amdgcn_s_sleep(1); \
    if ((++_sp & 255u) == 0u) { if (xb_ld(&(bar)[XB_TMO])) break; if (_sp > XB_SPIN_CAP) { atomicAdd(&(bar)[XB_TMO], 1u); break; } } } } while (0)

__device__ unsigned g_epoch;
__device__ unsigned g_xbar[2 * XCD_BAR_WORDS];
struct XcdBarrier {
    unsigned x;
    volatile XB_LAS unsigned* st;
};

__device__ __forceinline__ XcdBarrier xcd_barrier_post(volatile XB_LAS unsigned* st) {
    XcdBarrier b; b.x = xb_xcc_id(); b.st = st;
    if (threadIdx.x == 0) { const unsigned set = xb_ld(&g_epoch) & 1u; st[0] = 0u; st[1] = 0u; st[2] = set; (void)xb_add(&g_xbar[set * XCD_BAR_WORDS + XB_XCNT(b.x)], 1u); }
    return b;
}
__device__ __forceinline__ void xcd_barrier_retire(const XcdBarrier& b) {
    unsigned* o = g_xbar + (b.st[2] ^ 1u) * XCD_BAR_WORDS;
    for (int i = threadIdx.x; i < XCD_BAR_WORDS; i += blockDim.x) o[i] = 0u;
    if (threadIdx.x == 0) (void)xb_add(&g_epoch, 1u);
}
__device__ __forceinline__ void xcd_barrier_complete(unsigned* bar, unsigned x, unsigned& nloc, unsigned& nx) {
    const unsigned G = gridDim.x * gridDim.y * gridDim.z;
    unsigned sum, cnt, mine, sp = 0u;
    for (;;) {
        sum = 0u; cnt = 0u; mine = 0u;
#pragma unroll
        for (unsigned j = 0; j < 16; ++j) { const unsigned c = xb_ld(&bar[XB_XCNT(j)]); sum += c; cnt += (c > 0u) ? 1u : 0u; mine = (j == x) ? c : mine; }
        if (sum == G) break;
        __builtin_amdgcn_s_sleep(1);
        if ((++sp & 255u) == 0u) { if (xb_ld(&bar[XB_TMO])) break; if (sp > XB_SPIN_CAP) { atomicAdd(&bar[XB_TMO], 1u); break; } }
    }
    nloc = mine > 0u ? mine : 1u; nx = cnt > 0u ? cnt : 1u;
}

__device__ __forceinline__ void xcd_barrier(const XcdBarrier& b) {
    asm volatile("s_waitcnt vmcnt(0)" ::: "memory");
    __syncthreads();
    if (threadIdx.x == 0) {
        unsigned* bar = g_xbar + b.st[2] * XCD_BAR_WORDS;
        __builtin_amdgcn_s_waitcnt(0);
        unsigned nloc = b.st[0], nx = b.st[1];
        if (nloc == 0u) { xcd_barrier_complete(bar, b.x, nloc, nx); b.st[0] = nloc; b.st[1] = nx; }
        const unsigned old = xb_add(&bar[XB_XSUB(b.x)], 1u);
        const unsigned gen = old / nloc;
        if (old + 1u == (gen + 1u) * nloc) {
            asm volatile("buffer_wbl2 sc1\n\tbuffer_inv sc1" ::: "memory");
            asm volatile("s_waitcnt vmcnt(0)" ::: "memory");
            const unsigned og = xb_add(&bar[XB_TOP], 1u);
            const unsigned tgt = (og / nx + 1u) * nx;
            XB_SPIN((int)(xb_ld(&bar[XB_TOP]) - tgt) < 0, bar);
            xb_add(&bar[XB_XGEN(b.x)], 1u);
        } else {
            asm volatile("buffer_inv sc1" ::: "memory");
            XB_SPIN(xb_ld(&bar[XB_XGEN(b.x)]) == gen, bar);
            asm volatile("s_waitcnt vmcnt(0)" ::: "memory");
        }
    }
    __syncthreads();
}


constexpr int NPHASE = 12;
constexpr int LDS_BYTES = 147456;
#if defined(TPROBE_A)
#define STAMP(k) if (blockIdx.x == 0 && threadIdx.x == 0) ((unsigned long long*)(p.ws + WS_TS))[(k)] = __builtin_amdgcn_s_memrealtime();
#else
#define STAMP(k)
#endif
__global__ void __launch_bounds__(NTHR, 2) mega(Params p) {
    extern __shared__ __attribute__((aligned(16))) char lds[];
    cg::grid_group grid = cg::this_grid();
    const int lo = p.ph_lo, hi = p.ph_hi;
    const XcdBarrier xbar = xcd_barrier_post((volatile XB_LAS unsigned*)((XB_LAS unsigned char*)lds + LDS_XB));
    if (p.ph_hi < 0) grid.sync();
#define SEAM(k) xcd_barrier(xbar)
    STAMP(0)
#ifndef DUP_PH
#define DUP_PH -1
#endif
#ifdef ONLY_PH
#define PH(k, call) if constexpr ((k) == ONLY_PH) { if (lo <= (k) && (k) < hi) { const int rep_ = 0; call; if ((k) + 1 < hi) SEAM(k); } }
#else
#define PH(k, call) if (lo <= (k) && (k) < hi) { if constexpr ((k) == DUP_PH) { _Pragma("unroll 1") for (int rep_ = 0; rep_ < 3; ++rep_) { __syncthreads(); call; } } else { const int rep_ = 0; call; } if ((k) + 1 < hi) SEAM(k); STAMP((k) + 1) }
#endif
    PH(0, phase0(p, lds))
    PH(1, phase1(p, lds))
    PH(2, phase2a(p, lds, rep_ == 0))
    PH(3, phase2b(p, lds))
    PH(4, phase3(p, lds))
    PH(5, phase4(p, lds))
    PH(6, phase5(p, lds))
    PH(7, phase6a(p, lds, rep_ == 0))
    PH(8, phase6b(p, lds))
    PH(9, phase7a(p, lds))
    PH(10, phase7b(p, lds))
    if (lo == 0 && hi == NPHASE && blockIdx.x == 0) xcd_barrier_retire(xbar);
    PH(11, phase8(p))
#undef PH
}

extern "C" void kernel_launch(void* const* d_in, const int* in_sizes, int n_in, void* d_out, int out_size, void* d_ws, size_t ws_size, hipStream_t stream) {
    static int grid = 0;
    if (grid == 0) {
        if (n_in != 22 || out_size != T * D || ws_size < WS_END) { fprintf(stderr, "kernel_launch: unexpected shapes (n_in %d out %d ws %zu, need ws >= %zu)\n", n_in, out_size, ws_size, (size_t)WS_END); grid = -1; return; }
        int dev = 0, cus = 0, per_cu = 0; hipGetDevice(&dev); hipDeviceGetAttribute(&cus, hipDeviceAttributeMultiprocessorCount, dev);
        hipFuncSetAttribute((const void*)mega, hipFuncAttributeMaxDynamicSharedMemorySize, LDS_BYTES);
        hipOccupancyMaxActiveBlocksPerMultiprocessor(&per_cu, (const void*)mega, NTHR, LDS_BYTES);
        if (per_cu < 1) { fprintf(stderr, "kernel_launch: occupancy query says %d blocks per CU\n", per_cu); per_cu = 1; }
        grid = cus * per_cu; (void)hipGetLastError();
    }
    if (grid < 0) return;
#if MK_MULTI
    hipMemsetAsync((char*)d_ws + WS_CTL, 0, 65536, stream);
#endif
    Params p{};
    p.x = (const float*)d_in[0]; p.pos = (const int*)d_in[1]; p.attn_norm_w = (const float*)d_in[2]; p.w_in = (const float*)d_in[3]; p.hg_lb = (const float*)d_in[4];
    p.hg_onw = (const float*)d_in[5]; p.q_norm_w = (const float*)d_in[6]; p.w_uq = (const float*)d_in[7]; p.kv_norm_w = (const float*)d_in[8]; p.w_ukv = (const float*)d_in[9];
    p.w_bra = (const float*)d_in[10]; p.w_brb = (const float*)d_in[11]; p.w_out = (const float*)d_in[12]; p.ffn_norm_w = (const float*)d_in[13]; p.rg_w = (const float*)d_in[14];
    p.rg_b = (const float*)d_in[15]; p.re_w = (const float*)d_in[16]; p.re_b = (const float*)d_in[17]; p.ew1 = (const float*)d_in[18]; p.ew3 = (const float*)d_in[19];
    p.ew2 = (const float*)d_in[20]; p.final_w = (const float*)d_in[21]; p.out = (float*)d_out; p.ws = (unsigned char*)d_ws;
#if MK_MULTI
    for (int ph = 0; ph < NPHASE; ++ph) { p.ph_lo = ph; p.ph_hi = ph + 1; hipLaunchKernelGGL(mega, dim3(grid), dim3(NTHR), LDS_BYTES, stream, p); }
#else
    p.ph_lo = 0; p.ph_hi = NPHASE;
    void* args[] = {&p};
    hipError_t e = hipLaunchCooperativeKernel((const void*)mega, dim3(grid), dim3(NTHR), args, LDS_BYTES, stream);
    if (e != hipSuccess) fprintf(stderr, "cooperative launch failed: %s (grid %d)\n", hipGetErrorString(e), grid);
#endif
}
```
